# Optimizing an MI355X kernel written in HIP

```python
import math
import jax, jax.numpy as jnp
from jax import lax
import numpy as np

D_MODEL = 1024
BATCH = 4
SEQ = 8192
DEPTH = 2

N_MIXERS = 2
RET_HEADS = 4
RET_QK_DIM = D_MODEL // RET_HEADS
RET_V_DIM = 2 * D_MODEL // RET_HEADS
RET_CHUNK = 128
RET_IN = 2 * RET_HEADS * RET_QK_DIM + 2 * RET_HEADS * RET_V_DIM
SWA_Q_HEADS = 16
SWA_KV_HEADS = 2
SWA_GROUP = SWA_Q_HEADS // SWA_KV_HEADS
SWA_HEAD_DIM = 64
WINDOW = 128
SWA_BLOCK = 128
SWA_IN = (SWA_Q_HEADS + 2 * SWA_KV_HEADS) * SWA_HEAD_DIM
N_EXPERTS = 32
TOP_K = 4
D_FF = D_MODEL
SWIGLU_ALPHA = 1.702
SWIGLU_LIMIT = 7.0
MOE_BLOCK = 128
LN_EPS = 1e-5
GN_EPS = 1e-6
DEEPNORM_ALPHA = (2 * DEPTH) ** 0.25
DEEPNORM_BETA = (8 * DEPTH) ** -0.25
N_RET_LAYERS = (DEPTH + 1) // 2
N_SWA_LAYERS = DEPTH // 2

kernel_name = "retnet_swa_sink_moe_deepnorm_hybrid"


def layer_norm(x, g, b):
    xf = x.astype(jnp.float32)
    mu = jnp.mean(xf, axis=-1, keepdims=True)
    xc = xf - mu
    var = jnp.mean(xc * xc, axis=-1, keepdims=True)
    return (xc * lax.rsqrt(var + LN_EPS) * g.astype(jnp.float32) + b.astype(jnp.float32)).astype(x.dtype)


def retention(x, w_in, w_out):
    B, S, _ = x.shape
    H, dk, dv, C = RET_HEADS, RET_QK_DIM, RET_V_DIM, RET_CHUNK
    nc = S // C
    proj = x @ w_in
    q, k, v, g = jnp.split(proj, [H * dk, 2 * H * dk, 2 * H * dk + H * dv], axis=-1)

    def chunks(t, d):
        return t.astype(jnp.float32).reshape(B, nc, C, H, d).transpose(1, 0, 3, 2, 4)

    qc = chunks(q, dk)
    kc = chunks(k, dk) * (dk ** -0.5)
    vc = chunks(v, dv)
    log_g = jnp.log(1.0 - 2.0 ** (-5.0 - jnp.arange(H, dtype=jnp.float32)))
    pos = jnp.arange(C, dtype=jnp.float32)
    rel = pos[:, None] - pos[None, :]
    decay_mask = jnp.where(rel >= 0, jnp.exp(log_g[:, None, None] * jnp.maximum(rel, 0.0)), 0.0)
    q_decay = jnp.exp(log_g[:, None] * (pos + 1.0))[..., None]
    k_decay = jnp.exp(log_g[:, None] * (C - 1.0 - pos))[..., None]
    chunk_decay = jnp.exp(log_g * C)[:, None, None]

    def step(state, inp):
        qi, ki, vi = inp
        scores = jnp.einsum('bhik,bhjk->bhij', qi, ki) * decay_mask
        o = jnp.einsum('bhij,bhjv->bhiv', scores, vi) + jnp.einsum('bhik,bhkv->bhiv', qi * q_decay, state)
        state = state * chunk_decay + jnp.einsum('bhjk,bhjv->bhkv', ki * k_decay, vi)
        return state, o

    state0 = jnp.zeros((B, H, dk, dv), jnp.float32)
    _, o = lax.scan(step, state0, (qc, kc, vc))
    o = o.transpose(1, 0, 3, 2, 4).reshape(B, S, H, dv)
    mu = jnp.mean(o, axis=-1, keepdims=True)
    oc = o - mu
    var = jnp.mean(oc * oc, axis=-1, keepdims=True)
    o = (oc * lax.rsqrt(var + GN_EPS)).reshape(B, S, H * dv).astype(x.dtype)
    return (jax.nn.silu(g) * o) @ w_out


def sliding_window_attention(x, w_in, b_in, w_out, b_out, sinks):
    B, S, _ = x.shape
    Hq, Hkv, G, hd, C = SWA_Q_HEADS, SWA_KV_HEADS, SWA_GROUP, SWA_HEAD_DIM, SWA_BLOCK
    nb = S // C
    proj = x @ w_in + b_in
    q, k, v = jnp.split(proj, [Hq * hd, Hq * hd + Hkv * hd], axis=-1)
    q = q.reshape(B, nb, C, Hkv, G, hd)
    k = k.reshape(B, nb, C, Hkv, hd)
    v = v.reshape(B, nb, C, Hkv, hd)

    def with_prev(t):
        prev = jnp.concatenate([jnp.zeros_like(t[:, :1]), t[:, :-1]], axis=1)
        return jnp.concatenate([prev, t], axis=2)

    kb, vb = with_prev(k), with_prev(v)
    scores = jnp.einsum('bnqhgd,bnkhd->bnhgqk', q, kb).astype(jnp.float32) * (hd ** -0.5)
    qi = jnp.arange(C)[:, None]
    kj = jnp.arange(2 * C)[None, :]
    dist = qi + C - kj
    blk = jnp.arange(nb)[:, None, None]
    valid = (dist >= 0) & (dist < WINDOW) & (blk * C + kj - C >= 0)
    slopes = (2.0 ** (-8.0 * jnp.arange(1, Hq + 1, dtype=jnp.float32) / Hq)).reshape(Hkv, G)
    scores = scores - slopes[:, :, None, None] * dist.astype(jnp.float32)
    scores = jnp.where(valid[None, :, None, None], scores, -jnp.inf)
    sink = jnp.broadcast_to(sinks.astype(jnp.float32).reshape(Hkv, G, 1, 1), scores.shape[:-1] + (1,))
    probs = jax.nn.softmax(jnp.concatenate([scores, sink], axis=-1), axis=-1)[..., :-1]
    o = jnp.einsum('bnhgqk,bnkhd->bnqhgd', probs.astype(x.dtype), vb).reshape(B, S, Hq * hd)
    return o @ w_out + b_out


def moe(x, w_router, b_router, w1, b1, w2, b2):
    B, S, D = x.shape
    T = B * S
    xt = x.reshape(T, D)
    logits = (xt @ w_router + b_router).astype(jnp.float32)
    top_val, top_idx = lax.top_k(logits, TOP_K)
    gates = jax.nn.softmax(top_val, axis=-1).astype(x.dtype).reshape(-1)
    flat_e = top_idx.reshape(-1)
    flat_tok = jnp.arange(T * TOP_K, dtype=jnp.int32) // TOP_K
    order = jnp.argsort(flat_e)
    sorted_e = flat_e[order]
    counts = jnp.bincount(flat_e, length=N_EXPERTS)
    padded = (counts + MOE_BLOCK - 1) // MOE_BLOCK * MOE_BLOCK
    start_sorted = jnp.cumsum(counts) - counts
    padded_end = jnp.cumsum(padded)
    start_padded = padded_end - padded
    dest = start_padded[sorted_e] + jnp.arange(T * TOP_K) - start_sorted[sorted_e]
    n_blocks = -(-(T * TOP_K) // MOE_BLOCK) + N_EXPERTS
    n_slots = n_blocks * MOE_BLOCK
    slot_tok = jnp.zeros((n_slots,), jnp.int32).at[dest].set(flat_tok[order])
    slot_gate = jnp.zeros((n_slots,), x.dtype).at[dest].set(gates[order])
    block_expert = jnp.minimum(
        jnp.searchsorted(padded_end, jnp.arange(n_blocks) * MOE_BLOCK, side='right'), N_EXPERTS - 1)
    x_blocks = xt[slot_tok].reshape(n_blocks, MOE_BLOCK, D)

    def expert_block(args):
        xb, e = args
        h = xb @ w1[e] + b1[e]
        glu = jnp.minimum(h[:, :D_FF], SWIGLU_LIMIT)
        lin = jnp.clip(h[:, D_FF:], -SWIGLU_LIMIT, SWIGLU_LIMIT)
        act = glu * jax.nn.sigmoid(SWIGLU_ALPHA * glu) * (lin + 1.0)
        return act @ w2[e] + b2[e]

    y = lax.map(expert_block, (x_blocks, block_expert)).reshape(n_slots, D)
    out = jnp.zeros_like(xt).at[slot_tok].add(y * slot_gate[:, None])
    return out.reshape(B, S, D)


def setup_inputs(seed: int = 0) -> dict:
    key = jax.random.key(seed)
    ks = jax.random.split(key, 20)
    f32 = jnp.float32
    beta = DEEPNORM_BETA
    x = jax.random.normal(ks[0], (BATCH, SEQ, D_MODEL), f32)
    ret_scale = jnp.concatenate([
        jnp.ones((2 * RET_HEADS * RET_QK_DIM,), f32),
        jnp.full((RET_HEADS * RET_V_DIM,), beta, f32),
        jnp.ones((RET_HEADS * RET_V_DIM,), f32)])
    w_ret_in = jax.random.normal(ks[1], (N_RET_LAYERS, D_MODEL, RET_IN), f32) * (D_MODEL ** -0.5) * ret_scale
    w_ret_out = jax.random.normal(ks[2], (N_RET_LAYERS, RET_HEADS * RET_V_DIM, D_MODEL), f32) * ((RET_HEADS * RET_V_DIM) ** -0.5) * beta
    swa_scale = jnp.concatenate([
        jnp.ones(((SWA_Q_HEADS + SWA_KV_HEADS) * SWA_HEAD_DIM,), f32),
        jnp.full((SWA_KV_HEADS * SWA_HEAD_DIM,), beta, f32)])
    w_swa_in = jax.random.normal(ks[3], (N_SWA_LAYERS, D_MODEL, SWA_IN), f32) * (D_MODEL ** -0.5) * swa_scale
    b_swa_in = 0.01 * jax.random.normal(ks[4], (N_SWA_LAYERS, SWA_IN), f32)
    w_swa_out = jax.random.normal(ks[5], (N_SWA_LAYERS, SWA_Q_HEADS * SWA_HEAD_DIM, D_MODEL), f32) * ((SWA_Q_HEADS * SWA_HEAD_DIM) ** -0.5) * beta
    b_swa_out = 0.01 * jax.random.normal(ks[6], (N_SWA_LAYERS, D_MODEL), f32)
    swa_sinks = 0.5 * jax.random.normal(ks[7], (N_SWA_LAYERS, SWA_Q_HEADS), f32)
    ln_mix_g = 1.0 + 0.05 * jax.random.normal(ks[8], (DEPTH, D_MODEL), f32)
    ln_mix_b = 0.01 * jax.random.normal(ks[9], (DEPTH, D_MODEL), f32)
    w_router = jax.random.normal(ks[10], (DEPTH, D_MODEL, N_EXPERTS), f32) * (D_MODEL ** -0.5)
    b_router = 0.01 * jax.random.normal(ks[11], (DEPTH, N_EXPERTS), f32)
    w_exp_in = jax.random.normal(ks[12], (DEPTH, N_EXPERTS, D_MODEL, 2 * D_FF), f32) * (D_MODEL ** -0.5)
    b_exp_in = 0.01 * jax.random.normal(ks[13], (DEPTH, N_EXPERTS, 2 * D_FF), f32)
    w_exp_out = jax.random.normal(ks[14], (DEPTH, N_EXPERTS, D_FF, D_MODEL), f32) * (D_FF ** -0.5) * beta
    b_exp_out = 0.01 * jax.random.normal(ks[15], (DEPTH, N_EXPERTS, D_MODEL), f32)
    ln_ffn_g = 1.0 + 0.05 * jax.random.normal(ks[16], (DEPTH, D_MODEL), f32)
    ln_ffn_b = 0.01 * jax.random.normal(ks[17], (DEPTH, D_MODEL), f32)
    return {"x": x, "w_ret_in": w_ret_in, "w_ret_out": w_ret_out,
            "w_swa_in": w_swa_in, "b_swa_in": b_swa_in, "w_swa_out": w_swa_out,
            "b_swa_out": b_swa_out, "swa_sinks": swa_sinks,
            "ln_mix_g": ln_mix_g, "ln_mix_b": ln_mix_b,
            "w_router": w_router, "b_router": b_router,
            "w_exp_in": w_exp_in, "b_exp_in": b_exp_in,
            "w_exp_out": w_exp_out, "b_exp_out": b_exp_out,
            "ln_ffn_g": ln_ffn_g, "ln_ffn_b": ln_ffn_b}


def reference(x, w_ret_in, w_ret_out, w_swa_in, b_swa_in, w_swa_out, b_swa_out, swa_sinks,
              ln_mix_g, ln_mix_b, w_router, b_router, w_exp_in, b_exp_in, w_exp_out, b_exp_out,
              ln_ffn_g, ln_ffn_b):
    for i in range(DEPTH):
        j = i // N_MIXERS
        if i % N_MIXERS == 0:
            m = retention(x, w_ret_in[j], w_ret_out[j])
        else:
            m = sliding_window_attention(x, w_swa_in[j], b_swa_in[j], w_swa_out[j], b_swa_out[j], swa_sinks[j])
        x = layer_norm(DEEPNORM_ALPHA * x + m, ln_mix_g[i], ln_mix_b[i])
        f = moe(x, w_router[i], b_router[i], w_exp_in[i], b_exp_in[i], w_exp_out[i], b_exp_out[i])
        x = layer_norm(DEEPNORM_ALPHA * x + f, ln_ffn_g[i], ln_ffn_b[i])
    return x
```

```cpp
#include <hip/hip_runtime.h>
#include <cstdio>
#include <cstdint>
#include <cmath>
namespace nv {
typedef float f32x16 __attribute__((ext_vector_type(16)));
constexpr int T = 32768, D = 1024, SEQ = 8192;
constexpr int NSLOT = 135168, NTILE = 1056;
constexpr float ALPHA = 1.4142135623730951f;

struct GemmArgs {
    const float* A; const int* rowidx; const float* B; const int* tile_expert; const float* bias; float* C;
    long b_estride, bias_estride; int lda, ldb, ldc, M, N, K, mode, pad;
};
__global__ __launch_bounds__(256) void k_gemm(GemmArgs g) {
    __shared__ float sA[128][17];
    __shared__ float sB[16][64];
    __shared__ float sB2[16][64];
    const int tid = threadIdx.x, lane = tid & 63, w = tid >> 6;
    const int n0 = blockIdx.x * 64, m0 = blockIdx.y * 128;
    const int e = g.tile_expert ? g.tile_expert[blockIdx.y] : 0;
    const float* B = g.B + (long)e * g.b_estride;
    const int ar = tid >> 2, ak = (tid & 3) * 4;
    const float* arow0 = g.A + (long)(g.rowidx ? g.rowidx[m0 + ar] : m0 + ar) * g.lda + ak;
    const float* arow1 = g.A + (long)(g.rowidx ? g.rowidx[m0 + ar + 64] : m0 + ar + 64) * g.lda + ak;
    const int bk = tid >> 4, bc = (tid & 15) * 4;
    f32x16 acc0 = {0}, acc1 = {0}, acc2 = {0}, acc3 = {0};
    for (int k0 = 0; k0 < g.K; k0 += 16) {
        const float4 a0 = *(const float4*)(arow0 + k0), a1 = *(const float4*)(arow1 + k0);
        const float4 b0 = *(const float4*)(B + (long)(k0 + bk) * g.ldb + n0 + bc);
        float4 b1 = b0;
        if (g.mode == 1) b1 = *(const float4*)(B + (long)(k0 + bk) * g.ldb + n0 + 1024 + bc);
        __syncthreads();
        sA[ar][ak] = a0.x; sA[ar][ak + 1] = a0.y; sA[ar][ak + 2] = a0.z; sA[ar][ak + 3] = a0.w;
        sA[ar + 64][ak] = a1.x; sA[ar + 64][ak + 1] = a1.y; sA[ar + 64][ak + 2] = a1.z; sA[ar + 64][ak + 3] = a1.w;
        *(float4*)&sB[bk][bc] = b0; *(float4*)&sB2[bk][bc] = b1;
        __syncthreads();
#pragma unroll
        for (int kk = 0; kk < 8; ++kk) {
            const float a = sA[w * 32 + (lane & 31)][2 * kk + (lane >> 5)];
            const float bA = sB[2 * kk + (lane >> 5)][lane & 31], bB = sB[2 * kk + (lane >> 5)][32 + (lane & 31)];
            acc0 = __builtin_amdgcn_mfma_f32_32x32x2f32(a, bA, acc0, 0, 0, 0);
            acc1 = __builtin_amdgcn_mfma_f32_32x32x2f32(a, bB, acc1, 0, 0, 0);
            if (g.mode == 1) {
                const float cA = sB2[2 * kk + (lane >> 5)][lane & 31], cB = sB2[2 * kk + (lane >> 5)][32 + (lane & 31)];
                acc2 = __builtin_amdgcn_mfma_f32_32x32x2f32(a, cA, acc2, 0, 0, 0);
                acc3 = __builtin_amdgcn_mfma_f32_32x32x2f32(a, cB, acc3, 0, 0, 0);
            }
        }
    }
    const float* bias = g.bias ? g.bias + (long)e * g.bias_estride : nullptr;
#pragma unroll
    for (int nt = 0; nt < 2; ++nt) {
        const int col = n0 + nt * 32 + (lane & 31);
        const float bv = bias ? bias[col] : 0.f, bv2 = (bias && g.mode == 1) ? bias[col + 1024] : 0.f;
#pragma unroll
        for (int r = 0; r < 16; ++r) {
            const int row = m0 + w * 32 + (r & 3) + 8 * (r >> 2) + 4 * (lane >> 5);
            float v = (nt ? acc1[r] : acc0[r]) + bv;
            if (g.mode == 1) {
                const float glu = fminf(v, 7.0f);
                const float lin = fminf(fmaxf((nt ? acc3[r] : acc2[r]) + bv2, -7.0f), 7.0f);
                v = glu * (1.0f / (1.0f + expf(-1.702f * glu))) * (lin + 1.0f);
            }
            g.C[(long)row * g.ldc + col] = v;
        }
    }
}

__device__ __forceinline__ float wsum(float v) {
#pragma unroll
    for (int o = 1; o < 64; o <<= 1) v += __shfl_xor(v, o);
    return v;
}
__device__ __forceinline__ float wmax(float v) {
#pragma unroll
    for (int o = 1; o < 64; o <<= 1) v = fmaxf(v, __shfl_xor(v, o));
    return v;
}

__global__ __launch_bounds__(1024) void k_ret(const float* proj, float* o) {
    __shared__ float sq[16][256], sk[16][256];
    const int tid = threadIdx.x, lane = tid & 63, w = tid >> 6;
    const int blk = blockIdx.x, cg = blk & 31, h = (blk >> 5) & 3, b = blk >> 7;
    const int c = cg * 16 + w;
    const float gamma = 1.0f - exp2f(-5.0f - (float)h);
    float s0 = 0.f, s1 = 0.f, s2 = 0.f, s3 = 0.f;
    for (int t0 = 0; t0 < SEQ; t0 += 16) {
        __syncthreads();
        {
            const int st = tid >> 6, kk = (tid & 63) * 4;
            const float* row = proj + (long)(b * SEQ + t0 + st) * 6144;
            *(float4*)&sq[st][kk] = *(const float4*)(row + h * 256 + kk);
            float4 kv = *(const float4*)(row + 1024 + h * 256 + kk);
            kv.x *= 0.0625f; kv.y *= 0.0625f; kv.z *= 0.0625f; kv.w *= 0.0625f;
            *(float4*)&sk[st][kk] = kv;
        }
        __syncthreads();
#pragma unroll 4
        for (int st = 0; st < 16; ++st) {
            const long tok = (long)(b * SEQ + t0 + st);
            const float v = proj[tok * 6144 + 2048 + h * 512 + c];
            s0 = gamma * s0 + sk[st][lane] * v;       s1 = gamma * s1 + sk[st][lane + 64] * v;
            s2 = gamma * s2 + sk[st][lane + 128] * v; s3 = gamma * s3 + sk[st][lane + 192] * v;
            float p = sq[st][lane] * s0 + sq[st][lane + 64] * s1 + sq[st][lane + 128] * s2 + sq[st][lane + 192] * s3;
            p = wsum(p);
            if (lane == 0) o[tok * 2048 + h * 512 + c] = p;
        }
    }
}
__global__ __launch_bounds__(256) void k_gn_gate(const float* proj, float* o) {
    const int gw = blockIdx.x * 4 + (threadIdx.x >> 6), lane = threadIdx.x & 63;
    const int t = gw >> 2, h = gw & 3;
    float* op = o + (long)t * 2048 + h * 512; const float* gp = proj + (long)t * 6144 + 4096 + h * 512;
    float v[8]; float s = 0.f;
#pragma unroll
    for (int i = 0; i < 8; ++i) { v[i] = op[lane + 64 * i]; s += v[i]; }
    const float mean = wsum(s) * (1.0f / 512.0f); float q = 0.f;
#pragma unroll
    for (int i = 0; i < 8; ++i) { v[i] -= mean; q += v[i] * v[i]; }
    const float rstd = 1.0f / sqrtf(wsum(q) * (1.0f / 512.0f) + 1e-6f);
#pragma unroll
    for (int i = 0; i < 8; ++i) { const float gg = gp[lane + 64 * i]; op[lane + 64 * i] = gg / (1.0f + expf(-gg)) * v[i] * rstd; }
}
__global__ __launch_bounds__(256) void k_ln(const float* xprev, const float* m, const int* inv, const float* slot_gate, const float* gam, const float* bet, float* xout) {
    const int t = blockIdx.x * 4 + (threadIdx.x >> 6), lane = threadIdx.x & 63;
    float v[16]; float s = 0.f;
#pragma unroll
    for (int i = 0; i < 16; ++i) {
        const int c = lane + 64 * i; float mm;
        if (inv) { mm = 0.f;
#pragma unroll
            for (int k = 0; k < 4; ++k) { const int sl = inv[t * 4 + k]; mm += slot_gate[sl] * m[(long)sl * 1024 + c]; } }
        else mm = m[(long)t * 1024 + c];
        v[i] = ALPHA * xprev[(long)t * 1024 + c] + mm; s += v[i];
    }
    const float mean = wsum(s) * (1.0f / 1024.0f); float q = 0.f;
#pragma unroll
    for (int i = 0; i < 16; ++i) { v[i] -= mean; q += v[i] * v[i]; }
    const float rstd = 1.0f / sqrtf(wsum(q) * (1.0f / 1024.0f) + 1e-5f);
#pragma unroll
    for (int i = 0; i < 16; ++i) { const int c = lane + 64 * i; xout[(long)t * 1024 + c] = v[i] * rstd * gam[c] + bet[c]; }
}
__global__ __launch_bounds__(256) void k_router(const float* x, const float* wr, const float* br, int* top_e, float* top_g) {
    const int t = blockIdx.x * 4 + (threadIdx.x >> 6), lane = threadIdx.x & 63, e = lane & 31, half = lane >> 5;
    const float* xr = x + (long)t * 1024 + half * 512; const float* w = wr + (long)half * 512 * 32 + e;
    float acc = 0.f;
    for (int k = 0; k < 512; ++k) acc += xr[k] * w[(long)k * 32];
    acc += __shfl_xor(acc, 32);
    float val = acc + br[e];
    float tv[4]; int ti[4];
#pragma unroll
    for (int r = 0; r < 4; ++r) {
        float bv = val; int bi = e;
#pragma unroll
        for (int o = 1; o < 32; o <<= 1) { const float ov = __shfl_xor(bv, o); const int oi = __shfl_xor(bi, o); if (ov > bv || (ov == bv && oi < bi)) { bv = ov; bi = oi; } }
        tv[r] = bv; ti[r] = bi; if (e == bi) val = -INFINITY;
    }
    const float e1 = expf(tv[1] - tv[0]), e2 = expf(tv[2] - tv[0]), e3 = expf(tv[3] - tv[0]); const float inv = 1.0f / (1.0f + e1 + e2 + e3);
    if (lane == 0) { top_e[t * 4] = ti[0]; top_e[t * 4 + 1] = ti[1]; top_e[t * 4 + 2] = ti[2]; top_e[t * 4 + 3] = ti[3];
        top_g[t * 4] = inv; top_g[t * 4 + 1] = e1 * inv; top_g[t * 4 + 2] = e2 * inv; top_g[t * 4 + 3] = e3 * inv; }
}
__global__ __launch_bounds__(1024) void k_moe_sort(const int* top_e, const float* top_g, int* slot_tok, float* slot_gate, int* inv, int* tile_expert) {
    extern __shared__ int sm[];
    int* cnt = sm; int* spad = sm + 1024 * 33; int* pend = spad + 32;
    const int tid = threadIdx.x;
    for (int i = tid; i < NSLOT; i += 1024) { slot_tok[i] = 0; slot_gate[i] = 0.f; }
    for (int i = 0; i < 32; ++i) cnt[tid * 33 + i] = 0;
    for (int j = tid * 128; j < tid * 128 + 128; ++j) cnt[tid * 33 + top_e[j]]++;
    __syncthreads();
    if (tid < 32) { int run = 0; for (int i = 0; i < 1024; ++i) { const int c = cnt[i * 33 + tid]; cnt[i * 33 + tid] = run; run += c; } pend[tid] = run; }
    __syncthreads();
    if (tid == 0) { int pe = 0; for (int e = 0; e < 32; ++e) { const int p = (pend[e] + 127) / 128 * 128; spad[e] = pe; pe += p; pend[e] = pe; } }
    __syncthreads();
    for (int j = tid * 128; j < tid * 128 + 128; ++j) { const int e = top_e[j]; const int pos = cnt[tid * 33 + e]++; const int sl = spad[e] + pos;
        slot_tok[sl] = j >> 2; slot_gate[sl] = top_g[j]; inv[j] = sl; }
    for (int b = tid; b < NTILE; b += 1024) { int c = 0; for (int e = 0; e < 32; ++e) c += (pend[e] <= b * 128) ? 1 : 0; tile_expert[b] = c < 31 ? c : 31; }
}
__global__ __launch_bounds__(256) void k_swa(const float* proj, const float* sinks, float* o) {
    const int gw = blockIdx.x * 4 + (threadIdx.x >> 6), lane = threadIdx.x & 63;
    const int t = gw >> 4, hq = gw & 15, hkv = hq >> 3, pos = t & (SEQ - 1);
    const float qd = proj[(long)t * 1280 + hq * 64 + lane];
    const float slope = exp2f(-0.5f * (float)(hq + 1)), sink = sinks[hq];
    float sc[2];
#pragma unroll
    for (int u = 0; u < 2; ++u) {
        const int dist = lane + 64 * u; const bool valid = (pos - dist >= 0);
        const float* kr = proj + (long)(valid ? t - dist : t) * 1280 + 1024 + hkv * 64; float dot = 0.f;
#pragma unroll
        for (int d4 = 0; d4 < 16; ++d4) { const float4 kv = *(const float4*)(kr + d4 * 4);
            dot += __shfl(qd, d4 * 4) * kv.x + __shfl(qd, d4 * 4 + 1) * kv.y + __shfl(qd, d4 * 4 + 2) * kv.z + __shfl(qd, d4 * 4 + 3) * kv.w; }
        sc[u] = valid ? dot * 0.125f - slope * (float)dist : -INFINITY;
    }
    const float mx = fmaxf(wmax(fmaxf(sc[0], sc[1])), sink);
    const float p0 = expf(sc[0] - mx), p1 = expf(sc[1] - mx);
    const float den = wsum(p0 + p1) + expf(sink - mx);
    const float q0 = p0 / den, q1 = p1 / den;
    float acc = 0.f;
    for (int j = 0; j < 128; ++j) {
        const float pj = __shfl(j < 64 ? q0 : q1, j & 63);
        if (pos - j >= 0) acc += pj * proj[(long)(t - j) * 1280 + 1152 + hkv * 64 + lane];
    }
    o[(long)t * 1024 + hq * 64 + lane] = acc;
}
}
namespace nv {
constexpr size_t MiBn = 1u << 20;
constexpr size_t N_PROJ = 16 * MiBn, N_OBUF = 800 * MiBn, N_MBUF = 1328 * MiBn, N_X1 = 1456 * MiBn, N_X2 = 1584 * MiBn, N_MISC = 1712 * MiBn, N_END = 1728 * MiBn;
static void gemm(hipStream_t st, const float* A, int lda, const int* rowidx, const float* B, int ldb, long bes, const int* te, const float* bias, long bias_es,
                 float* C, int ldc, int M, int N, int K, int mode) {
    GemmArgs g{}; g.A = A; g.rowidx = rowidx; g.B = B; g.tile_expert = te; g.bias = bias; g.C = C; g.b_estride = bes; g.bias_estride = bias_es;
    g.lda = lda; g.ldb = ldb; g.ldc = ldc; g.M = M; g.N = N; g.K = K; g.mode = mode; g.pad = 0;
    hipLaunchKernelGGL(k_gemm, dim3(N / 64, M / 128), dim3(256), 0, st, g);
}
static void moe(hipStream_t st, unsigned char* ws, const float* x1, const float* wr, const float* br, const float* w1, const float* b1, const float* w2, const float* b2,
                const float* gam, const float* bet, float* xout) {
    int* top_e = (int*)(ws + N_MISC); float* top_g = (float*)(ws + N_MISC + 1 * MiBn); int* inv = (int*)(ws + N_MISC + 2 * MiBn);
    int* slot_tok = (int*)(ws + N_MISC + 3 * MiBn); float* slot_gate = (float*)(ws + N_MISC + 4 * MiBn); int* tile_e = (int*)(ws + N_MISC + 5 * MiBn);
    float* act = (float*)(ws + N_OBUF); float* y = (float*)(ws + N_PROJ);
    hipLaunchKernelGGL(k_router, dim3(T / 4), dim3(256), 0, st, x1, wr, br, top_e, top_g);
    hipLaunchKernelGGL(k_moe_sort, dim3(1), dim3(1024), (1024 * 33 + 64) * 4, st, top_e, top_g, slot_tok, slot_gate, inv, tile_e);
    gemm(st, x1, 1024, slot_tok, w1, 2048, 1024L * 2048, tile_e, b1, 2048, act, 1024, NSLOT, 1024, 1024, 1);
    gemm(st, act, 1024, nullptr, w2, 1024, 1024L * 1024, tile_e, b2, 1024, y, 1024, NSLOT, 1024, 1024, 0);
    hipLaunchKernelGGL(k_ln, dim3(T / 4), dim3(256), 0, st, x1, y, inv, slot_gate, gam, bet, xout);
}
static void forward(void* const* d_in, float* out, unsigned char* ws, hipStream_t st) {
    const float* x = (const float*)d_in[0]; const float* w_ret_in = (const float*)d_in[1]; const float* w_ret_out = (const float*)d_in[2];
    const float* w_swa_in = (const float*)d_in[3]; const float* b_swa_in = (const float*)d_in[4]; const float* w_swa_out = (const float*)d_in[5];
    const float* b_swa_out = (const float*)d_in[6]; const float* sinks = (const float*)d_in[7]; const float* ln_mix_g = (const float*)d_in[8];
    const float* ln_mix_b = (const float*)d_in[9]; const float* w_router = (const float*)d_in[10]; const float* b_router = (const float*)d_in[11];
    const float* w_exp_in = (const float*)d_in[12]; const float* b_exp_in = (const float*)d_in[13]; const float* w_exp_out = (const float*)d_in[14];
    const float* b_exp_out = (const float*)d_in[15]; const float* ln_ffn_g = (const float*)d_in[16]; const float* ln_ffn_b = (const float*)d_in[17];
    float* proj = (float*)(ws + N_PROJ); float* obuf = (float*)(ws + N_OBUF); float* mbuf = (float*)(ws + N_MBUF); float* x1 = (float*)(ws + N_X1); float* x2 = (float*)(ws + N_X2);
    static bool attr = false;
    if (!attr) { (void)hipFuncSetAttribute((const void*)k_moe_sort, hipFuncAttributeMaxDynamicSharedMemorySize, (1024 * 33 + 64) * 4); attr = true; }
    gemm(st, x, 1024, nullptr, w_ret_in, 6144, 0, nullptr, nullptr, 0, proj, 6144, T, 6144, 1024, 0);
    hipLaunchKernelGGL(k_ret, dim3(512), dim3(1024), 0, st, proj, obuf);
    hipLaunchKernelGGL(k_gn_gate, dim3(T), dim3(256), 0, st, proj, obuf);
    gemm(st, obuf, 2048, nullptr, w_ret_out, 1024, 0, nullptr, nullptr, 0, mbuf, 1024, T, 1024, 2048, 0);
    hipLaunchKernelGGL(k_ln, dim3(T / 4), dim3(256), 0, st, x, mbuf, (const int*)nullptr, (const float*)nullptr, ln_mix_g, ln_mix_b, x1);
    moe(st, ws, x1, w_router, b_router, w_exp_in, b_exp_in, w_exp_out, b_exp_out, ln_ffn_g, ln_ffn_b, x2);
    gemm(st, x2, 1024, nullptr, w_swa_in, 1280, 0, nullptr, b_swa_in, 0, proj, 1280, T, 1280, 1024, 0);
    hipLaunchKernelGGL(k_swa, dim3(T * 16 / 4), dim3(256), 0, st, proj, sinks, obuf);
    gemm(st, obuf, 1024, nullptr, w_swa_out, 1024, 0, nullptr, b_swa_out, 0, mbuf, 1024, T, 1024, 1024, 0);
    hipLaunchKernelGGL(k_ln, dim3(T / 4), dim3(256), 0, st, x2, mbuf, (const int*)nullptr, (const float*)nullptr, ln_mix_g + 1024, ln_mix_b + 1024, x1);
    moe(st, ws, x1, w_router + 1024 * 32, b_router + 32, w_exp_in + 32L * 1024 * 2048, b_exp_in + 32 * 2048, w_exp_out + 32L * 1024 * 1024, b_exp_out + 32 * 1024,
        ln_ffn_g + 1024, ln_ffn_b + 1024, out);
}
}
extern "C" void kernel_launch(void* const* d_in, const int* in_sizes, int n_in, void* d_out, int out_size, void* d_ws, size_t ws_size, hipStream_t stream) {
    if (n_in != 18 || out_size != nv::T * nv::D || ws_size < nv::N_END) { fprintf(stderr, "kernel_launch: unexpected shapes / workspace (%d inputs, out %d, ws %zu)\n", n_in, out_size, ws_size); return; }
    nv::forward(d_in, (float*)d_out, (unsigned char*)d_ws, stream);
}
```

```cpp
#include <hip/hip_runtime.h>
#include <cstdio>
#include <cstdint>
#include <cmath>
#define GAS __attribute__((address_space(1)))
#define LAS __attribute__((address_space(3)))
typedef unsigned short bf16;
typedef unsigned v4u __attribute__((ext_vector_type(4)));
typedef float f32x4 __attribute__((ext_vector_type(4)));
typedef short bf16x8 __attribute__((ext_vector_type(8)));
typedef GAS unsigned gu32;
typedef GAS unsigned long long gu64;
#define RLX_AGENT __ATOMIC_RELAXED, __HIP_MEMORY_SCOPE_AGENT
#define LDS_WAIT() asm volatile("s_waitcnt lgkmcnt(0)" ::: "memory")
#define VM_WAIT() asm volatile("s_waitcnt vmcnt(0)" ::: "memory")
__device__ __forceinline__ unsigned long long rt() { return __builtin_amdgcn_s_memrealtime(); }
#define XB_TMO      128
#define XB_XCNT(j)  (256  + 64 * (j))
#define XB_XSUB(j)  (1280 + 64 * (j))
#define XB_XGEN(j)  (2304 + 64 * (j))
#define XB_TOP      3328
#define XB_TOPGEN   3392
#define XCD_BAR_WORDS 3456
#define XB_SPIN_CAP (1u << 18)

__device__ __forceinline__ unsigned xb_ld(unsigned* p)              { return __hip_atomic_load(p, __ATOMIC_RELAXED, __HIP_MEMORY_SCOPE_AGENT); }
__device__ __forceinline__ unsigned xb_add(unsigned* p, unsigned v) { return __hip_atomic_fetch_add(p, v, __ATOMIC_RELAXED, __HIP_MEMORY_SCOPE_AGENT); }
__device__ __forceinline__ unsigned xb_xcc_id() { return (unsigned)__builtin_amdgcn_s_getreg((3 << 11) | 20) & 0xFu; }
#define XB_SPIN(cond, bar) do { unsigned _sp = 0; while (cond) { __builtin_amdgcn_s_sleep(1); \
    if ((++_sp & 255u) == 0u) { if (xb_ld(&(bar)[XB_TMO])) break; if (_sp > XB_SPIN_CAP) { atomicAdd(&(bar)[XB_TMO], 1u); break; } } } } while (0)

struct XcdBarrier {
    unsigned* bar; unsigned x;
    volatile LAS unsigned* st;
};

__device__ __forceinline__ XcdBarrier xcd_barrier_post(unsigned* bar, volatile LAS unsigned* st) {
    XcdBarrier b; b.bar = bar; b.x = xb_xcc_id(); b.st = st;
    if (threadIdx.x == 0) (void)xb_add(&bar[XB_XCNT(b.x)], 1u);
    return b;
}
__device__ __forceinline__ void xcd_barrier_complete(unsigned* bar, unsigned x, unsigned& nloc, unsigned& nx) {
    const unsigned G = gridDim.x * gridDim.y * gridDim.z;
    unsigned sum, cnt, mine, sp = 0u;
    for (;;) {
        sum = 0u; cnt = 0u; mine = 0u;
#pragma unroll
        for (unsigned j = 0; j < 16; ++j) { const unsigned c = xb_ld(&bar[XB_XCNT(j)]); sum += c; cnt += (c > 0u) ? 1u : 0u; mine = (j == x) ? c : mine; }
        if (sum == G) break;
        __builtin_amdgcn_s_sleep(1);
        if ((++sp & 255u) == 0u) { if (xb_ld(&bar[XB_TMO])) break; if (sp > XB_SPIN_CAP) { atomicAdd(&bar[XB_TMO], 1u); break; } }
    }
    nloc = mine > 0u ? mine : 1u; nx = cnt > 0u ? cnt : 1u;
}

__device__ __forceinline__ void xcd_barrier(const XcdBarrier& b) {
    asm volatile("s_waitcnt vmcnt(0)" ::: "memory");
    __syncthreads();
    if (threadIdx.x == 0) {
        unsigned* bar = b.bar;
        __builtin_amdgcn_s_waitcnt(0);
        unsigned nloc = b.st[0], nx = b.st[1];
        if (nloc == 0u) { xcd_barrier_complete(bar, b.x, nloc, nx); b.st[0] = nloc; b.st[1] = nx; }
        const unsigned old = xb_add(&bar[XB_XSUB(b.x)], 1u);
        const unsigned gen = old / nloc;
        if (old + 1u == (gen + 1u) * nloc) {
            __builtin_amdgcn_fence(__ATOMIC_RELEASE, "agent");
            asm volatile("s_waitcnt vmcnt(0)" ::: "memory");
            const unsigned og = xb_add(&bar[XB_TOP], 1u);
            const unsigned tg = og / nx;
            if (og + 1u == (tg + 1u) * nx) xb_add(&bar[XB_TOPGEN], 1u);
            else XB_SPIN(xb_ld(&bar[XB_TOPGEN]) == tg, bar);
            __builtin_amdgcn_fence(__ATOMIC_ACQUIRE, "agent");
            xb_add(&bar[XB_XGEN(b.x)], 1u);
            asm volatile("s_waitcnt vmcnt(0)" ::: "memory");
        } else {
            XB_SPIN(xb_ld(&bar[XB_XGEN(b.x)]) == gen, bar);
            __builtin_amdgcn_fence(__ATOMIC_ACQUIRE, "agent");
            asm volatile("s_waitcnt vmcnt(0)" ::: "memory");
        }
    }
    __syncthreads();
}
namespace pg {
#define PG_LAS __attribute__((address_space(3)))
typedef unsigned short h16;
typedef _Float16 f16x8 __attribute__((ext_vector_type(8)));
typedef __bf16 bf16x8 __attribute__((ext_vector_type(8)));
typedef _Float16 f16x2 __attribute__((ext_vector_type(2)));
typedef float f32x4 __attribute__((ext_vector_type(4)));
typedef float f32x2 __attribute__((ext_vector_type(2)));
typedef unsigned u32x4 __attribute__((ext_vector_type(4)));
typedef unsigned u32x2 __attribute__((ext_vector_type(2)));
constexpr int BM = 256, BK = 64, HALF = 128, HTB = HALF * BK * 2  , STAGE_BYTES = 8 * HTB;

__host__ __device__ __forceinline__ int lds_byte(int r, int c) { const int st = (r >> 4) * 2 + (c >> 5), rr = r & 15, cc = c & 31, ob = rr * 64 + cc * 2; return st * 1024 + (ob ^ (((ob >> 9) & 1) << 5)); }
__host__ __device__ __forceinline__ void stage_rc(int b, int& R, int& C) { const int st = b / 1024, sb = b % 1024, swz = sb ^ (((sb >> 9) & 1) << 5); R = (st >> 1) * 16 + swz / 64; C = (st & 1) * 32 + (swz % 64) / 2; }
__host__ __device__ __forceinline__ int perm32(int rho) { const int n = rho >> 4, i = rho & 15; return 8 * (i >> 2) + 4 * n + (i & 3); }
__device__ __forceinline__ unsigned pkh(float lo, float hi) { const f32x2 v = {lo, hi}; const f16x2 h = __builtin_convertvector(v, f16x2); return __builtin_bit_cast(unsigned, h); }

typedef int i32x8 __attribute__((ext_vector_type(8)));
typedef int i32x4 __attribute__((ext_vector_type(4)));
__device__ __forceinline__ i32x8 cat8(f16x8 lo, f16x8 hi) { return __builtin_shufflevector(__builtin_bit_cast(i32x4, lo), __builtin_bit_cast(i32x4, hi), 0, 1, 2, 3, 4, 5, 6, 7); }
__device__ __forceinline__ void mfma_f8(f32x4& c, const i32x8& a, const i32x8& b, int scale) {
    asm volatile("v_mfma_scale_f32_16x16x128_f8f6f4 %0, %1, %2, %0, %3, %3 op_sel_hi:[0,0,0]" : "+v"(c) : "v"(a), "v"(b), "v"(scale)); }
struct Unit { const char* a; const char* b; int pm, pn, e, x; };
typedef f32x4 Acc[2][2][4][2];
__device__ __forceinline__ void acc_zero(Acc& acc) {
#pragma unroll
    for (int a = 0; a < 2; ++a)
#pragma unroll
        for (int b = 0; b < 2; ++b)
#pragma unroll
            for (int m = 0; m < 4; ++m)
#pragma unroll
                for (int n = 0; n < 2; ++n) acc[a][b][m][n] = (f32x4){0.f, 0.f, 0.f, 0.f};
}
struct EpiBase {
    static constexpr bool PERM = false;
    __device__ __forceinline__ void init(Acc& acc, const Unit&, int, int, int, int) const { acc_zero(acc); }
    __device__ __forceinline__ void reinit(Acc& acc, const Unit&, const Unit&, int, int, int, int) const { acc_zero(acc); }
};

template <class Epi, class Sched, int MODE  , bool ALIGN_EPI, int ES = 2  , bool BF = false  , int ILV = 2  >
__device__ __forceinline__ void gemm_phase(PG_LAS unsigned char* lds, const int lda, const int ldb, const int nt_, const Sched& S, const Epi& E, const int lda1 = 0, const int ldb1 = 0, const int skew_ticks = 0  ) {
    constexpr bool GATHER = (MODE == 1), DUAL = (MODE == 2);
    int nt = nt_; asm volatile("" : "+s"(nt));
    int tid_ = threadIdx.x; asm volatile("" : "+v"(tid_));
    const int tid = tid_, wid = __builtin_amdgcn_readfirstlane(tid >> 6), lane = tid & 63, wr = wid >> 2, wc = wid & 3, fr = lane & 15, fq = lane >> 4;
    unsigned voffA[2], voffB[2]; int sR[2], sC[2];
#pragma unroll
    for (int i = 0; i < 2; ++i) { int R, C; stage_rc(tid * 16 + i * 8192, R, C); sR[i] = R; sC[i] = C; const int Rb = Epi::PERM ? ((R & ~31) + perm32(R & 31)) : R;
        voffA[i] = (unsigned)(R * lda * ES + C * 2); voffB[i] = (unsigned)(Rb * ldb * ES + C * 2); }
    const size_t kstep = (size_t)(BK * 2);
    const size_t hstepA0 = GATHER ? 0 : (size_t)HALF * lda * ES, hstepB0 = (size_t)HALF * ldb * ES, hstepA1 = (size_t)HALF * lda1 * ES, hstepB1 = (size_t)HALF * ldb1 * ES;
    unsigned wA1[2], wB1[2];
#pragma unroll
    for (int i = 0; i < 2; ++i) { const int Rb = Epi::PERM ? ((sR[i] & ~31) + perm32(sR[i] & 31)) : sR[i]; wA1[i] = (unsigned)(sR[i] * lda1 * ES + sC[i] * 2); wB1[i] = (unsigned)(Rb * ldb1 * ES + sC[i] * 2); }
    unsigned vAc[2], vBc[2], vAn[2], vBn[2], vA2[2], vB2[2];
    size_t hAc = hstepA0, hBc = hstepB0, hAn = hstepA0, hBn = hstepB0, hA2 = hstepA0, hB2 = hstepB0;
    const unsigned ldsw = (unsigned)wid * 1024u;
    const int aoff = (ES == 2) ? lds_byte(wr * 64 + fr, fq * 8) : lds_byte(wr * 64 + fr, fq * 16), boff = (ES == 2) ? lds_byte(wc * 32 + fr, fq * 8) : lds_byte(wc * 32 + fr, fq * 16);
    unsigned gc[2][2], gn[2][2], g2[2][2];
#define PG_SA(b, h) (((b) * 2 + (h)) * HTB)
#define PG_SB(b, h) ((4 + (b) * 2 + (h)) * HTB)
#define PG_STAGE(bufoff, gbase, voff) do { _Pragma("unroll") for (int _i = 0; _i < 2; ++_i) \
        __builtin_amdgcn_global_load_lds((const unsigned*)((const char*)(gbase) + (voff)[_i]), (PG_LAS unsigned*)(lds + (bufoff) + ldsw + _i * 8192), 16, 0, 0); } while (0)
#define PG_STAGE_A(bufoff, kptr, h, G, VA, HA) do { if constexpr (GATHER) { PG_STAGE(bufoff, kptr, G[h]); } else { PG_STAGE(bufoff, (kptr) + (h) * (HA), VA); } } while (0)
#define PG_CFG(u, VA, VB, HA, HB) do { if constexpr (DUAL) { const bool _x = (u).x != 0; _Pragma("unroll") for (int _i = 0; _i < 2; ++_i) { VA[_i] = _x ? wA1[_i] : voffA[_i]; VB[_i] = _x ? wB1[_i] : voffB[_i]; } \
        HA = _x ? hstepA1 : hstepA0; HB = _x ? hstepB1 : hstepB0; } else { _Pragma("unroll") for (int _i = 0; _i < 2; ++_i) { VA[_i] = voffA[_i]; VB[_i] = voffB[_i]; } HA = hstepA0; HB = hstepB0; } } while (0)
#define PG_GLOAD(dst, u) do { _Pragma("unroll") for (int _h = 0; _h < 2; ++_h) _Pragma("unroll") for (int _i = 0; _i < 2; ++_i) \
        dst[_h][_i] = S.arow(u, _h * HALF + sR[_i]) * (unsigned)(lda * ES) + (unsigned)(sC[_i] * 2); } while (0)
#define PG_LDF(p) (*(const PG_LAS f16x8*)(p))
#define PG_LDA(dst, b, h) do { if constexpr (ES == 2) { _Pragma("unroll") for (int m = 0; m < 4; ++m) _Pragma("unroll") for (int k = 0; k < 2; ++k) dst[m][k] = PG_LDF(lds + PG_SA(b, h) + aoff + m * 2048 + k * 1024); } \
        else { _Pragma("unroll") for (int m = 0; m < 4; ++m) dst##8[m] = cat8(PG_LDF(lds + PG_SA(b, h) + aoff + m * 2048), PG_LDF(lds + PG_SA(b, h) + aoff + m * 2048 + 16)); } } while (0)
#define PG_LDB(dst, b, h) do { if constexpr (ES == 2) { _Pragma("unroll") for (int n = 0; n < 2; ++n) _Pragma("unroll") for (int k = 0; k < 2; ++k) dst[n][k] = PG_LDF(lds + PG_SB(b, h) + boff + n * 2048 + k * 1024); } \
        else { _Pragma("unroll") for (int n = 0; n < 2; ++n) dst##8[n] = cat8(PG_LDF(lds + PG_SB(b, h) + boff + n * 2048), PG_LDF(lds + PG_SB(b, h) + boff + n * 2048 + 16)); } } while (0)
#define PG_MMA(ai, bj, At, Bt) do { __builtin_amdgcn_s_setprio(1); if constexpr (ES == 2) { _Pragma("unroll") for (int m = 0; m < 4; ++m) _Pragma("unroll") for (int n = 0; n < 2; ++n) _Pragma("unroll") for (int k = 0; k < 2; ++k) \
        acc[ai][bj][m][n] = BF ? __builtin_amdgcn_mfma_f32_16x16x32_bf16(__builtin_bit_cast(bf16x8, Bt[n][k]), __builtin_bit_cast(bf16x8, At[m][k]), acc[ai][bj][m][n], 0, 0, 0) : __builtin_amdgcn_mfma_f32_16x16x32_f16(Bt[n][k], At[m][k], acc[ai][bj][m][n], 0, 0, 0); } else { _Pragma("unroll") for (int m = 0; m < 4; ++m) _Pragma("unroll") for (int n = 0; n < 2; ++n) \
        mfma_f8(acc[ai][bj][m][n], Bt##8[n], At##8[m], f8scale); } \
        __builtin_amdgcn_s_setprio(0); } while (0)
#define PG_MMH(ai, bj, At, Bt, M0) do { __builtin_amdgcn_s_setprio(1); if constexpr (ES == 2) { _Pragma("unroll") for (int m = (M0); m < (M0) + 2; ++m) _Pragma("unroll") for (int n = 0; n < 2; ++n) _Pragma("unroll") for (int k = 0; k < 2; ++k) \
        acc[ai][bj][m][n] = BF ? __builtin_amdgcn_mfma_f32_16x16x32_bf16(__builtin_bit_cast(bf16x8, Bt[n][k]), __builtin_bit_cast(bf16x8, At[m][k]), acc[ai][bj][m][n], 0, 0, 0) : __builtin_amdgcn_mfma_f32_16x16x32_f16(Bt[n][k], At[m][k], acc[ai][bj][m][n], 0, 0, 0); } else { _Pragma("unroll") for (int m = (M0); m < (M0) + 2; ++m) _Pragma("unroll") for (int n = 0; n < 2; ++n) \
        mfma_f8(acc[ai][bj][m][n], Bt##8[n], At##8[m], f8scale); } \
        __builtin_amdgcn_s_setprio(0); } while (0)
#define PG_WAIT_V(n) asm volatile("s_waitcnt vmcnt(" #n ")" ::: "memory")
#define PG_WAIT_L(n) asm volatile("s_waitcnt lgkmcnt(" #n ")" ::: "memory")
#define PG_BAR __builtin_amdgcn_s_barrier()
#define PG_SCHED __builtin_amdgcn_sched_barrier(0)
    if (skew_ticks > 0) { const unsigned long long t0 = __builtin_amdgcn_s_memrealtime(); while (__builtin_amdgcn_s_memrealtime() - t0 < (unsigned long long)skew_ticks) __builtin_amdgcn_s_sleep(8); }
    Unit cur, nxt; int ui = 0;
    if (!S.next(0, cur)) return;
    Acc acc;
    E.init(acc, cur, wr, wc, fr, fq);
    f16x8 At[4][2], B0[2][2], B1[2][2];
    int f8scale = 0x7f7f7f7f; asm volatile("" : "+v"(f8scale));
    i32x8 At8[4], B08[2], B18[2];
    const char* cA = cur.a; const char* cB = cur.b;
    if constexpr (GATHER) { PG_GLOAD(gc, cur); }
    PG_CFG(cur, vAc, vBc, hAc, hBc);
    PG_STAGE(PG_SB(0, 0), cB, vBc); PG_STAGE(PG_SB(0, 1), cB + hBc, vBc); PG_STAGE_A(PG_SA(0, 0), cA, 0, gc, vAc, hAc); PG_STAGE_A(PG_SA(0, 1), cA, 1, gc, vAc, hAc);
    if (wr == 1) PG_BAR;
    PG_WAIT_V(2); PG_BAR;
    if constexpr (ILV >= 2) { PG_STAGE(PG_SB(1, 0), cB + kstep, vBc); PG_STAGE(PG_SB(1, 1), cB + hBc + kstep, vBc); PG_WAIT_V(4); PG_BAR; }
    else { PG_STAGE(PG_SB(1, 0), cB + kstep, vBc); PG_STAGE_A(PG_SA(1, 0), cA + kstep, 0, gc, vAc, hAc); PG_STAGE(PG_SB(1, 1), cB + hBc + kstep, vBc);
    PG_WAIT_V(6); PG_BAR; }
    for (;;) {
        const bool has_next = S.next(ui + 1, nxt);
        const char* nA = has_next ? nxt.a : cA; const char* nB = has_next ? nxt.b : cB;
        if constexpr (GATHER) { if (has_next) { PG_GLOAD(gn, nxt); } else {
#pragma unroll
            for (int h = 0; h < 2; ++h)
#pragma unroll
                for (int i = 0; i < 2; ++i) gn[h][i] = gc[h][i]; } }
        if (has_next) { PG_CFG(nxt, vAn, vBn, hAn, hBn); } else { PG_CFG(cur, vAn, vBn, hAn, hBn); }
        for (int t = 0; t < nt; t += 2) {
            const bool last = (t == nt - 2);
            const char* a1 = cA + (size_t)(t + 1) * kstep;
            const char* a2 = last ? nA : cA + (size_t)(t + 2) * kstep; const char* b2 = last ? nB : cB + (size_t)(t + 2) * kstep;
            const char* a3 = a2 + kstep; const char* b3 = b2 + kstep;
            if constexpr (GATHER) {
#pragma unroll
                for (int h = 0; h < 2; ++h)
#pragma unroll
                    for (int i = 0; i < 2; ++i) g2[h][i] = last ? gn[h][i] : gc[h][i]; }
            if constexpr (DUAL) {
#pragma unroll
                for (int i = 0; i < 2; ++i) { vA2[i] = last ? vAn[i] : vAc[i]; vB2[i] = last ? vBn[i] : vBc[i]; }
                hA2 = last ? hAn : hAc; hB2 = last ? hBn : hBc;
            } else {
#pragma unroll
                for (int i = 0; i < 2; ++i) { vA2[i] = vAc[i]; vB2[i] = vBc[i]; }
                hA2 = hAc; hB2 = hBc; }
            if constexpr (ILV == 3) {
            PG_LDB(B0, 0, 0); PG_LDB(B1, 0, 1); PG_SCHED; PG_LDA(At, 0, 0); PG_STAGE_A(PG_SA(1, 0), a1, 0, gc, vAc, hAc);
            PG_WAIT_V(6); PG_WAIT_L(0); PG_BAR; PG_MMA(0, 0, At, B0); PG_SCHED; PG_STAGE_A(PG_SA(1, 1), a1, 1, gc, vAc, hAc); PG_SCHED; PG_MMA(0, 1, At, B1); PG_BAR; PG_SCHED;
            PG_LDA(At, 0, 1); PG_STAGE(PG_SB(0, 0), b2, vB2);
            PG_WAIT_V(4); PG_WAIT_L(0); PG_BAR; PG_MMA(1, 0, At, B0); PG_SCHED; PG_STAGE(PG_SB(0, 1), b2 + hB2, vB2); PG_SCHED; PG_MMA(1, 1, At, B1); PG_BAR; PG_SCHED;
            PG_LDB(B0, 1, 0); PG_LDB(B1, 1, 1); PG_SCHED; PG_LDA(At, 1, 0); PG_STAGE_A(PG_SA(0, 0), a2, 0, g2, vA2, hA2);
            PG_WAIT_V(6); PG_WAIT_L(0); PG_BAR; PG_MMA(0, 0, At, B0); PG_SCHED; PG_STAGE_A(PG_SA(0, 1), a2, 1, g2, vA2, hA2); PG_SCHED; PG_MMA(0, 1, At, B1); PG_BAR; PG_SCHED;
            PG_LDA(At, 1, 1); PG_STAGE(PG_SB(1, 0), b3, vB2);
            PG_WAIT_V(4); PG_WAIT_L(0); PG_BAR; PG_MMA(1, 0, At, B0); PG_SCHED; PG_STAGE(PG_SB(1, 1), b3 + hB2, vB2); PG_SCHED; PG_MMA(1, 1, At, B1); PG_BAR; PG_SCHED;
            } else if constexpr (ILV == 4) {
            PG_LDB(B0, 0, 0); PG_SCHED; PG_LDA(At, 0, 0); PG_STAGE_A(PG_SA(1, 0), a1, 0, gc, vAc, hAc); PG_STAGE_A(PG_SA(1, 1), a1, 1, gc, vAc, hAc);
            PG_WAIT_V(8); PG_WAIT_L(0); PG_BAR; PG_MMA(0, 0, At, B0); PG_SCHED; PG_LDB(B1, 0, 1); PG_WAIT_L(0); PG_SCHED; PG_MMA(0, 1, At, B1); PG_BAR; PG_SCHED;
            PG_LDA(At, 0, 1); PG_STAGE(PG_SB(0, 0), b2, vB2); PG_STAGE(PG_SB(0, 1), b2 + hB2, vB2);
            PG_WAIT_V(6); PG_WAIT_L(0); PG_BAR; PG_MMA(1, 0, At, B0); PG_MMA(1, 1, At, B1); PG_BAR; PG_SCHED;
            PG_LDB(B0, 1, 0); PG_SCHED; PG_LDA(At, 1, 0); PG_STAGE_A(PG_SA(0, 0), a2, 0, g2, vA2, hA2); PG_STAGE_A(PG_SA(0, 1), a2, 1, g2, vA2, hA2);
            PG_WAIT_V(8); PG_WAIT_L(0); PG_BAR; PG_MMA(0, 0, At, B0); PG_SCHED; PG_LDB(B1, 1, 1); PG_WAIT_L(0); PG_SCHED; PG_MMA(0, 1, At, B1); PG_BAR; PG_SCHED;
            PG_LDA(At, 1, 1); PG_STAGE(PG_SB(1, 0), b3, vB2); PG_STAGE(PG_SB(1, 1), b3 + hB2, vB2);
            PG_WAIT_V(6); PG_WAIT_L(0); PG_BAR; PG_MMA(1, 0, At, B0); PG_MMA(1, 1, At, B1); PG_BAR; PG_SCHED;
            } else if constexpr (ILV == 2) {
            PG_LDB(B0, 0, 0); PG_LDB(B1, 0, 1); PG_SCHED; PG_STAGE_A(PG_SA(1, 0), a1, 0, gc, vAc, hAc); PG_SCHED; PG_LDA(At, 0, 0); PG_SCHED; PG_STAGE_A(PG_SA(1, 1), a1, 1, gc, vAc, hAc);
            PG_WAIT_V(8); PG_BAR; PG_WAIT_L(0); PG_MMA(0, 0, At, B0); PG_MMA(0, 1, At, B1); PG_BAR; PG_SCHED;
            PG_LDA(At, 0, 1); PG_STAGE(PG_SB(0, 0), b2, vB2); PG_STAGE(PG_SB(0, 1), b2 + hB2, vB2);
            PG_WAIT_V(6); PG_BAR; PG_WAIT_L(0); PG_MMA(1, 0, At, B0); PG_MMA(1, 1, At, B1); PG_BAR; PG_SCHED;
            PG_LDB(B0, 1, 0); PG_LDB(B1, 1, 1); PG_SCHED; PG_STAGE_A(PG_SA(0, 0), a2, 0, g2, vA2, hA2); PG_SCHED; PG_LDA(At, 1, 0); PG_SCHED; PG_STAGE_A(PG_SA(0, 1), a2, 1, g2, vA2, hA2);
            PG_WAIT_V(8); PG_BAR; PG_WAIT_L(0); PG_MMA(0, 0, At, B0); PG_MMA(0, 1, At, B1); PG_BAR; PG_SCHED;
            PG_LDA(At, 1, 1); PG_STAGE(PG_SB(1, 0), b3, vB2); PG_STAGE(PG_SB(1, 1), b3 + hB2, vB2);
            PG_WAIT_V(6); PG_BAR; PG_WAIT_L(0); PG_MMA(1, 0, At, B0); PG_MMA(1, 1, At, B1); PG_BAR; PG_SCHED;
            } else if constexpr (ILV == 1) {
            PG_LDB(B0, 0, 0); PG_LDB(B1, 0, 1); PG_SCHED; PG_LDA(At, 0, 0);
            PG_WAIT_V(6); PG_WAIT_L(0); PG_BAR; PG_MMA(0, 0, At, B0); PG_SCHED; PG_STAGE_A(PG_SA(1, 1), a1, 1, gc, vAc, hAc); PG_SCHED; PG_MMA(0, 1, At, B1); PG_BAR; PG_SCHED;
            PG_LDA(At, 0, 1);
            PG_WAIT_V(2); PG_WAIT_L(0); PG_BAR; PG_MMH(1, 0, At, B0, 0); PG_SCHED; PG_STAGE(PG_SB(0, 0), b2, vB2); PG_SCHED; PG_MMH(1, 0, At, B0, 2); PG_SCHED; PG_STAGE(PG_SB(0, 1), b2 + hB2, vB2); PG_SCHED;
                PG_MMH(1, 1, At, B1, 0); PG_SCHED; PG_STAGE_A(PG_SA(0, 0), a2, 0, g2, vA2, hA2); PG_SCHED; PG_MMH(1, 1, At, B1, 2); PG_BAR; PG_SCHED;
            PG_LDB(B0, 1, 0); PG_LDB(B1, 1, 1); PG_SCHED; PG_LDA(At, 1, 0);
            PG_WAIT_V(6); PG_WAIT_L(0); PG_BAR; PG_MMA(0, 0, At, B0); PG_SCHED; PG_STAGE_A(PG_SA(0, 1), a2, 1, g2, vA2, hA2); PG_SCHED; PG_MMA(0, 1, At, B1); PG_BAR; PG_SCHED;
            PG_LDA(At, 1, 1);
            PG_WAIT_V(2); PG_WAIT_L(0); PG_BAR; PG_MMH(1, 0, At, B0, 0); PG_SCHED; PG_STAGE(PG_SB(1, 0), b3, vB2); PG_SCHED; PG_MMH(1, 0, At, B0, 2); PG_SCHED; PG_STAGE(PG_SB(1, 1), b3 + hB2, vB2); PG_SCHED;
                PG_MMH(1, 1, At, B1, 0); PG_SCHED; PG_STAGE_A(PG_SA(1, 0), a3, 0, g2, vA2, hA2); PG_SCHED; PG_MMH(1, 1, At, B1, 2); PG_BAR; PG_SCHED;
            } else {
            PG_LDB(B0, 0, 0); PG_LDB(B1, 0, 1); PG_SCHED; PG_LDA(At, 0, 0); PG_STAGE_A(PG_SA(1, 1), a1, 1, gc, vAc, hAc);
            PG_WAIT_V(8); PG_WAIT_L(0); PG_BAR; PG_MMA(0, 0, At, B0); PG_MMA(0, 1, At, B1); PG_BAR; PG_SCHED;
            PG_LDA(At, 0, 1); PG_STAGE(PG_SB(0, 0), b2, vB2); PG_STAGE(PG_SB(0, 1), b2 + hB2, vB2); PG_STAGE_A(PG_SA(0, 0), a2, 0, g2, vA2, hA2);
            PG_WAIT_V(8); PG_WAIT_L(0); PG_BAR; PG_MMA(1, 0, At, B0); PG_MMA(1, 1, At, B1); PG_BAR; PG_SCHED;
            PG_LDB(B0, 1, 0); PG_LDB(B1, 1, 1); PG_SCHED; PG_LDA(At, 1, 0); PG_STAGE_A(PG_SA(0, 1), a2, 1, g2, vA2, hA2);
            PG_WAIT_V(8); PG_WAIT_L(0); PG_BAR; PG_MMA(0, 0, At, B0); PG_MMA(0, 1, At, B1); PG_BAR; PG_SCHED;
            PG_LDA(At, 1, 1); PG_STAGE(PG_SB(1, 0), b3, vB2); PG_STAGE(PG_SB(1, 1), b3 + hB2, vB2); PG_STAGE_A(PG_SA(1, 0), a3, 0, g2, vA2, hA2);
            PG_WAIT_V(8); PG_WAIT_L(0); PG_BAR; PG_MMA(1, 0, At, B0); PG_MMA(1, 1, At, B1); PG_BAR; PG_SCHED;
            }
        }
        if constexpr (ES == 1) asm volatile("s_nop 15\n\ts_nop 15" ::: "memory");
        if constexpr (ALIGN_EPI) { if (wr == 0) PG_BAR; }
        E(acc, cur, wr, wc, fr, fq);
        if (!has_next) break;
        E.reinit(acc, cur, nxt, wr, wc, fr, fq);
        cur = nxt; cA = nA; cB = nB; ++ui;
        if constexpr (GATHER) {
#pragma unroll
            for (int h = 0; h < 2; ++h)
#pragma unroll
                for (int i = 0; i < 2; ++i) gc[h][i] = gn[h][i]; }
        if constexpr (DUAL) {
#pragma unroll
            for (int i = 0; i < 2; ++i) { vAc[i] = vAn[i]; vBc[i] = vBn[i]; }
            hAc = hAn; hBc = hBn; }
        if constexpr (ALIGN_EPI) { if (wr == 1) PG_BAR; }
    }
    PG_WAIT_V(0);
    if constexpr (!ALIGN_EPI) { if (wr == 0) PG_BAR; }
    PG_BAR;
#undef PG_SA
#undef PG_SB
#undef PG_STAGE
#undef PG_STAGE_A
#undef PG_GLOAD
#undef PG_CFG
#undef PG_LDA
#undef PG_LDF
#undef PG_LDB
#undef PG_MMA
#undef PG_MMH
#undef PG_WAIT_V
#undef PG_WAIT_L
#undef PG_BAR
#undef PG_SCHED
}
}
constexpr int NWAVES = 8;
constexpr int T_ = 32768, D_ = 1024, SEQ_ = 8192;
constexpr int NSLOT_MAX = (512 + 32) * 256, NTILE_MAX = 544;
constexpr float ALPHA_ = 1.4142135623730951f, LN_EPS_ = 1e-5f;
constexpr int RING_OFF = 0, RING_BYTES = 131072;
constexpr int TAB_OFF = RING_BYTES, TAB_BYTES = 24576;
constexpr int LDSCTL_OFF = TAB_OFF + TAB_BYTES, MISC_OFF = LDSCTL_OFF + 320;
constexpr int LDS_BYTES = 159744;
constexpr int CW_TMO = 0, CW_CODE = 1, CW_NTILES = 64, CW_BAR = 4096;
constexpr int N_BAR_REGIONS = 12;
constexpr size_t CTL_ZERO_BYTES = 1u << 20;
static_assert((CW_BAR + N_BAR_REGIONS * XCD_BAR_WORDS) * 4 <= (int)CTL_ZERO_BYTES, "barrier regions inside the memset region");
typedef unsigned short h16;
typedef float f32x2v __attribute__((ext_vector_type(2)));
typedef unsigned v2u __attribute__((ext_vector_type(2)));
#define EPI_OPAQUE() asm volatile("" : "+v"(fr), "+v"(fq))

struct Params {
    const float *x, *w_ret_in, *w_ret_out, *w_swa_in, *b_swa_in, *w_swa_out, *b_swa_out, *sinks, *ln_mix_g, *ln_mix_b, *w_router, *b_router, *w_exp_in, *b_exp_in, *w_exp_out, *b_exp_out, *ln_ffn_g, *ln_ffn_b;
    float* out;
    unsigned* ctl;
    int *top_e, *rankp, *inv, *slot_tok, *wg_cnt, *tile_e; float *top_g, *slot_gate;
    h16 *wri_t, *wfm_t, *wro_t, *wsi_t, *wso_t, *w1_t, *w2_t;
    h16 *xh0, *x1h, *x2h, *yh; float *x1f, *x2f, *yf;
    h16 *act, *yy;
    h16 *q, *k, *sg, *kdt, *vt, *pp, *st, *o, *og; float* ltot;
    h16 *sq, *skv, *kvt, *so;
    const float* cv_src; h16* cv_dst; size_t cv_n; float* projf;
    unsigned char *w1q, *w2q, *x1q, *actq;
    int ph_lo, ph_hi, li, layer;
};

struct Frame {
    LAS unsigned char* lds; volatile LAS unsigned* MISC; gu32* ctl;
    int tid, lane, wave, vcu, G;
};
__device__ __forceinline__ float wave_sum(float v) {
    v += __builtin_bit_cast(float, __builtin_amdgcn_update_dpp(0, __builtin_bit_cast(int, v), 0x111, 0xf, 0xf, true));
    v += __builtin_bit_cast(float, __builtin_amdgcn_update_dpp(0, __builtin_bit_cast(int, v), 0x112, 0xf, 0xf, true));
    v += __builtin_bit_cast(float, __builtin_amdgcn_update_dpp(0, __builtin_bit_cast(int, v), 0x114, 0xf, 0xf, true));
    v += __builtin_bit_cast(float, __builtin_amdgcn_update_dpp(0, __builtin_bit_cast(int, v), 0x118, 0xf, 0xf, true));
    v += __builtin_bit_cast(float, __builtin_amdgcn_update_dpp(0, __builtin_bit_cast(int, v), 0x142, 0xa, 0xf, true));
    v += __builtin_bit_cast(float, __builtin_amdgcn_update_dpp(0, __builtin_bit_cast(int, v), 0x143, 0xc, 0xf, true));
    return __builtin_bit_cast(float, __builtin_amdgcn_readlane(__builtin_bit_cast(int, v), 63));
}
__device__ __forceinline__ unsigned pkh(float lo, float hi) { return pg::pkh(lo, hi); }
__device__ __forceinline__ float h2f(unsigned short h) { return (float)__builtin_bit_cast(_Float16, h); }

template <class RowMap>
__device__ __forceinline__ void transpose_item(const float* W, int K, int N, h16* WT, const RowMap& rm, LAS float* scr, int item, int lane) {
    const int nblk = N / 32, kb = item / nblk, nb = item % nblk, k0 = 64 * kb, n0 = 32 * nb;
#pragma unroll 8
    for (int i = 0; i < 32; ++i) { const int kk = 2 * i + (lane >> 5); scr[kk * 33 + (lane & 31)] = W[(size_t)(k0 + kk) * N + n0 + (lane & 31)]; }
    LDS_WAIT(); asm volatile("" ::: "memory");
    const int c = lane & 7;
#pragma unroll
    for (int j = 0; j < 4; ++j) { const int n = (lane >> 3) + 8 * j; const LAS float* s = scr + (8 * c) * 33 + n;
        v4u o; o.x = pkh(s[0 * 33], s[1 * 33]); o.y = pkh(s[2 * 33], s[3 * 33]); o.z = pkh(s[4 * 33], s[5 * 33]); o.w = pkh(s[6 * 33], s[7 * 33]);
        const long dr = rm(n0 + n);
        if (dr >= 0) *(GAS v4u*)(WT + (size_t)dr * K + k0 + 8 * c) = o; }
    LDS_WAIT(); asm volatile("" ::: "memory");
}
struct RmIdent { int off; __device__ __forceinline__ long operator()(int n) const { return off + n; } };
struct RmW1 { __device__ __forceinline__ long operator()(int n) const { const int j = n & 1023; return 256 * (j >> 7) + (n >> 10) * 128 + (j & 127); } };
struct RmRange { int lo, hi, off; __device__ __forceinline__ long operator()(int n) const { return (n >= lo && n < hi) ? (long)(off + n - lo) : -1; } };

__device__ __forceinline__ void ph_convert_moe(const Params& p, Frame& F, int layer) {
    LAS float* scr = (LAS float*)(F.lds + RING_OFF + F.wave * 16384);
    const int gw = F.vcu * NWAVES + F.wave, NGW = F.G * NWAVES;
    constexpr int I1 = (1024 / 64) * (2048 / 32), I2 = (1024 / 64) * (1024 / 32);
    const float* w1 = p.w_exp_in + (size_t)layer * 32 * 1024 * 2048; const float* w2 = p.w_exp_out + (size_t)layer * 32 * 1024 * 1024;
    h16* w1t = p.w1_t + (size_t)layer * 32 * 2048 * 1024; h16* w2t = p.w2_t + (size_t)layer * 32 * 1024 * 1024;
    for (int it = gw; it < 32 * (I1 + I2); it += NGW) {
        if (it < 32 * I1) { const int e = it / I1, r = it % I1; transpose_item(w1 + (size_t)e * 1024 * 2048, 1024, 2048, w1t + (size_t)e * 2048 * 1024, RmW1{}, scr, r, F.lane); }
        else { const int q = it - 32 * I1, e = q / I2, r = q % I2; transpose_item(w2 + (size_t)e * 1024 * 1024, 1024, 1024, w2t + (size_t)e * 1024 * 1024, RmIdent{0}, scr, r, F.lane); }
    }
}
__device__ __forceinline__ void ph_cvt_rows(const float* src, h16* dst, size_t n, Frame& F) {
    const size_t stride = (size_t)F.G * 512 * 8;
    for (size_t i0 = ((size_t)blockIdx.x * 512 + F.tid) * 8; i0 < n; i0 += 4 * stride) {
        f32x4 a[4], b[4];
#pragma unroll
        for (int u = 0; u < 4; ++u) { const size_t i = i0 + u * stride; if (i < n) { a[u] = *(const GAS f32x4*)(src + i); b[u] = *(const GAS f32x4*)(src + i + 4); } }
#pragma unroll
        for (int u = 0; u < 4; ++u) { const size_t i = i0 + u * stride; if (i < n) { v4u o; o.x = pkh(a[u].x, a[u].y); o.y = pkh(a[u].z, a[u].w); o.z = pkh(b[u].x, b[u].y); o.w = pkh(b[u].z, b[u].w); *(GAS v4u*)(dst + i) = o; } }
    }
}

__device__ __forceinline__ void ph_rank(const Params& p, Frame& F) {
    LAS int* se = (LAS int*)(F.lds + RING_OFF);
    for (int cc = blockIdx.x; cc < T_ / 128; cc += F.G) {
        __syncthreads();
        const int j = F.tid; const int e = p.top_e[cc * 512 + j];
        se[j] = e;
        __syncthreads();
        int r = 0;
        for (int q = 0; q < j; ++q) r += (se[q] == e) ? 1 : 0;
        p.rankp[cc * 512 + j] = r;
        if (j < 32) { int c = 0; for (int q = 0; q < 512; ++q) c += (se[q] == j) ? 1 : 0; p.wg_cnt[cc * 32 + j] = c; }
    }
}
__device__ __forceinline__ void ph_assign(const Params& p, Frame& F, int layer) {
    LAS int* tot = (LAS int*)(F.lds + RING_OFF);
    LAS int* bef = tot + 512;
    LAS int* tst = bef + 512;
    LAS int* bas = tst + 64;
    LAS int* ttl = bas + 32;
    for (int cc = blockIdx.x; cc < T_ / 128; cc += F.G) {
        __syncthreads();
        { const int e = F.tid & 31, part = F.tid >> 5; int s = 0, b = 0;
          for (int c2 = part * 16; c2 < part * 16 + 16; ++c2) { const int v = p.wg_cnt[c2 * 32 + e]; s += v; b += (c2 < cc) ? v : 0; }
          tot[part * 32 + e] = s; bef[part * 32 + e] = b; }
        __syncthreads();
        if (F.tid < 32) { int s = 0, b = 0; for (int q = 0; q < 16; ++q) { s += tot[q * 32 + F.tid]; b += bef[q * 32 + F.tid]; } ttl[F.tid] = s; bas[F.tid] = b; }
        __syncthreads();
        if (F.tid == 0) { int ts = 0; for (int e = 0; e < 32; ++e) { tst[e] = ts; ts += (ttl[e] + 255) >> 8; } tst[32] = ts; }
        __syncthreads();
        { const int j = F.tid, ent = cc * 512 + j, e = p.top_e[ent]; const int sl = 256 * tst[e] + bas[e] + p.rankp[ent];
          p.slot_tok[sl] = ent >> 2; p.slot_gate[sl] = p.top_g[ent]; p.inv[ent] = sl; }
        if (cc < 32) { const int e = cc; for (int sl = 256 * tst[e] + ttl[e] + F.tid; sl < 256 * tst[e + 1]; sl += 512) { p.slot_tok[sl] = 0; p.slot_gate[sl] = 0.f; } }
        if (cc == 0) { for (int rt = F.tid; rt < tst[32]; rt += 512) { int e = 0; for (int q = 1; q < 32; ++q) e += (tst[q] <= rt) ? 1 : 0; p.tile_e[rt] = e; }
            if (F.tid == 0) __hip_atomic_store(F.ctl + CW_NTILES + 64 * layer, (unsigned)tst[32], RLX_AGENT); }
    }
}

constexpr int MOE_MAXU = 20;
#ifndef MOE_F8_L0
#define MOE_F8_L0 1
#endif
constexpr int F8_FROM = MOE_F8_L0 ? 0 : 32;
struct MoeSched {
    const char* abase; const char* wbase; LAS const int* lt_e; LAS const int* lt_tok; int ntiles, nct_log, G, c; size_t a_tile_bytes, w_expert_bytes, w_tile_bytes;
    __device__ __forceinline__ bool next(int i, pg::Unit& u) const {
        const int L = i * G + c; if (L >= (ntiles << nct_log) || i >= MOE_MAXU) return false;
        const int rt = L >> nct_log, ct = L & ((1 << nct_log) - 1);
        const int e = __builtin_amdgcn_readfirstlane(lt_e[i]);
        u.a = abase + (size_t)rt * a_tile_bytes; u.b = wbase + (size_t)e * w_expert_bytes + (size_t)ct * w_tile_bytes; u.pm = rt; u.pn = ct; u.e = e; u.x = i; return true;
    }
    __device__ __forceinline__ unsigned arow(const pg::Unit& u, int r) const { return (unsigned)lt_tok[u.x * 256 + r]; }
};
__device__ __forceinline__ void moe_tables(Frame& F, const int* tile_e, const int* slot_tok, int ntiles, int nct_log, bool gather) {
    LAS int* lt_e = (LAS int*)(F.lds + TAB_OFF); LAS int* lt_tok = lt_e + 32;
    __syncthreads();
    for (int i = 0; i < MOE_MAXU; ++i) { const int L = i * F.G + F.vcu; if (L >= (ntiles << nct_log)) break; const int rt = L >> nct_log;
        if (F.tid == 0) lt_e[i] = tile_e[rt];
        if (gather && F.tid < 256) lt_tok[i * 256 + F.tid] = slot_tok[rt * 256 + F.tid]; }
    __syncthreads();
}
struct EpiSwiglu : pg::EpiBase {
    static constexpr bool PERM = true;
    h16* act; const float* b1;
    __device__ __forceinline__ void operator()(const pg::Acc& acc, const pg::Unit& u, int wr, int wc, int fr, int fq) const { EPI_OPAQUE();
        const int c0 = u.pn * 128 + wc * 32 + 8 * fq;
        const float* bg = b1 + (size_t)u.e * 2048 + c0; const float* bl = bg + 1024;
        const f32x4 g0 = *(const f32x4*)bg, g1 = *(const f32x4*)(bg + 4), l0 = *(const f32x4*)bl, l1 = *(const f32x4*)(bl + 4);
#pragma unroll
        for (int ai = 0; ai < 2; ++ai)
#pragma unroll
            for (int m = 0; m < 4; ++m) {
                const size_t row = (size_t)u.pm * 256 + ai * 128 + wr * 64 + m * 16 + fr;
                float r[8];
#pragma unroll
                for (int n = 0; n < 2; ++n)
#pragma unroll
                    for (int j = 0; j < 4; ++j) {
                        const float glu = fminf(acc[ai][0][m][n][j] + (n ? g1[j] : g0[j]), 7.0f);
                        const float lin = fminf(fmaxf(acc[ai][1][m][n][j] + (n ? l1[j] : l0[j]), -7.0f), 7.0f);
                        r[n * 4 + j] = glu * __builtin_amdgcn_rcpf(1.0f + __builtin_amdgcn_exp2f(-1.702f * 1.4426950408889634f * glu)) * (lin + 1.0f);
                    }
                v4u w; w.x = pkh(r[0], r[1]); w.y = pkh(r[2], r[3]); w.z = pkh(r[4], r[5]); w.w = pkh(r[6], r[7]);
                *(v4u*)(act + row * 1024 + c0) = w;
            }
    }
};
template <int VAR> struct EpiSwigluP : pg::EpiBase {
    static constexpr bool PERM = true;
    h16* act; const float* b1;
    __device__ __forceinline__ void operator()(const pg::Acc& acc, const pg::Unit& u, int wr, int wc, int fr, int fq) const { EPI_OPAQUE();
        const int c0 = u.pn * 128 + wc * 32 + 8 * fq;
        const float* bg = b1 + (size_t)u.e * 2048 + c0; const float* bl = bg + 1024;
        const f32x4 g0 = *(const f32x4*)bg, g1 = *(const f32x4*)(bg + 4), l0 = *(const f32x4*)bl, l1 = *(const f32x4*)(bl + 4);
#pragma unroll
        for (int ai = 0; ai < 2; ++ai)
#pragma unroll
            for (int m = 0; m < 4; ++m) {
                const size_t row = (size_t)u.pm * 256 + ai * 128 + wr * 64 + m * 16 + fr;
                float r[8];
#pragma unroll
                for (int n = 0; n < 2; ++n)
#pragma unroll
                    for (int j = 0; j < 4; ++j) {
                        const float glu = fminf(acc[ai][0][m][n][j] + (n ? g1[j] : g0[j]), 7.0f);
                        const float lin = fminf(fmaxf(acc[ai][1][m][n][j] + (n ? l1[j] : l0[j]), -7.0f), 7.0f);
                        r[n * 4 + j] = (VAR == 2) ? glu + lin : glu * __builtin_amdgcn_rcpf(1.0f + __builtin_amdgcn_exp2f(-1.702f * 1.4426950408889634f * glu)) * (lin + 1.0f);
                    }
                v4u w; w.x = pkh(r[0], r[1]); w.y = pkh(r[2], r[3]); w.z = pkh(r[4], r[5]); w.w = pkh(r[6], r[7]);
                if (VAR == 1) { asm volatile("" :: "v"(w.x), "v"(w.y), "v"(w.z), "v"(w.w)); } else { *(v4u*)(act + row * 1024 + c0) = w; }
            }
    }
};
struct EpiMoeOut : pg::EpiBase {
    static constexpr bool PERM = true;
    h16* __restrict__ y; const float* __restrict__ b2; const float* __restrict__ gate;
    __device__ __forceinline__ void operator()(const pg::Acc& acc, const pg::Unit& u, int wr, int wc, int fr, int fq) const { EPI_OPAQUE();
        float gt[2][4]; f32x4 bv[2][2];
#pragma unroll
        for (int ai = 0; ai < 2; ++ai)
#pragma unroll
            for (int m = 0; m < 4; ++m) gt[ai][m] = gate[(size_t)u.pm * 256 + ai * 128 + wr * 64 + m * 16 + fr];
#pragma unroll
        for (int bj = 0; bj < 2; ++bj) { const float* bp = b2 + (size_t)u.e * 1024 + u.pn * 256 + bj * 128 + wc * 32 + 8 * fq; bv[bj][0] = *(const f32x4*)bp; bv[bj][1] = *(const f32x4*)(bp + 4); }
#pragma unroll
        for (int ai = 0; ai < 2; ++ai)
#pragma unroll
            for (int m = 0; m < 4; ++m) {
                const size_t row = (size_t)u.pm * 256 + ai * 128 + wr * 64 + m * 16 + fr;
#pragma unroll
                for (int bj = 0; bj < 2; ++bj) {
                    const int c0 = u.pn * 256 + bj * 128 + wc * 32 + 8 * fq;
                    const f32x4 v0 = (acc[ai][bj][m][0] + bv[bj][0]) * gt[ai][m], v1 = (acc[ai][bj][m][1] + bv[bj][1]) * gt[ai][m];
                    v4u w; w.x = pkh(v0[0], v0[1]); w.y = pkh(v0[2], v0[3]); w.z = pkh(v1[0], v1[1]); w.w = pkh(v1[2], v1[3]);
                    *(v4u*)(y + row * 1024 + c0) = w;
                }
            }
    }
};
template <bool Y8> __device__ __forceinline__ void ph_combine_ln(const Params& p, Frame& F, const h16* xprev, const float* gam, const float* bet, float* outf, h16* outh) {
    int lane = F.lane; asm volatile("" : "+v"(lane));
    const int gw = F.vcu * NWAVES + F.wave, NGW = F.G * NWAVES;
    constexpr int NT = Y8 ? 4 : 3;
    for (int tb = gw * NT; tb < T_; tb += NGW * NT) {
        v4u xw[NT][2], yw[Y8 ? 1 : NT][2][4]; v2u yq[Y8 ? NT : 1][2][4];
#pragma unroll
        for (int u = 0; u < NT; ++u) { const int t = tb + u < T_ ? tb + u : T_ - 1; int sl[4];
#pragma unroll
            for (int k = 0; k < 4; ++k) sl[k] = p.inv[t * 4 + k];
#pragma unroll
            for (int j = 0; j < 2; ++j) { const int c = 8 * lane + 512 * j; xw[u][j] = *(const GAS v4u*)(xprev + (size_t)t * 1024 + c);
#pragma unroll
                for (int k = 0; k < 4; ++k) { if constexpr (Y8) yq[u][j][k] = *(const GAS v2u*)((const unsigned char*)p.yy + (size_t)sl[k] * 1024 + c); else yw[u][j][k] = *(const GAS v4u*)(p.yy + (size_t)sl[k] * 1024 + c); } } }
#pragma unroll
        for (int u = 0; u < NT; ++u) { const int t = tb + u; if (t >= T_) break;
            float v[16]; float s = 0.f;
#pragma unroll
            for (int j = 0; j < 2; ++j) { const v4u x4 = xw[u][j];
                float a[8] = {h2f(x4.x & 0xffff) * ALPHA_, h2f(x4.x >> 16) * ALPHA_, h2f(x4.y & 0xffff) * ALPHA_, h2f(x4.y >> 16) * ALPHA_, h2f(x4.z & 0xffff) * ALPHA_, h2f(x4.z >> 16) * ALPHA_, h2f(x4.w & 0xffff) * ALPHA_, h2f(x4.w >> 16) * ALPHA_};
#pragma unroll
                for (int k = 0; k < 4; ++k) {
                    if constexpr (Y8) { const v2u w8 = yq[u][j][k]; const f32x2v p0 = __builtin_amdgcn_cvt_pk_f32_fp8((int)w8.x, false), p1 = __builtin_amdgcn_cvt_pk_f32_fp8((int)w8.x, true), p2 = __builtin_amdgcn_cvt_pk_f32_fp8((int)w8.y, false), p3 = __builtin_amdgcn_cvt_pk_f32_fp8((int)w8.y, true);
                        a[0] += p0.x * 0.03125f; a[1] += p0.y * 0.03125f; a[2] += p1.x * 0.03125f; a[3] += p1.y * 0.03125f; a[4] += p2.x * 0.03125f; a[5] += p2.y * 0.03125f; a[6] += p3.x * 0.03125f; a[7] += p3.y * 0.03125f; }
                    else { const v4u w = yw[u][j][k];
                    a[0] += h2f(w.x & 0xffff); a[1] += h2f(w.x >> 16); a[2] += h2f(w.y & 0xffff); a[3] += h2f(w.y >> 16);
                    a[4] += h2f(w.z & 0xffff); a[5] += h2f(w.z >> 16); a[6] += h2f(w.w & 0xffff); a[7] += h2f(w.w >> 16); } }
#pragma unroll
                for (int q = 0; q < 8; ++q) { v[j * 8 + q] = a[q]; s += a[q]; } }
            const float mean = wave_sum(s) * (1.0f / 1024.0f); float qq = 0.f;
#pragma unroll
            for (int q = 0; q < 16; ++q) { v[q] -= mean; qq += v[q] * v[q]; }
            const float rstd = 1.0f / sqrtf(wave_sum(qq) * (1.0f / 1024.0f) + LN_EPS_);
#pragma unroll
            for (int j = 0; j < 2; ++j) {
                const int c = 8 * lane + 512 * j;
                const f32x4 ga = *(const GAS f32x4*)(gam + c), gb = *(const GAS f32x4*)(gam + c + 4), ba = *(const GAS f32x4*)(bet + c), bb = *(const GAS f32x4*)(bet + c + 4);
                f32x4 oa, ob;
                oa.x = v[j * 8 + 0] * rstd * ga.x + ba.x; oa.y = v[j * 8 + 1] * rstd * ga.y + ba.y; oa.z = v[j * 8 + 2] * rstd * ga.z + ba.z; oa.w = v[j * 8 + 3] * rstd * ga.w + ba.w;
                ob.x = v[j * 8 + 4] * rstd * gb.x + bb.x; ob.y = v[j * 8 + 5] * rstd * gb.y + bb.y; ob.z = v[j * 8 + 6] * rstd * gb.z + bb.z; ob.w = v[j * 8 + 7] * rstd * gb.w + bb.w;
                if (outf) { *(GAS f32x4*)(outf + (size_t)t * 1024 + c) = oa; *(GAS f32x4*)(outf + (size_t)t * 1024 + c + 4) = ob; }
                if (outh) { v4u w; w.x = pkh(oa.x, oa.y); w.y = pkh(oa.z, oa.w); w.z = pkh(ob.x, ob.y); w.w = pkh(ob.z, ob.w); *(GAS v4u*)(outh + (size_t)t * 1024 + c) = w; }
            } }
    }
}
struct CvJob { const float* src; h16* dst; int K, N, n_off, n_cnt, row_off, w1map, f8; };
__device__ __forceinline__ void cv_load(const CvJob& j, int item, int lane, float (&ld)[32]) {
    const int nblk = j.n_cnt / 32, kb = item / nblk, nb = item % nblk, k0 = 64 * kb, n0 = j.n_off + 32 * nb;
#pragma unroll
    for (int i = 0; i < 32; ++i) { const int kk = 2 * i + (lane >> 5); ld[i] = j.src[(size_t)(k0 + kk) * j.N + n0 + (lane & 31)]; }
}
__device__ __forceinline__ void cv_finish(const CvJob& j, LAS float* scr, int item, int lane, const float (&ld)[32]) {
    const int nblk = j.n_cnt / 32, kb = item / nblk, nb = item % nblk, k0 = 64 * kb, n0 = j.n_off + 32 * nb;
#pragma unroll
    for (int i = 0; i < 32; ++i) { const int kk = 2 * i + (lane >> 5); scr[kk * 33 + (lane & 31)] = ld[i]; }
    LDS_WAIT(); asm volatile("" ::: "memory");
    const int c = lane & 7;
#pragma unroll
    for (int q = 0; q < 4; ++q) { const int n = (lane >> 3) + 8 * q; const LAS float* s = scr + (8 * c) * 33 + n;
        const int nn = n0 + n - j.n_off; const int jj = nn & 1023;
        const long dr = j.w1map ? (long)(256 * (jj >> 7) + (nn >> 10) * 128 + (jj & 127)) : (long)(j.row_off + nn);
        if (j.f8) { int lo = 0, hi = 0;
            lo = __builtin_amdgcn_cvt_pk_fp8_f32(s[0 * 33] * 32.f, s[1 * 33] * 32.f, lo, false); lo = __builtin_amdgcn_cvt_pk_fp8_f32(s[2 * 33] * 32.f, s[3 * 33] * 32.f, lo, true);
            hi = __builtin_amdgcn_cvt_pk_fp8_f32(s[4 * 33] * 32.f, s[5 * 33] * 32.f, hi, false); hi = __builtin_amdgcn_cvt_pk_fp8_f32(s[6 * 33] * 32.f, s[7 * 33] * 32.f, hi, true);
            v2u o8; o8.x = (unsigned)lo; o8.y = (unsigned)hi; *(GAS v2u*)((unsigned char*)j.dst + (size_t)dr * j.K + k0 + 8 * c) = o8; }
        else { v4u o; o.x = pkh(s[0 * 33], s[1 * 33]); o.y = pkh(s[2 * 33], s[3 * 33]); o.z = pkh(s[4 * 33], s[5 * 33]); o.w = pkh(s[6 * 33], s[7 * 33]);
            *(GAS v4u*)(j.dst + (size_t)dr * j.K + k0 + 8 * c) = o; } }
    LDS_WAIT(); asm volatile("" ::: "memory");
}
__device__ __forceinline__ int cv_decode(const Params& p, int it, CvJob& j) {
    constexpr int J1 = 1024, J2 = 1024, J3 = 1024, J4 = 1024, J5 = 640, J6 = 512, I1 = 1024, I2 = 512;
    int r = it;
    if (r < J1) { j = CvJob{p.w_ret_in, p.wri_t, 1024, 6144, 0, 2048, 0, 0, 0}; }
    else if ((r -= J1) < J2) { j = CvJob{p.w_ret_in, p.wri_t, 1024, 6144, 4096, 2048, 2048, 0, 0}; }
    else if ((r -= J2) < J3) { j = CvJob{p.w_ret_in, p.wfm_t, 1024, 6144, 2048, 2048, 0, 0, 0}; }
    else if ((r -= J3) < J4) { j = CvJob{p.w_ret_out, p.wro_t, 2048, 1024, 0, 1024, 0, 0, 0}; }
    else if ((r -= J4) < J5) { j = CvJob{p.w_swa_in, p.wsi_t, 1024, 1280, 0, 1280, 0, 0, 0}; }
    else if ((r -= J5) < J6) { j = CvJob{p.w_swa_out, p.wso_t, 1024, 1024, 0, 1024, 0, 0, 0}; }
    else if ((r -= J6) < 64 * I1) { const int e = r / I1; r %= I1; if (e < F8_FROM) j = CvJob{p.w_exp_in + (size_t)e * 1024 * 2048, p.w1_t + (size_t)e * 2048 * 1024, 1024, 2048, 0, 2048, 0, 1, 0};
        else j = CvJob{p.w_exp_in + (size_t)e * 1024 * 2048, (h16*)(p.w1q + (size_t)e * 2048 * 1024), 1024, 2048, 0, 2048, 0, 1, 1}; }
    else { r -= 64 * I1; const int e = r / I2; r %= I2; if (e < F8_FROM) j = CvJob{p.w_exp_out + (size_t)e * 1024 * 1024, p.w2_t + (size_t)e * 1024 * 1024, 1024, 1024, 0, 1024, 0, 0, 0};
        else j = CvJob{p.w_exp_out + (size_t)e * 1024 * 1024, (h16*)(p.w2q + (size_t)e * 1024 * 1024), 1024, 1024, 0, 1024, 0, 0, 1}; }
    return r;
}
__device__ __forceinline__ void ph_prologue(const Params& p, Frame& F) {
    LAS float* scr = (LAS float*)(F.lds + RING_OFF + F.wave * 16384);
    const int gw = F.vcu * NWAVES + F.wave, NGW = F.G * NWAVES;
    constexpr int NITEMS = 1024 + 1024 + 1024 + 1024 + 640 + 512 + 64 * (1024 + 512);
    int it = gw; CvJob j0, j1; int r0 = 0, r1 = 0; float ld0[32], ld1[32];
    if (it < NITEMS) { r0 = cv_decode(p, it, j0); cv_load(j0, r0, F.lane, ld0); }
    while (it < NITEMS) {
        const int nit = it + NGW; const bool hn = nit < NITEMS;
        if (hn) { r1 = cv_decode(p, nit, j1); cv_load(j1, r1, F.lane, ld1); }
        cv_finish(j0, scr, r0, F.lane, ld0);
        j0 = j1; r0 = r1;
#pragma unroll
        for (int i = 0; i < 32; ++i) ld0[i] = ld1[i];
        it = nit;
    }
    ph_cvt_rows(p.x, p.xh0, (size_t)T_ * D_, F);
}

struct DenseSched {
    const char* A; const char* B; size_t a_tile_bytes, b_tile_bytes; int nM, nN, nwg, G, c;
    __device__ __forceinline__ void init(const void* A_, int lda, const void* B_, int ldb, int M, int N, int G_, int c_, int rot = 0  ) {
        A = (const char*)A_; B = (const char*)B_; a_tile_bytes = (size_t)256 * lda * 2; b_tile_bytes = (size_t)256 * ldb * 2; nM = M / 256; nN = N / 256; nwg = nM * nN; G = G_; c = (c_ + G_ - rot) % G_; }
    __device__ __forceinline__ bool next(int i, pg::Unit& u) const {
        const long L = (long)i * G + c; if (L >= nwg) return false;
        int wgid = (int)L; { const int q = nwg / 8, r = nwg % 8, xcd = wgid % 8, off = wgid / 8; wgid = (xcd < r ? xcd * (q + 1) : r * (q + 1) + (xcd - r) * q) + off; }
        const int nig = 8 * nN, gid = wgid / nig, fm = gid * 8, gsz = (nM - fm) < 8 ? (nM - fm) : 8;
        u.pm = fm + ((wgid % nig) % gsz); u.pn = (wgid % nig) / gsz; u.e = 0; u.x = 0;
        u.a = A + (size_t)u.pm * a_tile_bytes; u.b = B + (size_t)u.pn * b_tile_bytes; return true;
    }
    __device__ __forceinline__ unsigned arow(const pg::Unit&, int) const { return 0u; }
};
struct EpiResid : pg::EpiBase {
    static constexpr bool PERM = true;
    const h16* __restrict__ xprevh; const float* __restrict__ bias; h16* __restrict__ yh;
    __device__ __forceinline__ void operator()(const pg::Acc& acc, const pg::Unit& u, int wr, int wc, int fr, int fq) const { EPI_OPAQUE();
        f32x4 bv[2][2];
#pragma unroll
        for (int bj = 0; bj < 2; ++bj) { const int col = u.pn * 256 + bj * 128 + wc * 32 + 8 * fq;
            bv[bj][0] = bias ? *(const f32x4*)(bias + col) : (f32x4){0.f, 0.f, 0.f, 0.f}; bv[bj][1] = bias ? *(const f32x4*)(bias + col + 4) : (f32x4){0.f, 0.f, 0.f, 0.f}; }
#pragma unroll
        for (int ai = 0; ai < 2; ++ai) {
            v4u xw[4][2];
#pragma unroll
            for (int m = 0; m < 4; ++m)
#pragma unroll
                for (int bj = 0; bj < 2; ++bj) { const size_t row = (size_t)u.pm * 256 + ai * 128 + wr * 64 + m * 16 + fr; xw[m][bj] = *(const v4u*)(xprevh + row * 1024 + u.pn * 256 + bj * 128 + wc * 32 + 8 * fq); }
#pragma unroll
            for (int m = 0; m < 4; ++m)
#pragma unroll
                for (int bj = 0; bj < 2; ++bj) { const size_t row = (size_t)u.pm * 256 + ai * 128 + wr * 64 + m * 16 + fr; const int col = u.pn * 256 + bj * 128 + wc * 32 + 8 * fq; const v4u x4 = xw[m][bj];
                    const f32x4 a = (f32x4){h2f(x4.x & 0xffff), h2f(x4.x >> 16), h2f(x4.y & 0xffff), h2f(x4.y >> 16)} * ALPHA_ + acc[ai][bj][m][0] + bv[bj][0];
                    const f32x4 b = (f32x4){h2f(x4.z & 0xffff), h2f(x4.z >> 16), h2f(x4.w & 0xffff), h2f(x4.w >> 16)} * ALPHA_ + acc[ai][bj][m][1] + bv[bj][1];
                    v4u w; w.x = pkh(a[0], a[1]); w.y = pkh(a[2], a[3]); w.z = pkh(b[0], b[1]); w.w = pkh(b[2], b[3]);
                    *(v4u*)(yh + row * 1024 + col) = w; } }
    }
};
struct EpiF32 : pg::EpiBase {
    const float* bias; float* c; int ldc;
    __device__ __forceinline__ void operator()(const pg::Acc& acc, const pg::Unit& u, int wr, int wc, int fr, int fq) const { EPI_OPAQUE();
#pragma unroll
        for (int ai = 0; ai < 2; ++ai)
#pragma unroll
            for (int m = 0; m < 4; ++m) { const size_t row = (size_t)u.pm * 256 + ai * 128 + wr * 64 + m * 16 + fr;
#pragma unroll
                for (int bj = 0; bj < 2; ++bj)
#pragma unroll
                    for (int n = 0; n < 2; ++n) { const int col = u.pn * 256 + bj * 128 + wc * 32 + n * 16 + 4 * fq;
                        f32x4 o = acc[ai][bj][m][n]; if (bias) o += *(const f32x4*)(bias + col);
                        *(f32x4*)(c + row * ldc + col) = o; } }
    }
};

constexpr int XROW16 = 1032;
typedef _Float16 f16x8r __attribute__((ext_vector_type(8)));
__device__ __forceinline__ void ph_ln_router(const Params& p, Frame& F, const float* gam, const float* bet, const float* wr, const float* br, unsigned char* xq, const int pmode = 0  ) {
    LAS unsigned short* X = (LAS unsigned short*)(F.lds);
    LAS float* PART = (LAS float*)(X + 32 * XROW16);
    LAS int* se = (LAS int*)(PART + 8 * 32 * 32);
    LAS float* LG = (LAS float*)(se + 512);
    LAS float* TV = LG + 1024;
    LAS int* cnt = (LAS int*)(TV + 128);
    int tid_o = F.tid; asm volatile("" : "+v"(tid_o));
    const int lane = tid_o & 63, w = F.wave, l15 = lane & 15, kg = lane >> 4;
    f16x8r wh[2][4], wl[2][4];
#pragma unroll
    for (int nt = 0; nt < 2; ++nt)
#pragma unroll
        for (int s = 0; s < 4; ++s) {
#pragma unroll
            for (int j = 0; j < 8; ++j) { const float v = wr[(size_t)(128 * w + 32 * s + 8 * kg + j) * 32 + 16 * nt + l15]; const _Float16 h = (_Float16)v; wh[nt][s][j] = h; wl[nt][s][j] = (_Float16)(v - (float)h); } }
    const float bias_e = br[tid_o & 31];
    for (int cc = blockIdx.x; cc < T_ / 128; cc += F.G) {
        v4u pre[4][2];
#pragma unroll
        for (int r = 0; r < 4; ++r)
#pragma unroll
            for (int j = 0; j < 2; ++j) pre[r][j] = *(const GAS v4u*)(p.yh + (size_t)(cc * 128 + 4 * w + r) * 1024 + 8 * lane + 512 * j);
        for (int blk = 0; blk < 4; ++blk) {
            const int t0 = cc * 128 + blk * 32;
            v4u cur[4][2];
#pragma unroll
            for (int r = 0; r < 4; ++r)
#pragma unroll
                for (int j = 0; j < 2; ++j) { cur[r][j] = pre[r][j]; if (blk < 3) pre[r][j] = *(const GAS v4u*)(p.yh + (size_t)(t0 + 32 + 4 * w + r) * 1024 + 8 * lane + 512 * j); }
#pragma unroll
            for (int r = 0; r < 4; ++r) {
                const int tl = 4 * w + r; const size_t t = (size_t)(t0 + tl);
                f32x4 v[4]; float s = 0.f;
#pragma unroll
                for (int j = 0; j < 2; ++j) { const v4u pw = cur[r][j]; v[2 * j] = (f32x4){h2f(pw.x & 0xffff), h2f(pw.x >> 16), h2f(pw.y & 0xffff), h2f(pw.y >> 16)}; v[2 * j + 1] = (f32x4){h2f(pw.z & 0xffff), h2f(pw.z >> 16), h2f(pw.w & 0xffff), h2f(pw.w >> 16)}; }
#pragma unroll
                for (int j = 0; j < 4; ++j) s += (v[j].x + v[j].y) + (v[j].z + v[j].w);
                const float mean = wave_sum(s) * (1.0f / 1024.0f); float q = 0.f;
#pragma unroll
                for (int j = 0; j < 4; ++j) { v[j] = v[j] - mean; q += (v[j].x * v[j].x + v[j].y * v[j].y) + (v[j].z * v[j].z + v[j].w * v[j].w); }
                const float rstd = 1.0f / sqrtf(wave_sum(q) * (1.0f / 1024.0f) + LN_EPS_);
#pragma unroll
                for (int j = 0; j < 2; ++j) { const int c = 8 * lane + 512 * j;
                    const f32x4 o0 = v[2 * j] * rstd * *(const GAS f32x4*)(gam + c) + *(const GAS f32x4*)(bet + c), o1 = v[2 * j + 1] * rstd * *(const GAS f32x4*)(gam + c + 4) + *(const GAS f32x4*)(bet + c + 4);
                    v4u hw; hw.x = pkh(o0.x, o0.y); hw.y = pkh(o0.z, o0.w); hw.z = pkh(o1.x, o1.y); hw.w = pkh(o1.z, o1.w);
                    *(GAS v4u*)(p.x1h + t * 1024 + c) = hw;
                    if (xq) { int qa = 0, qb = 0; qa = __builtin_amdgcn_cvt_pk_fp8_f32(o0.x, o0.y, qa, false); qa = __builtin_amdgcn_cvt_pk_fp8_f32(o0.z, o0.w, qa, true); qb = __builtin_amdgcn_cvt_pk_fp8_f32(o1.x, o1.y, qb, false); qb = __builtin_amdgcn_cvt_pk_fp8_f32(o1.z, o1.w, qb, true);
                        v2u q8; q8.x = (unsigned)qa; q8.y = (unsigned)qb; *(GAS v2u*)(xq + t * 1024 + c) = q8; }
                    *(LAS v4u*)(X + tl * XROW16 + c) = hw; }
            }
            if (pmode == 1) continue;
            __syncthreads();
            {
                f32x4 acc[2][2];
#pragma unroll
                for (int mt = 0; mt < 2; ++mt)
#pragma unroll
                    for (int nt = 0; nt < 2; ++nt) acc[mt][nt] = (f32x4){0.f, 0.f, 0.f, 0.f};
#pragma unroll
                for (int s = 0; s < 4; ++s)
#pragma unroll
                    for (int mt = 0; mt < 2; ++mt) { const f16x8r a = *(const LAS f16x8r*)(X + (16 * mt + l15) * XROW16 + 128 * w + 32 * s + 8 * kg);
#pragma unroll
                        for (int nt = 0; nt < 2; ++nt) { acc[mt][nt] = __builtin_amdgcn_mfma_f32_16x16x32_f16(a, wh[nt][s], acc[mt][nt], 0, 0, 0); acc[mt][nt] = __builtin_amdgcn_mfma_f32_16x16x32_f16(a, wl[nt][s], acc[mt][nt], 0, 0, 0); } }
#pragma unroll
                for (int mt = 0; mt < 2; ++mt)
#pragma unroll
                    for (int nt = 0; nt < 2; ++nt)
#pragma unroll
                        for (int r = 0; r < 4; ++r) PART[(w * 32 + 16 * mt + 4 * kg + r) * 32 + 16 * nt + l15] = acc[mt][nt][r];
            }
            __syncthreads();
#pragma unroll
            for (int ps = 0; ps < 2; ++ps) {
                const int tok = (tid_o >> 5) + 16 * ps, e = tid_o & 31; float val = bias_e;
#pragma unroll
                for (int q = 0; q < 8; ++q) val += PART[(q * 32 + tok) * 32 + e];
                LG[tok * 32 + e] = val;
                LDS_WAIT(); asm volatile("" ::: "memory");
                int rank = 0;
#pragma unroll
                for (int q4 = 0; q4 < 8; ++q4) { const f32x4 o = *(const LAS f32x4*)(LG + tok * 32 + 4 * q4);
                    rank += ((o.x > val) || (o.x == val && 4 * q4 < e)) ? 1 : 0; rank += ((o.y > val) || (o.y == val && 4 * q4 + 1 < e)) ? 1 : 0;
                    rank += ((o.z > val) || (o.z == val && 4 * q4 + 2 < e)) ? 1 : 0; rank += ((o.w > val) || (o.w == val && 4 * q4 + 3 < e)) ? 1 : 0; }
                const int t = t0 + tok;
                if (rank < 4) { TV[tok * 4 + rank] = val; p.top_e[t * 4 + rank] = e; se[(blk * 32 + tok) * 4 + rank] = e; }
                LDS_WAIT(); asm volatile("" ::: "memory");
                if (e < 4) { const f32x4 tv = *(const LAS f32x4*)(TV + tok * 4);
                    const float e1 = __expf(tv.y - tv.x), e2 = __expf(tv.z - tv.x), e3 = __expf(tv.w - tv.x); const float inv = 1.0f / (1.0f + e1 + e2 + e3);
                    p.top_g[t * 4 + e] = (e == 0 ? 1.0f : (e == 1 ? e1 : (e == 2 ? e2 : e3))) * inv; }
            }
        }
        __syncthreads();
        if (pmode == 0) {
            const int j = tid_o; const int e = se[j]; int r = 0;
            if (j < 32) cnt[j] = 0;
            __syncthreads();
#pragma unroll 8
            for (int q4 = 0; q4 < 128; ++q4) { const v4u sv = *(const LAS v4u*)(se + 4 * q4);
                r += ((int)sv.x == e && 4 * q4 < j) ? 1 : 0; r += ((int)sv.y == e && 4 * q4 + 1 < j) ? 1 : 0; r += ((int)sv.z == e && 4 * q4 + 2 < j) ? 1 : 0; r += ((int)sv.w == e && 4 * q4 + 3 < j) ? 1 : 0; }
            p.rankp[cc * 512 + j] = r;
            atomicAdd((int*)(cnt + e), 1);
            __syncthreads();
            if (j < 32) p.wg_cnt[cc * 32 + j] = cnt[j];
        }
        __syncthreads();
    }
}

__device__ __forceinline__ float lg2gamma(int h) { return h == 0 ? -0.04580368961312479f : (h == 1 ? -0.02272007650008353f : (h == 2 ? -0.011315313227834146f : -0.005646563141142063f)); }
struct EpiInTok : pg::EpiBase {
    static constexpr bool PERM = true;
    h16 *q, *k, *sg;
    __device__ __forceinline__ void operator()(const pg::Acc& acc, const pg::Unit& u, int wr, int wc, int fr, int fq) const { EPI_OPAQUE();
        const int pn = u.pn; h16* dst; int ld, cb; int mode;
        if (pn < 4) { dst = q; ld = 1024; cb = pn * 256; mode = 0; } else if (pn < 8) { dst = k; ld = 1024; cb = (pn - 4) * 256; mode = 1; } else { dst = sg; ld = 2048; cb = (pn - 8) * 256; mode = 2; }
#pragma unroll
        for (int ai = 0; ai < 2; ++ai)
#pragma unroll
            for (int m = 0; m < 4; ++m) { const size_t row = (size_t)u.pm * 256 + ai * 128 + wr * 64 + m * 16 + fr;
#pragma unroll
                for (int bj = 0; bj < 2; ++bj) { const int c0 = cb + bj * 128 + wc * 32 + 8 * fq; float r[8];
#pragma unroll
                    for (int n = 0; n < 2; ++n)
#pragma unroll
                        for (int j = 0; j < 4; ++j) { float v = acc[ai][bj][m][n][j];
                            if (mode == 1) v *= 0.0625f;
                            if (mode == 2) v = v * __builtin_amdgcn_rcpf(1.0f + __builtin_amdgcn_exp2f(-1.4426950408889634f * v));
                            r[n * 4 + j] = v; }
                    v4u w; w.x = pkh(r[0], r[1]); w.y = pkh(r[2], r[3]); w.z = pkh(r[4], r[5]); w.w = pkh(r[6], r[7]);
                    *(v4u*)(dst + row * ld + c0) = w; } }
    }
};
struct EpiInFeat : pg::EpiBase {
    static constexpr bool PERM = true;
    h16* __restrict__ vt;
    __device__ __forceinline__ void operator()(const pg::Acc& acc, const pg::Unit& u, int wr, int wc, int fr, int fq) const { EPI_OPAQUE();
        h16* dst = vt + ((size_t)u.pn * 2048 + (size_t)u.pm * 256) * 256;
#pragma unroll
        for (int bj = 0; bj < 2; ++bj) { const int c0 = bj * 128 + wc * 32 + 8 * fq;
#pragma unroll
            for (int ai = 0; ai < 2; ++ai)
#pragma unroll
                for (int m = 0; m < 4; ++m) { const size_t row = (size_t)(ai * 128 + wr * 64 + m * 16 + fr);
                    const f32x4 a = acc[ai][bj][m][0], b = acc[ai][bj][m][1];
                    v4u w; w.x = pkh(a[0], a[1]); w.y = pkh(a[2], a[3]); w.z = pkh(b[0], b[1]); w.w = pkh(b[2], b[3]);
                    *(v4u*)(dst + row * 256 + c0) = w; } }
    }
};
constexpr int KT_PITCH = 520;
__device__ __forceinline__ void ph_ktranspose(const Params& p, Frame& F) {
    LAS unsigned char* img = F.lds;
    for (int item = F.vcu; item < 512; item += F.G) {
        const int chunk = item >> 2, h = item & 3;
        __syncthreads();
        v4u ld[16];
#pragma unroll
        for (int i = 0; i < 16; ++i) { const int pc = F.tid + 512 * i, row = pc >> 5, c16 = pc & 31; ld[i] = *(const GAS v4u*)(p.k + ((size_t)(chunk * 256 + row)) * 1024 + h * 256 + c16 * 8); }
#pragma unroll
        for (int i = 0; i < 16; ++i) { const int pc = F.tid + 512 * i, row = pc >> 5, c16 = pc & 31; v2u lo; lo.x = ld[i].x; lo.y = ld[i].y; v2u hi; hi.x = ld[i].z; hi.y = ld[i].w;
            *(LAS v2u*)(img + row * KT_PITCH + c16 * 16) = lo; *(LAS v2u*)(img + row * KT_PITCH + c16 * 16 + 8) = hi; }
        __syncthreads();
        const int tg = F.tid & 31; const float lg = lg2gamma(h); float sc[8];
#pragma unroll
        for (int j = 0; j < 8; ++j) sc[j] = __builtin_amdgcn_exp2f((float)(255 - (8 * tg + j)) * lg);
        h16* dst = p.kdt + ((size_t)chunk * 1024 + h * 256) * 256;
#pragma unroll 4
        for (int r = 0; r < 16; ++r) { const int dk = (F.tid >> 5) + 16 * r; float v[8];
#pragma unroll
            for (int j = 0; j < 8; ++j) v[j] = h2f(*(const LAS unsigned short*)(img + (8 * tg + j) * KT_PITCH + dk * 2)) * sc[j];
            v4u w; w.x = pkh(v[0], v[1]); w.y = pkh(v[2], v[3]); w.z = pkh(v[4], v[5]); w.w = pkh(v[6], v[7]);
            *(GAS v4u*)(dst + (size_t)dk * 256 + 8 * tg) = w; }
    }
    __syncthreads();
}
struct RaSched {
    const h16 *q, *k; int G, c;
    __device__ __forceinline__ bool next(int i, pg::Unit& u) const {
        const int L = i * G + c; if (L >= 512) return false;
        const int bh = L >> 5, cch = L & 31, b = bh >> 2, h = bh & 3; const size_t off = ((size_t)(b * 8192 + cch * 256) * 1024 + h * 256) * 2;
        u.a = (const char*)q + off; u.b = (const char*)k + off; u.pm = L; u.pn = 0; u.e = L; u.x = h; return true; }
    __device__ __forceinline__ unsigned arow(const pg::Unit&, int) const { return 0u; }
};
struct EpiPP : pg::EpiBase {
    static constexpr bool PERM = true;
    h16* pp;
    __device__ __forceinline__ void operator()(const pg::Acc& acc, const pg::Unit& u, int wr, int wc, int fr, int fq) const { EPI_OPAQUE();
        const float lg = lg2gamma(u.x); h16* dst = pp + (size_t)u.e * 65536;
#pragma unroll
        for (int bj = 0; bj < 2; ++bj) { const int c0 = bj * 128 + wc * 32 + 8 * fq; float sc[8];
#pragma unroll
            for (int j = 0; j < 8; ++j) sc[j] = __builtin_amdgcn_exp2f(-(float)(c0 + j + 1) * lg);
#pragma unroll
            for (int ai = 0; ai < 2; ++ai)
#pragma unroll
                for (int m = 0; m < 4; ++m) { const int i = ai * 128 + wr * 64 + m * 16 + fr; float r[8];
#pragma unroll
                    for (int n = 0; n < 2; ++n)
#pragma unroll
                        for (int j = 0; j < 4; ++j) r[n * 4 + j] = (c0 + n * 4 + j <= i) ? acc[ai][bj][m][n][j] * sc[n * 4 + j] : 0.f;
                    v4u w; w.x = pkh(r[0], r[1]); w.y = pkh(r[2], r[3]); w.z = pkh(r[4], r[5]); w.w = pkh(r[6], r[7]);
                    *(v4u*)(dst + (size_t)i * 256 + c0) = w; } }
    }
};
struct R1Sched {
    const h16 *vt, *kdt; int nsub, G, c;
    __device__ __forceinline__ bool next(int i, pg::Unit& u) const {
        const int item = (i / nsub) * G + c, j = i % nsub; if (item >= 256) return false;
        if (nsub == 4 && ((item >> 1) & 7) == 7) return false;
        const int pm = item & 1, seg = (item >> 1) & 7, bh = item >> 4, b = bh >> 2, h = bh & 3; const size_t chunk = (size_t)b * 32 + seg * 4 + j;
        u.a = (const char*)vt + ((chunk * 2048 + h * 512 + pm * 256) * 256) * 2; u.b = (const char*)kdt + ((chunk * 1024 + h * 256) * 256) * 2;
        u.pm = pm; u.pn = j; u.e = item; u.x = h; return true; }
    __device__ __forceinline__ unsigned arow(const pg::Unit&, int) const { return 0u; }
};
__device__ __forceinline__ void acc_scale(pg::Acc& acc, float s) {
#pragma unroll
    for (int a = 0; a < 2; ++a)
#pragma unroll
        for (int b = 0; b < 2; ++b)
#pragma unroll
            for (int m = 0; m < 4; ++m)
#pragma unroll
                for (int n = 0; n < 2; ++n) acc[a][b][m][n] = acc[a][b][m][n] * s;
}
struct EpiSegTot : pg::EpiBase {
    static constexpr bool PERM = true;
    float* L;
    __device__ __forceinline__ void operator()(pg::Acc& acc, const pg::Unit& u, int wr, int wc, int fr, int fq) const { EPI_OPAQUE();
        if (u.pn < 3) { acc_scale(acc, __builtin_amdgcn_exp2f(256.0f * lg2gamma(u.x))); return; }
        float* dst = L + ((size_t)(u.e >> 1) * 512 + u.pm * 256) * 256;
#pragma unroll
        for (int ai = 0; ai < 2; ++ai)
#pragma unroll
            for (int m = 0; m < 4; ++m) { const int r = ai * 128 + wr * 64 + m * 16 + fr;
#pragma unroll
                for (int bj = 0; bj < 2; ++bj) { const int c0 = bj * 128 + wc * 32 + 8 * fq;
                    *(f32x4*)(dst + (size_t)r * 256 + c0) = acc[ai][bj][m][0]; *(f32x4*)(dst + (size_t)r * 256 + c0 + 4) = acc[ai][bj][m][1]; } }
    }
    __device__ __forceinline__ void reinit(pg::Acc& acc, const pg::Unit& cur, const pg::Unit& nxt, int, int, int, int) const { if (nxt.e != cur.e) pg::acc_zero(acc); }
};
struct EpiSnap : pg::EpiBase {
    static constexpr bool PERM = true;
    const float* L; h16* st;
    __device__ __forceinline__ void snap(const pg::Acc& acc, const pg::Unit& u, int j, int wr, int wc, int fr, int fq) const { EPI_OPAQUE();
        const int seg = (u.e >> 1) & 7, bh = u.e >> 4; h16* dst = st + ((size_t)(bh * 32 + seg * 4 + j) * 512 + u.pm * 256) * 256;
#pragma unroll
        for (int ai = 0; ai < 2; ++ai)
#pragma unroll
            for (int m = 0; m < 4; ++m) { const int r = ai * 128 + wr * 64 + m * 16 + fr;
#pragma unroll
                for (int bj = 0; bj < 2; ++bj) { const int c0 = bj * 128 + wc * 32 + 8 * fq; const f32x4 a = acc[ai][bj][m][0], b = acc[ai][bj][m][1];
                    v4u w; w.x = pkh(a[0], a[1]); w.y = pkh(a[2], a[3]); w.z = pkh(b[0], b[1]); w.w = pkh(b[2], b[3]);
                    *(v4u*)(dst + (size_t)r * 256 + c0) = w; } }
    }
    __device__ __forceinline__ void load(pg::Acc& acc, const pg::Unit& u, int wr, int wc, int fr, int fq) const { EPI_OPAQUE();
        const float* src = L + ((size_t)(u.e >> 1) * 512 + u.pm * 256) * 256;
#pragma unroll
        for (int ai = 0; ai < 2; ++ai)
#pragma unroll
            for (int m = 0; m < 4; ++m) { const int r = ai * 128 + wr * 64 + m * 16 + fr;
#pragma unroll
                for (int bj = 0; bj < 2; ++bj) { const int c0 = bj * 128 + wc * 32 + 8 * fq;
                    acc[ai][bj][m][0] = *(const f32x4*)(src + (size_t)r * 256 + c0); acc[ai][bj][m][1] = *(const f32x4*)(src + (size_t)r * 256 + c0 + 4); } }
    }
    __device__ __forceinline__ void init(pg::Acc& acc, const pg::Unit& u, int wr, int wc, int fr, int fq) const { EPI_OPAQUE(); load(acc, u, wr, wc, fr, fq); snap(acc, u, 0, wr, wc, fr, fq); acc_scale(acc, __builtin_amdgcn_exp2f(256.0f * lg2gamma(u.x))); }
    __device__ __forceinline__ void operator()(pg::Acc& acc, const pg::Unit& u, int wr, int wc, int fr, int fq) const { EPI_OPAQUE(); snap(acc, u, u.pn + 1, wr, wc, fr, fq); }
    __device__ __forceinline__ void reinit(pg::Acc& acc, const pg::Unit& cur, const pg::Unit& nxt, int wr, int wc, int fr, int fq) const { EPI_OPAQUE();
        if (nxt.e != cur.e) { load(acc, nxt, wr, wc, fr, fq); snap(acc, nxt, 0, wr, wc, fr, fq); }
        acc_scale(acc, __builtin_amdgcn_exp2f(256.0f * lg2gamma(nxt.x))); }
};
__device__ __forceinline__ void ph_carry(float* L, Frame& F) {
    const size_t n = (size_t)16 * 131072;
    for (size_t i = ((size_t)blockIdx.x * 512 + F.tid) * 4; i < n; i += (size_t)F.G * 512 * 4) {
        const int bh = (int)(i >> 17); const size_t el = i & 131071; const float g = __builtin_amdgcn_exp2f(1024.0f * lg2gamma(bh & 3));
        f32x4 s = {0.f, 0.f, 0.f, 0.f}, l[8];
#pragma unroll
        for (int sgm = 0; sgm < 8; ++sgm) l[sgm] = *(const GAS f32x4*)(L + ((size_t)(bh * 8 + sgm) << 17) + el);
#pragma unroll
        for (int sgm = 0; sgm < 8; ++sgm) { *(GAS f32x4*)(L + ((size_t)(bh * 8 + sgm) << 17) + el) = s; s = s * g + l[sgm]; }
    }
}
struct R2Sched {
    const h16 *pp, *vt, *q, *st; int G, c;
    __device__ __forceinline__ bool next(int i, pg::Unit& u) const {
        const int ch = (i >> 2) * G + c, pn = (i >> 1) & 1, x = i & 1; if (ch >= 512) return false;
        const int cch = ch & 31, bh = ch >> 5, b = bh >> 2, h = bh & 3; const size_t tok0 = (size_t)b * 8192 + cch * 256;
        if (x == 0) { u.a = (const char*)pp + (size_t)ch * 65536 * 2; u.b = (const char*)vt + (((tok0 >> 8) * 2048 + h * 512 + pn * 256) * 256) * 2; }
        else { u.a = (const char*)q + (tok0 * 1024 + h * 256) * 2; u.b = (const char*)st + ((size_t)ch * 512 + pn * 256) * 256 * 2; }
        u.pm = ch; u.pn = pn; u.e = (int)tok0; u.x = x; return true; }
    __device__ __forceinline__ unsigned arow(const pg::Unit&, int) const { return 0u; }
};
struct EpiRetOut : pg::EpiBase {
    static constexpr bool PERM = true;
    h16* __restrict__ o; const h16* __restrict__ sg; h16* __restrict__ og;
    __device__ __forceinline__ void operator()(const pg::Acc& acc, const pg::Unit& u, int wr, int wc, int fr, int fq) const { EPI_OPAQUE();
        if (u.x == 0) return;
        const int h = (u.pm >> 5) & 3; const float lg = lg2gamma(h);
#pragma unroll
        for (int ai = 0; ai < 2; ++ai)
#pragma unroll
            for (int m = 0; m < 4; ++m) { const int i = ai * 128 + wr * 64 + m * 16 + fr; const float qd = __builtin_amdgcn_exp2f((float)(i + 1) * lg);
                h16* dst = o + (size_t)(u.e + i) * 2048 + h * 512 + u.pn * 256;
#pragma unroll
                for (int bj = 0; bj < 2; ++bj) { const int c0 = bj * 128 + wc * 32 + 8 * fq; const f32x4 a = acc[ai][bj][m][0] * qd, b = acc[ai][bj][m][1] * qd;
                    v4u w; w.x = pkh(a[0], a[1]); w.y = pkh(a[2], a[3]); w.z = pkh(b[0], b[1]); w.w = pkh(b[2], b[3]);
                    *(v4u*)(dst + c0) = w; } }
        if (u.pn == 0) return;
        asm volatile("s_waitcnt vmcnt(0)" ::: "memory");
        __builtin_amdgcn_s_barrier(); asm volatile("" ::: "memory");
        const int wid = __builtin_amdgcn_readfirstlane((int)threadIdx.x >> 6), lane = (fq << 4) | fr;
#pragma unroll 1
        for (int r0 = 0; r0 < 32; r0 += 8) {
            v4u ow[8], gv[8];
#pragma unroll
            for (int q = 0; q < 8; ++q) { const size_t off = (size_t)(u.e + 32 * wid + r0 + q) * 2048 + h * 512 + 8 * lane; ow[q] = *(const GAS v4u*)(o + off); gv[q] = *(const GAS v4u*)(sg + off); }
#pragma unroll
            for (int q = 0; q < 8; ++q) { const size_t off = (size_t)(u.e + 32 * wid + r0 + q) * 2048 + h * 512 + 8 * lane; const v4u o4 = ow[q], g4 = gv[q];
                float v[8] = {h2f(o4.x & 0xffff), h2f(o4.x >> 16), h2f(o4.y & 0xffff), h2f(o4.y >> 16), h2f(o4.z & 0xffff), h2f(o4.z >> 16), h2f(o4.w & 0xffff), h2f(o4.w >> 16)};
                const float g[8] = {h2f(g4.x & 0xffff), h2f(g4.x >> 16), h2f(g4.y & 0xffff), h2f(g4.y >> 16), h2f(g4.z & 0xffff), h2f(g4.z >> 16), h2f(g4.w & 0xffff), h2f(g4.w >> 16)};
                float s = 0.f;
#pragma unroll
                for (int j = 0; j < 8; ++j) s += v[j];
                const float mean = wave_sum(s) * (1.0f / 512.0f); float qq = 0.f;
#pragma unroll
                for (int j = 0; j < 8; ++j) { v[j] -= mean; qq += v[j] * v[j]; }
                const float rstd = 1.0f / sqrtf(wave_sum(qq) * (1.0f / 512.0f) + 1e-6f);
                v4u w; w.x = pkh(g[0] * v[0] * rstd, g[1] * v[1] * rstd); w.y = pkh(g[2] * v[2] * rstd, g[3] * v[3] * rstd); w.z = pkh(g[4] * v[4] * rstd, g[5] * v[5] * rstd); w.w = pkh(g[6] * v[6] * rstd, g[7] * v[7] * rstd);
                *(GAS v4u*)(og + off) = w; }
        }
    }
    __device__ __forceinline__ void reinit(pg::Acc& acc, const pg::Unit&, const pg::Unit& nxt, int, int, int, int) const { if (nxt.x == 0) pg::acc_zero(acc); }
};
__device__ __forceinline__ void ph_gn_gate(const Params& p, Frame& F) {
    const int gw = F.vcu * NWAVES + F.wave, NGW = F.G * NWAVES, lane = F.lane;
    for (int it0 = gw * 4; it0 < T_ * 4; it0 += NGW * 4) {
        v4u ow[4], gv[4];
#pragma unroll
        for (int u = 0; u < 4; ++u) { const size_t off = (size_t)(it0 + u) * 512 + 8 * lane; ow[u] = *(const GAS v4u*)(p.o + off); gv[u] = *(const GAS v4u*)(p.sg + off); }
#pragma unroll
        for (int u = 0; u < 4; ++u) { const size_t off = (size_t)(it0 + u) * 512 + 8 * lane; const v4u o4 = ow[u], g4 = gv[u];
            float v[8] = {h2f(o4.x & 0xffff), h2f(o4.x >> 16), h2f(o4.y & 0xffff), h2f(o4.y >> 16), h2f(o4.z & 0xffff), h2f(o4.z >> 16), h2f(o4.w & 0xffff), h2f(o4.w >> 16)};
            const float g[8] = {h2f(g4.x & 0xffff), h2f(g4.x >> 16), h2f(g4.y & 0xffff), h2f(g4.y >> 16), h2f(g4.z & 0xffff), h2f(g4.z >> 16), h2f(g4.w & 0xffff), h2f(g4.w >> 16)};
            float s = 0.f;
#pragma unroll
            for (int j = 0; j < 8; ++j) s += v[j];
            const float mean = wave_sum(s) * (1.0f / 512.0f); float q = 0.f;
#pragma unroll
            for (int j = 0; j < 8; ++j) { v[j] -= mean; q += v[j] * v[j]; }
            const float rstd = 1.0f / sqrtf(wave_sum(q) * (1.0f / 512.0f) + 1e-6f);
            v4u w; w.x = pkh(g[0] * v[0] * rstd, g[1] * v[1] * rstd); w.y = pkh(g[2] * v[2] * rstd, g[3] * v[3] * rstd); w.z = pkh(g[4] * v[4] * rstd, g[5] * v[5] * rstd); w.w = pkh(g[6] * v[6] * rstd, g[7] * v[7] * rstd);
            *(GAS v4u*)(p.og + off) = w; }
    }
}
constexpr float SWA_C2 = 0.125f * 1.4426950408889634f;
struct EpiSwaTok : pg::EpiBase {
    static constexpr bool PERM = true;
    h16 *sq, *skv; const float* bias;
    __device__ __forceinline__ void operator()(const pg::Acc& acc, const pg::Unit& u, int wr, int wc, int fr, int fq) const { EPI_OPAQUE();
        const bool isq = u.pn < 4; h16* dst = isq ? sq : skv; const int ld = isq ? 1024 : 256, cb = isq ? u.pn * 256 : 0; const float sc = isq ? SWA_C2 : 1.0f;
#pragma unroll
        for (int bj = 0; bj < 2; ++bj) { const int ct = bj * 128 + wc * 32 + 8 * fq; const float* bp = bias + u.pn * 256 + ct;
            const f32x4 b0 = *(const f32x4*)bp, b1 = *(const f32x4*)(bp + 4);
#pragma unroll
            for (int ai = 0; ai < 2; ++ai)
#pragma unroll
                for (int m = 0; m < 4; ++m) { const size_t row = (size_t)u.pm * 256 + ai * 128 + wr * 64 + m * 16 + fr;
                    const f32x4 a = (acc[ai][bj][m][0] + b0) * sc, b = (acc[ai][bj][m][1] + b1) * sc;
                    v4u w; w.x = pkh(a[0], a[1]); w.y = pkh(a[2], a[3]); w.z = pkh(b[0], b[1]); w.w = pkh(b[2], b[3]);
                    *(v4u*)(dst + row * ld + cb + ct) = w; } }
    }
};
struct EpiSwaFeat : pg::EpiBase {
    static constexpr bool PERM = true;
    h16* __restrict__ kvt; const float* __restrict__ bias;
    __device__ __forceinline__ void operator()(const pg::Acc& acc, const pg::Unit& u, int wr, int wc, int fr, int fq) const { EPI_OPAQUE();
        float bv[2][4];
#pragma unroll
        for (int ai = 0; ai < 2; ++ai)
#pragma unroll
            for (int m = 0; m < 4; ++m) bv[ai][m] = bias[1024 + ai * 128 + wr * 64 + m * 16 + fr];
#pragma unroll
        for (int ai = 0; ai < 2; ++ai)
#pragma unroll
            for (int m = 0; m < 4; ++m) { const int r = ai * 128 + wr * 64 + m * 16 + fr;
#pragma unroll
                for (int bj = 0; bj < 2; ++bj) { const int ct = bj * 128 + wc * 32 + 8 * fq; const f32x4 a = acc[ai][bj][m][0] + bv[ai][m], b = acc[ai][bj][m][1] + bv[ai][m];
                    v4u w; w.x = pkh(a[0], a[1]); w.y = pkh(a[2], a[3]); w.z = pkh(b[0], b[1]); w.w = pkh(b[2], b[3]);
                    *(v4u*)(kvt + (size_t)r * T_ + (size_t)u.pn * 256 + ct) = w; } }
    }
};
typedef float f32x16 __attribute__((ext_vector_type(16)));
typedef _Float16 f16x8v __attribute__((ext_vector_type(8)));
typedef _Float16 f16x4v __attribute__((ext_vector_type(4)));
constexpr int KP = 144, VP = 520;
__device__ __forceinline__ void ph_swa_attn(const Params& p, Frame& F) {
    LAS unsigned char* Ks = F.lds; LAS unsigned char* Vs = F.lds + 256 * KP;
    const int lane = F.lane, w = F.wave, l31 = lane & 31, hh = lane >> 5;
    for (int unit = F.vcu; unit < 512; unit += F.G) {
        const int g = unit & 1, n = (unit >> 1) & 63, b = unit >> 7; const size_t tok0 = (size_t)b * SEQ_ + (size_t)n * 128;
        __syncthreads();
        for (int c = F.tid; c < 256 * 8; c += 512) { const int key = c >> 3, ch = c & 7; v4u val = {0u, 0u, 0u, 0u};
            if (n > 0 || key >= 128) val = *(const GAS v4u*)(p.skv + (tok0 - 128 + key) * 256 + g * 64 + ch * 8);
            *(LAS v4u*)(Ks + key * KP + ch * 16) = val; }
        for (int c = F.tid; c < 64 * 32; c += 512) { const int d = c >> 5, ch = c & 31; v4u val = {0u, 0u, 0u, 0u};
            if (n > 0 || ch >= 16) val = *(const GAS v4u*)(p.kvt + (size_t)(128 + g * 64 + d) * T_ + tok0 - 128 + ch * 8);
            v2u lo2; lo2.x = val.x; lo2.y = val.y; v2u hi2; hi2.x = val.z; hi2.y = val.w;
            *(LAS v2u*)(Vs + d * VP + ch * 16) = lo2; *(LAS v2u*)(Vs + d * VP + ch * 16 + 8) = hi2; }
        __syncthreads();
        const int hq = g * 8 + w; const float slope = __builtin_amdgcn_exp2f(-0.5f * (float)(hq + 1)) * 1.4426950408889634f, sink = p.sinks[hq] * 1.4426950408889634f;
#pragma nounroll
        for (int qi = 0; qi < 4; ++qi) {
            f16x8v qf[4];
            const h16* qrow = p.sq + (tok0 + qi * 32 + l31) * 1024 + hq * 64 + 8 * hh;
#pragma unroll
            for (int s = 0; s < 4; ++s) qf[s] = *(const GAS f16x8v*)(qrow + 16 * s);
            f32x16 sc[5];
#pragma unroll
            for (int t = 0; t < 5; ++t) {
                sc[t] = (f32x16){0.f, 0.f, 0.f, 0.f, 0.f, 0.f, 0.f, 0.f, 0.f, 0.f, 0.f, 0.f, 0.f, 0.f, 0.f, 0.f};
                const LAS unsigned char* kp = Ks + ((qi + t) * 32 + l31) * KP + 16 * hh;
#pragma unroll
                for (int s = 0; s < 4; ++s) { const f16x8v kf = *(const LAS f16x8v*)(kp + 32 * s); sc[t] = __builtin_amdgcn_mfma_f32_32x32x16_f16(kf, qf[s], sc[t], 0, 0, 0); }
            }
            float mx = sink;
            float basef = (float)(l31 + 128 - 4 * hh); asm volatile("" : "+v"(basef));
#pragma unroll
            for (int t = 0; t < 5; ++t) { const bool tile_ok = (n > 0) || (qi + t >= 4);
#pragma unroll
                for (int r = 0; r < 16; ++r) { const float distf = basef - (float)(32 * t + (r & 3) + 8 * (r >> 2));
                    bool ok = tile_ok; if (t == 0) ok = ok && (distf < 128.0f); if (t == 4) ok = ok && (distf >= 0.0f);
                    const float v = ok ? sc[t][r] - slope * distf : -INFINITY; sc[t][r] = v; mx = fmaxf(mx, v); } }
            mx = fmaxf(mx, __shfl_xor(mx, 32));
            float ls = 0.f; f16x8v pf[5][2];
#pragma unroll
            for (int t = 0; t < 5; ++t)
#pragma unroll
                for (int s2 = 0; s2 < 2; ++s2) { float e[8];
#pragma unroll
                    for (int j = 0; j < 8; ++j) { e[j] = __builtin_amdgcn_exp2f(sc[t][8 * s2 + j] - mx); ls += e[j]; }
                    v4u pw; pw.x = pkh(e[0], e[1]); pw.y = pkh(e[2], e[3]); pw.z = pkh(e[4], e[5]); pw.w = pkh(e[6], e[7]); pf[t][s2] = __builtin_bit_cast(f16x8v, pw); }
            ls += __shfl_xor(ls, 32); ls += __builtin_amdgcn_exp2f(sink - mx);
            const float rl = 1.0f / ls;
            f32x16 oa[2];
#pragma unroll
            for (int dt = 0; dt < 2; ++dt) { oa[dt] = (f32x16){0.f, 0.f, 0.f, 0.f, 0.f, 0.f, 0.f, 0.f, 0.f, 0.f, 0.f, 0.f, 0.f, 0.f, 0.f, 0.f};
                const LAS unsigned char* vp = Vs + (32 * dt + l31) * VP + (qi * 32 + 4 * hh) * 2;
#pragma unroll
                for (int t = 0; t < 5; ++t)
#pragma unroll
                    for (int s2 = 0; s2 < 2; ++s2) { const f16x4v v0 = *(const LAS f16x4v*)(vp + (t * 32 + s2 * 16) * 2), v1 = *(const LAS f16x4v*)(vp + (t * 32 + s2 * 16 + 8) * 2);
                        const f16x8v vf = __builtin_shufflevector(v0, v1, 0, 1, 2, 3, 4, 5, 6, 7);
                        oa[dt] = __builtin_amdgcn_mfma_f32_32x32x16_f16(vf, pf[t][s2], oa[dt], 0, 0, 0); } }
            h16* orow = p.so + (tok0 + qi * 32 + l31) * 1024 + hq * 64 + 4 * hh;
#pragma unroll
            for (int dt = 0; dt < 2; ++dt)
#pragma unroll
                for (int gq = 0; gq < 4; ++gq) { v2u ow; ow.x = pkh(oa[dt][4 * gq] * rl, oa[dt][4 * gq + 1] * rl); ow.y = pkh(oa[dt][4 * gq + 2] * rl, oa[dt][4 * gq + 3] * rl);
                    *(GAS v2u*)(orow + 32 * dt + 8 * gq) = ow; }
        }
    }
}

struct EpiNull : pg::EpiBase {
    static constexpr bool PERM = true;
    __device__ __forceinline__ void operator()(const pg::Acc& acc, const pg::Unit& u, int wr, int wc, int fr, int fq) const { asm volatile("" :: "v"(acc[0][0][0][0][0]), "v"(acc[1][1][3][1][3])); }
};

struct EpiSwigluQ : pg::EpiBase {
    static constexpr bool PERM = true;
    unsigned char* __restrict__ actq; const float* __restrict__ b1;
    typedef _Float16 h2 __attribute__((ext_vector_type(2)));
    typedef short s2 __attribute__((ext_vector_type(2)));
    __device__ __forceinline__ h2 act2(f32x2v g32, f32x2v l32) const {
        h2 g = __builtin_convertvector(g32, h2), l = __builtin_convertvector(l32, h2);
        g = __builtin_elementwise_min(g, (h2){7.0f16, 7.0f16});
        l = __builtin_elementwise_max(__builtin_elementwise_min(l, (h2){7.0f16, 7.0f16}), (h2){-7.0f16, -7.0f16});
        const h2 e = __builtin_elementwise_exp2(g * (h2){-2.4554f16, -2.4554f16});
        const h2 d = e + (h2){1.0f16, 1.0f16};
        const h2 r = {(_Float16)__builtin_amdgcn_rcph(d.x), (_Float16)__builtin_amdgcn_rcph(d.y)};
        return (g * r) * (l * (h2){4.0f16, 4.0f16} + (h2){4.0f16, 4.0f16});
    }
    __device__ __forceinline__ void operator()(const pg::Acc& acc, const pg::Unit& u, int wr, int wc, int fr, int fq) const { EPI_OPAQUE();
        const int c0 = u.pn * 128 + wc * 32 + 8 * fq;
        const float* bg = b1 + (size_t)u.e * 2048 + c0; const float* bl = bg + 1024;
        const f32x4 g0 = *(const f32x4*)bg, g1 = *(const f32x4*)(bg + 4), l0 = *(const f32x4*)bl, l1 = *(const f32x4*)(bl + 4);
#pragma unroll
        for (int ai = 0; ai < 2; ++ai)
#pragma unroll
            for (int m = 0; m < 4; ++m) {
                const size_t row = (size_t)u.pm * 256 + ai * 128 + wr * 64 + m * 16 + fr;
                const f32x4 ga = acc[ai][0][m][0] * 0.03125f + g0, gb = acc[ai][0][m][1] * 0.03125f + g1, la = acc[ai][1][m][0] * 0.03125f + l0, lb = acc[ai][1][m][1] * 0.03125f + l1;
                s2 lo = {0, 0}, hi = {0, 0};
                lo = __builtin_amdgcn_cvt_scalef32_pk_fp8_f16(lo, act2((f32x2v){ga.x, ga.y}, (f32x2v){la.x, la.y}), 1.0f, false);
                lo = __builtin_amdgcn_cvt_scalef32_pk_fp8_f16(lo, act2((f32x2v){ga.z, ga.w}, (f32x2v){la.z, la.w}), 1.0f, true);
                hi = __builtin_amdgcn_cvt_scalef32_pk_fp8_f16(hi, act2((f32x2v){gb.x, gb.y}, (f32x2v){lb.x, lb.y}), 1.0f, false);
                hi = __builtin_amdgcn_cvt_scalef32_pk_fp8_f16(hi, act2((f32x2v){gb.z, gb.w}, (f32x2v){lb.z, lb.w}), 1.0f, true);
                v2u w; w.x = __builtin_bit_cast(unsigned, lo); w.y = __builtin_bit_cast(unsigned, hi);
                *(v2u*)(actq + row * 1024 + c0) = w;
            }
    }
};
template <int VAR> struct EpiSwigluQP : pg::EpiBase {
    static constexpr bool PERM = true;
    unsigned char* __restrict__ actq; const float* __restrict__ b1;
    typedef _Float16 h2 __attribute__((ext_vector_type(2)));
    typedef short s2 __attribute__((ext_vector_type(2)));
    __device__ __forceinline__ h2 act2(f32x2v g32, f32x2v l32) const {
        h2 g = __builtin_convertvector(g32, h2), l = __builtin_convertvector(l32, h2);
        g = __builtin_elementwise_min(g, (h2){7.0f16, 7.0f16});
        l = __builtin_elementwise_max(__builtin_elementwise_min(l, (h2){7.0f16, 7.0f16}), (h2){-7.0f16, -7.0f16});
        const h2 e = __builtin_elementwise_exp2(g * (h2){-2.4554f16, -2.4554f16});
        const h2 d = e + (h2){1.0f16, 1.0f16};
        const h2 r = {(_Float16)__builtin_amdgcn_rcph(d.x), (_Float16)__builtin_amdgcn_rcph(d.y)};
        return (g * r) * (l * (h2){4.0f16, 4.0f16} + (h2){4.0f16, 4.0f16});
    }
    __device__ __forceinline__ void operator()(const pg::Acc& acc, const pg::Unit& u, int wr, int wc, int fr, int fq) const { EPI_OPAQUE();
        const int c0 = u.pn * 128 + wc * 32 + 8 * fq;
        const float* bg = b1 + (size_t)u.e * 2048 + c0; const float* bl = bg + 1024;
        const f32x4 g0 = *(const f32x4*)bg, g1 = *(const f32x4*)(bg + 4), l0 = *(const f32x4*)bl, l1 = *(const f32x4*)(bl + 4);
        if (VAR == 1) { asm volatile("" :: "v"(g0), "v"(g1), "v"(l0), "v"(l1));
#pragma unroll
            for (int ai = 0; ai < 2; ++ai)
#pragma unroll
                for (int bj = 0; bj < 2; ++bj)
#pragma unroll
                    for (int m = 0; m < 4; ++m) asm volatile("" :: "v"(acc[ai][bj][m][0]), "v"(acc[ai][bj][m][1]));
            return; }
#pragma unroll
        for (int ai = 0; ai < 2; ++ai)
#pragma unroll
            for (int m = 0; m < 4; ++m) {
                const size_t row = (size_t)u.pm * 256 + ai * 128 + wr * 64 + m * 16 + fr;
                const f32x4 ga = acc[ai][0][m][0] * 0.03125f + g0, gb = acc[ai][0][m][1] * 0.03125f + g1, la = acc[ai][1][m][0] * 0.03125f + l0, lb = acc[ai][1][m][1] * 0.03125f + l1;
                s2 lo = {0, 0}, hi = {0, 0};
                lo = __builtin_amdgcn_cvt_scalef32_pk_fp8_f16(lo, act2((f32x2v){ga.x, ga.y}, (f32x2v){la.x, la.y}), 1.0f, false);
                lo = __builtin_amdgcn_cvt_scalef32_pk_fp8_f16(lo, act2((f32x2v){ga.z, ga.w}, (f32x2v){la.z, la.w}), 1.0f, true);
                hi = __builtin_amdgcn_cvt_scalef32_pk_fp8_f16(hi, act2((f32x2v){gb.x, gb.y}, (f32x2v){lb.x, lb.y}), 1.0f, false);
                hi = __builtin_amdgcn_cvt_scalef32_pk_fp8_f16(hi, act2((f32x2v){gb.z, gb.w}, (f32x2v){lb.z, lb.w}), 1.0f, true);
                v2u w; w.x = __builtin_bit_cast(unsigned, lo); w.y = __builtin_bit_cast(unsigned, hi);
                if (VAR == 2) asm volatile("" :: "v"(w.x), "v"(w.y)); else *(v2u*)(actq + row * 1024 + c0) = w;
            }
    }
};
template <bool Y8> struct EpiMoeOutQ : pg::EpiBase {
    static constexpr bool PERM = true;
    unsigned char* __restrict__ y8; const float* __restrict__ b2; const float* __restrict__ gate;
    __device__ __forceinline__ void operator()(const pg::Acc& acc, const pg::Unit& u, int wr, int wc, int fr, int fq) const { EPI_OPAQUE();
        float gt[2][4]; f32x4 bv[2][2];
#pragma unroll
        for (int ai = 0; ai < 2; ++ai)
#pragma unroll
            for (int m = 0; m < 4; ++m) gt[ai][m] = gate[(size_t)u.pm * 256 + ai * 128 + wr * 64 + m * 16 + fr];
#pragma unroll
        for (int bj = 0; bj < 2; ++bj) { const float* bp = b2 + (size_t)u.e * 1024 + u.pn * 256 + bj * 128 + wc * 32 + 8 * fq; bv[bj][0] = *(const f32x4*)bp; bv[bj][1] = *(const f32x4*)(bp + 4); }
#pragma unroll
        for (int ai = 0; ai < 2; ++ai)
#pragma unroll
            for (int m = 0; m < 4; ++m) {
                const size_t row = (size_t)u.pm * 256 + ai * 128 + wr * 64 + m * 16 + fr;
#pragma unroll
                for (int bj = 0; bj < 2; ++bj) {
                    const int c0 = u.pn * 256 + bj * 128 + wc * 32 + 8 * fq;
                    const float gs = gt[ai][m] * (Y8 ? 32.0f : 1.0f);
                    const f32x4 v0 = (acc[ai][bj][m][0] * 0.0078125f + bv[bj][0]) * gs, v1 = (acc[ai][bj][m][1] * 0.0078125f + bv[bj][1]) * gs;
                    if (Y8) { int lo = 0, hi = 0;
                        lo = __builtin_amdgcn_cvt_pk_fp8_f32(v0[0], v0[1], lo, false); lo = __builtin_amdgcn_cvt_pk_fp8_f32(v0[2], v0[3], lo, true);
                        hi = __builtin_amdgcn_cvt_pk_fp8_f32(v1[0], v1[1], hi, false); hi = __builtin_amdgcn_cvt_pk_fp8_f32(v1[2], v1[3], hi, true);
                        v2u w; w.x = (unsigned)lo; w.y = (unsigned)hi; *(v2u*)(y8 + row * 1024 + c0) = w; }
                    else { v4u w; w.x = pkh(v0[0], v0[1]); w.y = pkh(v0[2], v0[3]); w.z = pkh(v1[0], v1[1]); w.w = pkh(v1[2], v1[3]); *(v4u*)((h16*)y8 + row * 1024 + c0) = w; }
                }
            }
    }
};

struct MoeSchedHot : MoeSched {
    __device__ __forceinline__ bool next(int i, pg::Unit& u) const { const bool ok = MoeSched::next(i, u); if (ok) { u.a = abase; u.b = wbase; } return ok; }
    __device__ __forceinline__ unsigned arow(const pg::Unit&, int r) const { return (unsigned)r; }
};

struct EpiKeep : pg::EpiBase {
    static constexpr bool PERM = true;
    __device__ __forceinline__ void operator()(const pg::Acc& acc, const pg::Unit& u, int wr, int wc, int fr, int fq) const {
#pragma unroll
        for (int ai = 0; ai < 2; ++ai)
#pragma unroll
            for (int bj = 0; bj < 2; ++bj)
#pragma unroll
                for (int m = 0; m < 4; ++m) asm volatile("" :: "v"(acc[ai][bj][m][0]), "v"(acc[ai][bj][m][1]));
    }
};
#ifndef PROBE_DBL
#define PROBE_DBL 0
#endif
#ifndef SKEW_STEP
#define SKEW_STEP 0
#endif
#define SKEW(F) (((F).vcu & 3) * SKEW_STEP)
#define DBL(bit, body) do { body; if ((PROBE_DBL >> (bit)) & 1) { GRID_BAR(); body; } } while (0)
template <int layer>
__device__ __forceinline__ void layer_tail(const Params& p, Frame& F, const XcdBarrier& bar) {
#define GRID_BAR() xcd_barrier(bar)
    {
        if (layer == 0) { DenseSched S; S.init(p.og, 2048, p.wro_t, 2048, T_, 1024, F.G, (int)blockIdx.x); EpiResid E; E.yh = p.yh; E.xprevh = p.xh0; E.bias = nullptr;
            pg::gemm_phase<EpiResid, DenseSched, 0, true>(F.lds + RING_OFF, 2048, 2048, 32, S, E); }
        else { DenseSched S; S.init(p.so, 1024, p.wso_t, 1024, T_, 1024, F.G, (int)blockIdx.x); EpiResid E; E.yh = p.yh; E.xprevh = p.x2h; E.bias = p.b_swa_out;
            pg::gemm_phase<EpiResid, DenseSched, 0, true>(F.lds + RING_OFF, 1024, 1024, 16, S, E); }
    }
    GRID_BAR();
    DBL(1, ph_ln_router(p, F, p.ln_mix_g + layer * 1024, p.ln_mix_b + layer * 1024, p.w_router + layer * 1024 * 32, p.b_router + layer * 32, (layer == 1 || MOE_F8_L0) ? p.x1q : (unsigned char*)nullptr));
#if (PROBE_DBL >> 19) & 1
    GRID_BAR();
    ph_ln_router(p, F, p.ln_mix_g + layer * 1024, p.ln_mix_b + layer * 1024, p.w_router + layer * 1024 * 32, p.b_router + layer * 32, layer == 1 ? p.x1q : (unsigned char*)nullptr, (PROBE_DBL >> 19) & 1);
#endif
    GRID_BAR();
    DBL(5, ph_assign(p, F, layer));
    GRID_BAR();
    {
        const int ntiles = (int)__hip_atomic_load(F.ctl + CW_NTILES + 64 * layer, RLX_AGENT);
        moe_tables(F, p.tile_e, p.slot_tok, ntiles, 3, true);
        if (layer == 0 && !MOE_F8_L0) {
            MoeSched S{(const char*)p.x1h, (const char*)p.w1_t, (LAS const int*)(F.lds + TAB_OFF), (LAS const int*)(F.lds + TAB_OFF) + 32, ntiles, 3, F.G, F.vcu, 0, (size_t)2048 * 1024 * 2, (size_t)256 * 1024 * 2};
            EpiSwiglu E; E.act = p.act; E.b1 = p.b_exp_in;
            pg::gemm_phase<EpiSwiglu, MoeSched, 1, true>(F.lds + RING_OFF, 1024, 1024, 16, S, E);
        } else {
            MoeSched S{(const char*)p.x1q, (const char*)(p.w1q + (size_t)layer * 32 * 2048 * 1024), (LAS const int*)(F.lds + TAB_OFF), (LAS const int*)(F.lds + TAB_OFF) + 32, ntiles, 3, F.G, F.vcu, 0, (size_t)2048 * 1024, (size_t)256 * 1024};
            EpiSwigluQ E; E.actq = p.actq; E.b1 = p.b_exp_in + (size_t)layer * 32 * 2048;
            pg::gemm_phase<EpiSwigluQ, MoeSched, 1, true, 1>(F.lds + RING_OFF, 1024, 1024, 8, S, E, 0, 0, SKEW(F));
        }
    }
    GRID_BAR();
#if (PROBE_DBL >> 21) & 3
    GRID_BAR();
    if (layer == 0) {
        const int ntiles = (int)__hip_atomic_load(F.ctl + CW_NTILES + 64 * layer, RLX_AGENT);
        moe_tables(F, p.tile_e, p.slot_tok, ntiles, 3, true);
        EpiSwigluP<1> E; E.act = p.yy; E.b1 = p.b_exp_in;
        if ((PROBE_DBL >> 22) & 1) { MoeSchedHot S{{((PROBE_DBL >> 23) & 1) ? (const char*)p.ctl : (const char*)p.x1h, ((PROBE_DBL >> 23) & 1) ? (const char*)p.ctl + 524288 : (const char*)p.w1_t, (LAS const int*)(F.lds + TAB_OFF), (LAS const int*)(F.lds + TAB_OFF) + 32, ntiles, 3, F.G, F.vcu, 0, (size_t)2048 * 1024 * 2, (size_t)256 * 1024 * 2}};
            pg::gemm_phase<EpiSwigluP<1>, MoeSchedHot, 1, true, 2, ((PROBE_DBL >> 24) & 1) != 0>(F.lds + RING_OFF, 1024, 1024, 16, S, E); }
        else { MoeSched S{(const char*)p.x1h, (const char*)p.w1_t, (LAS const int*)(F.lds + TAB_OFF), (LAS const int*)(F.lds + TAB_OFF) + 32, ntiles, 3, F.G, F.vcu, 0, (size_t)2048 * 1024 * 2, (size_t)256 * 1024 * 2};
            pg::gemm_phase<EpiSwigluP<1>, MoeSched, 1, true, 2, ((PROBE_DBL >> 24) & 1) != 0>(F.lds + RING_OFF, 1024, 1024, 16, S, E); }
    }
#endif
#if (PROBE_DBL >> 29) & 3
    GRID_BAR();
    {
        const int ntiles = (int)__hip_atomic_load(F.ctl + CW_NTILES + 64 * layer, RLX_AGENT);
        moe_tables(F, p.tile_e, p.slot_tok, ntiles, 3, true);
        MoeSched S{(const char*)p.x1q, (const char*)(p.w1q + (size_t)layer * 32 * 2048 * 1024), (LAS const int*)(F.lds + TAB_OFF), (LAS const int*)(F.lds + TAB_OFF) + 32, ntiles, 3, F.G, F.vcu, 0, (size_t)2048 * 1024, (size_t)256 * 1024};
        EpiSwigluQP<((PROBE_DBL >> 29) & 3)> E; E.actq = p.actq; E.b1 = p.b_exp_in + (size_t)layer * 32 * 2048;
        pg::gemm_phase<EpiSwigluQP<((PROBE_DBL >> 29) & 3)>, MoeSched, 1, true, 1>(F.lds + RING_OFF, 1024, 1024, 8, S, E);
    }
#endif
#if (PROBE_DBL >> 25) & 1
    GRID_BAR();
    {
        const int ntiles = (int)__hip_atomic_load(F.ctl + CW_NTILES + 64 * layer, RLX_AGENT);
        moe_tables(F, p.tile_e, p.slot_tok, ntiles, 3, true);
        MoeSched S{(const char*)p.x1q, (const char*)(p.w1q + (size_t)layer * 32 * 2048 * 1024), (LAS const int*)(F.lds + TAB_OFF), (LAS const int*)(F.lds + TAB_OFF) + 32, ntiles, 3, F.G, F.vcu, 0, (size_t)2048 * 1024, (size_t)256 * 1024};
        EpiKeep E;
        pg::gemm_phase<EpiKeep, MoeSched, 1, true, 1>(F.lds + RING_OFF, 1024, 1024, 8, S, E);
    }
#endif
#if (PROBE_DBL >> 26) & 1
    GRID_BAR();
    {
        const int ntiles = (int)__hip_atomic_load(F.ctl + CW_NTILES + 64 * layer, RLX_AGENT);
        moe_tables(F, p.tile_e, p.slot_tok, ntiles, 3, true);
        MoeSched S{(const char*)p.x1q, (const char*)(p.w1q + (size_t)layer * 32 * 2048 * 1024), (LAS const int*)(F.lds + TAB_OFF), (LAS const int*)(F.lds + TAB_OFF) + 32, ntiles, 3, F.G, F.vcu, 0, (size_t)2048 * 1024, (size_t)256 * 1024};
        EpiSwigluQ E; E.actq = p.actq; E.b1 = p.b_exp_in + (size_t)layer * 32 * 2048;
        pg::gemm_phase<EpiSwigluQ, MoeSched, 1, true, 1>(F.lds + RING_OFF, 1024, 1024, 8, S, E);
    }
#endif
    {
        const int ntiles = (int)__hip_atomic_load(F.ctl + CW_NTILES + 64 * layer, RLX_AGENT);
        moe_tables(F, p.tile_e, p.slot_tok, ntiles, 2, false);
        if (layer == 0 && !MOE_F8_L0) {
            MoeSched S{(const char*)p.act, (const char*)p.w2_t, (LAS const int*)(F.lds + TAB_OFF), (LAS const int*)(F.lds + TAB_OFF) + 32, ntiles, 2, F.G, F.vcu, (size_t)256 * 1024 * 2, (size_t)1024 * 1024 * 2, (size_t)256 * 1024 * 2};
            EpiMoeOut E; E.y = p.yy; E.b2 = p.b_exp_out; E.gate = p.slot_gate;
            pg::gemm_phase<EpiMoeOut, MoeSched, 0, true>(F.lds + RING_OFF, 1024, 1024, 16, S, E);
        } else {
            MoeSched S{(const char*)p.actq, (const char*)(p.w2q + (size_t)layer * 32 * 1024 * 1024), (LAS const int*)(F.lds + TAB_OFF), (LAS const int*)(F.lds + TAB_OFF) + 32, ntiles, 2, F.G, F.vcu, (size_t)256 * 1024, (size_t)1024 * 1024, (size_t)256 * 1024};
            EpiMoeOutQ<layer == 1> E; E.y8 = (unsigned char*)p.yy; E.b2 = p.b_exp_out + (size_t)layer * 32 * 1024; E.gate = p.slot_gate;
            pg::gemm_phase<EpiMoeOutQ<layer == 1>, MoeSched, 0, true, 1>(F.lds + RING_OFF, 1024, 1024, 8, S, E, 0, 0, SKEW(F));
        }
    }
#if (PROBE_DBL >> 27) & 1
    GRID_BAR();
    {
        const int ntiles = (int)__hip_atomic_load(F.ctl + CW_NTILES + 64 * layer, RLX_AGENT);
        moe_tables(F, p.tile_e, p.slot_tok, ntiles, 2, false);
        MoeSched S{(const char*)p.actq, (const char*)(p.w2q + (size_t)layer * 32 * 1024 * 1024), (LAS const int*)(F.lds + TAB_OFF), (LAS const int*)(F.lds + TAB_OFF) + 32, ntiles, 2, F.G, F.vcu, (size_t)256 * 1024, (size_t)1024 * 1024, (size_t)256 * 1024};
        EpiMoeOutQ<layer == 1> E; E.y8 = (unsigned char*)p.yy; E.b2 = p.b_exp_out + (size_t)layer * 32 * 1024; E.gate = p.slot_gate;
        pg::gemm_phase<EpiMoeOutQ<layer == 1>, MoeSched, 0, true, 1>(F.lds + RING_OFF, 1024, 1024, 8, S, E);
    }
#endif
#if (PROBE_DBL >> 28) & 1
    GRID_BAR();
    {
        const int ntiles = (int)__hip_atomic_load(F.ctl + CW_NTILES + 64 * layer, RLX_AGENT);
        moe_tables(F, p.tile_e, p.slot_tok, ntiles, 2, false);
        MoeSched S{(const char*)p.actq, (const char*)(p.w2q + (size_t)layer * 32 * 1024 * 1024), (LAS const int*)(F.lds + TAB_OFF), (LAS const int*)(F.lds + TAB_OFF) + 32, ntiles, 2, F.G, F.vcu, (size_t)256 * 1024, (size_t)1024 * 1024, (size_t)256 * 1024};
        EpiKeep E;
        pg::gemm_phase<EpiKeep, MoeSched, 0, true, 1>(F.lds + RING_OFF, 1024, 1024, 8, S, E);
    }
#endif
    GRID_BAR();
    DBL(2, ph_combine_ln<layer == 1>(p, F, p.x1h, p.ln_ffn_g + layer * 1024, p.ln_ffn_b + layer * 1024, layer == 0 ? (float*)nullptr : p.out, layer == 0 ? p.x2h : (h16*)nullptr));
#undef GRID_BAR
}
__global__ void __launch_bounds__(NWAVES * 64, 2) mk_fwd(Params p) {
    extern __shared__ __attribute__((aligned(16))) unsigned char lds[];
    Frame F;
    F.lds = (LAS unsigned char*)lds;
    F.MISC = (volatile LAS unsigned*)(F.lds + MISC_OFF);
    F.tid = threadIdx.x; F.lane = F.tid & 63; F.wave = __builtin_amdgcn_readfirstlane(F.tid >> 6);
    F.G = gridDim.x; { const int bx = blockIdx.x; F.vcu = (F.G % 8 == 0) ? (bx % 8) * (F.G / 8) + bx / 8 : bx; }
    F.ctl = (gu32*)p.ctl;
    for (int u = F.tid; u < (LDS_BYTES - LDSCTL_OFF) / 4; u += NWAVES * 64) ((LAS unsigned*)(F.lds + LDSCTL_OFF))[u] = 0u;
    __syncthreads();
    XcdBarrier bar = xcd_barrier_post((unsigned*)p.ctl + CW_BAR, F.MISC + 8);
#define GRID_BAR() xcd_barrier(bar)
    DBL(0, ph_prologue(p, F));
    GRID_BAR();
    {
        { DenseSched S; S.init(p.xh0, 1024, p.wri_t, 1024, T_, 4096, F.G, (int)blockIdx.x); EpiInTok E; E.q = p.q; E.k = p.k; E.sg = p.sg;
          pg::gemm_phase<EpiInTok, DenseSched, 0, true>(F.lds + RING_OFF, 1024, 1024, 16, S, E, 0, 0, SKEW(F)); }
        { DenseSched S; S.init(p.wfm_t, 1024, p.xh0, 1024, 2048, T_, F.G, (int)blockIdx.x); EpiInFeat E; E.vt = p.vt;
          pg::gemm_phase<EpiInFeat, DenseSched, 0, true>(F.lds + RING_OFF, 1024, 1024, 16, S, E); }
    }
#if (PROBE_DBL >> 17) & 1
    GRID_BAR();
    { DenseSched S; S.init(p.xh0, 1024, p.wri_t, 1024, T_, 4096, F.G, (int)blockIdx.x); EpiInTok E; E.q = p.q; E.k = p.k; E.sg = p.sg;
      pg::gemm_phase<EpiInTok, DenseSched, 0, true>(F.lds + RING_OFF, 1024, 1024, 16, S, E); }
#endif
#if (PROBE_DBL >> 6) & 1
    GRID_BAR();
    {
        { DenseSched S; S.init(p.xh0, 1024, p.wri_t, 1024, T_, 4096, F.G, (int)blockIdx.x); EpiInTok E; E.q = p.q; E.k = p.k; E.sg = p.sg;
          pg::gemm_phase<EpiInTok, DenseSched, 0, true>(F.lds + RING_OFF, 1024, 1024, 16, S, E); }
        { DenseSched S; S.init(p.wfm_t, 1024, p.xh0, 1024, 2048, T_, F.G, (int)blockIdx.x); EpiInFeat E; E.vt = p.vt;
          pg::gemm_phase<EpiInFeat, DenseSched, 0, true>(F.lds + RING_OFF, 1024, 1024, 16, S, E); }
    }
#endif
    GRID_BAR();
    {
        ph_ktranspose(p, F);
        { RaSched S{p.q, p.k, F.G, F.vcu}; EpiPP E; E.pp = p.pp; pg::gemm_phase<EpiPP, RaSched, 0, true>(F.lds + RING_OFF, 1024, 1024, 4, S, E); }
    }
    GRID_BAR();
    {
        { R1Sched S{p.vt, p.kdt, 4, F.G, F.vcu}; EpiSegTot E; E.L = p.ltot; pg::gemm_phase<EpiSegTot, R1Sched, 0, false>(F.lds + RING_OFF, 256, 256, 4, S, E); }
    }
    GRID_BAR();
    ph_carry(p.ltot, F);
    GRID_BAR();
    { R1Sched S{p.vt, p.kdt, 3, F.G, F.vcu}; EpiSnap E; E.L = p.ltot; E.st = p.st; pg::gemm_phase<EpiSnap, R1Sched, 0, false>(F.lds + RING_OFF, 256, 256, 4, S, E); }
#if (PROBE_DBL >> 8) & 1
    GRID_BAR();
    { R1Sched S{p.vt, p.kdt, 3, F.G, F.vcu}; EpiSnap E; E.L = p.ltot; E.st = p.st; pg::gemm_phase<EpiSnap, R1Sched, 0, false>(F.lds + RING_OFF, 256, 256, 4, S, E); }
#endif
    GRID_BAR();
    { R2Sched S{p.pp, p.vt, p.q, p.st, F.G, F.vcu}; EpiRetOut E; E.o = p.o; E.sg = p.sg; E.og = p.og; pg::gemm_phase<EpiRetOut, R2Sched, 2, true>(F.lds + RING_OFF, 256, 256, 4, S, E, 1024, 256); }
    GRID_BAR();
    layer_tail<0>(p, F, bar);
    GRID_BAR();
    {
        { DenseSched S; S.init(p.x2h, 1024, p.wsi_t, 1024, T_, 1280, F.G, (int)blockIdx.x); EpiSwaTok E; E.sq = p.sq; E.skv = p.skv; E.bias = p.b_swa_in;
          pg::gemm_phase<EpiSwaTok, DenseSched, 0, true>(F.lds + RING_OFF, 1024, 1024, 16, S, E); }
        { DenseSched S; S.init(p.wsi_t + (size_t)1024 * 1024, 1024, p.x2h, 1024, 256, T_, F.G, (int)blockIdx.x, 128); EpiSwaFeat E; E.kvt = p.kvt; E.bias = p.b_swa_in;
          pg::gemm_phase<EpiSwaFeat, DenseSched, 0, true>(F.lds + RING_OFF, 1024, 1024, 16, S, E); }
    }
#if (PROBE_DBL >> 13) & 1
    GRID_BAR();
    {
        { DenseSched S; S.init(p.x2h, 1024, p.wsi_t, 1024, T_, 1280, F.G, (int)blockIdx.x); EpiSwaTok E; E.sq = p.sq; E.skv = p.skv; E.bias = p.b_swa_in;
          pg::gemm_phase<EpiSwaTok, DenseSched, 0, true>(F.lds + RING_OFF, 1024, 1024, 16, S, E); }
        { DenseSched S; S.init(p.wsi_t + (size_t)1024 * 1024, 1024, p.x2h, 1024, 256, T_, F.G, (int)blockIdx.x, 128); EpiSwaFeat E; E.kvt = p.kvt; E.bias = p.b_swa_in;
          pg::gemm_phase<EpiSwaFeat, DenseSched, 0, true>(F.lds + RING_OFF, 1024, 1024, 16, S, E); }
    }
#endif
    GRID_BAR();
    DBL(3, ph_swa_attn(p, F));
    GRID_BAR();
    layer_tail<1>(p, F, bar);
    if (__hip_atomic_load((gu32*)((unsigned*)p.ctl + CW_BAR + XB_TMO), RLX_AGENT) != 0u) {
        __syncthreads();
        for (size_t i = (size_t)blockIdx.x * 512 + F.tid; i < (size_t)T_ * D_; i += (size_t)F.G * 512) p.out[i] = __builtin_nanf("");
    }
#undef GRID_BAR
}

namespace host {
constexpr size_t MiB = 1u << 20;
static int g_grid = 0;
static bool setup() {
    if (g_grid) return g_grid > 0;
    int dev = 0, cus = 0;
    if (hipGetDevice(&dev) != hipSuccess || hipDeviceGetAttribute(&cus, hipDeviceAttributeMultiprocessorCount, dev) != hipSuccess) { g_grid = -1; return false; }
    if (hipFuncSetAttribute((const void*)mk_fwd, hipFuncAttributeMaxDynamicSharedMemorySize, LDS_BYTES) != hipSuccess) { g_grid = -1; return false; }
    (void)hipGetLastError();
    g_grid = cus;
    return true;
}
static void launch(hipStream_t st, Params p) {
    p.ph_lo = 0; p.ph_hi = 0; p.li = 0; p.layer = 0;
    hipLaunchKernelGGL(mk_fwd, dim3(g_grid), dim3(NWAVES * 64), LDS_BYTES, st, p);
}
static void fill_params(Params& p, void* const* d_in, float* out, unsigned char* ws) {
    const float** in = (const float**)&p.x;
    for (int i = 0; i < 18; ++i) in[i] = (const float*)d_in[i];
    p.out = out; p.ctl = (unsigned*)ws;
    const size_t M = MiB;
    p.top_e = (int*)(ws + 1 * M); p.top_g = (float*)(ws + 2 * M); p.rankp = (int*)(ws + 3 * M); p.inv = (int*)(ws + 4 * M); p.slot_tok = (int*)(ws + 5 * M); p.slot_gate = (float*)(ws + 6 * M);
    p.wg_cnt = (int*)(ws + 7 * M); p.tile_e = (int*)(ws + 8 * M);
    p.wri_t = (h16*)(ws + 17 * M); p.wfm_t = (h16*)(ws + 25 * M); p.wro_t = (h16*)(ws + 31 * M); p.wsi_t = (h16*)(ws + 35 * M); p.wso_t = (h16*)(ws + 38 * M);
    p.w1_t = (h16*)(ws + 40 * M); p.w2_t = (h16*)(ws + 296 * M);
    p.xh0 = (h16*)(ws + 424 * M); p.x1h = (h16*)(ws + 488 * M); p.x2h = (h16*)(ws + 552 * M);
    p.x1f = (float*)(ws + 616 * M); p.x2f = (float*)(ws + 744 * M); p.yf = (float*)(ws + 872 * M);
    p.act = (h16*)(ws + 1000 * M); p.yy = (h16*)(ws + 1272 * M);
}
}
extern "C" void kernel_launch(void* const* d_in, const int* in_sizes, int n_in, void* d_out, int out_size, void* d_ws, size_t ws_size, hipStream_t stream) {
    const size_t M = host::MiB;
    if (n_in != 18 || out_size != T_ * D_ || ws_size < 2040 * M) { fprintf(stderr, "kernel_launch: unexpected shapes / workspace (%d inputs, out %d, ws %zu)\n", n_in, out_size, ws_size); return; }
    if (!host::setup()) return;
    unsigned char* ws = (unsigned char*)d_ws; hipStream_t st = stream;
    (void)hipMemsetAsync(ws, 0, CTL_ZERO_BYTES, st);
    Params p{}; host::fill_params(p, d_in, (float*)d_out, ws);
    p.q = (h16*)(ws + 1000 * M); p.k = (h16*)(ws + 1064 * M); p.sg = (h16*)(ws + 1128 * M); p.kdt = (h16*)(ws + 1256 * M); p.vt = (h16*)(ws + 1320 * M);
    p.pp = (h16*)(ws + 1448 * M); p.st = (h16*)(ws + 1512 * M); p.ltot = (float*)(ws + 1640 * M); p.o = (h16*)(ws + 1704 * M); p.og = (h16*)(ws + 1832 * M);
    p.sq = (h16*)(ws + 1000 * M); p.skv = (h16*)(ws + 1064 * M); p.kvt = (h16*)(ws + 1080 * M); p.so = (h16*)(ws + 1096 * M);
    p.w1q = (unsigned char*)p.w1_t + (size_t)32 * 2048 * 1024 * 2; p.w2q = (unsigned char*)p.w2_t + (size_t)32 * 1024 * 1024 * 2;
    p.x1q = ws + 1560 * M; p.actq = (unsigned char*)p.act;
    p.yh = (h16*)p.yf;
    host::launch(st, p);
}
```

```cpp
#include <hip/hip_runtime.h>
#include <cstdio>
#include <cstdint>
#include <cmath>
#define GAS __attribute__((address_space(1)))
#define LAS __attribute__((address_space(3)))
typedef unsigned short bf16;
typedef unsigned v4u __attribute__((ext_vector_type(4)));
typedef float f32x4 __attribute__((ext_vector_type(4)));
typedef short bf16x8 __attribute__((ext_vector_type(8)));
typedef GAS unsigned gu32;
typedef GAS unsigned long long gu64;
#define RLX_AGENT __ATOMIC_RELAXED, __HIP_MEMORY_SCOPE_AGENT
#define LDS_WAIT() asm volatile("s_waitcnt lgkmcnt(0)" ::: "memory")
#define VM_WAIT() asm volatile("s_waitcnt vmcnt(0)" ::: "memory")
__device__ __forceinline__ unsigned long long rt() { return __builtin_amdgcn_s_memrealtime(); }
#define XB_TMO      128
#define XB_XCNT(j)  (256  + 64 * (j))
#define XB_XSUB(j)  (1280 + 64 * (j))
#define XB_XGEN(j)  (2304 + 64 * (j))
#define XB_TOP      3328
#define XB_TOPGEN   3392
#define XCD_BAR_WORDS 3456
#define XB_SPIN_CAP (1u << 18)

__device__ __forceinline__ unsigned xb_ld(unsigned* p)              { return __hip_atomic_load(p, __ATOMIC_RELAXED, __HIP_MEMORY_SCOPE_AGENT); }
__device__ __forceinline__ unsigned xb_add(unsigned* p, unsigned v) { return __hip_atomic_fetch_add(p, v, __ATOMIC_RELAXED, __HIP_MEMORY_SCOPE_AGENT); }
__device__ __forceinline__ unsigned xb_xcc_id() { return (unsigned)__builtin_amdgcn_s_getreg((3 << 11) | 20) & 0xFu; }
#define XB_SPIN(cond, bar) do { unsigned _sp = 0; while (cond) { __builtin_amdgcn_s_sleep(1); \
    if ((++_sp & 255u) == 0u) { if (xb_ld(&(bar)[XB_TMO])) break; if (_sp > XB_SPIN_CAP) { atomicAdd(&(bar)[XB_TMO], 1u); break; } } } } while (0)

struct XcdBarrier {
    unsigned* bar; unsigned x;
    volatile LAS unsigned* st;
};

__device__ __forceinline__ XcdBarrier xcd_barrier_post(unsigned* bar, volatile LAS unsigned* st) {
    XcdBarrier b; b.bar = bar; b.x = xb_xcc_id(); b.st = st;
    if (threadIdx.x == 0) (void)xb_add(&bar[XB_XCNT(b.x)], 1u);
    return b;
}
__device__ __forceinline__ void xcd_barrier_complete(unsigned* bar, unsigned x, unsigned& nloc, unsigned& nx) {
    const unsigned G = gridDim.x * gridDim.y * gridDim.z;
    unsigned sum, cnt, mine, sp = 0u;
    for (;;) {
        sum = 0u; cnt = 0u; mine = 0u;
#pragma unroll
        for (unsigned j = 0; j < 16; ++j) { const unsigned c = xb_ld(&bar[XB_XCNT(j)]); sum += c; cnt += (c > 0u) ? 1u : 0u; mine = (j == x) ? c : mine; }
        if (sum == G) break;
        __builtin_amdgcn_s_sleep(1);
        if ((++sp & 255u) == 0u) { if (xb_ld(&bar[XB_TMO])) break; if (sp > XB_SPIN_CAP) { atomicAdd(&bar[XB_TMO], 1u); break; } }
    }
    nloc = mine > 0u ? mine : 1u; nx = cnt > 0u ? cnt : 1u;
}

__device__ __forceinline__ void xcd_barrier(const XcdBarrier& b) {
    asm volatile("s_waitcnt vmcnt(0)" ::: "memory");
    __syncthreads();
    if (threadIdx.x == 0) {
        unsigned* bar = b.bar;
        __builtin_amdgcn_s_waitcnt(0);
        unsigned nloc = b.st[0], nx = b.st[1];
        if (nloc == 0u) { xcd_barrier_complete(bar, b.x, nloc, nx); b.st[0] = nloc; b.st[1] = nx; }
        const unsigned old = xb_add(&bar[XB_XSUB(b.x)], 1u);
        const unsigned gen = old / nloc;
        if (old + 1u == (gen + 1u) * nloc) {
            __builtin_amdgcn_fence(__ATOMIC_RELEASE, "agent");
            asm volatile("s_waitcnt vmcnt(0)" ::: "memory");
            const unsigned og = xb_add(&bar[XB_TOP], 1u);
            const unsigned tg = og / nx;
            if (og + 1u == (tg + 1u) * nx) xb_add(&bar[XB_TOPGEN], 1u);
            else XB_SPIN(xb_ld(&bar[XB_TOPGEN]) == tg, bar);
            __builtin_amdgcn_fence(__ATOMIC_ACQUIRE, "agent");
            xb_add(&bar[XB_XGEN(b.x)], 1u);
            asm volatile("s_waitcnt vmcnt(0)" ::: "memory");
        } else {
            XB_SPIN(xb_ld(&bar[XB_XGEN(b.x)]) == gen, bar);
            __builtin_amdgcn_fence(__ATOMIC_ACQUIRE, "agent");
            asm volatile("s_waitcnt vmcnt(0)" ::: "memory");
        }
    }
    __syncthreads();
}
namespace pg {
#define PG_LAS __attribute__((address_space(3)))
typedef unsigned short h16;
typedef _Float16 f16x8 __attribute__((ext_vector_type(8)));
typedef __bf16 bf16x8 __attribute__((ext_vector_type(8)));
typedef _Float16 f16x2 __attribute__((ext_vector_type(2)));
typedef float f32x4 __attribute__((ext_vector_type(4)));
typedef float f32x2 __attribute__((ext_vector_type(2)));
typedef unsigned u32x4 __attribute__((ext_vector_type(4)));
typedef unsigned u32x2 __attribute__((ext_vector_type(2)));
constexpr int BM = 256, BK = 64, HALF = 128, HTB = HALF * BK * 2  , STAGE_BYTES = 8 * HTB;

__host__ __device__ __forceinline__ int lds_byte(int r, int c) { const int st = (r >> 4) * 2 + (c >> 5), rr = r & 15, cc = c & 31, ob = rr * 64 + cc * 2; return st * 1024 + (ob ^ (((ob >> 9) & 1) << 5)); }
__host__ __device__ __forceinline__ void stage_rc(int b, int& R, int& C) { const int st = b / 1024, sb = b % 1024, swz = sb ^ (((sb >> 9) & 1) << 5); R = (st >> 1) * 16 + swz / 64; C = (st & 1) * 32 + (swz % 64) / 2; }
__host__ __device__ __forceinline__ int perm32(int rho) { const int n = rho >> 4, i = rho & 15; return 8 * (i >> 2) + 4 * n + (i & 3); }
__device__ __forceinline__ unsigned pkh(float lo, float hi) { const f32x2 v = {lo, hi}; const f16x2 h = __builtin_convertvector(v, f16x2); return __builtin_bit_cast(unsigned, h); }

typedef int i32x8 __attribute__((ext_vector_type(8)));
typedef int i32x4 __attribute__((ext_vector_type(4)));
__device__ __forceinline__ i32x8 cat8(f16x8 lo, f16x8 hi) { return __builtin_shufflevector(__builtin_bit_cast(i32x4, lo), __builtin_bit_cast(i32x4, hi), 0, 1, 2, 3, 4, 5, 6, 7); }
__device__ __forceinline__ void mfma_f8(f32x4& c, const i32x8& a, const i32x8& b, int scale) {
    asm volatile("v_mfma_scale_f32_16x16x128_f8f6f4 %0, %1, %2, %0, %3, %3 op_sel_hi:[0,0,0]" : "+v"(c) : "v"(a), "v"(b), "v"(scale)); }
struct Unit { const char* a; const char* b; int pm, pn, e, x; };
typedef f32x4 Acc[2][2][4][2];
__device__ __forceinline__ void acc_zero(Acc& acc) {
#pragma unroll
    for (int a = 0; a < 2; ++a)
#pragma unroll
        for (int b = 0; b < 2; ++b)
#pragma unroll
            for (int m = 0; m < 4; ++m)
#pragma unroll
                for (int n = 0; n < 2; ++n) acc[a][b][m][n] = (f32x4){0.f, 0.f, 0.f, 0.f};
}
struct EpiBase {
    static constexpr bool PERM = false;
    __device__ __forceinline__ void init(Acc& acc, const Unit&, int, int, int, int) const { acc_zero(acc); }
    __device__ __forceinline__ void reinit(Acc& acc, const Unit&, const Unit&, int, int, int, int) const { acc_zero(acc); }
};

template <class Epi, class Sched, int MODE  , bool ALIGN_EPI, int ES = 2  , bool BF = false  , int ILV = 2  >
__device__ __forceinline__ void gemm_phase(PG_LAS unsigned char* lds, const int lda, const int ldb, const int nt_, const Sched& S, const Epi& E, const int lda1 = 0, const int ldb1 = 0, const int skew_ticks = 0  ) {
    constexpr bool GATHER = (MODE == 1), DUAL = (MODE == 2);
    int nt = nt_; asm volatile("" : "+s"(nt));
    int tid_ = threadIdx.x; asm volatile("" : "+v"(tid_));
    const int tid = tid_, wid = __builtin_amdgcn_readfirstlane(tid >> 6), lane = tid & 63, wr = wid >> 2, wc = wid & 3, fr = lane & 15, fq = lane >> 4;
    unsigned voffA[2], voffB[2]; int sR[2], sC[2];
#pragma unroll
    for (int i = 0; i < 2; ++i) { int R, C; stage_rc(tid * 16 + i * 8192, R, C); sR[i] = R; sC[i] = C; const int Rb = Epi::PERM ? ((R & ~31) + perm32(R & 31)) : R;
        voffA[i] = (unsigned)(R * lda * ES + C * 2); voffB[i] = (unsigned)(Rb * ldb * ES + C * 2); }
    const size_t kstep = (size_t)(BK * 2);
    const size_t hstepA0 = GATHER ? 0 : (size_t)HALF * lda * ES, hstepB0 = (size_t)HALF * ldb * ES, hstepA1 = (size_t)HALF * lda1 * ES, hstepB1 = (size_t)HALF * ldb1 * ES;
    unsigned wA1[2], wB1[2];
#pragma unroll
    for (int i = 0; i < 2; ++i) { const int Rb = Epi::PERM ? ((sR[i] & ~31) + perm32(sR[i] & 31)) : sR[i]; wA1[i] = (unsigned)(sR[i] * lda1 * ES + sC[i] * 2); wB1[i] = (unsigned)(Rb * ldb1 * ES + sC[i] * 2); }
    unsigned vAc[2], vBc[2], vAn[2], vBn[2], vA2[2], vB2[2];
    size_t hAc = hstepA0, hBc = hstepB0, hAn = hstepA0, hBn = hstepB0, hA2 = hstepA0, hB2 = hstepB0;
    const unsigned ldsw = (unsigned)wid * 1024u;
    const int aoff = (ES == 2) ? lds_byte(wr * 64 + fr, fq * 8) : lds_byte(wr * 64 + fr, fq * 16), boff = (ES == 2) ? lds_byte(wc * 32 + fr, fq * 8) : lds_byte(wc * 32 + fr, fq * 16);
    unsigned gc[2][2], gn[2][2], g2[2][2];
#define PG_SA(b, h) (((b) * 2 + (h)) * HTB)
#define PG_SB(b, h) ((4 + (b) * 2 + (h)) * HTB)
#if !defined(PG_GLOBAL_DMA)
#define PG_STAGE(bufoff, gbase, voff) do { const __amdgpu_buffer_rsrc_t _r = __builtin_amdgcn_make_buffer_rsrc((void*)(gbase), 0, 0x7fffffff, 0x00020000); _Pragma("unroll") for (int _i = 0; _i < 2; ++_i) \
        __builtin_amdgcn_raw_ptr_buffer_load_lds(_r, (PG_LAS unsigned*)(lds + (bufoff) + ldsw + _i * 8192), 16, (int)(voff)[_i], 0, 0, 0); } while (0)
#else
#define PG_STAGE(bufoff, gbase, voff) do { _Pragma("unroll") for (int _i = 0; _i < 2; ++_i) \
        __builtin_amdgcn_global_load_lds((const unsigned*)((const char*)(gbase) + (voff)[_i]), (PG_LAS unsigned*)(lds + (bufoff) + ldsw + _i * 8192), 16, 0, 0); } while (0)
#endif
#define PG_STAGE_A(bufoff, kptr, h, G, VA, HA) do { if constexpr (GATHER) { PG_STAGE(bufoff, kptr, G[h]); } else { PG_STAGE(bufoff, (kptr) + (h) * (HA), VA); } } while (0)
#define PG_CFG(u, VA, VB, HA, HB) do { if constexpr (DUAL) { const bool _x = (u).x != 0; _Pragma("unroll") for (int _i = 0; _i < 2; ++_i) { VA[_i] = _x ? wA1[_i] : voffA[_i]; VB[_i] = _x ? wB1[_i] : voffB[_i]; } \
        HA = _x ? hstepA1 : hstepA0; HB = _x ? hstepB1 : hstepB0; } else { _Pragma("unroll") for (int _i = 0; _i < 2; ++_i) { VA[_i] = voffA[_i]; VB[_i] = voffB[_i]; } HA = hstepA0; HB = hstepB0; } } while (0)
#define PG_GLOAD(dst, u) do { _Pragma("unroll") for (int _h = 0; _h < 2; ++_h) _Pragma("unroll") for (int _i = 0; _i < 2; ++_i) \
        dst[_h][_i] = S.arow(u, _h * HALF + sR[_i]) * (unsigned)(lda * ES) + (unsigned)(sC[_i] * 2); } while (0)
#define PG_LDF(p) (*(const PG_LAS f16x8*)(p))
#define PG_LDA(dst, b, h) do { if constexpr (ES == 2) { _Pragma("unroll") for (int m = 0; m < 4; ++m) _Pragma("unroll") for (int k = 0; k < 2; ++k) dst[m][k] = PG_LDF(lds + PG_SA(b, h) + aoff + m * 2048 + k * 1024); } \
        else { _Pragma("unroll") for (int m = 0; m < 4; ++m) dst##8[m] = cat8(PG_LDF(lds + PG_SA(b, h) + aoff + m * 2048), PG_LDF(lds + PG_SA(b, h) + aoff + m * 2048 + 16)); } } while (0)
#define PG_LDB(dst, b, h) do { if constexpr (ES == 2) { _Pragma("unroll") for (int n = 0; n < 2; ++n) _Pragma("unroll") for (int k = 0; k < 2; ++k) dst[n][k] = PG_LDF(lds + PG_SB(b, h) + boff + n * 2048 + k * 1024); } \
        else { _Pragma("unroll") for (int n = 0; n < 2; ++n) dst##8[n] = cat8(PG_LDF(lds + PG_SB(b, h) + boff + n * 2048), PG_LDF(lds + PG_SB(b, h) + boff + n * 2048 + 16)); } } while (0)
#define PG_MMA(ai, bj, At, Bt) do { __builtin_amdgcn_s_setprio(1); if constexpr (ES == 2) { _Pragma("unroll") for (int m = 0; m < 4; ++m) _Pragma("unroll") for (int n = 0; n < 2; ++n) _Pragma("unroll") for (int k = 0; k < 2; ++k) \
        acc[ai][bj][m][n] = BF ? __builtin_amdgcn_mfma_f32_16x16x32_bf16(__builtin_bit_cast(bf16x8, Bt[n][k]), __builtin_bit_cast(bf16x8, At[m][k]), acc[ai][bj][m][n], 0, 0, 0) : __builtin_amdgcn_mfma_f32_16x16x32_f16(Bt[n][k], At[m][k], acc[ai][bj][m][n], 0, 0, 0); } else { _Pragma("unroll") for (int m = 0; m < 4; ++m) _Pragma("unroll") for (int n = 0; n < 2; ++n) \
        mfma_f8(acc[ai][bj][m][n], Bt##8[n], At##8[m], f8scale); } \
        __builtin_amdgcn_s_setprio(0); } while (0)
#define PG_MMH(ai, bj, At, Bt, M0) do { __builtin_amdgcn_s_setprio(1); if constexpr (ES == 2) { _Pragma("unroll") for (int m = (M0); m < (M0) + 2; ++m) _Pragma("unroll") for (int n = 0; n < 2; ++n) _Pragma("unroll") for (int k = 0; k < 2; ++k) \
        acc[ai][bj][m][n] = BF ? __builtin_amdgcn_mfma_f32_16x16x32_bf16(__builtin_bit_cast(bf16x8, Bt[n][k]), __builtin_bit_cast(bf16x8, At[m][k]), acc[ai][bj][m][n], 0, 0, 0) : __builtin_amdgcn_mfma_f32_16x16x32_f16(Bt[n][k], At[m][k], acc[ai][bj][m][n], 0, 0, 0); } else { _Pragma("unroll") for (int m = (M0); m < (M0) + 2; ++m) _Pragma("unroll") for (int n = 0; n < 2; ++n) \
        mfma_f8(acc[ai][bj][m][n], Bt##8[n], At##8[m], f8scale); } \
        __builtin_amdgcn_s_setprio(0); } while (0)
#define PG_WAIT_V(n) asm volatile("s_waitcnt vmcnt(" #n ")" ::: "memory")
#define PG_WAIT_L(n) asm volatile("s_waitcnt lgkmcnt(" #n ")" ::: "memory")
#define PG_BAR __builtin_amdgcn_s_barrier()
#define PG_SCHED __builtin_amdgcn_sched_barrier(0)
    if (skew_ticks > 0) { const unsigned long long t0 = __builtin_amdgcn_s_memrealtime(); while (__builtin_amdgcn_s_memrealtime() - t0 < (unsigned long long)skew_ticks) __builtin_amdgcn_s_sleep(8); }
    Unit cur, nxt; int ui = 0;
    if (!S.next(0, cur)) return;
    Acc acc;
    E.init(acc, cur, wr, wc, fr, fq);
    f16x8 At[4][2], B0[2][2], B1[2][2];
    int f8scale = 0x7f7f7f7f; asm volatile("" : "+v"(f8scale));
    i32x8 At8[4], B08[2], B18[2];
    const char* cA = cur.a; const char* cB = cur.b;
    if constexpr (GATHER) { PG_GLOAD(gc, cur); }
    PG_CFG(cur, vAc, vBc, hAc, hBc);
    PG_STAGE(PG_SB(0, 0), cB, vBc); PG_STAGE(PG_SB(0, 1), cB + hBc, vBc); PG_STAGE_A(PG_SA(0, 0), cA, 0, gc, vAc, hAc); PG_STAGE_A(PG_SA(0, 1), cA, 1, gc, vAc, hAc);
    if (wr == 1) PG_BAR;
    PG_WAIT_V(2); PG_BAR;
    if constexpr (ILV >= 2 && ILV <= 4) { PG_STAGE(PG_SB(1, 0), cB + kstep, vBc); PG_STAGE(PG_SB(1, 1), cB + hBc + kstep, vBc); PG_WAIT_V(4); PG_BAR; }
    else { PG_STAGE(PG_SB(1, 0), cB + kstep, vBc); PG_STAGE_A(PG_SA(1, 0), cA + kstep, 0, gc, vAc, hAc); PG_STAGE(PG_SB(1, 1), cB + hBc + kstep, vBc);
    PG_WAIT_V(6); PG_BAR; }
    for (;;) {
        const bool has_next = S.next(ui + 1, nxt);
        const char* nA = has_next ? nxt.a : cA; const char* nB = has_next ? nxt.b : cB;
        if constexpr (GATHER) { if (has_next) { PG_GLOAD(gn, nxt); } else {
#pragma unroll
            for (int h = 0; h < 2; ++h)
#pragma unroll
                for (int i = 0; i < 2; ++i) gn[h][i] = gc[h][i]; } }
        if (has_next) { PG_CFG(nxt, vAn, vBn, hAn, hBn); } else { PG_CFG(cur, vAn, vBn, hAn, hBn); }
        for (int t = 0; t < nt; t += 2) {
            const bool last = (t == nt - 2);
            const char* a1 = cA + (size_t)(t + 1) * kstep;
            const char* a2 = last ? nA : cA + (size_t)(t + 2) * kstep; const char* b2 = last ? nB : cB + (size_t)(t + 2) * kstep;
            const char* a3 = a2 + kstep; const char* b3 = b2 + kstep;
            if constexpr (GATHER) {
#pragma unroll
                for (int h = 0; h < 2; ++h)
#pragma unroll
                    for (int i = 0; i < 2; ++i) g2[h][i] = last ? gn[h][i] : gc[h][i]; }
            if constexpr (DUAL) {
#pragma unroll
                for (int i = 0; i < 2; ++i) { vA2[i] = last ? vAn[i] : vAc[i]; vB2[i] = last ? vBn[i] : vBc[i]; }
                hA2 = last ? hAn : hAc; hB2 = last ? hBn : hBc;
            } else {
#pragma unroll
                for (int i = 0; i < 2; ++i) { vA2[i] = vAc[i]; vB2[i] = vBc[i]; }
                hA2 = hAc; hB2 = hBc; }
            if constexpr (ILV == 5) {
            PG_LDB(B0, 0, 0); PG_SCHED; PG_LDA(At, 0, 0); PG_STAGE_A(PG_SA(1, 1), a1, 1, gc, vAc, hAc);
            PG_WAIT_L(8); PG_BAR; PG_WAIT_L(0); PG_MMA(0, 0, At, B0); PG_BAR; PG_SCHED;
            PG_LDB(B1, 0, 1); PG_STAGE(PG_SB(0, 0), b2, vB2);
            PG_BAR; PG_WAIT_L(0); PG_MMA(0, 1, At, B1); PG_BAR; PG_SCHED;
            PG_LDA(At, 0, 1); PG_STAGE_A(PG_SA(0, 0), a2, 0, g2, vA2, hA2);
            PG_BAR; PG_WAIT_L(0); PG_MMA(1, 0, At, B0); PG_BAR; PG_SCHED;
            PG_STAGE(PG_SB(0, 1), b2 + hB2, vB2);
            PG_WAIT_V(6); PG_BAR; PG_MMA(1, 1, At, B1); PG_BAR; PG_SCHED;
            PG_LDB(B0, 1, 0); PG_SCHED; PG_LDA(At, 1, 0); PG_STAGE_A(PG_SA(0, 1), a2, 1, g2, vA2, hA2);
            PG_WAIT_L(8); PG_BAR; PG_WAIT_L(0); PG_MMA(0, 0, At, B0); PG_BAR; PG_SCHED;
            PG_LDB(B1, 1, 1); PG_STAGE(PG_SB(1, 0), b3, vB2);
            PG_BAR; PG_WAIT_L(0); PG_MMA(0, 1, At, B1); PG_BAR; PG_SCHED;
            PG_LDA(At, 1, 1); PG_STAGE_A(PG_SA(1, 0), a3, 0, g2, vA2, hA2);
            PG_BAR; PG_WAIT_L(0); PG_MMA(1, 0, At, B0); PG_BAR; PG_SCHED;
            PG_STAGE(PG_SB(1, 1), b3 + hB2, vB2);
            PG_WAIT_V(6); PG_BAR; PG_MMA(1, 1, At, B1); PG_BAR; PG_SCHED;
            } else if constexpr (ILV == 3) {
            PG_LDB(B0, 0, 0); PG_LDB(B1, 0, 1); PG_SCHED; PG_LDA(At, 0, 0); PG_STAGE_A(PG_SA(1, 0), a1, 0, gc, vAc, hAc);
            PG_WAIT_V(6); PG_WAIT_L(0); PG_BAR; PG_MMA(0, 0, At, B0); PG_SCHED; PG_STAGE_A(PG_SA(1, 1), a1, 1, gc, vAc, hAc); PG_SCHED; PG_MMA(0, 1, At, B1); PG_BAR; PG_SCHED;
            PG_LDA(At, 0, 1); PG_STAGE(PG_SB(0, 0), b2, vB2);
            PG_WAIT_V(4); PG_WAIT_L(0); PG_BAR; PG_MMA(1, 0, At, B0); PG_SCHED; PG_STAGE(PG_SB(0, 1), b2 + hB2, vB2); PG_SCHED; PG_MMA(1, 1, At, B1); PG_BAR; PG_SCHED;
            PG_LDB(B0, 1, 0); PG_LDB(B1, 1, 1); PG_SCHED; PG_LDA(At, 1, 0); PG_STAGE_A(PG_SA(0, 0), a2, 0, g2, vA2, hA2);
            PG_WAIT_V(6); PG_WAIT_L(0); PG_BAR; PG_MMA(0, 0, At, B0); PG_SCHED; PG_STAGE_A(PG_SA(0, 1), a2, 1, g2, vA2, hA2); PG_SCHED; PG_MMA(0, 1, At, B1); PG_BAR; PG_SCHED;
            PG_LDA(At, 1, 1); PG_STAGE(PG_SB(1, 0), b3, vB2);
            PG_WAIT_V(4); PG_WAIT_L(0); PG_BAR; PG_MMA(1, 0, At, B0); PG_SCHED; PG_STAGE(PG_SB(1, 1), b3 + hB2, vB2); PG_SCHED; PG_MMA(1, 1, At, B1); PG_BAR; PG_SCHED;
            } else if constexpr (ILV == 4) {
            PG_LDB(B0, 0, 0); PG_SCHED; PG_LDA(At, 0, 0); PG_STAGE_A(PG_SA(1, 0), a1, 0, gc, vAc, hAc); PG_STAGE_A(PG_SA(1, 1), a1, 1, gc, vAc, hAc);
            PG_WAIT_V(8); PG_WAIT_L(0); PG_BAR; PG_MMA(0, 0, At, B0); PG_SCHED; PG_LDB(B1, 0, 1); PG_WAIT_L(0); PG_SCHED; PG_MMA(0, 1, At, B1); PG_BAR; PG_SCHED;
            PG_LDA(At, 0, 1); PG_STAGE(PG_SB(0, 0), b2, vB2); PG_STAGE(PG_SB(0, 1), b2 + hB2, vB2);
            PG_WAIT_V(6); PG_WAIT_L(0); PG_BAR; PG_MMA(1, 0, At, B0); PG_MMA(1, 1, At, B1); PG_BAR; PG_SCHED;
            PG_LDB(B0, 1, 0); PG_SCHED; PG_LDA(At, 1, 0); PG_STAGE_A(PG_SA(0, 0), a2, 0, g2, vA2, hA2); PG_STAGE_A(PG_SA(0, 1), a2, 1, g2, vA2, hA2);
            PG_WAIT_V(8); PG_WAIT_L(0); PG_BAR; PG_MMA(0, 0, At, B0); PG_SCHED; PG_LDB(B1, 1, 1); PG_WAIT_L(0); PG_SCHED; PG_MMA(0, 1, At, B1); PG_BAR; PG_SCHED;
            PG_LDA(At, 1, 1); PG_STAGE(PG_SB(1, 0), b3, vB2); PG_STAGE(PG_SB(1, 1), b3 + hB2, vB2);
            PG_WAIT_V(6); PG_WAIT_L(0); PG_BAR; PG_MMA(1, 0, At, B0); PG_MMA(1, 1, At, B1); PG_BAR; PG_SCHED;
            } else if constexpr (ILV == 2) {
            PG_LDB(B0, 0, 0); PG_LDB(B1, 0, 1); PG_SCHED; PG_STAGE_A(PG_SA(1, 0), a1, 0, gc, vAc, hAc); PG_SCHED; PG_LDA(At, 0, 0); PG_SCHED; PG_STAGE_A(PG_SA(1, 1), a1, 1, gc, vAc, hAc);
            PG_WAIT_V(8); PG_BAR; PG_WAIT_L(0); PG_MMA(0, 0, At, B0); PG_MMA(0, 1, At, B1); PG_BAR; PG_SCHED;
            PG_LDA(At, 0, 1); PG_STAGE(PG_SB(0, 0), b2, vB2); PG_STAGE(PG_SB(0, 1), b2 + hB2, vB2);
            PG_WAIT_V(6); PG_BAR; PG_WAIT_L(0); PG_MMA(1, 0, At, B0); PG_MMA(1, 1, At, B1); PG_BAR; PG_SCHED;
            PG_LDB(B0, 1, 0); PG_LDB(B1, 1, 1); PG_SCHED; PG_STAGE_A(PG_SA(0, 0), a2, 0, g2, vA2, hA2); PG_SCHED; PG_LDA(At, 1, 0); PG_SCHED; PG_STAGE_A(PG_SA(0, 1), a2, 1, g2, vA2, hA2);
            PG_WAIT_V(8); PG_BAR; PG_WAIT_L(0); PG_MMA(0, 0, At, B0); PG_MMA(0, 1, At, B1); PG_BAR; PG_SCHED;
            PG_LDA(At, 1, 1); PG_STAGE(PG_SB(1, 0), b3, vB2); PG_STAGE(PG_SB(1, 1), b3 + hB2, vB2);
            PG_WAIT_V(6); PG_BAR; PG_WAIT_L(0); PG_MMA(1, 0, At, B0); PG_MMA(1, 1, At, B1); PG_BAR; PG_SCHED;
            } else if constexpr (ILV == 1) {
            PG_LDB(B0, 0, 0); PG_LDB(B1, 0, 1); PG_SCHED; PG_LDA(At, 0, 0);
            PG_WAIT_V(6); PG_WAIT_L(0); PG_BAR; PG_MMA(0, 0, At, B0); PG_SCHED; PG_STAGE_A(PG_SA(1, 1), a1, 1, gc, vAc, hAc); PG_SCHED; PG_MMA(0, 1, At, B1); PG_BAR; PG_SCHED;
            PG_LDA(At, 0, 1);
            PG_WAIT_V(2); PG_WAIT_L(0); PG_BAR; PG_MMH(1, 0, At, B0, 0); PG_SCHED; PG_STAGE(PG_SB(0, 0), b2, vB2); PG_SCHED; PG_MMH(1, 0, At, B0, 2); PG_SCHED; PG_STAGE(PG_SB(0, 1), b2 + hB2, vB2); PG_SCHED;
                PG_MMH(1, 1, At, B1, 0); PG_SCHED; PG_STAGE_A(PG_SA(0, 0), a2, 0, g2, vA2, hA2); PG_SCHED; PG_MMH(1, 1, At, B1, 2); PG_BAR; PG_SCHED;
            PG_LDB(B0, 1, 0); PG_LDB(B1, 1, 1); PG_SCHED; PG_LDA(At, 1, 0);
            PG_WAIT_V(6); PG_WAIT_L(0); PG_BAR; PG_MMA(0, 0, At, B0); PG_SCHED; PG_STAGE_A(PG_SA(0, 1), a2, 1, g2, vA2, hA2); PG_SCHED; PG_MMA(0, 1, At, B1); PG_BAR; PG_SCHED;
            PG_LDA(At, 1, 1);
            PG_WAIT_V(2); PG_WAIT_L(0); PG_BAR; PG_MMH(1, 0, At, B0, 0); PG_SCHED; PG_STAGE(PG_SB(1, 0), b3, vB2); PG_SCHED; PG_MMH(1, 0, At, B0, 2); PG_SCHED; PG_STAGE(PG_SB(1, 1), b3 + hB2, vB2); PG_SCHED;
                PG_MMH(1, 1, At, B1, 0); PG_SCHED; PG_STAGE_A(PG_SA(1, 0), a3, 0, g2, vA2, hA2); PG_SCHED; PG_MMH(1, 1, At, B1, 2); PG_BAR; PG_SCHED;
            } else {
            PG_LDB(B0, 0, 0); PG_LDB(B1, 0, 1); PG_SCHED; PG_LDA(At, 0, 0); PG_STAGE_A(PG_SA(1, 1), a1, 1, gc, vAc, hAc);
            PG_WAIT_V(8); PG_WAIT_L(0); PG_BAR; PG_MMA(0, 0, At, B0); PG_MMA(0, 1, At, B1); PG_BAR; PG_SCHED;
            PG_LDA(At, 0, 1); PG_STAGE(PG_SB(0, 0), b2, vB2); PG_STAGE(PG_SB(0, 1), b2 + hB2, vB2); PG_STAGE_A(PG_SA(0, 0), a2, 0, g2, vA2, hA2);
            PG_WAIT_V(8); PG_WAIT_L(0); PG_BAR; PG_MMA(1, 0, At, B0); PG_MMA(1, 1, At, B1); PG_BAR; PG_SCHED;
            PG_LDB(B0, 1, 0); PG_LDB(B1, 1, 1); PG_SCHED; PG_LDA(At, 1, 0); PG_STAGE_A(PG_SA(0, 1), a2, 1, g2, vA2, hA2);
            PG_WAIT_V(8); PG_WAIT_L(0); PG_BAR; PG_MMA(0, 0, At, B0); PG_MMA(0, 1, At, B1); PG_BAR; PG_SCHED;
            PG_LDA(At, 1, 1); PG_STAGE(PG_SB(1, 0), b3, vB2); PG_STAGE(PG_SB(1, 1), b3 + hB2, vB2); PG_STAGE_A(PG_SA(1, 0), a3, 0, g2, vA2, hA2);
            PG_WAIT_V(8); PG_WAIT_L(0); PG_BAR; PG_MMA(1, 0, At, B0); PG_MMA(1, 1, At, B1); PG_BAR; PG_SCHED;
            }
        }
        if constexpr (ES == 1) asm volatile("s_nop 15\n\ts_nop 15" ::: "memory");
        if constexpr (ALIGN_EPI) { if (wr == 0) PG_BAR; }
        E(acc, cur, wr, wc, fr, fq);
        if (!has_next) break;
        E.reinit(acc, cur, nxt, wr, wc, fr, fq);
        cur = nxt; cA = nA; cB = nB; ++ui;
        if constexpr (GATHER) {
#pragma unroll
            for (int h = 0; h < 2; ++h)
#pragma unroll
                for (int i = 0; i < 2; ++i) gc[h][i] = gn[h][i]; }
        if constexpr (DUAL) {
#pragma unroll
            for (int i = 0; i < 2; ++i) { vAc[i] = vAn[i]; vBc[i] = vBn[i]; }
            hAc = hAn; hBc = hBn; }
        if constexpr (ALIGN_EPI) { if (wr == 1) PG_BAR; }
    }
    PG_WAIT_V(0);
    if constexpr (!ALIGN_EPI) { if (wr == 0) PG_BAR; }
    PG_BAR;
#undef PG_SA
#undef PG_SB
#undef PG_STAGE
#undef PG_STAGE_A
#undef PG_GLOAD
#undef PG_CFG
#undef PG_LDA
#undef PG_LDF
#undef PG_LDB
#undef PG_MMA
#undef PG_MMH
#undef PG_WAIT_V
#undef PG_WAIT_L
#undef PG_BAR
#undef PG_SCHED
}
}
constexpr int NWAVES = 8;
constexpr int T_ = 32768, D_ = 1024, SEQ_ = 8192;
constexpr int NSLOT_MAX = (512 + 32) * 256, NTILE_MAX = 544;
constexpr float ALPHA_ = 1.4142135623730951f, LN_EPS_ = 1e-5f;
constexpr int RING_OFF = 0, RING_BYTES = 131072;
constexpr int TAB_OFF = RING_BYTES, TAB_BYTES = 24576;
constexpr int LDSCTL_OFF = TAB_OFF + TAB_BYTES, MISC_OFF = LDSCTL_OFF + 320;
constexpr int LDS_BYTES = 159744;
constexpr int CW_TMO = 0, CW_CODE = 1, CW_NTILES = 64, CW_BAR = 4096;
constexpr int N_BAR_REGIONS = 12;
constexpr size_t CTL_ZERO_BYTES = 1u << 20;
static_assert((CW_BAR + N_BAR_REGIONS * XCD_BAR_WORDS) * 4 <= (int)CTL_ZERO_BYTES, "barrier regions inside the memset region");
typedef unsigned short h16;
typedef float f32x2v __attribute__((ext_vector_type(2)));
typedef unsigned v2u __attribute__((ext_vector_type(2)));
#define EPI_OPAQUE() asm volatile("" : "+v"(fr), "+v"(fq))

struct Params {
    const float *x, *w_ret_in, *w_ret_out, *w_swa_in, *b_swa_in, *w_swa_out, *b_swa_out, *sinks, *ln_mix_g, *ln_mix_b, *w_router, *b_router, *w_exp_in, *b_exp_in, *w_exp_out, *b_exp_out, *ln_ffn_g, *ln_ffn_b;
    float* out;
    unsigned* ctl;
    int *top_e, *rankp, *inv, *slot_tok, *wg_cnt, *tile_e; float *top_g, *slot_gate;
    h16 *wri_t, *wfm_t, *wro_t, *wsi_t, *wso_t, *w1_t, *w2_t;
    h16 *xh0, *x1h, *x2h, *yh; float *x1f, *x2f, *yf;
    h16 *act, *yy;
    h16 *q, *k, *sg, *kdt, *vt, *pp, *st, *o, *og; float* ltot;
    h16 *sq, *skv, *kvt, *so;
    const float* cv_src; h16* cv_dst; size_t cv_n; float* projf;
    unsigned char *w1q, *w2q, *x1q, *actq;
    int ph_lo, ph_hi, li, layer;
};

struct Frame {
    LAS unsigned char* lds; volatile LAS unsigned* MISC; gu32* ctl;
    int tid, lane, wave, vcu, G;
};
__device__ __forceinline__ float wave_sum(float v) {
    v += __builtin_bit_cast(float, __builtin_amdgcn_update_dpp(0, __builtin_bit_cast(int, v), 0x111, 0xf, 0xf, true));
    v += __builtin_bit_cast(float, __builtin_amdgcn_update_dpp(0, __builtin_bit_cast(int, v), 0x112, 0xf, 0xf, true));
    v += __builtin_bit_cast(float, __builtin_amdgcn_update_dpp(0, __builtin_bit_cast(int, v), 0x114, 0xf, 0xf, true));
    v += __builtin_bit_cast(float, __builtin_amdgcn_update_dpp(0, __builtin_bit_cast(int, v), 0x118, 0xf, 0xf, true));
    v += __builtin_bit_cast(float, __builtin_amdgcn_update_dpp(0, __builtin_bit_cast(int, v), 0x142, 0xa, 0xf, true));
    v += __builtin_bit_cast(float, __builtin_amdgcn_update_dpp(0, __builtin_bit_cast(int, v), 0x143, 0xc, 0xf, true));
    return __builtin_bit_cast(float, __builtin_amdgcn_readlane(__builtin_bit_cast(int, v), 63));
}
__device__ __forceinline__ unsigned pkh(float lo, float hi) { return pg::pkh(lo, hi); }
__device__ __forceinline__ float h2f(unsigned short h) { return (float)__builtin_bit_cast(_Float16, h); }

template <class RowMap>
__device__ __forceinline__ void transpose_item(const float* W, int K, int N, h16* WT, const RowMap& rm, LAS float* scr, int item, int lane) {
    const int nblk = N / 32, kb = item / nblk, nb = item % nblk, k0 = 64 * kb, n0 = 32 * nb;
#pragma unroll 8
    for (int i = 0; i < 32; ++i) { const int kk = 2 * i + (lane >> 5); scr[kk * 33 + (lane & 31)] = W[(size_t)(k0 + kk) * N + n0 + (lane & 31)]; }
    LDS_WAIT(); asm volatile("" ::: "memory");
    const int c = lane & 7;
#pragma unroll
    for (int j = 0; j < 4; ++j) { const int n = (lane >> 3) + 8 * j; const LAS float* s = scr + (8 * c) * 33 + n;
        v4u o; o.x = pkh(s[0 * 33], s[1 * 33]); o.y = pkh(s[2 * 33], s[3 * 33]); o.z = pkh(s[4 * 33], s[5 * 33]); o.w = pkh(s[6 * 33], s[7 * 33]);
        const long dr = rm(n0 + n);
        if (dr >= 0) *(GAS v4u*)(WT + (size_t)dr * K + k0 + 8 * c) = o; }
    LDS_WAIT(); asm volatile("" ::: "memory");
}
struct RmIdent { int off; __device__ __forceinline__ long operator()(int n) const { return off + n; } };
struct RmW1 { __device__ __forceinline__ long operator()(int n) const { const int j = n & 1023; return 256 * (j >> 7) + (n >> 10) * 128 + (j & 127); } };
struct RmRange { int lo, hi, off; __device__ __forceinline__ long operator()(int n) const { return (n >= lo && n < hi) ? (long)(off + n - lo) : -1; } };

__device__ __forceinline__ void ph_convert_moe(const Params& p, Frame& F, int layer) {
    LAS float* scr = (LAS float*)(F.lds + RING_OFF + F.wave * 16384);
    const int gw = F.vcu * NWAVES + F.wave, NGW = F.G * NWAVES;
    constexpr int I1 = (1024 / 64) * (2048 / 32), I2 = (1024 / 64) * (1024 / 32);
    const float* w1 = p.w_exp_in + (size_t)layer * 32 * 1024 * 2048; const float* w2 = p.w_exp_out + (size_t)layer * 32 * 1024 * 1024;
    h16* w1t = p.w1_t + (size_t)layer * 32 * 2048 * 1024; h16* w2t = p.w2_t + (size_t)layer * 32 * 1024 * 1024;
    for (int it = gw; it < 32 * (I1 + I2); it += NGW) {
        if (it < 32 * I1) { const int e = it / I1, r = it % I1; transpose_item(w1 + (size_t)e * 1024 * 2048, 1024, 2048, w1t + (size_t)e * 2048 * 1024, RmW1{}, scr, r, F.lane); }
        else { const int q = it - 32 * I1, e = q / I2, r = q % I2; transpose_item(w2 + (size_t)e * 1024 * 1024, 1024, 1024, w2t + (size_t)e * 1024 * 1024, RmIdent{0}, scr, r, F.lane); }
    }
}
__device__ __forceinline__ void ph_cvt_rows(const float* src, h16* dst, size_t n, Frame& F) {
    const size_t stride = (size_t)F.G * 512 * 8;
    for (size_t i0 = ((size_t)blockIdx.x * 512 + F.tid) * 8; i0 < n; i0 += 4 * stride) {
        f32x4 a[4], b[4];
#pragma unroll
        for (int u = 0; u < 4; ++u) { const size_t i = i0 + u * stride; if (i < n) { a[u] = *(const GAS f32x4*)(src + i); b[u] = *(const GAS f32x4*)(src + i + 4); } }
#pragma unroll
        for (int u = 0; u < 4; ++u) { const size_t i = i0 + u * stride; if (i < n) { v4u o; o.x = pkh(a[u].x, a[u].y); o.y = pkh(a[u].z, a[u].w); o.z = pkh(b[u].x, b[u].y); o.w = pkh(b[u].z, b[u].w); *(GAS v4u*)(dst + i) = o; } }
    }
}

__device__ __forceinline__ void ph_rank(const Params& p, Frame& F) {
    LAS int* se = (LAS int*)(F.lds + RING_OFF);
    for (int cc = blockIdx.x; cc < T_ / 128; cc += F.G) {
        __syncthreads();
        const int j = F.tid; const int e = p.top_e[cc * 512 + j];
        se[j] = e;
        __syncthreads();
        int r = 0;
        for (int q = 0; q < j; ++q) r += (se[q] == e) ? 1 : 0;
        p.rankp[cc * 512 + j] = r;
        if (j < 32) { int c = 0; for (int q = 0; q < 512; ++q) c += (se[q] == j) ? 1 : 0; p.wg_cnt[cc * 32 + j] = c; }
    }
}
__device__ __forceinline__ void ph_assign(const Params& p, Frame& F, int layer) {
    int tid_o = F.tid; asm volatile("" : "+v"(tid_o));
    LAS int* tot = (LAS int*)(F.lds + RING_OFF);
    LAS int* bef = tot + 512;
    LAS int* tst = bef + 512;
    LAS int* bas = tst + 64;
    LAS int* ttl = bas + 32;
    for (int cc = blockIdx.x; cc < T_ / 128; cc += F.G) {
        __syncthreads();
        { const int e = tid_o & 31, part = tid_o >> 5; int s = 0, b = 0;
          for (int c2 = part * 16; c2 < part * 16 + 16; ++c2) { const int v = p.wg_cnt[c2 * 32 + e]; s += v; b += (c2 < cc) ? v : 0; }
          tot[part * 32 + e] = s; bef[part * 32 + e] = b; }
        __syncthreads();
        if (tid_o < 32) { int s = 0, b = 0; for (int q = 0; q < 16; ++q) { s += tot[q * 32 + tid_o]; b += bef[q * 32 + tid_o]; } ttl[tid_o] = s; bas[tid_o] = b; }
        __syncthreads();
        if (tid_o == 0) { int ts = 0; for (int e = 0; e < 32; ++e) { tst[e] = ts; ts += (ttl[e] + 255) >> 8; } tst[32] = ts; }
        __syncthreads();
        { const int j = tid_o, ent = cc * 512 + j, e = p.top_e[ent]; const int sl = 256 * tst[e] + bas[e] + p.rankp[ent];
          p.slot_tok[sl] = ent >> 2; p.slot_gate[sl] = p.top_g[ent]; p.inv[ent] = sl; }
        if (cc < 32) { const int e = cc; for (int sl = 256 * tst[e] + ttl[e] + tid_o; sl < 256 * tst[e + 1]; sl += 512) { p.slot_tok[sl] = 0; p.slot_gate[sl] = 0.f; } }
        if (cc == 0) { for (int rt = tid_o; rt < tst[32]; rt += 512) { int e = 0; for (int q = 1; q < 32; ++q) e += (tst[q] <= rt) ? 1 : 0; p.tile_e[rt] = e; }
            if (tid_o == 0) __hip_atomic_store(F.ctl + CW_NTILES + 64 * layer, (unsigned)tst[32], RLX_AGENT); }
    }
}

constexpr int MOE_MAXU = 20;
#ifndef MOE_F8_L0
#define MOE_F8_L0 1
#endif
constexpr int F8_FROM = MOE_F8_L0 ? 0 : 32;
struct MoeSched {
    const char* abase; const char* wbase; LAS const int* lt_e; LAS const int* lt_tok; int ntiles, nct_log, G, c; size_t a_tile_bytes, w_expert_bytes, w_tile_bytes;
    __device__ __forceinline__ bool next(int i, pg::Unit& u) const {
        const int L = i * G + c; if (L >= (ntiles << nct_log) || i >= MOE_MAXU) return false;
        const int rt = L >> nct_log, ct = L & ((1 << nct_log) - 1);
        const int e = __builtin_amdgcn_readfirstlane(lt_e[i]);
        u.a = abase + (size_t)rt * a_tile_bytes; u.b = wbase + (size_t)e * w_expert_bytes + (size_t)ct * w_tile_bytes; u.pm = rt; u.pn = ct; u.e = e; u.x = i; return true;
    }
    __device__ __forceinline__ unsigned arow(const pg::Unit& u, int r) const { return (unsigned)lt_tok[u.x * 256 + r]; }
};
__device__ __forceinline__ void moe_tables(Frame& F, const int* tile_e, const int* slot_tok, int ntiles, int nct_log, bool gather) {
    LAS int* lt_e = (LAS int*)(F.lds + TAB_OFF); LAS int* lt_tok = lt_e + 32;
    __syncthreads();
    for (int i = 0; i < MOE_MAXU; ++i) { const int L = i * F.G + F.vcu; if (L >= (ntiles << nct_log)) break; const int rt = L >> nct_log;
        if (F.tid == 0) lt_e[i] = tile_e[rt];
        if (gather && F.tid < 256) lt_tok[i * 256 + F.tid] = slot_tok[rt * 256 + F.tid]; }
    __syncthreads();
}
struct EpiSwiglu : pg::EpiBase {
    static constexpr bool PERM = true;
    h16* act; const float* b1;
    __device__ __forceinline__ void operator()(const pg::Acc& acc, const pg::Unit& u, int wr, int wc, int fr, int fq) const { EPI_OPAQUE();
        const int c0 = u.pn * 128 + wc * 32 + 8 * fq;
        const float* bg = b1 + (size_t)u.e * 2048 + c0; const float* bl = bg + 1024;
        const f32x4 g0 = *(const f32x4*)bg, g1 = *(const f32x4*)(bg + 4), l0 = *(const f32x4*)bl, l1 = *(const f32x4*)(bl + 4);
#pragma unroll
        for (int ai = 0; ai < 2; ++ai)
#pragma unroll
            for (int m = 0; m < 4; ++m) {
                const size_t row = (size_t)u.pm * 256 + ai * 128 + wr * 64 + m * 16 + fr;
                float r[8];
#pragma unroll
                for (int n = 0; n < 2; ++n)
#pragma unroll
                    for (int j = 0; j < 4; ++j) {
                        const float glu = fminf(acc[ai][0][m][n][j] + (n ? g1[j] : g0[j]), 7.0f);
                        const float lin = fminf(fmaxf(acc[ai][1][m][n][j] + (n ? l1[j] : l0[j]), -7.0f), 7.0f);
                        r[n * 4 + j] = glu * __builtin_amdgcn_rcpf(1.0f + __builtin_amdgcn_exp2f(-1.702f * 1.4426950408889634f * glu)) * (lin + 1.0f);
                    }
                v4u w; w.x = pkh(r[0], r[1]); w.y = pkh(r[2], r[3]); w.z = pkh(r[4], r[5]); w.w = pkh(r[6], r[7]);
                *(v4u*)(act + row * 1024 + c0) = w;
            }
    }
};
template <int VAR> struct EpiSwigluP : pg::EpiBase {
    static constexpr bool PERM = true;
    h16* act; const float* b1;
    __device__ __forceinline__ void operator()(const pg::Acc& acc, const pg::Unit& u, int wr, int wc, int fr, int fq) const { EPI_OPAQUE();
        const int c0 = u.pn * 128 + wc * 32 + 8 * fq;
        const float* bg = b1 + (size_t)u.e * 2048 + c0; const float* bl = bg + 1024;
        const f32x4 g0 = *(const f32x4*)bg, g1 = *(const f32x4*)(bg + 4), l0 = *(const f32x4*)bl, l1 = *(const f32x4*)(bl + 4);
#pragma unroll
        for (int ai = 0; ai < 2; ++ai)
#pragma unroll
            for (int m = 0; m < 4; ++m) {
                const size_t row = (size_t)u.pm * 256 + ai * 128 + wr * 64 + m * 16 + fr;
                float r[8];
#pragma unroll
                for (int n = 0; n < 2; ++n)
#pragma unroll
                    for (int j = 0; j < 4; ++j) {
                        const float glu = fminf(acc[ai][0][m][n][j] + (n ? g1[j] : g0[j]), 7.0f);
                        const float lin = fminf(fmaxf(acc[ai][1][m][n][j] + (n ? l1[j] : l0[j]), -7.0f), 7.0f);
                        r[n * 4 + j] = (VAR == 2) ? glu + lin : glu * __builtin_amdgcn_rcpf(1.0f + __builtin_amdgcn_exp2f(-1.702f * 1.4426950408889634f * glu)) * (lin + 1.0f);
                    }
                v4u w; w.x = pkh(r[0], r[1]); w.y = pkh(r[2], r[3]); w.z = pkh(r[4], r[5]); w.w = pkh(r[6], r[7]);
                if (VAR == 1) { asm volatile("" :: "v"(w.x), "v"(w.y), "v"(w.z), "v"(w.w)); } else { *(v4u*)(act + row * 1024 + c0) = w; }
            }
    }
};
struct EpiMoeOut : pg::EpiBase {
    static constexpr bool PERM = true;
    h16* __restrict__ y; const float* __restrict__ b2; const float* __restrict__ gate;
    __device__ __forceinline__ void operator()(const pg::Acc& acc, const pg::Unit& u, int wr, int wc, int fr, int fq) const { EPI_OPAQUE();
        float gt[2][4]; f32x4 bv[2][2];
#pragma unroll
        for (int ai = 0; ai < 2; ++ai)
#pragma unroll
            for (int m = 0; m < 4; ++m) gt[ai][m] = gate[(size_t)u.pm * 256 + ai * 128 + wr * 64 + m * 16 + fr];
#pragma unroll
        for (int bj = 0; bj < 2; ++bj) { const float* bp = b2 + (size_t)u.e * 1024 + u.pn * 256 + bj * 128 + wc * 32 + 8 * fq; bv[bj][0] = *(const f32x4*)bp; bv[bj][1] = *(const f32x4*)(bp + 4); }
#pragma unroll
        for (int ai = 0; ai < 2; ++ai)
#pragma unroll
            for (int m = 0; m < 4; ++m) {
                const size_t row = (size_t)u.pm * 256 + ai * 128 + wr * 64 + m * 16 + fr;
#pragma unroll
                for (int bj = 0; bj < 2; ++bj) {
                    const int c0 = u.pn * 256 + bj * 128 + wc * 32 + 8 * fq;
                    const f32x4 v0 = (acc[ai][bj][m][0] + bv[bj][0]) * gt[ai][m], v1 = (acc[ai][bj][m][1] + bv[bj][1]) * gt[ai][m];
                    v4u w; w.x = pkh(v0[0], v0[1]); w.y = pkh(v0[2], v0[3]); w.z = pkh(v1[0], v1[1]); w.w = pkh(v1[2], v1[3]);
                    *(v4u*)(y + row * 1024 + c0) = w;
                }
            }
    }
};
template <bool Y8> __device__ __forceinline__ void ph_combine_ln(const Params& p, Frame& F, const h16* xprev, const float* gam, const float* bet, float* outf, h16* outh) {
    int lane = F.lane; asm volatile("" : "+v"(lane));
    const int gw = F.vcu * NWAVES + F.wave, NGW = F.G * NWAVES;
    constexpr int NT = Y8 ? 4 : 3;
    for (int tb = gw * NT; tb < T_; tb += NGW * NT) {
        v4u xw[NT][2], yw[Y8 ? 1 : NT][2][4]; v2u yq[Y8 ? NT : 1][2][4];
#pragma unroll
        for (int u = 0; u < NT; ++u) { const int t = tb + u < T_ ? tb + u : T_ - 1; int sl[4];
#pragma unroll
            for (int k = 0; k < 4; ++k) sl[k] = p.inv[t * 4 + k];
#pragma unroll
            for (int j = 0; j < 2; ++j) { const int c = 8 * lane + 512 * j; xw[u][j] = *(const GAS v4u*)(xprev + (size_t)t * 1024 + c);
#pragma unroll
                for (int k = 0; k < 4; ++k) { if constexpr (Y8) yq[u][j][k] = *(const GAS v2u*)((const unsigned char*)p.yy + (size_t)sl[k] * 1024 + c); else yw[u][j][k] = *(const GAS v4u*)(p.yy + (size_t)sl[k] * 1024 + c); } } }
#pragma unroll
        for (int u = 0; u < NT; ++u) { const int t = tb + u; if (t >= T_) break;
            float v[16]; float s = 0.f;
#pragma unroll
            for (int j = 0; j < 2; ++j) { const v4u x4 = xw[u][j];
                float a[8] = {h2f(x4.x & 0xffff) * ALPHA_, h2f(x4.x >> 16) * ALPHA_, h2f(x4.y & 0xffff) * ALPHA_, h2f(x4.y >> 16) * ALPHA_, h2f(x4.z & 0xffff) * ALPHA_, h2f(x4.z >> 16) * ALPHA_, h2f(x4.w & 0xffff) * ALPHA_, h2f(x4.w >> 16) * ALPHA_};
#pragma unroll
                for (int k = 0; k < 4; ++k) {
                    if constexpr (Y8) { const v2u w8 = yq[u][j][k]; const f32x2v p0 = __builtin_amdgcn_cvt_pk_f32_fp8((int)w8.x, false), p1 = __builtin_amdgcn_cvt_pk_f32_fp8((int)w8.x, true), p2 = __builtin_amdgcn_cvt_pk_f32_fp8((int)w8.y, false), p3 = __builtin_amdgcn_cvt_pk_f32_fp8((int)w8.y, true);
                        a[0] += p0.x * 0.03125f; a[1] += p0.y * 0.03125f; a[2] += p1.x * 0.03125f; a[3] += p1.y * 0.03125f; a[4] += p2.x * 0.03125f; a[5] += p2.y * 0.03125f; a[6] += p3.x * 0.03125f; a[7] += p3.y * 0.03125f; }
                    else { const v4u w = yw[u][j][k];
                    a[0] += h2f(w.x & 0xffff); a[1] += h2f(w.x >> 16); a[2] += h2f(w.y & 0xffff); a[3] += h2f(w.y >> 16);
                    a[4] += h2f(w.z & 0xffff); a[5] += h2f(w.z >> 16); a[6] += h2f(w.w & 0xffff); a[7] += h2f(w.w >> 16); } }
#pragma unroll
                for (int q = 0; q < 8; ++q) { v[j * 8 + q] = a[q]; s += a[q]; } }
            const float mean = wave_sum(s) * (1.0f / 1024.0f); float qq = 0.f;
#pragma unroll
            for (int q = 0; q < 16; ++q) { v[q] -= mean; qq += v[q] * v[q]; }
            const float rstd = 1.0f / sqrtf(wave_sum(qq) * (1.0f / 1024.0f) + LN_EPS_);
#pragma unroll
            for (int j = 0; j < 2; ++j) {
                const int c = 8 * lane + 512 * j;
                const f32x4 ga = *(const GAS f32x4*)(gam + c), gb = *(const GAS f32x4*)(gam + c + 4), ba = *(const GAS f32x4*)(bet + c), bb = *(const GAS f32x4*)(bet + c + 4);
                f32x4 oa, ob;
                oa.x = v[j * 8 + 0] * rstd * ga.x + ba.x; oa.y = v[j * 8 + 1] * rstd * ga.y + ba.y; oa.z = v[j * 8 + 2] * rstd * ga.z + ba.z; oa.w = v[j * 8 + 3] * rstd * ga.w + ba.w;
                ob.x = v[j * 8 + 4] * rstd * gb.x + bb.x; ob.y = v[j * 8 + 5] * rstd * gb.y + bb.y; ob.z = v[j * 8 + 6] * rstd * gb.z + bb.z; ob.w = v[j * 8 + 7] * rstd * gb.w + bb.w;
                if (outf) { *(GAS f32x4*)(outf + (size_t)t * 1024 + c) = oa; *(GAS f32x4*)(outf + (size_t)t * 1024 + c + 4) = ob; }
                if (outh) { v4u w; w.x = pkh(oa.x, oa.y); w.y = pkh(oa.z, oa.w); w.z = pkh(ob.x, ob.y); w.w = pkh(ob.z, ob.w); *(GAS v4u*)(outh + (size_t)t * 1024 + c) = w; }
            } }
    }
}
struct CvJob { const float* src; h16* dst; int K, N, n_off, n_cnt, row_off, w1map, f8; };
__device__ __forceinline__ void cv_load(const CvJob& j, int item, int lane, float (&ld)[32]) {
    const int nblk = j.n_cnt / 32, kb = item / nblk, nb = item % nblk, k0 = 64 * kb, n0 = j.n_off + 32 * nb;
#pragma unroll
    for (int i = 0; i < 32; ++i) { const int kk = 2 * i + (lane >> 5); ld[i] = j.src[(size_t)(k0 + kk) * j.N + n0 + (lane & 31)]; }
}
__device__ __forceinline__ void cv_finish(const CvJob& j, LAS float* scr, int item, int lane, const float (&ld)[32]) {
    const int nblk = j.n_cnt / 32, kb = item / nblk, nb = item % nblk, k0 = 64 * kb, n0 = j.n_off + 32 * nb;
#pragma unroll
    for (int i = 0; i < 32; ++i) { const int kk = 2 * i + (lane >> 5); scr[kk * 33 + (lane & 31)] = ld[i]; }
    LDS_WAIT(); asm volatile("" ::: "memory");
    const int c = lane & 7;
#pragma unroll
    for (int q = 0; q < 4; ++q) { const int n = (lane >> 3) + 8 * q; const LAS float* s = scr + (8 * c) * 33 + n;
        const int nn = n0 + n - j.n_off; const int jj = nn & 1023;
        const long dr = j.w1map ? (long)(256 * (jj >> 7) + (nn >> 10) * 128 + (jj & 127)) : (long)(j.row_off + nn);
        if (j.f8) { int lo = 0, hi = 0;
            lo = __builtin_amdgcn_cvt_pk_fp8_f32(s[0 * 33] * 32.f, s[1 * 33] * 32.f, lo, false); lo = __builtin_amdgcn_cvt_pk_fp8_f32(s[2 * 33] * 32.f, s[3 * 33] * 32.f, lo, true);
            hi = __builtin_amdgcn_cvt_pk_fp8_f32(s[4 * 33] * 32.f, s[5 * 33] * 32.f, hi, false); hi = __builtin_amdgcn_cvt_pk_fp8_f32(s[6 * 33] * 32.f, s[7 * 33] * 32.f, hi, true);
            v2u o8; o8.x = (unsigned)lo; o8.y = (unsigned)hi; *(GAS v2u*)((unsigned char*)j.dst + (size_t)dr * j.K + k0 + 8 * c) = o8; }
        else { v4u o; o.x = pkh(s[0 * 33], s[1 * 33]); o.y = pkh(s[2 * 33], s[3 * 33]); o.z = pkh(s[4 * 33], s[5 * 33]); o.w = pkh(s[6 * 33], s[7 * 33]);
            *(GAS v4u*)(j.dst + (size_t)dr * j.K + k0 + 8 * c) = o; } }
    LDS_WAIT(); asm volatile("" ::: "memory");
}
__device__ __forceinline__ int cv_decode(const Params& p, int it, CvJob& j) {
    constexpr int J1 = 1024, J2 = 1024, J3 = 1024, J4 = 1024, J5 = 640, J6 = 512, I1 = 1024, I2 = 512;
    int r = it;
    if (r < J1) { j = CvJob{p.w_ret_in, p.wri_t, 1024, 6144, 0, 2048, 0, 0, 0}; }
    else if ((r -= J1) < J2) { j = CvJob{p.w_ret_in, p.wri_t, 1024, 6144, 4096, 2048, 2048, 0, 0}; }
    else if ((r -= J2) < J3) { j = CvJob{p.w_ret_in, p.wfm_t, 1024, 6144, 2048, 2048, 0, 0, 0}; }
    else if ((r -= J3) < J4) { j = CvJob{p.w_ret_out, p.wro_t, 2048, 1024, 0, 1024, 0, 0, 0}; }
    else if ((r -= J4) < J5) { j = CvJob{p.w_swa_in, p.wsi_t, 1024, 1280, 0, 1280, 0, 0, 0}; }
    else if ((r -= J5) < J6) { j = CvJob{p.w_swa_out, p.wso_t, 1024, 1024, 0, 1024, 0, 0, 0}; }
    else if ((r -= J6) < 64 * I1) { const int e = r / I1; r %= I1; if (e < F8_FROM) j = CvJob{p.w_exp_in + (size_t)e * 1024 * 2048, p.w1_t + (size_t)e * 2048 * 1024, 1024, 2048, 0, 2048, 0, 1, 0};
        else j = CvJob{p.w_exp_in + (size_t)e * 1024 * 2048, (h16*)(p.w1q + (size_t)e * 2048 * 1024), 1024, 2048, 0, 2048, 0, 1, 1}; }
    else { r -= 64 * I1; const int e = r / I2; r %= I2; if (e < F8_FROM) j = CvJob{p.w_exp_out + (size_t)e * 1024 * 1024, p.w2_t + (size_t)e * 1024 * 1024, 1024, 1024, 0, 1024, 0, 0, 0};
        else j = CvJob{p.w_exp_out + (size_t)e * 1024 * 1024, (h16*)(p.w2q + (size_t)e * 1024 * 1024), 1024, 1024, 0, 1024, 0, 0, 1}; }
    return r;
}
__device__ __forceinline__ void ph_prologue(const Params& p, Frame& F) {
    LAS float* scr = (LAS float*)(F.lds + RING_OFF + F.wave * 16384);
    const int gw = F.vcu * NWAVES + F.wave, NGW = F.G * NWAVES;
    constexpr int NITEMS = 1024 + 1024 + 1024 + 1024 + 640 + 512 + 64 * (1024 + 512);
    int it = gw; CvJob j0, j1; int r0 = 0, r1 = 0; float ld0[32], ld1[32];
    if (it < NITEMS) { r0 = cv_decode(p, it, j0); cv_load(j0, r0, F.lane, ld0); }
    while (it < NITEMS) {
        const int nit = it + NGW; const bool hn = nit < NITEMS;
        if (hn) { r1 = cv_decode(p, nit, j1); cv_load(j1, r1, F.lane, ld1); }
        cv_finish(j0, scr, r0, F.lane, ld0);
        j0 = j1; r0 = r1;
#pragma unroll
        for (int i = 0; i < 32; ++i) ld0[i] = ld1[i];
        it = nit;
    }
    ph_cvt_rows(p.x, p.xh0, (size_t)T_ * D_, F);
}

struct DenseSched {
    const char* A; const char* B; size_t a_tile_bytes, b_tile_bytes; int nM, nN, nwg, G, c;
    __device__ __forceinline__ void init(const void* A_, int lda, const void* B_, int ldb, int M, int N, int G_, int c_, int rot = 0  ) {
        A = (const char*)A_; B = (const char*)B_; a_tile_bytes = (size_t)256 * lda * 2; b_tile_bytes = (size_t)256 * ldb * 2; nM = M / 256; nN = N / 256; nwg = nM * nN; G = G_; c = (c_ + G_ - rot) % G_; }
    __device__ __forceinline__ bool next(int i, pg::Unit& u) const {
        const long L = (long)i * G + c; if (L >= nwg) return false;
        int wgid = (int)L; { const int q = nwg / 8, r = nwg % 8, xcd = wgid % 8, off = wgid / 8; wgid = (xcd < r ? xcd * (q + 1) : r * (q + 1) + (xcd - r) * q) + off; }
        const int nig = 8 * nN, gid = wgid / nig, fm = gid * 8, gsz = (nM - fm) < 8 ? (nM - fm) : 8;
        u.pm = fm + ((wgid % nig) % gsz); u.pn = (wgid % nig) / gsz; u.e = 0; u.x = 0;
        u.a = A + (size_t)u.pm * a_tile_bytes; u.b = B + (size_t)u.pn * b_tile_bytes; return true;
    }
    __device__ __forceinline__ unsigned arow(const pg::Unit&, int) const { return 0u; }
};
struct EpiResid : pg::EpiBase {
    static constexpr bool PERM = true;
    const h16* __restrict__ xprevh; const float* __restrict__ bias; h16* __restrict__ yh;
    __device__ __forceinline__ void operator()(const pg::Acc& acc, const pg::Unit& u, int wr, int wc, int fr, int fq) const { EPI_OPAQUE();
        f32x4 bv[2][2];
#pragma unroll
        for (int bj = 0; bj < 2; ++bj) { const int col = u.pn * 256 + bj * 128 + wc * 32 + 8 * fq;
            bv[bj][0] = bias ? *(const f32x4*)(bias + col) : (f32x4){0.f, 0.f, 0.f, 0.f}; bv[bj][1] = bias ? *(const f32x4*)(bias + col + 4) : (f32x4){0.f, 0.f, 0.f, 0.f}; }
#pragma unroll
        for (int ai = 0; ai < 2; ++ai) {
            v4u xw[4][2];
#pragma unroll
            for (int m = 0; m < 4; ++m)
#pragma unroll
                for (int bj = 0; bj < 2; ++bj) { const size_t row = (size_t)u.pm * 256 + ai * 128 + wr * 64 + m * 16 + fr; xw[m][bj] = *(const v4u*)(xprevh + row * 1024 + u.pn * 256 + bj * 128 + wc * 32 + 8 * fq); }
#pragma unroll
            for (int m = 0; m < 4; ++m)
#pragma unroll
                for (int bj = 0; bj < 2; ++bj) { const size_t row = (size_t)u.pm * 256 + ai * 128 + wr * 64 + m * 16 + fr; const int col = u.pn * 256 + bj * 128 + wc * 32 + 8 * fq; const v4u x4 = xw[m][bj];
                    const f32x4 a = (f32x4){h2f(x4.x & 0xffff), h2f(x4.x >> 16), h2f(x4.y & 0xffff), h2f(x4.y >> 16)} * ALPHA_ + acc[ai][bj][m][0] + bv[bj][0];
                    const f32x4 b = (f32x4){h2f(x4.z & 0xffff), h2f(x4.z >> 16), h2f(x4.w & 0xffff), h2f(x4.w >> 16)} * ALPHA_ + acc[ai][bj][m][1] + bv[bj][1];
                    v4u w; w.x = pkh(a[0], a[1]); w.y = pkh(a[2], a[3]); w.z = pkh(b[0], b[1]); w.w = pkh(b[2], b[3]);
                    *(v4u*)(yh + row * 1024 + col) = w; } }
    }
};
struct EpiF32 : pg::EpiBase {
    const float* bias; float* c; int ldc;
    __device__ __forceinline__ void operator()(const pg::Acc& acc, const pg::Unit& u, int wr, int wc, int fr, int fq) const { EPI_OPAQUE();
#pragma unroll
        for (int ai = 0; ai < 2; ++ai)
#pragma unroll
            for (int m = 0; m < 4; ++m) { const size_t row = (size_t)u.pm * 256 + ai * 128 + wr * 64 + m * 16 + fr;
#pragma unroll
                for (int bj = 0; bj < 2; ++bj)
#pragma unroll
                    for (int n = 0; n < 2; ++n) { const int col = u.pn * 256 + bj * 128 + wc * 32 + n * 16 + 4 * fq;
                        f32x4 o = acc[ai][bj][m][n]; if (bias) o += *(const f32x4*)(bias + col);
                        *(f32x4*)(c + row * ldc + col) = o; } }
    }
};

constexpr int XROW16 = 1032;
typedef _Float16 f16x8r __attribute__((ext_vector_type(8)));
__device__ __forceinline__ void ph_ln_router(const Params& p, Frame& F, const float* gam, const float* bet, const float* wr, const float* br, unsigned char* xq, const int pmode = 0  ) {
    LAS unsigned short* X = (LAS unsigned short*)(F.lds);
    LAS float* PART = (LAS float*)(X + 32 * XROW16);
    LAS int* se = (LAS int*)(PART + 8 * 32 * 32);
    LAS float* LG = (LAS float*)(se + 512);
    LAS float* TV = LG + 1024;
    LAS int* cnt = (LAS int*)(TV + 128);
    int tid_o = F.tid; asm volatile("" : "+v"(tid_o));
    const int lane = tid_o & 63, w = F.wave, l15 = lane & 15, kg = lane >> 4;
    f16x8r wh[2][4], wl[2][4];
#pragma unroll
    for (int nt = 0; nt < 2; ++nt)
#pragma unroll
        for (int s = 0; s < 4; ++s) {
#pragma unroll
            for (int j = 0; j < 8; ++j) { const float v = wr[(size_t)(128 * w + 32 * s + 8 * kg + j) * 32 + 16 * nt + l15]; const _Float16 h = (_Float16)v; wh[nt][s][j] = h; wl[nt][s][j] = (_Float16)(v - (float)h); } }
    const float bias_e = br[tid_o & 31];
    for (int cc = blockIdx.x; cc < T_ / 128; cc += F.G) {
        v4u pre[4][2];
#pragma unroll
        for (int r = 0; r < 4; ++r)
#pragma unroll
            for (int j = 0; j < 2; ++j) pre[r][j] = *(const GAS v4u*)(p.yh + (size_t)(cc * 128 + 4 * w + r) * 1024 + 8 * lane + 512 * j);
        for (int blk = 0; blk < 4; ++blk) {
            const int t0 = cc * 128 + blk * 32;
            v4u cur[4][2];
#pragma unroll
            for (int r = 0; r < 4; ++r)
#pragma unroll
                for (int j = 0; j < 2; ++j) { cur[r][j] = pre[r][j]; if (blk < 3) pre[r][j] = *(const GAS v4u*)(p.yh + (size_t)(t0 + 32 + 4 * w + r) * 1024 + 8 * lane + 512 * j); }
#pragma unroll
            for (int r = 0; r < 4; ++r) {
                const int tl = 4 * w + r; const size_t t = (size_t)(t0 + tl);
                f32x4 v[4]; float s = 0.f;
#pragma unroll
                for (int j = 0; j < 2; ++j) { const v4u pw = cur[r][j]; v[2 * j] = (f32x4){h2f(pw.x & 0xffff), h2f(pw.x >> 16), h2f(pw.y & 0xffff), h2f(pw.y >> 16)}; v[2 * j + 1] = (f32x4){h2f(pw.z & 0xffff), h2f(pw.z >> 16), h2f(pw.w & 0xffff), h2f(pw.w >> 16)}; }
#pragma unroll
                for (int j = 0; j < 4; ++j) s += (v[j].x + v[j].y) + (v[j].z + v[j].w);
                const float mean = wave_sum(s) * (1.0f / 1024.0f); float q = 0.f;
#pragma unroll
                for (int j = 0; j < 4; ++j) { v[j] = v[j] - mean; q += (v[j].x * v[j].x + v[j].y * v[j].y) + (v[j].z * v[j].z + v[j].w * v[j].w); }
                const float rstd = 1.0f / sqrtf(wave_sum(q) * (1.0f / 1024.0f) + LN_EPS_);
#pragma unroll
                for (int j = 0; j < 2; ++j) { const int c = 8 * lane + 512 * j;
                    const f32x4 o0 = v[2 * j] * rstd * *(const GAS f32x4*)(gam + c) + *(const GAS f32x4*)(bet + c), o1 = v[2 * j + 1] * rstd * *(const GAS f32x4*)(gam + c + 4) + *(const GAS f32x4*)(bet + c + 4);
                    v4u hw; hw.x = pkh(o0.x, o0.y); hw.y = pkh(o0.z, o0.w); hw.z = pkh(o1.x, o1.y); hw.w = pkh(o1.z, o1.w);
                    *(GAS v4u*)(p.x1h + t * 1024 + c) = hw;
                    if (xq) { int qa = 0, qb = 0; qa = __builtin_amdgcn_cvt_pk_fp8_f32(o0.x, o0.y, qa, false); qa = __builtin_amdgcn_cvt_pk_fp8_f32(o0.z, o0.w, qa, true); qb = __builtin_amdgcn_cvt_pk_fp8_f32(o1.x, o1.y, qb, false); qb = __builtin_amdgcn_cvt_pk_fp8_f32(o1.z, o1.w, qb, true);
                        v2u q8; q8.x = (unsigned)qa; q8.y = (unsigned)qb; *(GAS v2u*)(xq + t * 1024 + c) = q8; }
                    *(LAS v4u*)(X + tl * XROW16 + c) = hw; }
            }
            if (pmode == 1) continue;
            __syncthreads();
            {
                f32x4 acc[2][2];
#pragma unroll
                for (int mt = 0; mt < 2; ++mt)
#pragma unroll
                    for (int nt = 0; nt < 2; ++nt) acc[mt][nt] = (f32x4){0.f, 0.f, 0.f, 0.f};
#pragma unroll
                for (int s = 0; s < 4; ++s)
#pragma unroll
                    for (int mt = 0; mt < 2; ++mt) { const f16x8r a = *(const LAS f16x8r*)(X + (16 * mt + l15) * XROW16 + 128 * w + 32 * s + 8 * kg);
#pragma unroll
                        for (int nt = 0; nt < 2; ++nt) { acc[mt][nt] = __builtin_amdgcn_mfma_f32_16x16x32_f16(a, wh[nt][s], acc[mt][nt], 0, 0, 0); acc[mt][nt] = __builtin_amdgcn_mfma_f32_16x16x32_f16(a, wl[nt][s], acc[mt][nt], 0, 0, 0); } }
#pragma unroll
                for (int mt = 0; mt < 2; ++mt)
#pragma unroll
                    for (int nt = 0; nt < 2; ++nt)
#pragma unroll
                        for (int r = 0; r < 4; ++r) PART[(w * 32 + 16 * mt + 4 * kg + r) * 32 + 16 * nt + l15] = acc[mt][nt][r];
            }
            __syncthreads();
#pragma unroll
            for (int ps = 0; ps < 2; ++ps) {
                const int tok = (tid_o >> 5) + 16 * ps, e = tid_o & 31; float val = bias_e;
#pragma unroll
                for (int q = 0; q < 8; ++q) val += PART[(q * 32 + tok) * 32 + e];
                LG[tok * 32 + e] = val;
                LDS_WAIT(); asm volatile("" ::: "memory");
                int rank = 0;
#pragma unroll
                for (int q4 = 0; q4 < 8; ++q4) { const f32x4 o = *(const LAS f32x4*)(LG + tok * 32 + 4 * q4);
                    rank += ((o.x > val) || (o.x == val && 4 * q4 < e)) ? 1 : 0; rank += ((o.y > val) || (o.y == val && 4 * q4 + 1 < e)) ? 1 : 0;
                    rank += ((o.z > val) || (o.z == val && 4 * q4 + 2 < e)) ? 1 : 0; rank += ((o.w > val) || (o.w == val && 4 * q4 + 3 < e)) ? 1 : 0; }
                const int t = t0 + tok;
                if (rank < 4) { TV[tok * 4 + rank] = val; p.top_e[t * 4 + rank] = e; se[(blk * 32 + tok) * 4 + rank] = e; }
                LDS_WAIT(); asm volatile("" ::: "memory");
                if (e < 4) { const f32x4 tv = *(const LAS f32x4*)(TV + tok * 4);
                    const float e1 = __expf(tv.y - tv.x), e2 = __expf(tv.z - tv.x), e3 = __expf(tv.w - tv.x); const float inv = 1.0f / (1.0f + e1 + e2 + e3);
                    p.top_g[t * 4 + e] = (e == 0 ? 1.0f : (e == 1 ? e1 : (e == 2 ? e2 : e3))) * inv; }
            }
        }
        __syncthreads();
        if (pmode == 0) {
            const int j = tid_o; const int e = se[j]; int r = 0;
            if (j < 32) cnt[j] = 0;
            __syncthreads();
#pragma unroll 8
            for (int q4 = 0; q4 < 128; ++q4) { const v4u sv = *(const LAS v4u*)(se + 4 * q4);
                r += ((int)sv.x == e && 4 * q4 < j) ? 1 : 0; r += ((int)sv.y == e && 4 * q4 + 1 < j) ? 1 : 0; r += ((int)sv.z == e && 4 * q4 + 2 < j) ? 1 : 0; r += ((int)sv.w == e && 4 * q4 + 3 < j) ? 1 : 0; }
            p.rankp[cc * 512 + j] = r;
            atomicAdd((int*)(cnt + e), 1);
            __syncthreads();
            if (j < 32) p.wg_cnt[cc * 32 + j] = cnt[j];
        }
        __syncthreads();
    }
}

__device__ __forceinline__ float lg2gamma(int h) { return h == 0 ? -0.04580368961312479f : (h == 1 ? -0.02272007650008353f : (h == 2 ? -0.011315313227834146f : -0.005646563141142063f)); }
struct EpiInTok : pg::EpiBase {
    static constexpr bool PERM = true;
    h16 *q, *k, *sg;
    __device__ __forceinline__ void operator()(const pg::Acc& acc, const pg::Unit& u, int wr, int wc, int fr, int fq) const { EPI_OPAQUE();
        const int pn = u.pn; h16* dst; int ld, cb; int mode;
        if (pn < 4) { dst = q; ld = 1024; cb = pn * 256; mode = 0; } else if (pn < 8) { dst = k; ld = 1024; cb = (pn - 4) * 256; mode = 1; } else { dst = sg; ld = 2048; cb = (pn - 8) * 256; mode = 2; }
#pragma unroll
        for (int ai = 0; ai < 2; ++ai)
#pragma unroll
            for (int m = 0; m < 4; ++m) { const size_t row = (size_t)u.pm * 256 + ai * 128 + wr * 64 + m * 16 + fr;
#pragma unroll
                for (int bj = 0; bj < 2; ++bj) { const int c0 = cb + bj * 128 + wc * 32 + 8 * fq; float r[8];
#pragma unroll
                    for (int n = 0; n < 2; ++n)
#pragma unroll
                        for (int j = 0; j < 4; ++j) { float v = acc[ai][bj][m][n][j];
                            if (mode == 1) v *= 0.0625f;
                            if (mode == 2) v = v * __builtin_amdgcn_rcpf(1.0f + __builtin_amdgcn_exp2f(-1.4426950408889634f * v));
                            r[n * 4 + j] = v; }
                    v4u w; w.x = pkh(r[0], r[1]); w.y = pkh(r[2], r[3]); w.z = pkh(r[4], r[5]); w.w = pkh(r[6], r[7]);
                    *(v4u*)(dst + row * ld + c0) = w; } }
    }
};
struct EpiInFeat : pg::EpiBase {
    static constexpr bool PERM = true;
    h16* __restrict__ vt;
    __device__ __forceinline__ void operator()(const pg::Acc& acc, const pg::Unit& u, int wr, int wc, int fr, int fq) const { EPI_OPAQUE();
        h16* dst = vt + ((size_t)u.pn * 2048 + (size_t)u.pm * 256) * 256;
#pragma unroll
        for (int bj = 0; bj < 2; ++bj) { const int c0 = bj * 128 + wc * 32 + 8 * fq;
#pragma unroll
            for (int ai = 0; ai < 2; ++ai)
#pragma unroll
                for (int m = 0; m < 4; ++m) { const size_t row = (size_t)(ai * 128 + wr * 64 + m * 16 + fr);
                    const f32x4 a = acc[ai][bj][m][0], b = acc[ai][bj][m][1];
                    v4u w; w.x = pkh(a[0], a[1]); w.y = pkh(a[2], a[3]); w.z = pkh(b[0], b[1]); w.w = pkh(b[2], b[3]);
                    *(v4u*)(dst + row * 256 + c0) = w; } }
    }
};
constexpr int KT_PITCH = 520;
__device__ __forceinline__ void ph_ktranspose(const Params& p, Frame& F) {
    LAS unsigned char* img = F.lds;
    for (int item = F.vcu; item < 512; item += F.G) {
        const int chunk = item >> 2, h = item & 3;
        __syncthreads();
        v4u ld[16];
#pragma unroll
        for (int i = 0; i < 16; ++i) { const int pc = F.tid + 512 * i, row = pc >> 5, c16 = pc & 31; ld[i] = *(const GAS v4u*)(p.k + ((size_t)(chunk * 256 + row)) * 1024 + h * 256 + c16 * 8); }
#pragma unroll
        for (int i = 0; i < 16; ++i) { const int pc = F.tid + 512 * i, row = pc >> 5, c16 = pc & 31; v2u lo; lo.x = ld[i].x; lo.y = ld[i].y; v2u hi; hi.x = ld[i].z; hi.y = ld[i].w;
            *(LAS v2u*)(img + row * KT_PITCH + c16 * 16) = lo; *(LAS v2u*)(img + row * KT_PITCH + c16 * 16 + 8) = hi; }
        __syncthreads();
        const int tg = F.tid & 31; const float lg = lg2gamma(h); float sc[8];
#pragma unroll
        for (int j = 0; j < 8; ++j) sc[j] = __builtin_amdgcn_exp2f((float)(255 - (8 * tg + j)) * lg);
        h16* dst = p.kdt + ((size_t)chunk * 1024 + h * 256) * 256;
#pragma unroll 4
        for (int r = 0; r < 16; ++r) { const int dk = (F.tid >> 5) + 16 * r; float v[8];
#pragma unroll
            for (int j = 0; j < 8; ++j) v[j] = h2f(*(const LAS unsigned short*)(img + (8 * tg + j) * KT_PITCH + dk * 2)) * sc[j];
            v4u w; w.x = pkh(v[0], v[1]); w.y = pkh(v[2], v[3]); w.z = pkh(v[4], v[5]); w.w = pkh(v[6], v[7]);
            *(GAS v4u*)(dst + (size_t)dk * 256 + 8 * tg) = w; }
    }
    __syncthreads();
}
struct RaSched {
    const h16 *q, *k; int G, c;
    __device__ __forceinline__ bool next(int i, pg::Unit& u) const {
        const int L = i * G + c; if (L >= 512) return false;
        const int bh = L >> 5, cch = L & 31, b = bh >> 2, h = bh & 3; const size_t off = ((size_t)(b * 8192 + cch * 256) * 1024 + h * 256) * 2;
        u.a = (const char*)q + off; u.b = (const char*)k + off; u.pm = L; u.pn = 0; u.e = L; u.x = h; return true; }
    __device__ __forceinline__ unsigned arow(const pg::Unit&, int) const { return 0u; }
};
struct EpiPP : pg::EpiBase {
    static constexpr bool PERM = true;
    h16* pp;
    __device__ __forceinline__ void operator()(const pg::Acc& acc, const pg::Unit& u, int wr, int wc, int fr, int fq) const { EPI_OPAQUE();
        const float lg = lg2gamma(u.x); h16* dst = pp + (size_t)u.e * 65536;
#pragma unroll
        for (int bj = 0; bj < 2; ++bj) { const int c0 = bj * 128 + wc * 32 + 8 * fq; float sc[8];
#pragma unroll
            for (int j = 0; j < 8; ++j) sc[j] = __builtin_amdgcn_exp2f(-(float)(c0 + j + 1) * lg);
#pragma unroll
            for (int ai = 0; ai < 2; ++ai)
#pragma unroll
                for (int m = 0; m < 4; ++m) { const int i = ai * 128 + wr * 64 + m * 16 + fr; float r[8];
#pragma unroll
                    for (int n = 0; n < 2; ++n)
#pragma unroll
                        for (int j = 0; j < 4; ++j) r[n * 4 + j] = (c0 + n * 4 + j <= i) ? acc[ai][bj][m][n][j] * sc[n * 4 + j] : 0.f;
                    v4u w; w.x = pkh(r[0], r[1]); w.y = pkh(r[2], r[3]); w.z = pkh(r[4], r[5]); w.w = pkh(r[6], r[7]);
                    *(v4u*)(dst + (size_t)i * 256 + c0) = w; } }
    }
};
struct R1Sched {
    const h16 *vt, *kdt; int nsub, G, c;
    __device__ __forceinline__ bool next(int i, pg::Unit& u) const {
        const int item = (i / nsub) * G + c, j = i % nsub; if (item >= 256) return false;
        if (nsub == 4 && ((item >> 1) & 7) == 7) return false;
        const int pm = item & 1, seg = (item >> 1) & 7, bh = item >> 4, b = bh >> 2, h = bh & 3; const size_t chunk = (size_t)b * 32 + seg * 4 + j;
        u.a = (const char*)vt + ((chunk * 2048 + h * 512 + pm * 256) * 256) * 2; u.b = (const char*)kdt + ((chunk * 1024 + h * 256) * 256) * 2;
        u.pm = pm; u.pn = j; u.e = item; u.x = h; return true; }
    __device__ __forceinline__ unsigned arow(const pg::Unit&, int) const { return 0u; }
};
__device__ __forceinline__ void acc_scale(pg::Acc& acc, float s) {
#pragma unroll
    for (int a = 0; a < 2; ++a)
#pragma unroll
        for (int b = 0; b < 2; ++b)
#pragma unroll
            for (int m = 0; m < 4; ++m)
#pragma unroll
                for (int n = 0; n < 2; ++n) acc[a][b][m][n] = acc[a][b][m][n] * s;
}
struct EpiSegTot : pg::EpiBase {
    static constexpr bool PERM = true;
    float* L;
    __device__ __forceinline__ void operator()(pg::Acc& acc, const pg::Unit& u, int wr, int wc, int fr, int fq) const { EPI_OPAQUE();
        if (u.pn < 3) { acc_scale(acc, __builtin_amdgcn_exp2f(256.0f * lg2gamma(u.x))); return; }
        float* dst = L + ((size_t)(u.e >> 1) * 512 + u.pm * 256) * 256;
#pragma unroll
        for (int ai = 0; ai < 2; ++ai)
#pragma unroll
            for (int m = 0; m < 4; ++m) { const int r = ai * 128 + wr * 64 + m * 16 + fr;
#pragma unroll
                for (int bj = 0; bj < 2; ++bj) { const int c0 = bj * 128 + wc * 32 + 8 * fq;
                    *(f32x4*)(dst + (size_t)r * 256 + c0) = acc[ai][bj][m][0]; *(f32x4*)(dst + (size_t)r * 256 + c0 + 4) = acc[ai][bj][m][1]; } }
    }
    __device__ __forceinline__ void reinit(pg::Acc& acc, const pg::Unit& cur, const pg::Unit& nxt, int, int, int, int) const { if (nxt.e != cur.e) pg::acc_zero(acc); }
};
struct EpiSnap : pg::EpiBase {
    static constexpr bool PERM = true;
    const float* L; h16* st;
    __device__ __forceinline__ void snap(const pg::Acc& acc, const pg::Unit& u, int j, int wr, int wc, int fr, int fq) const { EPI_OPAQUE();
        const int seg = (u.e >> 1) & 7, bh = u.e >> 4; h16* dst = st + ((size_t)(bh * 32 + seg * 4 + j) * 512 + u.pm * 256) * 256;
#pragma unroll
        for (int ai = 0; ai < 2; ++ai)
#pragma unroll
            for (int m = 0; m < 4; ++m) { const int r = ai * 128 + wr * 64 + m * 16 + fr;
#pragma unroll
                for (int bj = 0; bj < 2; ++bj) { const int c0 = bj * 128 + wc * 32 + 8 * fq; const f32x4 a = acc[ai][bj][m][0], b = acc[ai][bj][m][1];
                    v4u w; w.x = pkh(a[0], a[1]); w.y = pkh(a[2], a[3]); w.z = pkh(b[0], b[1]); w.w = pkh(b[2], b[3]);
                    *(v4u*)(dst + (size_t)r * 256 + c0) = w; } }
    }
    __device__ __forceinline__ void load(pg::Acc& acc, const pg::Unit& u, int wr, int wc, int fr, int fq) const { EPI_OPAQUE();
        const float* src = L + ((size_t)(u.e >> 1) * 512 + u.pm * 256) * 256;
#pragma unroll
        for (int ai = 0; ai < 2; ++ai)
#pragma unroll
            for (int m = 0; m < 4; ++m) { const int r = ai * 128 + wr * 64 + m * 16 + fr;
#pragma unroll
                for (int bj = 0; bj < 2; ++bj) { const int c0 = bj * 128 + wc * 32 + 8 * fq;
                    acc[ai][bj][m][0] = *(const f32x4*)(src + (size_t)r * 256 + c0); acc[ai][bj][m][1] = *(const f32x4*)(src + (size_t)r * 256 + c0 + 4); } }
    }
    __device__ __forceinline__ void init(pg::Acc& acc, const pg::Unit& u, int wr, int wc, int fr, int fq) const { EPI_OPAQUE(); load(acc, u, wr, wc, fr, fq); snap(acc, u, 0, wr, wc, fr, fq); acc_scale(acc, __builtin_amdgcn_exp2f(256.0f * lg2gamma(u.x))); }
    __device__ __forceinline__ void operator()(pg::Acc& acc, const pg::Unit& u, int wr, int wc, int fr, int fq) const { EPI_OPAQUE(); snap(acc, u, u.pn + 1, wr, wc, fr, fq); }
    __device__ __forceinline__ void reinit(pg::Acc& acc, const pg::Unit& cur, const pg::Unit& nxt, int wr, int wc, int fr, int fq) const { EPI_OPAQUE();
        if (nxt.e != cur.e) { load(acc, nxt, wr, wc, fr, fq); snap(acc, nxt, 0, wr, wc, fr, fq); }
        acc_scale(acc, __builtin_amdgcn_exp2f(256.0f * lg2gamma(nxt.x))); }
};
__device__ __forceinline__ void ph_carry(float* L, Frame& F) {
    const size_t n = (size_t)16 * 131072;
    int tid_o = F.tid; asm volatile("" : "+v"(tid_o));
    for (size_t i = ((size_t)blockIdx.x * 512 + tid_o) * 4; i < n; i += (size_t)F.G * 512 * 4) {
        const int bh = (int)(i >> 17); const size_t el = i & 131071; const float g = __builtin_amdgcn_exp2f(1024.0f * lg2gamma(bh & 3));
        f32x4 s = {0.f, 0.f, 0.f, 0.f}, l[8];
#pragma unroll
        for (int sgm = 0; sgm < 8; ++sgm) l[sgm] = *(const GAS f32x4*)(L + ((size_t)(bh * 8 + sgm) << 17) + el);
#pragma unroll
        for (int sgm = 0; sgm < 8; ++sgm) { *(GAS f32x4*)(L + ((size_t)(bh * 8 + sgm) << 17) + el) = s; s = s * g + l[sgm]; }
    }
}
struct R2Sched {
    const h16 *pp, *vt, *q, *st; int G, c;
    __device__ __forceinline__ bool next(int i, pg::Unit& u) const {
        const int ch = (i >> 2) * G + c, pn = (i >> 1) & 1, x = i & 1; if (ch >= 512) return false;
        const int cch = ch & 31, bh = ch >> 5, b = bh >> 2, h = bh & 3; const size_t tok0 = (size_t)b * 8192 + cch * 256;
        if (x == 0) { u.a = (const char*)pp + (size_t)ch * 65536 * 2; u.b = (const char*)vt + (((tok0 >> 8) * 2048 + h * 512 + pn * 256) * 256) * 2; }
        else { u.a = (const char*)q + (tok0 * 1024 + h * 256) * 2; u.b = (const char*)st + ((size_t)ch * 512 + pn * 256) * 256 * 2; }
        u.pm = ch; u.pn = pn; u.e = (int)tok0; u.x = x; return true; }
    __device__ __forceinline__ unsigned arow(const pg::Unit&, int) const { return 0u; }
};
struct EpiRetOut : pg::EpiBase {
    static constexpr bool PERM = true;
    h16* __restrict__ o; const h16* __restrict__ sg; h16* __restrict__ og;
    __device__ __forceinline__ void operator()(const pg::Acc& acc, const pg::Unit& u, int wr, int wc, int fr, int fq) const { EPI_OPAQUE();
        if (u.x == 0) return;
        const int h = (u.pm >> 5) & 3; const float lg = lg2gamma(h);
#pragma unroll
        for (int ai = 0; ai < 2; ++ai)
#pragma unroll
            for (int m = 0; m < 4; ++m) { const int i = ai * 128 + wr * 64 + m * 16 + fr; const float qd = __builtin_amdgcn_exp2f((float)(i + 1) * lg);
                h16* dst = o + (size_t)(u.e + i) * 2048 + h * 512 + u.pn * 256;
#pragma unroll
                for (int bj = 0; bj < 2; ++bj) { const int c0 = bj * 128 + wc * 32 + 8 * fq; const f32x4 a = acc[ai][bj][m][0] * qd, b = acc[ai][bj][m][1] * qd;
                    v4u w; w.x = pkh(a[0], a[1]); w.y = pkh(a[2], a[3]); w.z = pkh(b[0], b[1]); w.w = pkh(b[2], b[3]);
                    *(v4u*)(dst + c0) = w; } }
        if (u.pn == 0) return;
        asm volatile("s_waitcnt vmcnt(0)" ::: "memory");
        __builtin_amdgcn_s_barrier(); asm volatile("" ::: "memory");
        const int wid = __builtin_amdgcn_readfirstlane((int)threadIdx.x >> 6), lane = (fq << 4) | fr;
#pragma unroll 1
        for (int r0 = 0; r0 < 32; r0 += 8) {
            v4u ow[8], gv[8];
#pragma unroll
            for (int q = 0; q < 8; ++q) { const size_t off = (size_t)(u.e + 32 * wid + r0 + q) * 2048 + h * 512 + 8 * lane; ow[q] = *(const GAS v4u*)(o + off); gv[q] = *(const GAS v4u*)(sg + off); }
#pragma unroll
            for (int q = 0; q < 8; ++q) { const size_t off = (size_t)(u.e + 32 * wid + r0 + q) * 2048 + h * 512 + 8 * lane; const v4u o4 = ow[q], g4 = gv[q];
                float v[8] = {h2f(o4.x & 0xffff), h2f(o4.x >> 16), h2f(o4.y & 0xffff), h2f(o4.y >> 16), h2f(o4.z & 0xffff), h2f(o4.z >> 16), h2f(o4.w & 0xffff), h2f(o4.w >> 16)};
                const float g[8] = {h2f(g4.x & 0xffff), h2f(g4.x >> 16), h2f(g4.y & 0xffff), h2f(g4.y >> 16), h2f(g4.z & 0xffff), h2f(g4.z >> 16), h2f(g4.w & 0xffff), h2f(g4.w >> 16)};
                float s = 0.f;
#pragma unroll
                for (int j = 0; j < 8; ++j) s += v[j];
                const float mean = wave_sum(s) * (1.0f / 512.0f); float qq = 0.f;
#pragma unroll
                for (int j = 0; j < 8; ++j) { v[j] -= mean; qq += v[j] * v[j]; }
                const float rstd = 1.0f / sqrtf(wave_sum(qq) * (1.0f / 512.0f) + 1e-6f);
                v4u w; w.x = pkh(g[0] * v[0] * rstd, g[1] * v[1] * rstd); w.y = pkh(g[2] * v[2] * rstd, g[3] * v[3] * rstd); w.z = pkh(g[4] * v[4] * rstd, g[5] * v[5] * rstd); w.w = pkh(g[6] * v[6] * rstd, g[7] * v[7] * rstd);
                *(GAS v4u*)(og + off) = w; }
        }
    }
    __device__ __forceinline__ void reinit(pg::Acc& acc, const pg::Unit&, const pg::Unit& nxt, int, int, int, int) const { if (nxt.x == 0) pg::acc_zero(acc); }
};
__device__ __forceinline__ void ph_gn_gate(const Params& p, Frame& F) {
    const int gw = F.vcu * NWAVES + F.wave, NGW = F.G * NWAVES, lane = F.lane;
    for (int it0 = gw * 4; it0 < T_ * 4; it0 += NGW * 4) {
        v4u ow[4], gv[4];
#pragma unroll
        for (int u = 0; u < 4; ++u) { const size_t off = (size_t)(it0 + u) * 512 + 8 * lane; ow[u] = *(const GAS v4u*)(p.o + off); gv[u] = *(const GAS v4u*)(p.sg + off); }
#pragma unroll
        for (int u = 0; u < 4; ++u) { const size_t off = (size_t)(it0 + u) * 512 + 8 * lane; const v4u o4 = ow[u], g4 = gv[u];
            float v[8] = {h2f(o4.x & 0xffff), h2f(o4.x >> 16), h2f(o4.y & 0xffff), h2f(o4.y >> 16), h2f(o4.z & 0xffff), h2f(o4.z >> 16), h2f(o4.w & 0xffff), h2f(o4.w >> 16)};
            const float g[8] = {h2f(g4.x & 0xffff), h2f(g4.x >> 16), h2f(g4.y & 0xffff), h2f(g4.y >> 16), h2f(g4.z & 0xffff), h2f(g4.z >> 16), h2f(g4.w & 0xffff), h2f(g4.w >> 16)};
            float s = 0.f;
#pragma unroll
            for (int j = 0; j < 8; ++j) s += v[j];
            const float mean = wave_sum(s) * (1.0f / 512.0f); float q = 0.f;
#pragma unroll
            for (int j = 0; j < 8; ++j) { v[j] -= mean; q += v[j] * v[j]; }
            const float rstd = 1.0f / sqrtf(wave_sum(q) * (1.0f / 512.0f) + 1e-6f);
            v4u w; w.x = pkh(g[0] * v[0] * rstd, g[1] * v[1] * rstd); w.y = pkh(g[2] * v[2] * rstd, g[3] * v[3] * rstd); w.z = pkh(g[4] * v[4] * rstd, g[5] * v[5] * rstd); w.w = pkh(g[6] * v[6] * rstd, g[7] * v[7] * rstd);
            *(GAS v4u*)(p.og + off) = w; }
    }
}
constexpr float SWA_C2 = 0.125f * 1.4426950408889634f;
struct EpiSwaTok : pg::EpiBase {
    static constexpr bool PERM = true;
    h16 *sq, *skv; const float* bias;
    __device__ __forceinline__ void operator()(const pg::Acc& acc, const pg::Unit& u, int wr, int wc, int fr, int fq) const { EPI_OPAQUE();
        const bool isq = u.pn < 4; h16* dst = isq ? sq : skv; const int ld = isq ? 1024 : 256, cb = isq ? u.pn * 256 : 0; const float sc = isq ? SWA_C2 : 1.0f;
#pragma unroll
        for (int bj = 0; bj < 2; ++bj) { const int ct = bj * 128 + wc * 32 + 8 * fq; const float* bp = bias + u.pn * 256 + ct;
            const f32x4 b0 = *(const f32x4*)bp, b1 = *(const f32x4*)(bp + 4);
#pragma unroll
            for (int ai = 0; ai < 2; ++ai)
#pragma unroll
                for (int m = 0; m < 4; ++m) { const size_t row = (size_t)u.pm * 256 + ai * 128 + wr * 64 + m * 16 + fr;
                    const f32x4 a = (acc[ai][bj][m][0] + b0) * sc, b = (acc[ai][bj][m][1] + b1) * sc;
                    v4u w; w.x = pkh(a[0], a[1]); w.y = pkh(a[2], a[3]); w.z = pkh(b[0], b[1]); w.w = pkh(b[2], b[3]);
                    *(v4u*)(dst + row * ld + cb + ct) = w; } }
    }
};
struct EpiSwaFeat : pg::EpiBase {
    static constexpr bool PERM = true;
    h16* __restrict__ kvt; const float* __restrict__ bias;
    __device__ __forceinline__ void operator()(const pg::Acc& acc, const pg::Unit& u, int wr, int wc, int fr, int fq) const { EPI_OPAQUE();
        float bv[2][4];
#pragma unroll
        for (int ai = 0; ai < 2; ++ai)
#pragma unroll
            for (int m = 0; m < 4; ++m) bv[ai][m] = bias[1024 + ai * 128 + wr * 64 + m * 16 + fr];
#pragma unroll
        for (int ai = 0; ai < 2; ++ai)
#pragma unroll
            for (int m = 0; m < 4; ++m) { const int r = ai * 128 + wr * 64 + m * 16 + fr;
#pragma unroll
                for (int bj = 0; bj < 2; ++bj) { const int ct = bj * 128 + wc * 32 + 8 * fq; const f32x4 a = acc[ai][bj][m][0] + bv[ai][m], b = acc[ai][bj][m][1] + bv[ai][m];
                    v4u w; w.x = pkh(a[0], a[1]); w.y = pkh(a[2], a[3]); w.z = pkh(b[0], b[1]); w.w = pkh(b[2], b[3]);
                    *(v4u*)(kvt + (size_t)r * T_ + (size_t)u.pn * 256 + ct) = w; } }
    }
};
typedef float f32x16 __attribute__((ext_vector_type(16)));
typedef _Float16 f16x8v __attribute__((ext_vector_type(8)));
typedef _Float16 f16x4v __attribute__((ext_vector_type(4)));
constexpr int KP = 144, VP = 520;
__device__ __forceinline__ void ph_swa_attn(const Params& p, Frame& F) {
    LAS unsigned char* Ks = F.lds; LAS unsigned char* Vs = F.lds + 256 * KP;
    const int lane = F.lane, w = F.wave, l31 = lane & 31, hh = lane >> 5;
    for (int unit = F.vcu; unit < 512; unit += F.G) {
        const int g = unit & 1, n = (unit >> 1) & 63, b = unit >> 7; const size_t tok0 = (size_t)b * SEQ_ + (size_t)n * 128;
        __syncthreads();
        for (int c = F.tid; c < 256 * 8; c += 512) { const int key = c >> 3, ch = c & 7; v4u val = {0u, 0u, 0u, 0u};
            if (n > 0 || key >= 128) val = *(const GAS v4u*)(p.skv + (tok0 - 128 + key) * 256 + g * 64 + ch * 8);
            *(LAS v4u*)(Ks + key * KP + ch * 16) = val; }
        for (int c = F.tid; c < 64 * 32; c += 512) { const int d = c >> 5, ch = c & 31; v4u val = {0u, 0u, 0u, 0u};
            if (n > 0 || ch >= 16) val = *(const GAS v4u*)(p.kvt + (size_t)(128 + g * 64 + d) * T_ + tok0 - 128 + ch * 8);
            v2u lo2; lo2.x = val.x; lo2.y = val.y; v2u hi2; hi2.x = val.z; hi2.y = val.w;
            *(LAS v2u*)(Vs + d * VP + ch * 16) = lo2; *(LAS v2u*)(Vs + d * VP + ch * 16 + 8) = hi2; }
        __syncthreads();
        const int hq = g * 8 + w; const float slope = __builtin_amdgcn_exp2f(-0.5f * (float)(hq + 1)) * 1.4426950408889634f, sink = p.sinks[hq] * 1.4426950408889634f;
#pragma nounroll
        for (int qi = 0; qi < 4; ++qi) {
            f16x8v qf[4];
            const h16* qrow = p.sq + (tok0 + qi * 32 + l31) * 1024 + hq * 64 + 8 * hh;
#pragma unroll
            for (int s = 0; s < 4; ++s) qf[s] = *(const GAS f16x8v*)(qrow + 16 * s);
            f32x16 sc[5];
#pragma unroll
            for (int t = 0; t < 5; ++t) {
                sc[t] = (f32x16){0.f, 0.f, 0.f, 0.f, 0.f, 0.f, 0.f, 0.f, 0.f, 0.f, 0.f, 0.f, 0.f, 0.f, 0.f, 0.f};
                const LAS unsigned char* kp = Ks + ((qi + t) * 32 + l31) * KP + 16 * hh;
#pragma unroll
                for (int s = 0; s < 4; ++s) { const f16x8v kf = *(const LAS f16x8v*)(kp + 32 * s); sc[t] = __builtin_amdgcn_mfma_f32_32x32x16_f16(kf, qf[s], sc[t], 0, 0, 0); }
            }
            float mx = sink;
            float basef = (float)(l31 + 128 - 4 * hh); asm volatile("" : "+v"(basef));
#pragma unroll
            for (int t = 0; t < 5; ++t) { const bool tile_ok = (n > 0) || (qi + t >= 4);
#pragma unroll
                for (int r = 0; r < 16; ++r) { const float distf = basef - (float)(32 * t + (r & 3) + 8 * (r >> 2));
                    bool ok = tile_ok; if (t == 0) ok = ok && (distf < 128.0f); if (t == 4) ok = ok && (distf >= 0.0f);
                    const float v = ok ? sc[t][r] - slope * distf : -INFINITY; sc[t][r] = v; mx = fmaxf(mx, v); } }
            mx = fmaxf(mx, __shfl_xor(mx, 32));
            float ls = 0.f; f16x8v pf[5][2];
#pragma unroll
            for (int t = 0; t < 5; ++t)
#pragma unroll
                for (int s2 = 0; s2 < 2; ++s2) { float e[8];
#pragma unroll
                    for (int j = 0; j < 8; ++j) { e[j] = __builtin_amdgcn_exp2f(sc[t][8 * s2 + j] - mx); ls += e[j]; }
                    v4u pw; pw.x = pkh(e[0], e[1]); pw.y = pkh(e[2], e[3]); pw.z = pkh(e[4], e[5]); pw.w = pkh(e[6], e[7]); pf[t][s2] = __builtin_bit_cast(f16x8v, pw); }
            ls += __shfl_xor(ls, 32); ls += __builtin_amdgcn_exp2f(sink - mx);
            const float rl = 1.0f / ls;
            f32x16 oa[2];
#pragma unroll
            for (int dt = 0; dt < 2; ++dt) { oa[dt] = (f32x16){0.f, 0.f, 0.f, 0.f, 0.f, 0.f, 0.f, 0.f, 0.f, 0.f, 0.f, 0.f, 0.f, 0.f, 0.f, 0.f};
                const LAS unsigned char* vp = Vs + (32 * dt + l31) * VP + (qi * 32 + 4 * hh) * 2;
#pragma unroll
                for (int t = 0; t < 5; ++t)
#pragma unroll
                    for (int s2 = 0; s2 < 2; ++s2) { const f16x4v v0 = *(const LAS f16x4v*)(vp + (t * 32 + s2 * 16) * 2), v1 = *(const LAS f16x4v*)(vp + (t * 32 + s2 * 16 + 8) * 2);
                        const f16x8v vf = __builtin_shufflevector(v0, v1, 0, 1, 2, 3, 4, 5, 6, 7);
                        oa[dt] = __builtin_amdgcn_mfma_f32_32x32x16_f16(vf, pf[t][s2], oa[dt], 0, 0, 0); } }
            h16* orow = p.so + (tok0 + qi * 32 + l31) * 1024 + hq * 64 + 4 * hh;
#pragma unroll
            for (int dt = 0; dt < 2; ++dt)
#pragma unroll
                for (int gq = 0; gq < 4; ++gq) { v2u ow; ow.x = pkh(oa[dt][4 * gq] * rl, oa[dt][4 * gq + 1] * rl); ow.y = pkh(oa[dt][4 * gq + 2] * rl, oa[dt][4 * gq + 3] * rl);
                    *(GAS v2u*)(orow + 32 * dt + 8 * gq) = ow; }
        }
    }
}

struct EpiNull : pg::EpiBase {
    static constexpr bool PERM = true;
    __device__ __forceinline__ void operator()(const pg::Acc& acc, const pg::Unit& u, int wr, int wc, int fr, int fq) const { asm volatile("" :: "v"(acc[0][0][0][0][0]), "v"(acc[1][1][3][1][3])); }
};

struct EpiSwigluQ : pg::EpiBase {
    static constexpr bool PERM = true;
    unsigned char* __restrict__ actq; const float* __restrict__ b1;
    typedef _Float16 h2 __attribute__((ext_vector_type(2)));
    typedef short s2 __attribute__((ext_vector_type(2)));
    __device__ __forceinline__ h2 act2(f32x2v g32, f32x2v l32) const {
        h2 g = __builtin_convertvector(g32, h2), l = __builtin_convertvector(l32, h2);
        g = __builtin_elementwise_min(g, (h2){7.0f16, 7.0f16});
        l = __builtin_elementwise_max(__builtin_elementwise_min(l, (h2){7.0f16, 7.0f16}), (h2){-7.0f16, -7.0f16});
        const h2 e = __builtin_elementwise_exp2(g * (h2){-2.4554f16, -2.4554f16});
        const h2 d = e + (h2){1.0f16, 1.0f16};
        const h2 r = {(_Float16)__builtin_amdgcn_rcph(d.x), (_Float16)__builtin_amdgcn_rcph(d.y)};
        return (g * r) * (l * (h2){4.0f16, 4.0f16} + (h2){4.0f16, 4.0f16});
    }
    __device__ __forceinline__ void operator()(const pg::Acc& acc, const pg::Unit& u, int wr, int wc, int fr, int fq) const { EPI_OPAQUE();
        const int c0 = u.pn * 128 + wc * 32 + 8 * fq;
        const float* bg = b1 + (size_t)u.e * 2048 + c0; const float* bl = bg + 1024;
        const f32x4 g0 = *(const f32x4*)bg, g1 = *(const f32x4*)(bg + 4), l0 = *(const f32x4*)bl, l1 = *(const f32x4*)(bl + 4);
#pragma unroll
        for (int ai = 0; ai < 2; ++ai)
#pragma unroll
            for (int m = 0; m < 4; ++m) {
                const size_t row = (size_t)u.pm * 256 + ai * 128 + wr * 64 + m * 16 + fr;
                const f32x4 ga = acc[ai][0][m][0] * 0.03125f + g0, gb = acc[ai][0][m][1] * 0.03125f + g1, la = acc[ai][1][m][0] * 0.03125f + l0, lb = acc[ai][1][m][1] * 0.03125f + l1;
                s2 lo = {0, 0}, hi = {0, 0};
                lo = __builtin_amdgcn_cvt_scalef32_pk_fp8_f16(lo, act2((f32x2v){ga.x, ga.y}, (f32x2v){la.x, la.y}), 1.0f, false);
                lo = __builtin_amdgcn_cvt_scalef32_pk_fp8_f16(lo, act2((f32x2v){ga.z, ga.w}, (f32x2v){la.z, la.w}), 1.0f, true);
                hi = __builtin_amdgcn_cvt_scalef32_pk_fp8_f16(hi, act2((f32x2v){gb.x, gb.y}, (f32x2v){lb.x, lb.y}), 1.0f, false);
                hi = __builtin_amdgcn_cvt_scalef32_pk_fp8_f16(hi, act2((f32x2v){gb.z, gb.w}, (f32x2v){lb.z, lb.w}), 1.0f, true);
                v2u w; w.x = __builtin_bit_cast(unsigned, lo); w.y = __builtin_bit_cast(unsigned, hi);
                *(v2u*)(actq + row * 1024 + c0) = w;
            }
    }
};
template <int VAR> struct EpiSwigluQP : pg::EpiBase {
    static constexpr bool PERM = true;
    unsigned char* __restrict__ actq; const float* __restrict__ b1;
    typedef _Float16 h2 __attribute__((ext_vector_type(2)));
    typedef short s2 __attribute__((ext_vector_type(2)));
    __device__ __forceinline__ h2 act2(f32x2v g32, f32x2v l32) const {
        h2 g = __builtin_convertvector(g32, h2), l = __builtin_convertvector(l32, h2);
        g = __builtin_elementwise_min(g, (h2){7.0f16, 7.0f16});
        l = __builtin_elementwise_max(__builtin_elementwise_min(l, (h2){7.0f16, 7.0f16}), (h2){-7.0f16, -7.0f16});
        const h2 e = __builtin_elementwise_exp2(g * (h2){-2.4554f16, -2.4554f16});
        const h2 d = e + (h2){1.0f16, 1.0f16};
        const h2 r = {(_Float16)__builtin_amdgcn_rcph(d.x), (_Float16)__builtin_amdgcn_rcph(d.y)};
        return (g * r) * (l * (h2){4.0f16, 4.0f16} + (h2){4.0f16, 4.0f16});
    }
    __device__ __forceinline__ void operator()(const pg::Acc& acc, const pg::Unit& u, int wr, int wc, int fr, int fq) const { EPI_OPAQUE();
        const int c0 = u.pn * 128 + wc * 32 + 8 * fq;
        const float* bg = b1 + (size_t)u.e * 2048 + c0; const float* bl = bg + 1024;
        const f32x4 g0 = *(const f32x4*)bg, g1 = *(const f32x4*)(bg + 4), l0 = *(const f32x4*)bl, l1 = *(const f32x4*)(bl + 4);
        if (VAR == 1) { asm volatile("" :: "v"(g0), "v"(g1), "v"(l0), "v"(l1));
#pragma unroll
            for (int ai = 0; ai < 2; ++ai)
#pragma unroll
                for (int bj = 0; bj < 2; ++bj)
#pragma unroll
                    for (int m = 0; m < 4; ++m) asm volatile("" :: "v"(acc[ai][bj][m][0]), "v"(acc[ai][bj][m][1]));
            return; }
#pragma unroll
        for (int ai = 0; ai < 2; ++ai)
#pragma unroll
            for (int m = 0; m < 4; ++m) {
                const size_t row = (size_t)u.pm * 256 + ai * 128 + wr * 64 + m * 16 + fr;
                const f32x4 ga = acc[ai][0][m][0] * 0.03125f + g0, gb = acc[ai][0][m][1] * 0.03125f + g1, la = acc[ai][1][m][0] * 0.03125f + l0, lb = acc[ai][1][m][1] * 0.03125f + l1;
                s2 lo = {0, 0}, hi = {0, 0};
                lo = __builtin_amdgcn_cvt_scalef32_pk_fp8_f16(lo, act2((f32x2v){ga.x, ga.y}, (f32x2v){la.x, la.y}), 1.0f, false);
                lo = __builtin_amdgcn_cvt_scalef32_pk_fp8_f16(lo, act2((f32x2v){ga.z, ga.w}, (f32x2v){la.z, la.w}), 1.0f, true);
                hi = __builtin_amdgcn_cvt_scalef32_pk_fp8_f16(hi, act2((f32x2v){gb.x, gb.y}, (f32x2v){lb.x, lb.y}), 1.0f, false);
                hi = __builtin_amdgcn_cvt_scalef32_pk_fp8_f16(hi, act2((f32x2v){gb.z, gb.w}, (f32x2v){lb.z, lb.w}), 1.0f, true);
                v2u w; w.x = __builtin_bit_cast(unsigned, lo); w.y = __builtin_bit_cast(unsigned, hi);
                if (VAR == 2) asm volatile("" :: "v"(w.x), "v"(w.y)); else *(v2u*)(actq + row * 1024 + c0) = w;
            }
    }
};
template <bool Y8> struct EpiMoeOutQ : pg::EpiBase {
    static constexpr bool PERM = true;
    unsigned char* __restrict__ y8; const float* __restrict__ b2; const float* __restrict__ gate;
    __device__ __forceinline__ void operator()(const pg::Acc& acc, const pg::Unit& u, int wr, int wc, int fr, int fq) const { EPI_OPAQUE();
        float gt[2][4]; f32x4 bv[2][2];
#pragma unroll
        for (int ai = 0; ai < 2; ++ai)
#pragma unroll
            for (int m = 0; m < 4; ++m) gt[ai][m] = gate[(size_t)u.pm * 256 + ai * 128 + wr * 64 + m * 16 + fr];
#pragma unroll
        for (int bj = 0; bj < 2; ++bj) { const float* bp = b2 + (size_t)u.e * 1024 + u.pn * 256 + bj * 128 + wc * 32 + 8 * fq; bv[bj][0] = *(const f32x4*)bp; bv[bj][1] = *(const f32x4*)(bp + 4); }
#pragma unroll
        for (int ai = 0; ai < 2; ++ai)
#pragma unroll
            for (int m = 0; m < 4; ++m) {
                const size_t row = (size_t)u.pm * 256 + ai * 128 + wr * 64 + m * 16 + fr;
#pragma unroll
                for (int bj = 0; bj < 2; ++bj) {
                    const int c0 = u.pn * 256 + bj * 128 + wc * 32 + 8 * fq;
                    const float gs = gt[ai][m] * (Y8 ? 32.0f : 1.0f);
                    const f32x4 v0 = (acc[ai][bj][m][0] * 0.0078125f + bv[bj][0]) * gs, v1 = (acc[ai][bj][m][1] * 0.0078125f + bv[bj][1]) * gs;
                    if (Y8) { int lo = 0, hi = 0;
                        lo = __builtin_amdgcn_cvt_pk_fp8_f32(v0[0], v0[1], lo, false); lo = __builtin_amdgcn_cvt_pk_fp8_f32(v0[2], v0[3], lo, true);
                        hi = __builtin_amdgcn_cvt_pk_fp8_f32(v1[0], v1[1], hi, false); hi = __builtin_amdgcn_cvt_pk_fp8_f32(v1[2], v1[3], hi, true);
                        v2u w; w.x = (unsigned)lo; w.y = (unsigned)hi; *(v2u*)(y8 + row * 1024 + c0) = w; }
                    else { v4u w; w.x = pkh(v0[0], v0[1]); w.y = pkh(v0[2], v0[3]); w.z = pkh(v1[0], v1[1]); w.w = pkh(v1[2], v1[3]); *(v4u*)((h16*)y8 + row * 1024 + c0) = w; }
                }
            }
    }
};

struct MoeSchedHot : MoeSched {
    __device__ __forceinline__ bool next(int i, pg::Unit& u) const { const bool ok = MoeSched::next(i, u); if (ok) { u.a = abase; u.b = wbase; } return ok; }
    __device__ __forceinline__ unsigned arow(const pg::Unit&, int r) const { return (unsigned)r; }
};

struct EpiKeep : pg::EpiBase {
    static constexpr bool PERM = true;
    __device__ __forceinline__ void operator()(const pg::Acc& acc, const pg::Unit& u, int wr, int wc, int fr, int fq) const {
#pragma unroll
        for (int ai = 0; ai < 2; ++ai)
#pragma unroll
            for (int bj = 0; bj < 2; ++bj)
#pragma unroll
                for (int m = 0; m < 4; ++m) asm volatile("" :: "v"(acc[ai][bj][m][0]), "v"(acc[ai][bj][m][1]));
    }
};
#ifndef PROBE_DBL
#define PROBE_DBL 0
#endif
#ifndef SKEW_STEP
#define SKEW_STEP 0
#endif
#define SKEW(F) (((F).vcu & 3) * SKEW_STEP)
#define DBL(bit, body) do { body; if ((PROBE_DBL >> (bit)) & 1) { GRID_BAR(); body; } } while (0)
template <int layer>
__device__ __forceinline__ void layer_tail(const Params& p, Frame& F, const XcdBarrier& bar) {
#define GRID_BAR() xcd_barrier(bar)
    {
        if (layer == 0) { DenseSched S; S.init(p.og, 2048, p.wro_t, 2048, T_, 1024, F.G, (int)blockIdx.x); EpiResid E; E.yh = p.yh; E.xprevh = p.xh0; E.bias = nullptr;
            pg::gemm_phase<EpiResid, DenseSched, 0, true>(F.lds + RING_OFF, 2048, 2048, 32, S, E); }
        else { DenseSched S; S.init(p.so, 1024, p.wso_t, 1024, T_, 1024, F.G, (int)blockIdx.x); EpiResid E; E.yh = p.yh; E.xprevh = p.x2h; E.bias = p.b_swa_out;
            pg::gemm_phase<EpiResid, DenseSched, 0, true>(F.lds + RING_OFF, 1024, 1024, 16, S, E); }
    }
    GRID_BAR();
    DBL(1, ph_ln_router(p, F, p.ln_mix_g + layer * 1024, p.ln_mix_b + layer * 1024, p.w_router + layer * 1024 * 32, p.b_router + layer * 32, (layer == 1 || MOE_F8_L0) ? p.x1q : (unsigned char*)nullptr));
#if (PROBE_DBL >> 19) & 1
    GRID_BAR();
    ph_ln_router(p, F, p.ln_mix_g + layer * 1024, p.ln_mix_b + layer * 1024, p.w_router + layer * 1024 * 32, p.b_router + layer * 32, layer == 1 ? p.x1q : (unsigned char*)nullptr, (PROBE_DBL >> 19) & 1);
#endif
    GRID_BAR();
    DBL(5, ph_assign(p, F, layer));
    GRID_BAR();
    {
        const int ntiles = (int)__hip_atomic_load(F.ctl + CW_NTILES + 64 * layer, RLX_AGENT);
        moe_tables(F, p.tile_e, p.slot_tok, ntiles, 3, true);
        if (layer == 0 && !MOE_F8_L0) {
            MoeSched S{(const char*)p.x1h, (const char*)p.w1_t, (LAS const int*)(F.lds + TAB_OFF), (LAS const int*)(F.lds + TAB_OFF) + 32, ntiles, 3, F.G, F.vcu, 0, (size_t)2048 * 1024 * 2, (size_t)256 * 1024 * 2};
            EpiSwiglu E; E.act = p.act; E.b1 = p.b_exp_in;
            pg::gemm_phase<EpiSwiglu, MoeSched, 1, true>(F.lds + RING_OFF, 1024, 1024, 16, S, E);
        } else {
            MoeSched S{(const char*)p.x1q, (const char*)(p.w1q + (size_t)layer * 32 * 2048 * 1024), (LAS const int*)(F.lds + TAB_OFF), (LAS const int*)(F.lds + TAB_OFF) + 32, ntiles, 3, F.G, F.vcu, 0, (size_t)2048 * 1024, (size_t)256 * 1024};
            EpiSwigluQ E; E.actq = p.actq; E.b1 = p.b_exp_in + (size_t)layer * 32 * 2048;
            pg::gemm_phase<EpiSwigluQ, MoeSched, 1, true, 1>(F.lds + RING_OFF, 1024, 1024, 8, S, E, 0, 0, SKEW(F));
        }
    }
    GRID_BAR();
#if (PROBE_DBL >> 21) & 3
    GRID_BAR();
    if (layer == 0) {
        const int ntiles = (int)__hip_atomic_load(F.ctl + CW_NTILES + 64 * layer, RLX_AGENT);
        moe_tables(F, p.tile_e, p.slot_tok, ntiles, 3, true);
        EpiSwigluP<1> E; E.act = p.yy; E.b1 = p.b_exp_in;
        if ((PROBE_DBL >> 22) & 1) { MoeSchedHot S{{((PROBE_DBL >> 23) & 1) ? (const char*)p.ctl : (const char*)p.x1h, ((PROBE_DBL >> 23) & 1) ? (const char*)p.ctl + 524288 : (const char*)p.w1_t, (LAS const int*)(F.lds + TAB_OFF), (LAS const int*)(F.lds + TAB_OFF) + 32, ntiles, 3, F.G, F.vcu, 0, (size_t)2048 * 1024 * 2, (size_t)256 * 1024 * 2}};
            pg::gemm_phase<EpiSwigluP<1>, MoeSchedHot, 1, true, 2, ((PROBE_DBL >> 24) & 1) != 0>(F.lds + RING_OFF, 1024, 1024, 16, S, E); }
        else { MoeSched S{(const char*)p.x1h, (const char*)p.w1_t, (LAS const int*)(F.lds + TAB_OFF), (LAS const int*)(F.lds + TAB_OFF) + 32, ntiles, 3, F.G, F.vcu, 0, (size_t)2048 * 1024 * 2, (size_t)256 * 1024 * 2};
            pg::gemm_phase<EpiSwigluP<1>, MoeSched, 1, true, 2, ((PROBE_DBL >> 24) & 1) != 0>(F.lds + RING_OFF, 1024, 1024, 16, S, E); }
    }
#endif
#if (PROBE_DBL >> 29) & 3
    GRID_BAR();
    {
        const int ntiles = (int)__hip_atomic_load(F.ctl + CW_NTILES + 64 * layer, RLX_AGENT);
        moe_tables(F, p.tile_e, p.slot_tok, ntiles, 3, true);
        MoeSched S{(const char*)p.x1q, (const char*)(p.w1q + (size_t)layer * 32 * 2048 * 1024), (LAS const int*)(F.lds + TAB_OFF), (LAS const int*)(F.lds + TAB_OFF) + 32, ntiles, 3, F.G, F.vcu, 0, (size_t)2048 * 1024, (size_t)256 * 1024};
        EpiSwigluQP<((PROBE_DBL >> 29) & 3)> E; E.actq = p.actq; E.b1 = p.b_exp_in + (size_t)layer * 32 * 2048;
        pg::gemm_phase<EpiSwigluQP<((PROBE_DBL >> 29) & 3)>, MoeSched, 1, true, 1>(F.lds + RING_OFF, 1024, 1024, 8, S, E);
    }
#endif
#if (PROBE_DBL >> 25) & 1
    GRID_BAR();
    {
        const int ntiles = (int)__hip_atomic_load(F.ctl + CW_NTILES + 64 * layer, RLX_AGENT);
        moe_tables(F, p.tile_e, p.slot_tok, ntiles, 3, true);
        MoeSched S{(const char*)p.x1q, (const char*)(p.w1q + (size_t)layer * 32 * 2048 * 1024), (LAS const int*)(F.lds + TAB_OFF), (LAS const int*)(F.lds + TAB_OFF) + 32, ntiles, 3, F.G, F.vcu, 0, (size_t)2048 * 1024, (size_t)256 * 1024};
        EpiKeep E;
        pg::gemm_phase<EpiKeep, MoeSched, 1, true, 1>(F.lds + RING_OFF, 1024, 1024, 8, S, E);
    }
#endif
#if (PROBE_DBL >> 26) & 1
    GRID_BAR();
    {
        const int ntiles = (int)__hip_atomic_load(F.ctl + CW_NTILES + 64 * layer, RLX_AGENT);
        moe_tables(F, p.tile_e, p.slot_tok, ntiles, 3, true);
        MoeSched S{(const char*)p.x1q, (const char*)(p.w1q + (size_t)layer * 32 * 2048 * 1024), (LAS const int*)(F.lds + TAB_OFF), (LAS const int*)(F.lds + TAB_OFF) + 32, ntiles, 3, F.G, F.vcu, 0, (size_t)2048 * 1024, (size_t)256 * 1024};
        EpiSwigluQ E; E.actq = p.actq; E.b1 = p.b_exp_in + (size_t)layer * 32 * 2048;
        pg::gemm_phase<EpiSwigluQ, MoeSched, 1, true, 1>(F.lds + RING_OFF, 1024, 1024, 8, S, E);
    }
#endif
    {
        const int ntiles = (int)__hip_atomic_load(F.ctl + CW_NTILES + 64 * layer, RLX_AGENT);
        moe_tables(F, p.tile_e, p.slot_tok, ntiles, 2, false);
        if (layer == 0 && !MOE_F8_L0) {
            MoeSched S{(const char*)p.act, (const char*)p.w2_t, (LAS const int*)(F.lds + TAB_OFF), (LAS const int*)(F.lds + TAB_OFF) + 32, ntiles, 2, F.G, F.vcu, (size_t)256 * 1024 * 2, (size_t)1024 * 1024 * 2, (size_t)256 * 1024 * 2};
            EpiMoeOut E; E.y = p.yy; E.b2 = p.b_exp_out; E.gate = p.slot_gate;
            pg::gemm_phase<EpiMoeOut, MoeSched, 0, true>(F.lds + RING_OFF, 1024, 1024, 16, S, E);
        } else {
            MoeSched S{(const char*)p.actq, (const char*)(p.w2q + (size_t)layer * 32 * 1024 * 1024), (LAS const int*)(F.lds + TAB_OFF), (LAS const int*)(F.lds + TAB_OFF) + 32, ntiles, 2, F.G, F.vcu, (size_t)256 * 1024, (size_t)1024 * 1024, (size_t)256 * 1024};
            EpiMoeOutQ<layer == 1> E; E.y8 = (unsigned char*)p.yy; E.b2 = p.b_exp_out + (size_t)layer * 32 * 1024; E.gate = p.slot_gate;
            pg::gemm_phase<EpiMoeOutQ<layer == 1>, MoeSched, 0, true, 1>(F.lds + RING_OFF, 1024, 1024, 8, S, E, 0, 0, SKEW(F));
        }
    }
#if (PROBE_DBL >> 27) & 1
    GRID_BAR();
    {
        const int ntiles = (int)__hip_atomic_load(F.ctl + CW_NTILES + 64 * layer, RLX_AGENT);
        moe_tables(F, p.tile_e, p.slot_tok, ntiles, 2, false);
        MoeSched S{(const char*)p.actq, (const char*)(p.w2q + (size_t)layer * 32 * 1024 * 1024), (LAS const int*)(F.lds + TAB_OFF), (LAS const int*)(F.lds + TAB_OFF) + 32, ntiles, 2, F.G, F.vcu, (size_t)256 * 1024, (size_t)1024 * 1024, (size_t)256 * 1024};
        EpiMoeOutQ<layer == 1> E; E.y8 = (unsigned char*)p.yy; E.b2 = p.b_exp_out + (size_t)layer * 32 * 1024; E.gate = p.slot_gate;
        pg::gemm_phase<EpiMoeOutQ<layer == 1>, MoeSched, 0, true, 1>(F.lds + RING_OFF, 1024, 1024, 8, S, E);
    }
#endif
#if (PROBE_DBL >> 28) & 1
    GRID_BAR();
    {
        const int ntiles = (int)__hip_atomic_load(F.ctl + CW_NTILES + 64 * layer, RLX_AGENT);
        moe_tables(F, p.tile_e, p.slot_tok, ntiles, 2, false);
        MoeSched S{(const char*)p.actq, (const char*)(p.w2q + (size_t)layer * 32 * 1024 * 1024), (LAS const int*)(F.lds + TAB_OFF), (LAS const int*)(F.lds + TAB_OFF) + 32, ntiles, 2, F.G, F.vcu, (size_t)256 * 1024, (size_t)1024 * 1024, (size_t)256 * 1024};
        EpiKeep E;
        pg::gemm_phase<EpiKeep, MoeSched, 0, true, 1>(F.lds + RING_OFF, 1024, 1024, 8, S, E);
    }
#endif
    GRID_BAR();
    DBL(2, ph_combine_ln<layer == 1>(p, F, p.x1h, p.ln_ffn_g + layer * 1024, p.ln_ffn_b + layer * 1024, layer == 0 ? (float*)nullptr : p.out, layer == 0 ? p.x2h : (h16*)nullptr));
#undef GRID_BAR
}
__global__ void __launch_bounds__(NWAVES * 64, 2) mk_fwd(Params p) {
    extern __shared__ __attribute__((aligned(16))) unsigned char lds[];
    Frame F;
    F.lds = (LAS unsigned char*)lds;
    F.MISC = (volatile LAS unsigned*)(F.lds + MISC_OFF);
    F.tid = threadIdx.x; F.lane = F.tid & 63; F.wave = __builtin_amdgcn_readfirstlane(F.tid >> 6);
    F.G = gridDim.x; { const int bx = blockIdx.x; F.vcu = (F.G % 8 == 0) ? (bx % 8) * (F.G / 8) + bx / 8 : bx; }
    F.ctl = (gu32*)p.ctl;
    for (int u = F.tid; u < (LDS_BYTES - LDSCTL_OFF) / 4; u += NWAVES * 64) ((LAS unsigned*)(F.lds + LDSCTL_OFF))[u] = 0u;
    __syncthreads();
    XcdBarrier bar = xcd_barrier_post((unsigned*)p.ctl + CW_BAR, F.MISC + 8);
#define GRID_BAR() xcd_barrier(bar)
    DBL(0, ph_prologue(p, F));
    GRID_BAR();
    {
        { DenseSched S; S.init(p.xh0, 1024, p.wri_t, 1024, T_, 4096, F.G, (int)blockIdx.x); EpiInTok E; E.q = p.q; E.k = p.k; E.sg = p.sg;
          pg::gemm_phase<EpiInTok, DenseSched, 0, true>(F.lds + RING_OFF, 1024, 1024, 16, S, E, 0, 0, SKEW(F)); }
        { DenseSched S; S.init(p.wfm_t, 1024, p.xh0, 1024, 2048, T_, F.G, (int)blockIdx.x); EpiInFeat E; E.vt = p.vt;
          pg::gemm_phase<EpiInFeat, DenseSched, 0, true>(F.lds + RING_OFF, 1024, 1024, 16, S, E); }
    }
#if (PROBE_DBL >> 17) & 1
    GRID_BAR();
    { DenseSched S; S.init(p.xh0, 1024, p.wri_t, 1024, T_, 4096, F.G, (int)blockIdx.x); EpiInTok E; E.q = p.q; E.k = p.k; E.sg = p.sg;
      pg::gemm_phase<EpiInTok, DenseSched, 0, true>(F.lds + RING_OFF, 1024, 1024, 16, S, E); }
#endif
#if (PROBE_DBL >> 6) & 1
    GRID_BAR();
    {
        { DenseSched S; S.init(p.xh0, 1024, p.wri_t, 1024, T_, 4096, F.G, (int)blockIdx.x); EpiInTok E; E.q = p.q; E.k = p.k; E.sg = p.sg;
          pg::gemm_phase<EpiInTok, DenseSched, 0, true>(F.lds + RING_OFF, 1024, 1024, 16, S, E); }
        { DenseSched S; S.init(p.wfm_t, 1024, p.xh0, 1024, 2048, T_, F.G, (int)blockIdx.x); EpiInFeat E; E.vt = p.vt;
          pg::gemm_phase<EpiInFeat, DenseSched, 0, true>(F.lds + RING_OFF, 1024, 1024, 16, S, E); }
    }
#endif
    GRID_BAR();
    {
        ph_ktranspose(p, F);
        { RaSched S{p.q, p.k, F.G, F.vcu}; EpiPP E; E.pp = p.pp; pg::gemm_phase<EpiPP, RaSched, 0, true>(F.lds + RING_OFF, 1024, 1024, 4, S, E); }
    }
    GRID_BAR();
    {
        { R1Sched S{p.vt, p.kdt, 4, F.G, F.vcu}; EpiSegTot E; E.L = p.ltot; pg::gemm_phase<EpiSegTot, R1Sched, 0, false>(F.lds + RING_OFF, 256, 256, 4, S, E); }
    }
    GRID_BAR();
    ph_carry(p.ltot, F);
    GRID_BAR();
    { R1Sched S{p.vt, p.kdt, 3, F.G, F.vcu}; EpiSnap E; E.L = p.ltot; E.st = p.st; pg::gemm_phase<EpiSnap, R1Sched, 0, false>(F.lds + RING_OFF, 256, 256, 4, S, E); }
#if (PROBE_DBL >> 8) & 1
    GRID_BAR();
    { R1Sched S{p.vt, p.kdt, 3, F.G, F.vcu}; EpiSnap E; E.L = p.ltot; E.st = p.st; pg::gemm_phase<EpiSnap, R1Sched, 0, false>(F.lds + RING_OFF, 256, 256, 4, S, E); }
#endif
    GRID_BAR();
    { R2Sched S{p.pp, p.vt, p.q, p.st, F.G, F.vcu}; EpiRetOut E; E.o = p.o; E.sg = p.sg; E.og = p.og; pg::gemm_phase<EpiRetOut, R2Sched, 2, true>(F.lds + RING_OFF, 256, 256, 4, S, E, 1024, 256); }
    GRID_BAR();
    layer_tail<0>(p, F, bar);
    GRID_BAR();
    {
        { DenseSched S; S.init(p.x2h, 1024, p.wsi_t, 1024, T_, 1280, F.G, (int)blockIdx.x); EpiSwaTok E; E.sq = p.sq; E.skv = p.skv; E.bias = p.b_swa_in;
          pg::gemm_phase<EpiSwaTok, DenseSched, 0, true>(F.lds + RING_OFF, 1024, 1024, 16, S, E); }
        { DenseSched S; S.init(p.wsi_t + (size_t)1024 * 1024, 1024, p.x2h, 1024, 256, T_, F.G, (int)blockIdx.x, 128); EpiSwaFeat E; E.kvt = p.kvt; E.bias = p.b_swa_in;
          pg::gemm_phase<EpiSwaFeat, DenseSched, 0, true>(F.lds + RING_OFF, 1024, 1024, 16, S, E); }
    }
#if (PROBE_DBL >> 13) & 1
    GRID_BAR();
    {
        { DenseSched S; S.init(p.x2h, 1024, p.wsi_t, 1024, T_, 1280, F.G, (int)blockIdx.x); EpiSwaTok E; E.sq = p.sq; E.skv = p.skv; E.bias = p.b_swa_in;
          pg::gemm_phase<EpiSwaTok, DenseSched, 0, true>(F.lds + RING_OFF, 1024, 1024, 16, S, E); }
        { DenseSched S; S.init(p.wsi_t + (size_t)1024 * 1024, 1024, p.x2h, 1024, 256, T_, F.G, (int)blockIdx.x, 128); EpiSwaFeat E; E.kvt = p.kvt; E.bias = p.b_swa_in;
          pg::gemm_phase<EpiSwaFeat, DenseSched, 0, true>(F.lds + RING_OFF, 1024, 1024, 16, S, E); }
    }
#endif
    GRID_BAR();
    DBL(3, ph_swa_attn(p, F));
    GRID_BAR();
    layer_tail<1>(p, F, bar);
    if (__hip_atomic_load((gu32*)((unsigned*)p.ctl + CW_BAR + XB_TMO), RLX_AGENT) != 0u) {
        __syncthreads();
        for (size_t i = (size_t)blockIdx.x * 512 + F.tid; i < (size_t)T_ * D_; i += (size_t)F.G * 512) p.out[i] = __builtin_nanf("");
    }
#undef GRID_BAR
}

namespace host {
constexpr size_t MiB = 1u << 20;
static int g_grid = 0;
static bool setup() {
    if (g_grid) return g_grid > 0;
    int dev = 0, cus = 0;
    if (hipGetDevice(&dev) != hipSuccess || hipDeviceGetAttribute(&cus, hipDeviceAttributeMultiprocessorCount, dev) != hipSuccess) { g_grid = -1; return false; }
    if (hipFuncSetAttribute((const void*)mk_fwd, hipFuncAttributeMaxDynamicSharedMemorySize, LDS_BYTES) != hipSuccess) { g_grid = -1; return false; }
    (void)hipGetLastError();
    g_grid = cus;
    return true;
}
static void launch(hipStream_t st, Params p) {
    p.ph_lo = 0; p.ph_hi = 0; p.li = 0; p.layer = 0;
    hipLaunchKernelGGL(mk_fwd, dim3(g_grid), dim3(NWAVES * 64), LDS_BYTES, st, p);
}
static void fill_params(Params& p, void* const* d_in, float* out, unsigned char* ws) {
    const float** in = (const float**)&p.x;
    for (int i = 0; i < 18; ++i) in[i] = (const float*)d_in[i];
    p.out = out; p.ctl = (unsigned*)ws;
    const size_t M = MiB;
    p.top_e = (int*)(ws + 1 * M); p.top_g = (float*)(ws + 2 * M); p.rankp = (int*)(ws + 3 * M); p.inv = (int*)(ws + 4 * M); p.slot_tok = (int*)(ws + 5 * M); p.slot_gate = (float*)(ws + 6 * M);
    p.wg_cnt = (int*)(ws + 7 * M); p.tile_e = (int*)(ws + 8 * M);
    p.wri_t = (h16*)(ws + 17 * M); p.wfm_t = (h16*)(ws + 25 * M); p.wro_t = (h16*)(ws + 31 * M); p.wsi_t = (h16*)(ws + 35 * M); p.wso_t = (h16*)(ws + 38 * M);
    p.w1_t = (h16*)(ws + 40 * M); p.w2_t = (h16*)(ws + 296 * M);
    p.xh0 = (h16*)(ws + 424 * M); p.x1h = (h16*)(ws + 488 * M); p.x2h = (h16*)(ws + 552 * M);
    p.x1f = (float*)(ws + 616 * M); p.x2f = (float*)(ws + 744 * M); p.yf = (float*)(ws + 872 * M);
    p.act = (h16*)(ws + 1000 * M); p.yy = (h16*)(ws + 1272 * M);
}
}
extern "C" void kernel_launch(void* const* d_in, const int* in_sizes, int n_in, void* d_out, int out_size, void* d_ws, size_t ws_size, hipStream_t stream) {
    const size_t M = host::MiB;
    if (n_in != 18 || out_size != T_ * D_ || ws_size < 2040 * M) { fprintf(stderr, "kernel_launch: unexpected shapes / workspace (%d inputs, out %d, ws %zu)\n", n_in, out_size, ws_size); return; }
    if (!host::setup()) return;
    unsigned char* ws = (unsigned char*)d_ws; hipStream_t st = stream;
    (void)hipMemsetAsync(ws, 0, CTL_ZERO_BYTES, st);
    Params p{}; host::fill_params(p, d_in, (float*)d_out, ws);
    p.q = (h16*)(ws + 1000 * M); p.k = (h16*)(ws + 1064 * M); p.sg = (h16*)(ws + 1128 * M); p.kdt = (h16*)(ws + 1256 * M); p.vt = (h16*)(ws + 1320 * M);
    p.pp = (h16*)(ws + 1448 * M); p.st = (h16*)(ws + 1512 * M); p.ltot = (float*)(ws + 1640 * M); p.o = (h16*)(ws + 1704 * M); p.og = (h16*)(ws + 1832 * M);
    p.sq = (h16*)(ws + 1000 * M); p.skv = (h16*)(ws + 1064 * M); p.kvt = (h16*)(ws + 1080 * M); p.so = (h16*)(ws + 1096 * M);
    p.w1q = (unsigned char*)p.w1_t + (size_t)32 * 2048 * 1024 * 2; p.w2q = (unsigned char*)p.w2_t + (size_t)32 * 1024 * 1024 * 2;
    p.x1q = ws + 1560 * M; p.actq = (unsigned char*)p.act;
    p.yh = (h16*)p.yf;
    host::launch(st, p);
}
```

```cpp
#include <hip/hip_runtime.h>
#include <cstdio>
#include <cstdint>
#include <cmath>
#define GAS __attribute__((address_space(1)))
#define LAS __attribute__((address_space(3)))
typedef unsigned short bf16;
typedef unsigned v4u __attribute__((ext_vector_type(4)));
typedef float f32x4 __attribute__((ext_vector_type(4)));
typedef short bf16x8 __attribute__((ext_vector_type(8)));
typedef GAS unsigned gu32;
typedef GAS unsigned long long gu64;
#define RLX_AGENT __ATOMIC_RELAXED, __HIP_MEMORY_SCOPE_AGENT
#define LDS_WAIT() asm volatile("s_waitcnt lgkmcnt(0)" ::: "memory")
#define VM_WAIT() asm volatile("s_waitcnt vmcnt(0)" ::: "memory")
__device__ __forceinline__ unsigned long long rt() { return __builtin_amdgcn_s_memrealtime(); }
#define XB_TMO      128
#define XB_XCNT(j)  (256  + 64 * (j))
#define XB_XSUB(j)  (1280 + 64 * (j))
#define XB_XGEN(j)  (2304 + 64 * (j))
#define XB_TOP      3328
#define XB_TOPGEN   3392
#define XCD_BAR_WORDS 3456
#define XB_SPIN_CAP (1u << 18)

__device__ __forceinline__ unsigned xb_ld(unsigned* p)              { return __hip_atomic_load(p, __ATOMIC_RELAXED, __HIP_MEMORY_SCOPE_AGENT); }
__device__ __forceinline__ unsigned xb_add(unsigned* p, unsigned v) { return __hip_atomic_fetch_add(p, v, __ATOMIC_RELAXED, __HIP_MEMORY_SCOPE_AGENT); }
__device__ __forceinline__ unsigned xb_xcc_id() { return (unsigned)__builtin_amdgcn_s_getreg((3 << 11) | 20) & 0xFu; }
#define XB_SPIN(cond, bar) do { unsigned _sp = 0; while (cond) { __builtin_amdgcn_s_sleep(1); \
    if ((++_sp & 255u) == 0u) { if (xb_ld(&(bar)[XB_TMO])) break; if (_sp > XB_SPIN_CAP) { atomicAdd(&(bar)[XB_TMO], 1u); break; } } } } while (0)

struct XcdBarrier {
    unsigned* bar; unsigned x;
    volatile LAS unsigned* st;
};

__device__ __forceinline__ XcdBarrier xcd_barrier_post(unsigned* bar, volatile LAS unsigned* st) {
    XcdBarrier b; b.bar = bar; b.x = xb_xcc_id(); b.st = st;
    if (threadIdx.x == 0) (void)xb_add(&bar[XB_XCNT(b.x)], 1u);
    return b;
}
__device__ __forceinline__ void xcd_barrier_complete(unsigned* bar, unsigned x, unsigned& nloc, unsigned& nx) {
    const unsigned G = gridDim.x * gridDim.y * gridDim.z;
    unsigned sum, cnt, mine, sp = 0u;
    for (;;) {
        sum = 0u; cnt = 0u; mine = 0u;
#pragma unroll
        for (unsigned j = 0; j < 16; ++j) { const unsigned c = xb_ld(&bar[XB_XCNT(j)]); sum += c; cnt += (c > 0u) ? 1u : 0u; mine = (j == x) ? c : mine; }
        if (sum == G) break;
        __builtin_amdgcn_s_sleep(1);
        if ((++sp & 255u) == 0u) { if (xb_ld(&bar[XB_TMO])) break; if (sp > XB_SPIN_CAP) { atomicAdd(&bar[XB_TMO], 1u); break; } }
    }
    nloc = mine > 0u ? mine : 1u; nx = cnt > 0u ? cnt : 1u;
}

__device__ __forceinline__ void xcd_barrier(const XcdBarrier& b) {
    asm volatile("s_waitcnt vmcnt(0)" ::: "memory");
    __syncthreads();
    if (threadIdx.x == 0) {
        unsigned* bar = b.bar;
        __builtin_amdgcn_s_waitcnt(0);
        unsigned nloc = b.st[0], nx = b.st[1];
        if (nloc == 0u) { xcd_barrier_complete(bar, b.x, nloc, nx); b.st[0] = nloc; b.st[1] = nx; }
        const unsigned old = xb_add(&bar[XB_XSUB(b.x)], 1u);
        const unsigned gen = old / nloc;
        if (old + 1u == (gen + 1u) * nloc) {
            __builtin_amdgcn_fence(__ATOMIC_RELEASE, "agent");
            asm volatile("s_waitcnt vmcnt(0)" ::: "memory");
            const unsigned og = xb_add(&bar[XB_TOP], 1u);
            const unsigned tg = og / nx;
            if (og + 1u == (tg + 1u) * nx) xb_add(&bar[XB_TOPGEN], 1u);
            else XB_SPIN(xb_ld(&bar[XB_TOPGEN]) == tg, bar);
            __builtin_amdgcn_fence(__ATOMIC_ACQUIRE, "agent");
            xb_add(&bar[XB_XGEN(b.x)], 1u);
            asm volatile("s_waitcnt vmcnt(0)" ::: "memory");
        } else {
            XB_SPIN(xb_ld(&bar[XB_XGEN(b.x)]) == gen, bar);
            __builtin_amdgcn_fence(__ATOMIC_ACQUIRE, "agent");
            asm volatile("s_waitcnt vmcnt(0)" ::: "memory");
        }
    }
    __syncthreads();
}
namespace pg {
#define PG_LAS __attribute__((address_space(3)))
typedef unsigned short h16;
typedef _Float16 f16x8 __attribute__((ext_vector_type(8)));
typedef __bf16 bf16x8 __attribute__((ext_vector_type(8)));
typedef _Float16 f16x2 __attribute__((ext_vector_type(2)));
typedef float f32x4 __attribute__((ext_vector_type(4)));
typedef float f32x2 __attribute__((ext_vector_type(2)));
typedef unsigned u32x4 __attribute__((ext_vector_type(4)));
typedef unsigned u32x2 __attribute__((ext_vector_type(2)));
constexpr int BM = 256, BK = 64, HALF = 128, HTB = HALF * BK * 2  , STAGE_BYTES = 8 * HTB;

__host__ __device__ __forceinline__ int lds_byte(int r, int c) { const int st = (r >> 4) * 2 + (c >> 5), rr = r & 15, cc = c & 31, ob = rr * 64 + cc * 2; return st * 1024 + (ob ^ (((ob >> 9) & 1) << 5)); }
__host__ __device__ __forceinline__ void stage_rc(int b, int& R, int& C) { const int st = b / 1024, sb = b % 1024, swz = sb ^ (((sb >> 9) & 1) << 5); R = (st >> 1) * 16 + swz / 64; C = (st & 1) * 32 + (swz % 64) / 2; }
__host__ __device__ __forceinline__ int perm32(int rho) { const int n = rho >> 4, i = rho & 15; return 8 * (i >> 2) + 4 * n + (i & 3); }
__device__ __forceinline__ unsigned pkh(float lo, float hi) { const f32x2 v = {lo, hi}; const f16x2 h = __builtin_convertvector(v, f16x2); return __builtin_bit_cast(unsigned, h); }

typedef int i32x8 __attribute__((ext_vector_type(8)));
typedef int i32x4 __attribute__((ext_vector_type(4)));
__device__ __forceinline__ i32x8 cat8(f16x8 lo, f16x8 hi) { return __builtin_shufflevector(__builtin_bit_cast(i32x4, lo), __builtin_bit_cast(i32x4, hi), 0, 1, 2, 3, 4, 5, 6, 7); }
__device__ __forceinline__ void mfma_f8(f32x4& c, const i32x8& a, const i32x8& b, int scale) {
    asm volatile("v_mfma_scale_f32_16x16x128_f8f6f4 %0, %1, %2, %0, %3, %3 op_sel_hi:[0,0,0]" : "+v"(c) : "v"(a), "v"(b), "v"(scale)); }
struct Unit { const char* a; const char* b; int pm, pn, e, x; };
typedef f32x4 Acc[2][2][4][2];
__device__ __forceinline__ void acc_zero(Acc& acc) {
#pragma unroll
    for (int a = 0; a < 2; ++a)
#pragma unroll
        for (int b = 0; b < 2; ++b)
#pragma unroll
            for (int m = 0; m < 4; ++m)
#pragma unroll
                for (int n = 0; n < 2; ++n) acc[a][b][m][n] = (f32x4){0.f, 0.f, 0.f, 0.f};
}
struct EpiBase {
    static constexpr bool PERM = false;
    __device__ __forceinline__ void init(Acc& acc, const Unit&, int, int, int, int) const { acc_zero(acc); }
    __device__ __forceinline__ void reinit(Acc& acc, const Unit&, const Unit&, int, int, int, int) const { acc_zero(acc); }
};

template <class Epi, class Sched, int MODE  , bool ALIGN_EPI, int ES = 2  , bool BF = false  , int ILV = 2  >
__device__ __forceinline__ void gemm_phase(PG_LAS unsigned char* lds, const int lda, const int ldb, const int nt_, const Sched& S, const Epi& E, const int lda1 = 0, const int ldb1 = 0, const int skew_ticks = 0  ) {
    constexpr bool GATHER = (MODE == 1), DUAL = (MODE == 2);
    int nt = nt_; asm volatile("" : "+s"(nt));
    int tid_ = threadIdx.x; asm volatile("" : "+v"(tid_));
    const int tid = tid_, wid = __builtin_amdgcn_readfirstlane(tid >> 6), lane = tid & 63, wr = wid >> 2, wc = wid & 3, fr = lane & 15, fq = lane >> 4;
    unsigned voffA[2], voffB[2]; int sR[2], sC[2];
#pragma unroll
    for (int i = 0; i < 2; ++i) { int R, C; stage_rc(tid * 16 + i * 8192, R, C); sR[i] = R; sC[i] = C; const int Rb = Epi::PERM ? ((R & ~31) + perm32(R & 31)) : R;
        voffA[i] = (unsigned)(R * lda * ES + C * 2); voffB[i] = (unsigned)(Rb * ldb * ES + C * 2); }
    const size_t kstep = (size_t)(BK * 2);
    const size_t hstepA0 = GATHER ? 0 : (size_t)HALF * lda * ES, hstepB0 = (size_t)HALF * ldb * ES, hstepA1 = (size_t)HALF * lda1 * ES, hstepB1 = (size_t)HALF * ldb1 * ES;
    unsigned wA1[2], wB1[2];
#pragma unroll
    for (int i = 0; i < 2; ++i) { const int Rb = Epi::PERM ? ((sR[i] & ~31) + perm32(sR[i] & 31)) : sR[i]; wA1[i] = (unsigned)(sR[i] * lda1 * ES + sC[i] * 2); wB1[i] = (unsigned)(Rb * ldb1 * ES + sC[i] * 2); }
    unsigned vAc[2], vBc[2], vAn[2], vBn[2], vA2[2], vB2[2];
    size_t hAc = hstepA0, hBc = hstepB0, hAn = hstepA0, hBn = hstepB0, hA2 = hstepA0, hB2 = hstepB0;
    const unsigned ldsw = (unsigned)wid * 1024u;
    const int aoff = (ES == 2) ? lds_byte(wr * 64 + fr, fq * 8) : lds_byte(wr * 64 + fr, fq * 16), boff = (ES == 2) ? lds_byte(wc * 32 + fr, fq * 8) : lds_byte(wc * 32 + fr, fq * 16);
    unsigned gc[2][2], gn[2][2], g2[2][2];
#define PG_SA(b, h) (((b) * 2 + (h)) * HTB)
#define PG_SB(b, h) ((4 + (b) * 2 + (h)) * HTB)
#if !defined(PG_GLOBAL_DMA)
#define PG_STAGE(bufoff, gbase, voff) do { const __amdgpu_buffer_rsrc_t _r = __builtin_amdgcn_make_buffer_rsrc((void*)(gbase), 0, 0x7fffffff, 0x00020000); _Pragma("unroll") for (int _i = 0; _i < 2; ++_i) \
        __builtin_amdgcn_raw_ptr_buffer_load_lds(_r, (PG_LAS unsigned*)(lds + (bufoff) + ldsw + _i * 8192), 16, (int)(voff)[_i], 0, 0, 0); } while (0)
#else
#define PG_STAGE(bufoff, gbase, voff) do { _Pragma("unroll") for (int _i = 0; _i < 2; ++_i) \
        __builtin_amdgcn_global_load_lds((const unsigned*)((const char*)(gbase) + (voff)[_i]), (PG_LAS unsigned*)(lds + (bufoff) + ldsw + _i * 8192), 16, 0, 0); } while (0)
#endif
#define PG_STAGE_A(bufoff, kptr, h, G, VA, HA) do { if constexpr (GATHER) { PG_STAGE(bufoff, kptr, G[h]); } else { PG_STAGE(bufoff, (kptr) + (h) * (HA), VA); } } while (0)
#define PG_CFG(u, VA, VB, HA, HB) do { if constexpr (DUAL) { const bool _x = (u).x != 0; _Pragma("unroll") for (int _i = 0; _i < 2; ++_i) { VA[_i] = _x ? wA1[_i] : voffA[_i]; VB[_i] = _x ? wB1[_i] : voffB[_i]; } \
        HA = _x ? hstepA1 : hstepA0; HB = _x ? hstepB1 : hstepB0; } else { _Pragma("unroll") for (int _i = 0; _i < 2; ++_i) { VA[_i] = voffA[_i]; VB[_i] = voffB[_i]; } HA = hstepA0; HB = hstepB0; } } while (0)
#define PG_GLOAD(dst, u) do { _Pragma("unroll") for (int _h = 0; _h < 2; ++_h) _Pragma("unroll") for (int _i = 0; _i < 2; ++_i) \
        dst[_h][_i] = S.arow(u, _h * HALF + sR[_i]) * (unsigned)(lda * ES) + (unsigned)(sC[_i] * 2); } while (0)
#define PG_LDF(p) (*(const PG_LAS f16x8*)(p))
#define PG_LDA(dst, b, h) do { if constexpr (ES == 2) { _Pragma("unroll") for (int m = 0; m < 4; ++m) _Pragma("unroll") for (int k = 0; k < 2; ++k) dst[m][k] = PG_LDF(lds + PG_SA(b, h) + aoff + m * 2048 + k * 1024); } \
        else { _Pragma("unroll") for (int m = 0; m < 4; ++m) dst##8[m] = cat8(PG_LDF(lds + PG_SA(b, h) + aoff + m * 2048), PG_LDF(lds + PG_SA(b, h) + aoff + m * 2048 + 16)); } } while (0)
#define PG_LDB(dst, b, h) do { if constexpr (ES == 2) { _Pragma("unroll") for (int n = 0; n < 2; ++n) _Pragma("unroll") for (int k = 0; k < 2; ++k) dst[n][k] = PG_LDF(lds + PG_SB(b, h) + boff + n * 2048 + k * 1024); } \
        else { _Pragma("unroll") for (int n = 0; n < 2; ++n) dst##8[n] = cat8(PG_LDF(lds + PG_SB(b, h) + boff + n * 2048), PG_LDF(lds + PG_SB(b, h) + boff + n * 2048 + 16)); } } while (0)
#define PG_MMA(ai, bj, At, Bt) do { __builtin_amdgcn_s_setprio(1); if constexpr (ES == 2) { _Pragma("unroll") for (int m = 0; m < 4; ++m) _Pragma("unroll") for (int n = 0; n < 2; ++n) _Pragma("unroll") for (int k = 0; k < 2; ++k) \
        acc[ai][bj][m][n] = BF ? __builtin_amdgcn_mfma_f32_16x16x32_bf16(__builtin_bit_cast(bf16x8, Bt[n][k]), __builtin_bit_cast(bf16x8, At[m][k]), acc[ai][bj][m][n], 0, 0, 0) : __builtin_amdgcn_mfma_f32_16x16x32_f16(Bt[n][k], At[m][k], acc[ai][bj][m][n], 0, 0, 0); } else { _Pragma("unroll") for (int m = 0; m < 4; ++m) _Pragma("unroll") for (int n = 0; n < 2; ++n) \
        mfma_f8(acc[ai][bj][m][n], Bt##8[n], At##8[m], f8scale); } \
        __builtin_amdgcn_s_setprio(0); } while (0)
#define PG_MMH(ai, bj, At, Bt, M0) do { __builtin_amdgcn_s_setprio(1); if constexpr (ES == 2) { _Pragma("unroll") for (int m = (M0); m < (M0) + 2; ++m) _Pragma("unroll") for (int n = 0; n < 2; ++n) _Pragma("unroll") for (int k = 0; k < 2; ++k) \
        acc[ai][bj][m][n] = BF ? __builtin_amdgcn_mfma_f32_16x16x32_bf16(__builtin_bit_cast(bf16x8, Bt[n][k]), __builtin_bit_cast(bf16x8, At[m][k]), acc[ai][bj][m][n], 0, 0, 0) : __builtin_amdgcn_mfma_f32_16x16x32_f16(Bt[n][k], At[m][k], acc[ai][bj][m][n], 0, 0, 0); } else { _Pragma("unroll") for (int m = (M0); m < (M0) + 2; ++m) _Pragma("unroll") for (int n = 0; n < 2; ++n) \
        mfma_f8(acc[ai][bj][m][n], Bt##8[n], At##8[m], f8scale); } \
        __builtin_amdgcn_s_setprio(0); } while (0)
#define PG_WAIT_V(n) asm volatile("s_waitcnt vmcnt(" #n ")" ::: "memory")
#define PG_WAIT_L(n) asm volatile("s_waitcnt lgkmcnt(" #n ")" ::: "memory")
#define PG_BAR __builtin_amdgcn_s_barrier()
#define PG_SCHED __builtin_amdgcn_sched_barrier(0)
    if (skew_ticks > 0) { const unsigned long long t0 = __builtin_amdgcn_s_memrealtime(); while (__builtin_amdgcn_s_memrealtime() - t0 < (unsigned long long)skew_ticks) __builtin_amdgcn_s_sleep(8); }
    Unit cur, nxt; int ui = 0;
    if (!S.next(0, cur)) return;
    Acc acc;
    E.init(acc, cur, wr, wc, fr, fq);
    f16x8 At[4][2], B0[2][2], B1[2][2];
    int f8scale = 0x7f7f7f7f; asm volatile("" : "+v"(f8scale));
    i32x8 At8[4], B08[2], B18[2];
    const char* cA = cur.a; const char* cB = cur.b;
    if constexpr (GATHER) { PG_GLOAD(gc, cur); }
    PG_CFG(cur, vAc, vBc, hAc, hBc);
    PG_STAGE(PG_SB(0, 0), cB, vBc); PG_STAGE(PG_SB(0, 1), cB + hBc, vBc); PG_STAGE_A(PG_SA(0, 0), cA, 0, gc, vAc, hAc); PG_STAGE_A(PG_SA(0, 1), cA, 1, gc, vAc, hAc);
    if (wr == 1) PG_BAR;
    PG_WAIT_V(2); PG_BAR;
    if constexpr (ILV >= 2 && ILV <= 4) { PG_STAGE(PG_SB(1, 0), cB + kstep, vBc); PG_STAGE(PG_SB(1, 1), cB + hBc + kstep, vBc); PG_WAIT_V(4); PG_BAR; }
    else { PG_STAGE(PG_SB(1, 0), cB + kstep, vBc); PG_STAGE_A(PG_SA(1, 0), cA + kstep, 0, gc, vAc, hAc); PG_STAGE(PG_SB(1, 1), cB + hBc + kstep, vBc);
    PG_WAIT_V(6); PG_BAR; }
    for (;;) {
        const bool has_next = S.next(ui + 1, nxt);
        const char* nA = has_next ? nxt.a : cA; const char* nB = has_next ? nxt.b : cB;
        if constexpr (GATHER) { if (has_next) { PG_GLOAD(gn, nxt); } else {
#pragma unroll
            for (int h = 0; h < 2; ++h)
#pragma unroll
                for (int i = 0; i < 2; ++i) gn[h][i] = gc[h][i]; } }
        if (has_next) { PG_CFG(nxt, vAn, vBn, hAn, hBn); } else { PG_CFG(cur, vAn, vBn, hAn, hBn); }
        for (int t = 0; t < nt; t += 2) {
            const bool last = (t == nt - 2);
            const char* a1 = cA + (size_t)(t + 1) * kstep;
            const char* a2 = last ? nA : cA + (size_t)(t + 2) * kstep; const char* b2 = last ? nB : cB + (size_t)(t + 2) * kstep;
            const char* a3 = a2 + kstep; const char* b3 = b2 + kstep;
            if constexpr (GATHER) {
#pragma unroll
                for (int h = 0; h < 2; ++h)
#pragma unroll
                    for (int i = 0; i < 2; ++i) g2[h][i] = last ? gn[h][i] : gc[h][i]; }
            if constexpr (DUAL) {
#pragma unroll
                for (int i = 0; i < 2; ++i) { vA2[i] = last ? vAn[i] : vAc[i]; vB2[i] = last ? vBn[i] : vBc[i]; }
                hA2 = last ? hAn : hAc; hB2 = last ? hBn : hBc;
            } else {
#pragma unroll
                for (int i = 0; i < 2; ++i) { vA2[i] = vAc[i]; vB2[i] = vBc[i]; }
                hA2 = hAc; hB2 = hBc; }
            if constexpr (ILV == 5) {
            PG_LDB(B0, 0, 0); PG_SCHED; PG_LDA(At, 0, 0); PG_STAGE_A(PG_SA(1, 1), a1, 1, gc, vAc, hAc);
            PG_WAIT_L(8); PG_BAR; PG_WAIT_L(0); PG_MMA(0, 0, At, B0); PG_BAR; PG_SCHED;
            PG_LDB(B1, 0, 1); PG_STAGE(PG_SB(0, 0), b2, vB2);
            PG_BAR; PG_WAIT_L(0); PG_MMA(0, 1, At, B1); PG_BAR; PG_SCHED;
            PG_LDA(At, 0, 1); PG_STAGE_A(PG_SA(0, 0), a2, 0, g2, vA2, hA2);
            PG_BAR; PG_WAIT_L(0); PG_MMA(1, 0, At, B0); PG_BAR; PG_SCHED;
            PG_STAGE(PG_SB(0, 1), b2 + hB2, vB2);
            PG_WAIT_V(6); PG_BAR; PG_MMA(1, 1, At, B1); PG_BAR; PG_SCHED;
            PG_LDB(B0, 1, 0); PG_SCHED; PG_LDA(At, 1, 0); PG_STAGE_A(PG_SA(0, 1), a2, 1, g2, vA2, hA2);
            PG_WAIT_L(8); PG_BAR; PG_WAIT_L(0); PG_MMA(0, 0, At, B0); PG_BAR; PG_SCHED;
            PG_LDB(B1, 1, 1); PG_STAGE(PG_SB(1, 0), b3, vB2);
            PG_BAR; PG_WAIT_L(0); PG_MMA(0, 1, At, B1); PG_BAR; PG_SCHED;
            PG_LDA(At, 1, 1); PG_STAGE_A(PG_SA(1, 0), a3, 0, g2, vA2, hA2);
            PG_BAR; PG_WAIT_L(0); PG_MMA(1, 0, At, B0); PG_BAR; PG_SCHED;
            PG_STAGE(PG_SB(1, 1), b3 + hB2, vB2);
            PG_WAIT_V(6); PG_BAR; PG_MMA(1, 1, At, B1); PG_BAR; PG_SCHED;
            } else if constexpr (ILV == 3) {
            PG_LDB(B0, 0, 0); PG_LDB(B1, 0, 1); PG_SCHED; PG_LDA(At, 0, 0); PG_STAGE_A(PG_SA(1, 0), a1, 0, gc, vAc, hAc);
            PG_WAIT_V(6); PG_WAIT_L(0); PG_BAR; PG_MMA(0, 0, At, B0); PG_SCHED; PG_STAGE_A(PG_SA(1, 1), a1, 1, gc, vAc, hAc); PG_SCHED; PG_MMA(0, 1, At, B1); PG_BAR; PG_SCHED;
            PG_LDA(At, 0, 1); PG_STAGE(PG_SB(0, 0), b2, vB2);
            PG_WAIT_V(4); PG_WAIT_L(0); PG_BAR; PG_MMA(1, 0, At, B0); PG_SCHED; PG_STAGE(PG_SB(0, 1), b2 + hB2, vB2); PG_SCHED; PG_MMA(1, 1, At, B1); PG_BAR; PG_SCHED;
            PG_LDB(B0, 1, 0); PG_LDB(B1, 1, 1); PG_SCHED; PG_LDA(At, 1, 0); PG_STAGE_A(PG_SA(0, 0), a2, 0, g2, vA2, hA2);
            PG_WAIT_V(6); PG_WAIT_L(0); PG_BAR; PG_MMA(0, 0, At, B0); PG_SCHED; PG_STAGE_A(PG_SA(0, 1), a2, 1, g2, vA2, hA2); PG_SCHED; PG_MMA(0, 1, At, B1); PG_BAR; PG_SCHED;
            PG_LDA(At, 1, 1); PG_STAGE(PG_SB(1, 0), b3, vB2);
            PG_WAIT_V(4); PG_WAIT_L(0); PG_BAR; PG_MMA(1, 0, At, B0); PG_SCHED; PG_STAGE(PG_SB(1, 1), b3 + hB2, vB2); PG_SCHED; PG_MMA(1, 1, At, B1); PG_BAR; PG_SCHED;
            } else if constexpr (ILV == 4) {
            PG_LDB(B0, 0, 0); PG_SCHED; PG_STAGE_A(PG_SA(1, 0), a1, 0, gc, vAc, hAc); PG_SCHED; PG_LDA(At, 0, 0); PG_SCHED; PG_STAGE_A(PG_SA(1, 1), a1, 1, gc, vAc, hAc);
            PG_WAIT_V(8); PG_BAR; PG_WAIT_L(0); PG_MMA(0, 0, At, B0); PG_SCHED; PG_LDB(B1, 0, 1); PG_WAIT_L(0); PG_SCHED; PG_MMA(0, 1, At, B1); PG_BAR; PG_SCHED;
            PG_LDA(At, 0, 1); PG_STAGE(PG_SB(0, 0), b2, vB2); PG_STAGE(PG_SB(0, 1), b2 + hB2, vB2);
            PG_WAIT_V(6); PG_BAR; PG_WAIT_L(0); PG_MMA(1, 0, At, B0); PG_MMA(1, 1, At, B1); PG_BAR; PG_SCHED;
            PG_LDB(B0, 1, 0); PG_SCHED; PG_STAGE_A(PG_SA(0, 0), a2, 0, g2, vA2, hA2); PG_SCHED; PG_LDA(At, 1, 0); PG_SCHED; PG_STAGE_A(PG_SA(0, 1), a2, 1, g2, vA2, hA2);
            PG_WAIT_V(8); PG_BAR; PG_WAIT_L(0); PG_MMA(0, 0, At, B0); PG_SCHED; PG_LDB(B1, 1, 1); PG_WAIT_L(0); PG_SCHED; PG_MMA(0, 1, At, B1); PG_BAR; PG_SCHED;
            PG_LDA(At, 1, 1); PG_STAGE(PG_SB(1, 0), b3, vB2); PG_STAGE(PG_SB(1, 1), b3 + hB2, vB2);
            PG_WAIT_V(6); PG_BAR; PG_WAIT_L(0); PG_MMA(1, 0, At, B0); PG_MMA(1, 1, At, B1); PG_BAR; PG_SCHED;
            } else if constexpr (ILV == 2) {
            PG_LDB(B0, 0, 0); PG_LDB(B1, 0, 1); PG_SCHED; PG_STAGE_A(PG_SA(1, 0), a1, 0, gc, vAc, hAc); PG_SCHED; PG_LDA(At, 0, 0); PG_SCHED; PG_STAGE_A(PG_SA(1, 1), a1, 1, gc, vAc, hAc);
            PG_WAIT_V(8); PG_BAR; PG_WAIT_L(0); PG_MMA(0, 0, At, B0); PG_MMA(0, 1, At, B1); PG_BAR; PG_SCHED;
            PG_LDA(At, 0, 1); PG_STAGE(PG_SB(0, 0), b2, vB2); PG_STAGE(PG_SB(0, 1), b2 + hB2, vB2);
            PG_WAIT_V(6); PG_BAR; PG_WAIT_L(0); PG_MMA(1, 0, At, B0); PG_MMA(1, 1, At, B1); PG_BAR; PG_SCHED;
            PG_LDB(B0, 1, 0); PG_LDB(B1, 1, 1); PG_SCHED; PG_STAGE_A(PG_SA(0, 0), a2, 0, g2, vA2, hA2); PG_SCHED; PG_LDA(At, 1, 0); PG_SCHED; PG_STAGE_A(PG_SA(0, 1), a2, 1, g2, vA2, hA2);
            PG_WAIT_V(8); PG_BAR; PG_WAIT_L(0); PG_MMA(0, 0, At, B0); PG_MMA(0, 1, At, B1); PG_BAR; PG_SCHED;
            PG_LDA(At, 1, 1); PG_STAGE(PG_SB(1, 0), b3, vB2); PG_STAGE(PG_SB(1, 1), b3 + hB2, vB2);
            PG_WAIT_V(6); PG_BAR; PG_WAIT_L(0); PG_MMA(1, 0, At, B0); PG_MMA(1, 1, At, B1); PG_BAR; PG_SCHED;
            } else if constexpr (ILV == 1) {
            PG_LDB(B0, 0, 0); PG_LDB(B1, 0, 1); PG_SCHED; PG_LDA(At, 0, 0);
            PG_WAIT_V(6); PG_WAIT_L(0); PG_BAR; PG_MMA(0, 0, At, B0); PG_SCHED; PG_STAGE_A(PG_SA(1, 1), a1, 1, gc, vAc, hAc); PG_SCHED; PG_MMA(0, 1, At, B1); PG_BAR; PG_SCHED;
            PG_LDA(At, 0, 1);
            PG_WAIT_V(2); PG_WAIT_L(0); PG_BAR; PG_MMH(1, 0, At, B0, 0); PG_SCHED; PG_STAGE(PG_SB(0, 0), b2, vB2); PG_SCHED; PG_MMH(1, 0, At, B0, 2); PG_SCHED; PG_STAGE(PG_SB(0, 1), b2 + hB2, vB2); PG_SCHED;
                PG_MMH(1, 1, At, B1, 0); PG_SCHED; PG_STAGE_A(PG_SA(0, 0), a2, 0, g2, vA2, hA2); PG_SCHED; PG_MMH(1, 1, At, B1, 2); PG_BAR; PG_SCHED;
            PG_LDB(B0, 1, 0); PG_LDB(B1, 1, 1); PG_SCHED; PG_LDA(At, 1, 0);
            PG_WAIT_V(6); PG_WAIT_L(0); PG_BAR; PG_MMA(0, 0, At, B0); PG_SCHED; PG_STAGE_A(PG_SA(0, 1), a2, 1, g2, vA2, hA2); PG_SCHED; PG_MMA(0, 1, At, B1); PG_BAR; PG_SCHED;
            PG_LDA(At, 1, 1);
            PG_WAIT_V(2); PG_WAIT_L(0); PG_BAR; PG_MMH(1, 0, At, B0, 0); PG_SCHED; PG_STAGE(PG_SB(1, 0), b3, vB2); PG_SCHED; PG_MMH(1, 0, At, B0, 2); PG_SCHED; PG_STAGE(PG_SB(1, 1), b3 + hB2, vB2); PG_SCHED;
                PG_MMH(1, 1, At, B1, 0); PG_SCHED; PG_STAGE_A(PG_SA(1, 0), a3, 0, g2, vA2, hA2); PG_SCHED; PG_MMH(1, 1, At, B1, 2); PG_BAR; PG_SCHED;
            } else {
            PG_LDB(B0, 0, 0); PG_LDB(B1, 0, 1); PG_SCHED; PG_LDA(At, 0, 0); PG_STAGE_A(PG_SA(1, 1), a1, 1, gc, vAc, hAc);
            PG_WAIT_V(8); PG_WAIT_L(0); PG_BAR; PG_MMA(0, 0, At, B0); PG_MMA(0, 1, At, B1); PG_BAR; PG_SCHED;
            PG_LDA(At, 0, 1); PG_STAGE(PG_SB(0, 0), b2, vB2); PG_STAGE(PG_SB(0, 1), b2 + hB2, vB2); PG_STAGE_A(PG_SA(0, 0), a2, 0, g2, vA2, hA2);
            PG_WAIT_V(8); PG_WAIT_L(0); PG_BAR; PG_MMA(1, 0, At, B0); PG_MMA(1, 1, At, B1); PG_BAR; PG_SCHED;
            PG_LDB(B0, 1, 0); PG_LDB(B1, 1, 1); PG_SCHED; PG_LDA(At, 1, 0); PG_STAGE_A(PG_SA(0, 1), a2, 1, g2, vA2, hA2);
            PG_WAIT_V(8); PG_WAIT_L(0); PG_BAR; PG_MMA(0, 0, At, B0); PG_MMA(0, 1, At, B1); PG_BAR; PG_SCHED;
            PG_LDA(At, 1, 1); PG_STAGE(PG_SB(1, 0), b3, vB2); PG_STAGE(PG_SB(1, 1), b3 + hB2, vB2); PG_STAGE_A(PG_SA(1, 0), a3, 0, g2, vA2, hA2);
            PG_WAIT_V(8); PG_WAIT_L(0); PG_BAR; PG_MMA(1, 0, At, B0); PG_MMA(1, 1, At, B1); PG_BAR; PG_SCHED;
            }
        }
        if constexpr (ES == 1) asm volatile("s_nop 15\n\ts_nop 15" ::: "memory");
        if constexpr (ALIGN_EPI) { if (wr == 0) PG_BAR; }
        E(acc, cur, wr, wc, fr, fq);
        if (!has_next) break;
        E.reinit(acc, cur, nxt, wr, wc, fr, fq);
        cur = nxt; cA = nA; cB = nB; ++ui;
        if constexpr (GATHER) {
#pragma unroll
            for (int h = 0; h < 2; ++h)
#pragma unroll
                for (int i = 0; i < 2; ++i) gc[h][i] = gn[h][i]; }
        if constexpr (DUAL) {
#pragma unroll
            for (int i = 0; i < 2; ++i) { vAc[i] = vAn[i]; vBc[i] = vBn[i]; }
            hAc = hAn; hBc = hBn; }
        if constexpr (ALIGN_EPI) { if (wr == 1) PG_BAR; }
    }
    PG_WAIT_V(0);
    if constexpr (!ALIGN_EPI) { if (wr == 0) PG_BAR; }
    PG_BAR;
#undef PG_SA
#undef PG_SB
#undef PG_STAGE
#undef PG_STAGE_A
#undef PG_GLOAD
#undef PG_CFG
#undef PG_LDA
#undef PG_LDF
#undef PG_LDB
#undef PG_MMA
#undef PG_MMH
#undef PG_WAIT_V
#undef PG_WAIT_L
#undef PG_BAR
#undef PG_SCHED
}
}
constexpr int NWAVES = 8;
constexpr int T_ = 32768, D_ = 1024, SEQ_ = 8192;
constexpr int NSLOT_MAX = (512 + 32) * 256, NTILE_MAX = 544;
constexpr float ALPHA_ = 1.4142135623730951f, LN_EPS_ = 1e-5f;
constexpr int RING_OFF = 0, RING_BYTES = 131072;
constexpr int TAB_OFF = RING_BYTES, TAB_BYTES = 24576;
constexpr int LDSCTL_OFF = TAB_OFF + TAB_BYTES, MISC_OFF = LDSCTL_OFF + 320;
constexpr int LDS_BYTES = 159744;
constexpr int CW_TMO = 0, CW_CODE = 1, CW_NTILES = 64, CW_BAR = 4096;
constexpr int N_BAR_REGIONS = 12;
constexpr size_t CTL_ZERO_BYTES = 1u << 20;
static_assert((CW_BAR + N_BAR_REGIONS * XCD_BAR_WORDS) * 4 <= (int)CTL_ZERO_BYTES, "barrier regions inside the memset region");
typedef unsigned short h16;
typedef float f32x2v __attribute__((ext_vector_type(2)));
typedef unsigned v2u __attribute__((ext_vector_type(2)));
#define EPI_OPAQUE() asm volatile("" : "+v"(fr), "+v"(fq))

struct Params {
    const float *x, *w_ret_in, *w_ret_out, *w_swa_in, *b_swa_in, *w_swa_out, *b_swa_out, *sinks, *ln_mix_g, *ln_mix_b, *w_router, *b_router, *w_exp_in, *b_exp_in, *w_exp_out, *b_exp_out, *ln_ffn_g, *ln_ffn_b;
    float* out;
    unsigned* ctl;
    int *top_e, *rankp, *inv, *slot_tok, *wg_cnt, *tile_e; float *top_g, *slot_gate;
    h16 *wri_t, *wfm_t, *wro_t, *wsi_t, *wso_t, *w1_t, *w2_t;
    h16 *xh0, *x1h, *x2h, *yh; float *x1f, *x2f, *yf;
    h16 *act, *yy;
    h16 *q, *k, *sg, *kdt, *vt, *pp, *st, *o, *og; float* ltot;
    h16 *sq, *skv, *kvt, *so;
    const float* cv_src; h16* cv_dst; size_t cv_n; float* projf;
    unsigned char *w1q, *w2q, *x1q, *actq;
    int ph_lo, ph_hi, li, layer;
};

struct Frame {
    LAS unsigned char* lds; volatile LAS unsigned* MISC; gu32* ctl;
    int tid, lane, wave, vcu, G;
};
__device__ __forceinline__ float wave_sum(float v) {
    v += __builtin_bit_cast(float, __builtin_amdgcn_update_dpp(0, __builtin_bit_cast(int, v), 0x111, 0xf, 0xf, true));
    v += __builtin_bit_cast(float, __builtin_amdgcn_update_dpp(0, __builtin_bit_cast(int, v), 0x112, 0xf, 0xf, true));
    v += __builtin_bit_cast(float, __builtin_amdgcn_update_dpp(0, __builtin_bit_cast(int, v), 0x114, 0xf, 0xf, true));
    v += __builtin_bit_cast(float, __builtin_amdgcn_update_dpp(0, __builtin_bit_cast(int, v), 0x118, 0xf, 0xf, true));
    v += __builtin_bit_cast(float, __builtin_amdgcn_update_dpp(0, __builtin_bit_cast(int, v), 0x142, 0xa, 0xf, true));
    v += __builtin_bit_cast(float, __builtin_amdgcn_update_dpp(0, __builtin_bit_cast(int, v), 0x143, 0xc, 0xf, true));
    return __builtin_bit_cast(float, __builtin_amdgcn_readlane(__builtin_bit_cast(int, v), 63));
}
__device__ __forceinline__ unsigned pkh(float lo, float hi) { return pg::pkh(lo, hi); }
__device__ __forceinline__ float h2f(unsigned short h) { return (float)__builtin_bit_cast(_Float16, h); }

template <class RowMap>
__device__ __forceinline__ void transpose_item(const float* W, int K, int N, h16* WT, const RowMap& rm, LAS float* scr, int item, int lane) {
    const int nblk = N / 32, kb = item / nblk, nb = item % nblk, k0 = 64 * kb, n0 = 32 * nb;
#pragma unroll 8
    for (int i = 0; i < 32; ++i) { const int kk = 2 * i + (lane >> 5); scr[kk * 33 + (lane & 31)] = W[(size_t)(k0 + kk) * N + n0 + (lane & 31)]; }
    LDS_WAIT(); asm volatile("" ::: "memory");
    const int c = lane & 7;
#pragma unroll
    for (int j = 0; j < 4; ++j) { const int n = (lane >> 3) + 8 * j; const LAS float* s = scr + (8 * c) * 33 + n;
        v4u o; o.x = pkh(s[0 * 33], s[1 * 33]); o.y = pkh(s[2 * 33], s[3 * 33]); o.z = pkh(s[4 * 33], s[5 * 33]); o.w = pkh(s[6 * 33], s[7 * 33]);
        const long dr = rm(n0 + n);
        if (dr >= 0) *(GAS v4u*)(WT + (size_t)dr * K + k0 + 8 * c) = o; }
    LDS_WAIT(); asm volatile("" ::: "memory");
}
struct RmIdent { int off; __device__ __forceinline__ long operator()(int n) const { return off + n; } };
struct RmW1 { __device__ __forceinline__ long operator()(int n) const { const int j = n & 1023; return 256 * (j >> 7) + (n >> 10) * 128 + (j & 127); } };
struct RmRange { int lo, hi, off; __device__ __forceinline__ long operator()(int n) const { return (n >= lo && n < hi) ? (long)(off + n - lo) : -1; } };

__device__ __forceinline__ void ph_convert_moe(const Params& p, Frame& F, int layer) {
    LAS float* scr = (LAS float*)(F.lds + RING_OFF + F.wave * 16384);
    const int gw = F.vcu * NWAVES + F.wave, NGW = F.G * NWAVES;
    constexpr int I1 = (1024 / 64) * (2048 / 32), I2 = (1024 / 64) * (1024 / 32);
    const float* w1 = p.w_exp_in + (size_t)layer * 32 * 1024 * 2048; const float* w2 = p.w_exp_out + (size_t)layer * 32 * 1024 * 1024;
    h16* w1t = p.w1_t + (size_t)layer * 32 * 2048 * 1024; h16* w2t = p.w2_t + (size_t)layer * 32 * 1024 * 1024;
    for (int it = gw; it < 32 * (I1 + I2); it += NGW) {
        if (it < 32 * I1) { const int e = it / I1, r = it % I1; transpose_item(w1 + (size_t)e * 1024 * 2048, 1024, 2048, w1t + (size_t)e * 2048 * 1024, RmW1{}, scr, r, F.lane); }
        else { const int q = it - 32 * I1, e = q / I2, r = q % I2; transpose_item(w2 + (size_t)e * 1024 * 1024, 1024, 1024, w2t + (size_t)e * 1024 * 1024, RmIdent{0}, scr, r, F.lane); }
    }
}
__device__ __forceinline__ void ph_cvt_rows(const float* src, h16* dst, size_t n, Frame& F) {
    const size_t stride = (size_t)F.G * 512 * 8;
    for (size_t i0 = ((size_t)blockIdx.x * 512 + F.tid) * 8; i0 < n; i0 += 4 * stride) {
        f32x4 a[4], b[4];
#pragma unroll
        for (int u = 0; u < 4; ++u) { const size_t i = i0 + u * stride; if (i < n) { a[u] = *(const GAS f32x4*)(src + i); b[u] = *(const GAS f32x4*)(src + i + 4); } }
#pragma unroll
        for (int u = 0; u < 4; ++u) { const size_t i = i0 + u * stride; if (i < n) { v4u o; o.x = pkh(a[u].x, a[u].y); o.y = pkh(a[u].z, a[u].w); o.z = pkh(b[u].x, b[u].y); o.w = pkh(b[u].z, b[u].w); *(GAS v4u*)(dst + i) = o; } }
    }
}

__device__ __forceinline__ void ph_rank(const Params& p, Frame& F) {
    LAS int* se = (LAS int*)(F.lds + RING_OFF);
    for (int cc = blockIdx.x; cc < T_ / 128; cc += F.G) {
        __syncthreads();
        const int j = F.tid; const int e = p.top_e[cc * 512 + j];
        se[j] = e;
        __syncthreads();
        int r = 0;
        for (int q = 0; q < j; ++q) r += (se[q] == e) ? 1 : 0;
        p.rankp[cc * 512 + j] = r;
        if (j < 32) { int c = 0; for (int q = 0; q < 512; ++q) c += (se[q] == j) ? 1 : 0; p.wg_cnt[cc * 32 + j] = c; }
    }
}
__device__ __forceinline__ void ph_assign(const Params& p, Frame& F, int layer) {
    int tid_o = F.tid; asm volatile("" : "+v"(tid_o));
    LAS int* tot = (LAS int*)(F.lds + RING_OFF);
    LAS int* bef = tot + 512;
    LAS int* tst = bef + 512;
    LAS int* bas = tst + 64;
    LAS int* ttl = bas + 32;
    for (int cc = blockIdx.x; cc < T_ / 128; cc += F.G) {
        __syncthreads();
        { const int e = tid_o & 31, part = tid_o >> 5; int s = 0, b = 0;
          for (int c2 = part * 16; c2 < part * 16 + 16; ++c2) { const int v = p.wg_cnt[c2 * 32 + e]; s += v; b += (c2 < cc) ? v : 0; }
          tot[part * 32 + e] = s; bef[part * 32 + e] = b; }
        __syncthreads();
        if (tid_o < 32) { int s = 0, b = 0; for (int q = 0; q < 16; ++q) { s += tot[q * 32 + tid_o]; b += bef[q * 32 + tid_o]; } ttl[tid_o] = s; bas[tid_o] = b; }
        __syncthreads();
        if (tid_o == 0) { int ts = 0; for (int e = 0; e < 32; ++e) { tst[e] = ts; ts += (ttl[e] + 255) >> 8; } tst[32] = ts; }
        __syncthreads();
        { const int j = tid_o, ent = cc * 512 + j, e = p.top_e[ent]; const int sl = 256 * tst[e] + bas[e] + p.rankp[ent];
          p.slot_tok[sl] = ent >> 2; p.slot_gate[sl] = p.top_g[ent]; p.inv[ent] = sl; }
        if (cc < 32) { const int e = cc; for (int sl = 256 * tst[e] + ttl[e] + tid_o; sl < 256 * tst[e + 1]; sl += 512) { p.slot_tok[sl] = 0; p.slot_gate[sl] = 0.f; } }
        if (cc == 0) { for (int rt = tid_o; rt < tst[32]; rt += 512) { int e = 0; for (int q = 1; q < 32; ++q) e += (tst[q] <= rt) ? 1 : 0; p.tile_e[rt] = e; }
            if (tid_o == 0) __hip_atomic_store(F.ctl + CW_NTILES + 64 * layer, (unsigned)tst[32], RLX_AGENT); }
    }
}

constexpr int MOE_MAXU = 20;
#ifndef MOE_F8_L0
#define MOE_F8_L0 1
#endif
constexpr int F8_FROM = MOE_F8_L0 ? 0 : 32;
struct MoeSched {
    const char* abase; const char* wbase; LAS const int* lt_e; LAS const int* lt_tok; int ntiles, nct_log, G, c; size_t a_tile_bytes, w_expert_bytes, w_tile_bytes;
    __device__ __forceinline__ bool next(int i, pg::Unit& u) const {
        const int L = i * G + c; if (L >= (ntiles << nct_log) || i >= MOE_MAXU) return false;
        const int rt = L >> nct_log, ct = L & ((1 << nct_log) - 1);
        const int e = __builtin_amdgcn_readfirstlane(lt_e[i]);
        u.a = abase + (size_t)rt * a_tile_bytes; u.b = wbase + (size_t)e * w_expert_bytes + (size_t)ct * w_tile_bytes; u.pm = rt; u.pn = ct; u.e = e; u.x = i; return true;
    }
    __device__ __forceinline__ unsigned arow(const pg::Unit& u, int r) const { return (unsigned)lt_tok[u.x * 256 + r]; }
};
__device__ __forceinline__ void moe_tables(Frame& F, const int* tile_e, const int* slot_tok, int ntiles, int nct_log, bool gather) {
    LAS int* lt_e = (LAS int*)(F.lds + TAB_OFF); LAS int* lt_tok = lt_e + 32;
    __syncthreads();
    for (int i = 0; i < MOE_MAXU; ++i) { const int L = i * F.G + F.vcu; if (L >= (ntiles << nct_log)) break; const int rt = L >> nct_log;
        if (F.tid == 0) lt_e[i] = tile_e[rt];
        if (gather && F.tid < 256) lt_tok[i * 256 + F.tid] = slot_tok[rt * 256 + F.tid]; }
    __syncthreads();
}
struct EpiSwiglu : pg::EpiBase {
    static constexpr bool PERM = true;
    h16* act; const float* b1;
    __device__ __forceinline__ void operator()(const pg::Acc& acc, const pg::Unit& u, int wr, int wc, int fr, int fq) const { EPI_OPAQUE();
        const int c0 = u.pn * 128 + wc * 32 + 8 * fq;
        const float* bg = b1 + (size_t)u.e * 2048 + c0; const float* bl = bg + 1024;
        const f32x4 g0 = *(const f32x4*)bg, g1 = *(const f32x4*)(bg + 4), l0 = *(const f32x4*)bl, l1 = *(const f32x4*)(bl + 4);
#pragma unroll
        for (int ai = 0; ai < 2; ++ai)
#pragma unroll
            for (int m = 0; m < 4; ++m) {
                const size_t row = (size_t)u.pm * 256 + ai * 128 + wr * 64 + m * 16 + fr;
                float r[8];
#pragma unroll
                for (int n = 0; n < 2; ++n)
#pragma unroll
                    for (int j = 0; j < 4; ++j) {
                        const float glu = fminf(acc[ai][0][m][n][j] + (n ? g1[j] : g0[j]), 7.0f);
                        const float lin = fminf(fmaxf(acc[ai][1][m][n][j] + (n ? l1[j] : l0[j]), -7.0f), 7.0f);
                        r[n * 4 + j] = glu * __builtin_amdgcn_rcpf(1.0f + __builtin_amdgcn_exp2f(-1.702f * 1.4426950408889634f * glu)) * (lin + 1.0f);
                    }
                v4u w; w.x = pkh(r[0], r[1]); w.y = pkh(r[2], r[3]); w.z = pkh(r[4], r[5]); w.w = pkh(r[6], r[7]);
                *(v4u*)(act + row * 1024 + c0) = w;
            }
    }
};
template <int VAR> struct EpiSwigluP : pg::EpiBase {
    static constexpr bool PERM = true;
    h16* act; const float* b1;
    __device__ __forceinline__ void operator()(const pg::Acc& acc, const pg::Unit& u, int wr, int wc, int fr, int fq) const { EPI_OPAQUE();
        const int c0 = u.pn * 128 + wc * 32 + 8 * fq;
        const float* bg = b1 + (size_t)u.e * 2048 + c0; const float* bl = bg + 1024;
        const f32x4 g0 = *(const f32x4*)bg, g1 = *(const f32x4*)(bg + 4), l0 = *(const f32x4*)bl, l1 = *(const f32x4*)(bl + 4);
#pragma unroll
        for (int ai = 0; ai < 2; ++ai)
#pragma unroll
            for (int m = 0; m < 4; ++m) {
                const size_t row = (size_t)u.pm * 256 + ai * 128 + wr * 64 + m * 16 + fr;
                float r[8];
#pragma unroll
                for (int n = 0; n < 2; ++n)
#pragma unroll
                    for (int j = 0; j < 4; ++j) {
                        const float glu = fminf(acc[ai][0][m][n][j] + (n ? g1[j] : g0[j]), 7.0f);
                        const float lin = fminf(fmaxf(acc[ai][1][m][n][j] + (n ? l1[j] : l0[j]), -7.0f), 7.0f);
                        r[n * 4 + j] = (VAR == 2) ? glu + lin : glu * __builtin_amdgcn_rcpf(1.0f + __builtin_amdgcn_exp2f(-1.702f * 1.4426950408889634f * glu)) * (lin + 1.0f);
                    }
                v4u w; w.x = pkh(r[0], r[1]); w.y = pkh(r[2], r[3]); w.z = pkh(r[4], r[5]); w.w = pkh(r[6], r[7]);
                if (VAR == 1) { asm volatile("" :: "v"(w.x), "v"(w.y), "v"(w.z), "v"(w.w)); } else { *(v4u*)(act + row * 1024 + c0) = w; }
            }
    }
};
struct EpiMoeOut : pg::EpiBase {
    static constexpr bool PERM = true;
    h16* __restrict__ y; const float* __restrict__ b2; const float* __restrict__ gate;
    __device__ __forceinline__ void operator()(const pg::Acc& acc, const pg::Unit& u, int wr, int wc, int fr, int fq) const { EPI_OPAQUE();
        float gt[2][4]; f32x4 bv[2][2];
#pragma unroll
        for (int ai = 0; ai < 2; ++ai)
#pragma unroll
            for (int m = 0; m < 4; ++m) gt[ai][m] = gate[(size_t)u.pm * 256 + ai * 128 + wr * 64 + m * 16 + fr];
#pragma unroll
        for (int bj = 0; bj < 2; ++bj) { const float* bp = b2 + (size_t)u.e * 1024 + u.pn * 256 + bj * 128 + wc * 32 + 8 * fq; bv[bj][0] = *(const f32x4*)bp; bv[bj][1] = *(const f32x4*)(bp + 4); }
#pragma unroll
        for (int ai = 0; ai < 2; ++ai)
#pragma unroll
            for (int m = 0; m < 4; ++m) {
                const size_t row = (size_t)u.pm * 256 + ai * 128 + wr * 64 + m * 16 + fr;
#pragma unroll
                for (int bj = 0; bj < 2; ++bj) {
                    const int c0 = u.pn * 256 + bj * 128 + wc * 32 + 8 * fq;
                    const f32x4 v0 = (acc[ai][bj][m][0] + bv[bj][0]) * gt[ai][m], v1 = (acc[ai][bj][m][1] + bv[bj][1]) * gt[ai][m];
                    v4u w; w.x = pkh(v0[0], v0[1]); w.y = pkh(v0[2], v0[3]); w.z = pkh(v1[0], v1[1]); w.w = pkh(v1[2], v1[3]);
                    *(v4u*)(y + row * 1024 + c0) = w;
                }
            }
    }
};
template <bool Y8> __device__ __forceinline__ void ph_combine_ln(const Params& p, Frame& F, const h16* xprev, const float* gam, const float* bet, float* outf, h16* outh) {
    int lane = F.lane; asm volatile("" : "+v"(lane));
    const int gw = F.vcu * NWAVES + F.wave, NGW = F.G * NWAVES;
    constexpr int NT = Y8 ? 4 : 3;
    for (int tb = gw * NT; tb < T_; tb += NGW * NT) {
        v4u xw[NT][2], yw[Y8 ? 1 : NT][2][4]; v2u yq[Y8 ? NT : 1][2][4];
#pragma unroll
        for (int u = 0; u < NT; ++u) { const int t = tb + u < T_ ? tb + u : T_ - 1; int sl[4];
#pragma unroll
            for (int k = 0; k < 4; ++k) sl[k] = p.inv[t * 4 + k];
#pragma unroll
            for (int j = 0; j < 2; ++j) { const int c = 8 * lane + 512 * j; xw[u][j] = *(const GAS v4u*)(xprev + (size_t)t * 1024 + c);
#pragma unroll
                for (int k = 0; k < 4; ++k) { if constexpr (Y8) yq[u][j][k] = *(const GAS v2u*)((const unsigned char*)p.yy + (size_t)sl[k] * 1024 + c); else yw[u][j][k] = *(const GAS v4u*)(p.yy + (size_t)sl[k] * 1024 + c); } } }
#pragma unroll
        for (int u = 0; u < NT; ++u) { const int t = tb + u; if (t >= T_) break;
            float v[16]; float s = 0.f;
#pragma unroll
            for (int j = 0; j < 2; ++j) { const v4u x4 = xw[u][j];
                float a[8] = {h2f(x4.x & 0xffff) * ALPHA_, h2f(x4.x >> 16) * ALPHA_, h2f(x4.y & 0xffff) * ALPHA_, h2f(x4.y >> 16) * ALPHA_, h2f(x4.z & 0xffff) * ALPHA_, h2f(x4.z >> 16) * ALPHA_, h2f(x4.w & 0xffff) * ALPHA_, h2f(x4.w >> 16) * ALPHA_};
#pragma unroll
                for (int k = 0; k < 4; ++k) {
                    if constexpr (Y8) { const v2u w8 = yq[u][j][k]; const f32x2v p0 = __builtin_amdgcn_cvt_pk_f32_fp8((int)w8.x, false), p1 = __builtin_amdgcn_cvt_pk_f32_fp8((int)w8.x, true), p2 = __builtin_amdgcn_cvt_pk_f32_fp8((int)w8.y, false), p3 = __builtin_amdgcn_cvt_pk_f32_fp8((int)w8.y, true);
                        a[0] += p0.x * 0.03125f; a[1] += p0.y * 0.03125f; a[2] += p1.x * 0.03125f; a[3] += p1.y * 0.03125f; a[4] += p2.x * 0.03125f; a[5] += p2.y * 0.03125f; a[6] += p3.x * 0.03125f; a[7] += p3.y * 0.03125f; }
                    else { const v4u w = yw[u][j][k];
                    a[0] += h2f(w.x & 0xffff); a[1] += h2f(w.x >> 16); a[2] += h2f(w.y & 0xffff); a[3] += h2f(w.y >> 16);
                    a[4] += h2f(w.z & 0xffff); a[5] += h2f(w.z >> 16); a[6] += h2f(w.w & 0xffff); a[7] += h2f(w.w >> 16); } }
#pragma unroll
                for (int q = 0; q < 8; ++q) { v[j * 8 + q] = a[q]; s += a[q]; } }
            const float mean = wave_sum(s) * (1.0f / 1024.0f); float qq = 0.f;
#pragma unroll
            for (int q = 0; q < 16; ++q) { v[q] -= mean; qq += v[q] * v[q]; }
            const float rstd = 1.0f / sqrtf(wave_sum(qq) * (1.0f / 1024.0f) + LN_EPS_);
#pragma unroll
            for (int j = 0; j < 2; ++j) {
                const int c = 8 * lane + 512 * j;
                const f32x4 ga = *(const GAS f32x4*)(gam + c), gb = *(const GAS f32x4*)(gam + c + 4), ba = *(const GAS f32x4*)(bet + c), bb = *(const GAS f32x4*)(bet + c + 4);
                f32x4 oa, ob;
                oa.x = v[j * 8 + 0] * rstd * ga.x + ba.x; oa.y = v[j * 8 + 1] * rstd * ga.y + ba.y; oa.z = v[j * 8 + 2] * rstd * ga.z + ba.z; oa.w = v[j * 8 + 3] * rstd * ga.w + ba.w;
                ob.x = v[j * 8 + 4] * rstd * gb.x + bb.x; ob.y = v[j * 8 + 5] * rstd * gb.y + bb.y; ob.z = v[j * 8 + 6] * rstd * gb.z + bb.z; ob.w = v[j * 8 + 7] * rstd * gb.w + bb.w;
                if (outf) { *(GAS f32x4*)(outf + (size_t)t * 1024 + c) = oa; *(GAS f32x4*)(outf + (size_t)t * 1024 + c + 4) = ob; }
                if (outh) { v4u w; w.x = pkh(oa.x, oa.y); w.y = pkh(oa.z, oa.w); w.z = pkh(ob.x, ob.y); w.w = pkh(ob.z, ob.w); *(GAS v4u*)(outh + (size_t)t * 1024 + c) = w; }
            } }
    }
}
struct CvJob { const float* src; h16* dst; int K, N, n_off, n_cnt, row_off, w1map, f8; };
__device__ __forceinline__ void cv_load(const CvJob& j, int item, int lane, float (&ld)[32]) {
    const int nblk = j.n_cnt / 32, kb = item / nblk, nb = item % nblk, k0 = 64 * kb, n0 = j.n_off + 32 * nb;
#pragma unroll
    for (int i = 0; i < 32; ++i) { const int kk = 2 * i + (lane >> 5); ld[i] = __builtin_nontemporal_load(j.src + (size_t)(k0 + kk) * j.N + n0 + (lane & 31)); }
}
__device__ __forceinline__ void cv_finish(const CvJob& j, LAS float* scr, int item, int lane, const float (&ld)[32]) {
    const int nblk = j.n_cnt / 32, kb = item / nblk, nb = item % nblk, k0 = 64 * kb, n0 = j.n_off + 32 * nb;
#pragma unroll
    for (int i = 0; i < 32; ++i) { const int kk = 2 * i + (lane >> 5); scr[kk * 33 + (lane & 31)] = ld[i]; }
    LDS_WAIT(); asm volatile("" ::: "memory");
    const int c = lane & 7;
#pragma unroll
    for (int q = 0; q < 4; ++q) { const int n = (lane >> 3) + 8 * q; const LAS float* s = scr + (8 * c) * 33 + n;
        const int nn = n0 + n - j.n_off; const int jj = nn & 1023;
        const long dr = j.w1map ? (long)(256 * (jj >> 7) + (nn >> 10) * 128 + (jj & 127)) : (long)(j.row_off + nn);
        if (j.f8) { int lo = 0, hi = 0;
            lo = __builtin_amdgcn_cvt_pk_fp8_f32(s[0 * 33] * 32.f, s[1 * 33] * 32.f, lo, false); lo = __builtin_amdgcn_cvt_pk_fp8_f32(s[2 * 33] * 32.f, s[3 * 33] * 32.f, lo, true);
            hi = __builtin_amdgcn_cvt_pk_fp8_f32(s[4 * 33] * 32.f, s[5 * 33] * 32.f, hi, false); hi = __builtin_amdgcn_cvt_pk_fp8_f32(s[6 * 33] * 32.f, s[7 * 33] * 32.f, hi, true);
            v2u o8; o8.x = (unsigned)lo; o8.y = (unsigned)hi; *(GAS v2u*)((unsigned char*)j.dst + (size_t)dr * j.K + k0 + 8 * c) = o8; }
        else { v4u o; o.x = pkh(s[0 * 33], s[1 * 33]); o.y = pkh(s[2 * 33], s[3 * 33]); o.z = pkh(s[4 * 33], s[5 * 33]); o.w = pkh(s[6 * 33], s[7 * 33]);
            *(GAS v4u*)(j.dst + (size_t)dr * j.K + k0 + 8 * c) = o; } }
    LDS_WAIT(); asm volatile("" ::: "memory");
}
__device__ __forceinline__ int cv_decode(const Params& p, int it, CvJob& j) {
    constexpr int J1 = 1024, J2 = 1024, J3 = 1024, J4 = 1024, J5 = 640, J6 = 512, I1 = 1024, I2 = 512;
    int r = it;
    if (r < J1) { j = CvJob{p.w_ret_in, p.wri_t, 1024, 6144, 0, 2048, 0, 0, 0}; }
    else if ((r -= J1) < J2) { j = CvJob{p.w_ret_in, p.wri_t, 1024, 6144, 4096, 2048, 2048, 0, 0}; }
    else if ((r -= J2) < J3) { j = CvJob{p.w_ret_in, p.wfm_t, 1024, 6144, 2048, 2048, 0, 0, 0}; }
    else if ((r -= J3) < J4) { j = CvJob{p.w_ret_out, p.wro_t, 2048, 1024, 0, 1024, 0, 0, 0}; }
    else if ((r -= J4) < J5) { j = CvJob{p.w_swa_in, p.wsi_t, 1024, 1280, 0, 1280, 0, 0, 0}; }
    else if ((r -= J5) < J6) { j = CvJob{p.w_swa_out, p.wso_t, 1024, 1024, 0, 1024, 0, 0, 0}; }
    else if ((r -= J6) < 64 * I1) { const int e = r / I1; r %= I1; if (e < F8_FROM) j = CvJob{p.w_exp_in + (size_t)e * 1024 * 2048, p.w1_t + (size_t)e * 2048 * 1024, 1024, 2048, 0, 2048, 0, 1, 0};
        else j = CvJob{p.w_exp_in + (size_t)e * 1024 * 2048, (h16*)(p.w1q + (size_t)e * 2048 * 1024), 1024, 2048, 0, 2048, 0, 1, 1}; }
    else { r -= 64 * I1; const int e = r / I2; r %= I2; if (e < F8_FROM) j = CvJob{p.w_exp_out + (size_t)e * 1024 * 1024, p.w2_t + (size_t)e * 1024 * 1024, 1024, 1024, 0, 1024, 0, 0, 0};
        else j = CvJob{p.w_exp_out + (size_t)e * 1024 * 1024, (h16*)(p.w2q + (size_t)e * 1024 * 1024), 1024, 1024, 0, 1024, 0, 0, 1}; }
    return r;
}
__device__ __forceinline__ void ph_prologue(const Params& p, Frame& F) {
    LAS float* scr = (LAS float*)(F.lds + RING_OFF + F.wave * 16384);
    const int gw = F.vcu * NWAVES + F.wave, NGW = F.G * NWAVES;
    constexpr int NITEMS = 1024 + 1024 + 1024 + 1024 + 640 + 512 + 64 * (1024 + 512);
    int it = gw; CvJob j0, j1; int r0 = 0, r1 = 0; float ld0[32], ld1[32];
    if (it < NITEMS) { r0 = cv_decode(p, it, j0); cv_load(j0, r0, F.lane, ld0); }
    while (it < NITEMS) {
        const int nit = it + NGW; const bool hn = nit < NITEMS;
        if (hn) { r1 = cv_decode(p, nit, j1); cv_load(j1, r1, F.lane, ld1); }
        cv_finish(j0, scr, r0, F.lane, ld0);
        j0 = j1; r0 = r1;
#pragma unroll
        for (int i = 0; i < 32; ++i) ld0[i] = ld1[i];
        it = nit;
    }
    ph_cvt_rows(p.x, p.xh0, (size_t)T_ * D_, F);
}

struct DenseSched {
    const char* A; const char* B; size_t a_tile_bytes, b_tile_bytes; int nM, nN, nwg, G, c;
    __device__ __forceinline__ void init(const void* A_, int lda, const void* B_, int ldb, int M, int N, int G_, int c_, int rot = 0  ) {
        A = (const char*)A_; B = (const char*)B_; a_tile_bytes = (size_t)256 * lda * 2; b_tile_bytes = (size_t)256 * ldb * 2; nM = M / 256; nN = N / 256; nwg = nM * nN; G = G_; c = (c_ + G_ - rot) % G_; }
    __device__ __forceinline__ bool next(int i, pg::Unit& u) const {
        const long L = (long)i * G + c; if (L >= nwg) return false;
        int wgid = (int)L; { const int q = nwg / 8, r = nwg % 8, xcd = wgid % 8, off = wgid / 8; wgid = (xcd < r ? xcd * (q + 1) : r * (q + 1) + (xcd - r) * q) + off; }
        const int nig = 8 * nN, gid = wgid / nig, fm = gid * 8, gsz = (nM - fm) < 8 ? (nM - fm) : 8;
        u.pm = fm + ((wgid % nig) % gsz); u.pn = (wgid % nig) / gsz; u.e = 0; u.x = 0;
        u.a = A + (size_t)u.pm * a_tile_bytes; u.b = B + (size_t)u.pn * b_tile_bytes; return true;
    }
    __device__ __forceinline__ unsigned arow(const pg::Unit&, int) const { return 0u; }
};
struct EpiResid : pg::EpiBase {
    static constexpr bool PERM = true;
    const h16* __restrict__ xprevh; const float* __restrict__ bias; h16* __restrict__ yh;
    __device__ __forceinline__ void operator()(const pg::Acc& acc, const pg::Unit& u, int wr, int wc, int fr, int fq) const { EPI_OPAQUE();
        f32x4 bv[2][2];
#pragma unroll
        for (int bj = 0; bj < 2; ++bj) { const int col = u.pn * 256 + bj * 128 + wc * 32 + 8 * fq;
            bv[bj][0] = bias ? *(const f32x4*)(bias + col) : (f32x4){0.f, 0.f, 0.f, 0.f}; bv[bj][1] = bias ? *(const f32x4*)(bias + col + 4) : (f32x4){0.f, 0.f, 0.f, 0.f}; }
#pragma unroll
        for (int ai = 0; ai < 2; ++ai) {
            v4u xw[4][2];
#pragma unroll
            for (int m = 0; m < 4; ++m)
#pragma unroll
                for (int bj = 0; bj < 2; ++bj) { const size_t row = (size_t)u.pm * 256 + ai * 128 + wr * 64 + m * 16 + fr; xw[m][bj] = *(const v4u*)(xprevh + row * 1024 + u.pn * 256 + bj * 128 + wc * 32 + 8 * fq); }
#pragma unroll
            for (int m = 0; m < 4; ++m)
#pragma unroll
                for (int bj = 0; bj < 2; ++bj) { const size_t row = (size_t)u.pm * 256 + ai * 128 + wr * 64 + m * 16 + fr; const int col = u.pn * 256 + bj * 128 + wc * 32 + 8 * fq; const v4u x4 = xw[m][bj];
                    const f32x4 a = (f32x4){h2f(x4.x & 0xffff), h2f(x4.x >> 16), h2f(x4.y & 0xffff), h2f(x4.y >> 16)} * ALPHA_ + acc[ai][bj][m][0] + bv[bj][0];
                    const f32x4 b = (f32x4){h2f(x4.z & 0xffff), h2f(x4.z >> 16), h2f(x4.w & 0xffff), h2f(x4.w >> 16)} * ALPHA_ + acc[ai][bj][m][1] + bv[bj][1];
                    v4u w; w.x = pkh(a[0], a[1]); w.y = pkh(a[2], a[3]); w.z = pkh(b[0], b[1]); w.w = pkh(b[2], b[3]);
                    *(v4u*)(yh + row * 1024 + col) = w; } }
    }
};
struct EpiF32 : pg::EpiBase {
    const float* bias; float* c; int ldc;
    __device__ __forceinline__ void operator()(const pg::Acc& acc, const pg::Unit& u, int wr, int wc, int fr, int fq) const { EPI_OPAQUE();
#pragma unroll
        for (int ai = 0; ai < 2; ++ai)
#pragma unroll
            for (int m = 0; m < 4; ++m) { const size_t row = (size_t)u.pm * 256 + ai * 128 + wr * 64 + m * 16 + fr;
#pragma unroll
                for (int bj = 0; bj < 2; ++bj)
#pragma unroll
                    for (int n = 0; n < 2; ++n) { const int col = u.pn * 256 + bj * 128 + wc * 32 + n * 16 + 4 * fq;
                        f32x4 o = acc[ai][bj][m][n]; if (bias) o += *(const f32x4*)(bias + col);
                        *(f32x4*)(c + row * ldc + col) = o; } }
    }
};

constexpr int XROW16 = 1032;
typedef _Float16 f16x8r __attribute__((ext_vector_type(8)));
__device__ __forceinline__ void ph_ln_router(const Params& p, Frame& F, const float* gam, const float* bet, const float* wr, const float* br, unsigned char* xq, const int pmode = 0  ) {
    LAS unsigned short* X = (LAS unsigned short*)(F.lds);
    LAS float* PART = (LAS float*)(X + 32 * XROW16);
    LAS int* se = (LAS int*)(PART + 8 * 32 * 32);
    LAS float* LG = (LAS float*)(se + 512);
    LAS float* TV = LG + 1024;
    LAS int* cnt = (LAS int*)(TV + 128);
    int tid_o = F.tid; asm volatile("" : "+v"(tid_o));
    const int lane = tid_o & 63, w = F.wave, l15 = lane & 15, kg = lane >> 4;
    f16x8r wh[2][4], wl[2][4];
#pragma unroll
    for (int nt = 0; nt < 2; ++nt)
#pragma unroll
        for (int s = 0; s < 4; ++s) {
#pragma unroll
            for (int j = 0; j < 8; ++j) { const float v = wr[(size_t)(128 * w + 32 * s + 8 * kg + j) * 32 + 16 * nt + l15]; const _Float16 h = (_Float16)v; wh[nt][s][j] = h; wl[nt][s][j] = (_Float16)(v - (float)h); } }
    const float bias_e = br[tid_o & 31];
    for (int cc = blockIdx.x; cc < T_ / 128; cc += F.G) {
        v4u pre[4][2];
#pragma unroll
        for (int r = 0; r < 4; ++r)
#pragma unroll
            for (int j = 0; j < 2; ++j) pre[r][j] = *(const GAS v4u*)(p.yh + (size_t)(cc * 128 + 4 * w + r) * 1024 + 8 * lane + 512 * j);
        for (int blk = 0; blk < 4; ++blk) {
            const int t0 = cc * 128 + blk * 32;
            v4u cur[4][2];
#pragma unroll
            for (int r = 0; r < 4; ++r)
#pragma unroll
                for (int j = 0; j < 2; ++j) { cur[r][j] = pre[r][j]; if (blk < 3) pre[r][j] = *(const GAS v4u*)(p.yh + (size_t)(t0 + 32 + 4 * w + r) * 1024 + 8 * lane + 512 * j); }
#pragma unroll
            for (int r = 0; r < 4; ++r) {
                const int tl = 4 * w + r; const size_t t = (size_t)(t0 + tl);
                f32x4 v[4]; float s = 0.f;
#pragma unroll
                for (int j = 0; j < 2; ++j) { const v4u pw = cur[r][j]; v[2 * j] = (f32x4){h2f(pw.x & 0xffff), h2f(pw.x >> 16), h2f(pw.y & 0xffff), h2f(pw.y >> 16)}; v[2 * j + 1] = (f32x4){h2f(pw.z & 0xffff), h2f(pw.z >> 16), h2f(pw.w & 0xffff), h2f(pw.w >> 16)}; }
#pragma unroll
                for (int j = 0; j < 4; ++j) s += (v[j].x + v[j].y) + (v[j].z + v[j].w);
                const float mean = wave_sum(s) * (1.0f / 1024.0f); float q = 0.f;
#pragma unroll
                for (int j = 0; j < 4; ++j) { v[j] = v[j] - mean; q += (v[j].x * v[j].x + v[j].y * v[j].y) + (v[j].z * v[j].z + v[j].w * v[j].w); }
                const float rstd = 1.0f / sqrtf(wave_sum(q) * (1.0f / 1024.0f) + LN_EPS_);
#pragma unroll
                for (int j = 0; j < 2; ++j) { const int c = 8 * lane + 512 * j;
                    const f32x4 o0 = v[2 * j] * rstd * *(const GAS f32x4*)(gam + c) + *(const GAS f32x4*)(bet + c), o1 = v[2 * j + 1] * rstd * *(const GAS f32x4*)(gam + c + 4) + *(const GAS f32x4*)(bet + c + 4);
                    v4u hw; hw.x = pkh(o0.x, o0.y); hw.y = pkh(o0.z, o0.w); hw.z = pkh(o1.x, o1.y); hw.w = pkh(o1.z, o1.w);
                    *(GAS v4u*)(p.x1h + t * 1024 + c) = hw;
                    if (xq) { int qa = 0, qb = 0; qa = __builtin_amdgcn_cvt_pk_fp8_f32(o0.x, o0.y, qa, false); qa = __builtin_amdgcn_cvt_pk_fp8_f32(o0.z, o0.w, qa, true); qb = __builtin_amdgcn_cvt_pk_fp8_f32(o1.x, o1.y, qb, false); qb = __builtin_amdgcn_cvt_pk_fp8_f32(o1.z, o1.w, qb, true);
                        v2u q8; q8.x = (unsigned)qa; q8.y = (unsigned)qb; *(GAS v2u*)(xq + t * 1024 + c) = q8; }
                    *(LAS v4u*)(X + tl * XROW16 + c) = hw; }
            }
            if (pmode == 1) continue;
            __syncthreads();
            {
                f32x4 acc[2][2];
#pragma unroll
                for (int mt = 0; mt < 2; ++mt)
#pragma unroll
                    for (int nt = 0; nt < 2; ++nt) acc[mt][nt] = (f32x4){0.f, 0.f, 0.f, 0.f};
#pragma unroll
                for (int s = 0; s < 4; ++s)
#pragma unroll
                    for (int mt = 0; mt < 2; ++mt) { const f16x8r a = *(const LAS f16x8r*)(X + (16 * mt + l15) * XROW16 + 128 * w + 32 * s + 8 * kg);
#pragma unroll
                        for (int nt = 0; nt < 2; ++nt) { acc[mt][nt] = __builtin_amdgcn_mfma_f32_16x16x32_f16(a, wh[nt][s], acc[mt][nt], 0, 0, 0); acc[mt][nt] = __builtin_amdgcn_mfma_f32_16x16x32_f16(a, wl[nt][s], acc[mt][nt], 0, 0, 0); } }
#pragma unroll
                for (int mt = 0; mt < 2; ++mt)
#pragma unroll
                    for (int nt = 0; nt < 2; ++nt)
#pragma unroll
                        for (int r = 0; r < 4; ++r) PART[(w * 32 + 16 * mt + 4 * kg + r) * 32 + 16 * nt + l15] = acc[mt][nt][r];
            }
            __syncthreads();
#pragma unroll
            for (int ps = 0; ps < 2; ++ps) {
                const int tok = (tid_o >> 5) + 16 * ps, e = tid_o & 31; float val = bias_e;
#pragma unroll
                for (int q = 0; q < 8; ++q) val += PART[(q * 32 + tok) * 32 + e];
                LG[tok * 32 + e] = val;
                LDS_WAIT(); asm volatile("" ::: "memory");
                int rank = 0;
#pragma unroll
                for (int q4 = 0; q4 < 8; ++q4) { const f32x4 o = *(const LAS f32x4*)(LG + tok * 32 + 4 * q4);
                    rank += ((o.x > val) || (o.x == val && 4 * q4 < e)) ? 1 : 0; rank += ((o.y > val) || (o.y == val && 4 * q4 + 1 < e)) ? 1 : 0;
                    rank += ((o.z > val) || (o.z == val && 4 * q4 + 2 < e)) ? 1 : 0; rank += ((o.w > val) || (o.w == val && 4 * q4 + 3 < e)) ? 1 : 0; }
                const int t = t0 + tok;
                if (rank < 4) { TV[tok * 4 + rank] = val; p.top_e[t * 4 + rank] = e; se[(blk * 32 + tok) * 4 + rank] = e; }
                LDS_WAIT(); asm volatile("" ::: "memory");
                if (e < 4) { const f32x4 tv = *(const LAS f32x4*)(TV + tok * 4);
                    const float e1 = __expf(tv.y - tv.x), e2 = __expf(tv.z - tv.x), e3 = __expf(tv.w - tv.x); const float inv = 1.0f / (1.0f + e1 + e2 + e3);
                    p.top_g[t * 4 + e] = (e == 0 ? 1.0f : (e == 1 ? e1 : (e == 2 ? e2 : e3))) * inv; }
            }
        }
        __syncthreads();
        if (pmode == 0) {
            const int j = tid_o; const int e = se[j]; int r = 0;
            if (j < 32) cnt[j] = 0;
            __syncthreads();
#pragma unroll 8
            for (int q4 = 0; q4 < 128; ++q4) { const v4u sv = *(const LAS v4u*)(se + 4 * q4);
                r += ((int)sv.x == e && 4 * q4 < j) ? 1 : 0; r += ((int)sv.y == e && 4 * q4 + 1 < j) ? 1 : 0; r += ((int)sv.z == e && 4 * q4 + 2 < j) ? 1 : 0; r += ((int)sv.w == e && 4 * q4 + 3 < j) ? 1 : 0; }
            p.rankp[cc * 512 + j] = r;
            atomicAdd((int*)(cnt + e), 1);
            __syncthreads();
            if (j < 32) p.wg_cnt[cc * 32 + j] = cnt[j];
        }
        __syncthreads();
    }
}

__device__ __forceinline__ float lg2gamma(int h) { return h == 0 ? -0.04580368961312479f : (h == 1 ? -0.02272007650008353f : (h == 2 ? -0.011315313227834146f : -0.005646563141142063f)); }
struct EpiInTok : pg::EpiBase {
    static constexpr bool PERM = true;
    h16 *q, *k, *sg;
    __device__ __forceinline__ void operator()(const pg::Acc& acc, const pg::Unit& u, int wr, int wc, int fr, int fq) const { EPI_OPAQUE();
        const int pn = u.pn; h16* dst; int ld, cb; int mode;
        if (pn < 4) { dst = q; ld = 1024; cb = pn * 256; mode = 0; } else if (pn < 8) { dst = k; ld = 1024; cb = (pn - 4) * 256; mode = 1; } else { dst = sg; ld = 2048; cb = (pn - 8) * 256; mode = 2; }
#pragma unroll
        for (int ai = 0; ai < 2; ++ai)
#pragma unroll
            for (int m = 0; m < 4; ++m) { const size_t row = (size_t)u.pm * 256 + ai * 128 + wr * 64 + m * 16 + fr;
#pragma unroll
                for (int bj = 0; bj < 2; ++bj) { const int c0 = cb + bj * 128 + wc * 32 + 8 * fq; float r[8];
#pragma unroll
                    for (int n = 0; n < 2; ++n)
#pragma unroll
                        for (int j = 0; j < 4; ++j) { float v = acc[ai][bj][m][n][j];
                            if (mode == 1) v *= 0.0625f;
                            if (mode == 2) v = v * __builtin_amdgcn_rcpf(1.0f + __builtin_amdgcn_exp2f(-1.4426950408889634f * v));
                            r[n * 4 + j] = v; }
                    v4u w; w.x = pkh(r[0], r[1]); w.y = pkh(r[2], r[3]); w.z = pkh(r[4], r[5]); w.w = pkh(r[6], r[7]);
                    *(v4u*)(dst + row * ld + c0) = w; } }
    }
};
struct EpiInFeat : pg::EpiBase {
    static constexpr bool PERM = true;
    h16* __restrict__ vt;
    __device__ __forceinline__ void operator()(const pg::Acc& acc, const pg::Unit& u, int wr, int wc, int fr, int fq) const { EPI_OPAQUE();
        h16* dst = vt + ((size_t)u.pn * 2048 + (size_t)u.pm * 256) * 256;
#pragma unroll
        for (int bj = 0; bj < 2; ++bj) { const int c0 = bj * 128 + wc * 32 + 8 * fq;
#pragma unroll
            for (int ai = 0; ai < 2; ++ai)
#pragma unroll
                for (int m = 0; m < 4; ++m) { const size_t row = (size_t)(ai * 128 + wr * 64 + m * 16 + fr);
                    const f32x4 a = acc[ai][bj][m][0], b = acc[ai][bj][m][1];
                    v4u w; w.x = pkh(a[0], a[1]); w.y = pkh(a[2], a[3]); w.z = pkh(b[0], b[1]); w.w = pkh(b[2], b[3]);
                    *(v4u*)(dst + row * 256 + c0) = w; } }
    }
};
constexpr int KT_PITCH = 520;
__device__ __forceinline__ void ph_ktranspose(const Params& p, Frame& F) {
    LAS unsigned char* img = F.lds;
    for (int item = F.vcu; item < 512; item += F.G) {
        const int chunk = item >> 2, h = item & 3;
        __syncthreads();
        v4u ld[16];
#pragma unroll
        for (int i = 0; i < 16; ++i) { const int pc = F.tid + 512 * i, row = pc >> 5, c16 = pc & 31; ld[i] = *(const GAS v4u*)(p.k + ((size_t)(chunk * 256 + row)) * 1024 + h * 256 + c16 * 8); }
#pragma unroll
        for (int i = 0; i < 16; ++i) { const int pc = F.tid + 512 * i, row = pc >> 5, c16 = pc & 31; v2u lo; lo.x = ld[i].x; lo.y = ld[i].y; v2u hi; hi.x = ld[i].z; hi.y = ld[i].w;
            *(LAS v2u*)(img + row * KT_PITCH + c16 * 16) = lo; *(LAS v2u*)(img + row * KT_PITCH + c16 * 16 + 8) = hi; }
        __syncthreads();
        const int tg = F.tid & 31; const float lg = lg2gamma(h); float sc[8];
#pragma unroll
        for (int j = 0; j < 8; ++j) sc[j] = __builtin_amdgcn_exp2f((float)(255 - (8 * tg + j)) * lg);
        h16* dst = p.kdt + ((size_t)chunk * 1024 + h * 256) * 256;
#pragma unroll 4
        for (int r = 0; r < 16; ++r) { const int dk = (F.tid >> 5) + 16 * r; float v[8];
#pragma unroll
            for (int j = 0; j < 8; ++j) v[j] = h2f(*(const LAS unsigned short*)(img + (8 * tg + j) * KT_PITCH + dk * 2)) * sc[j];
            v4u w; w.x = pkh(v[0], v[1]); w.y = pkh(v[2], v[3]); w.z = pkh(v[4], v[5]); w.w = pkh(v[6], v[7]);
            *(GAS v4u*)(dst + (size_t)dk * 256 + 8 * tg) = w; }
    }
    __syncthreads();
}
struct RaSched {
    const h16 *q, *k; int G, c;
    __device__ __forceinline__ bool next(int i, pg::Unit& u) const {
        const int L = i * G + c; if (L >= 512) return false;
        const int bh = L >> 5, cch = L & 31, b = bh >> 2, h = bh & 3; const size_t off = ((size_t)(b * 8192 + cch * 256) * 1024 + h * 256) * 2;
        u.a = (const char*)q + off; u.b = (const char*)k + off; u.pm = L; u.pn = 0; u.e = L; u.x = h; return true; }
    __device__ __forceinline__ unsigned arow(const pg::Unit&, int) const { return 0u; }
};
struct EpiPP : pg::EpiBase {
    static constexpr bool PERM = true;
    h16* pp;
    __device__ __forceinline__ void operator()(const pg::Acc& acc, const pg::Unit& u, int wr, int wc, int fr, int fq) const { EPI_OPAQUE();
        const float lg = lg2gamma(u.x); h16* dst = pp + (size_t)u.e * 65536;
#pragma unroll
        for (int bj = 0; bj < 2; ++bj) { const int c0 = bj * 128 + wc * 32 + 8 * fq; float sc[8];
#pragma unroll
            for (int j = 0; j < 8; ++j) sc[j] = __builtin_amdgcn_exp2f(-(float)(c0 + j + 1) * lg);
#pragma unroll
            for (int ai = 0; ai < 2; ++ai)
#pragma unroll
                for (int m = 0; m < 4; ++m) { const int i = ai * 128 + wr * 64 + m * 16 + fr; float r[8];
#pragma unroll
                    for (int n = 0; n < 2; ++n)
#pragma unroll
                        for (int j = 0; j < 4; ++j) r[n * 4 + j] = (c0 + n * 4 + j <= i) ? acc[ai][bj][m][n][j] * sc[n * 4 + j] : 0.f;
                    v4u w; w.x = pkh(r[0], r[1]); w.y = pkh(r[2], r[3]); w.z = pkh(r[4], r[5]); w.w = pkh(r[6], r[7]);
                    *(v4u*)(dst + (size_t)i * 256 + c0) = w; } }
    }
};
struct R1Sched {
    const h16 *vt, *kdt; int nsub, G, c;
    __device__ __forceinline__ bool next(int i, pg::Unit& u) const {
        const int item = (i / nsub) * G + c, j = i % nsub; if (item >= 256) return false;
        if (nsub == 4 && ((item >> 1) & 7) == 7) return false;
        const int pm = item & 1, seg = (item >> 1) & 7, bh = item >> 4, b = bh >> 2, h = bh & 3; const size_t chunk = (size_t)b * 32 + seg * 4 + j;
        u.a = (const char*)vt + ((chunk * 2048 + h * 512 + pm * 256) * 256) * 2; u.b = (const char*)kdt + ((chunk * 1024 + h * 256) * 256) * 2;
        u.pm = pm; u.pn = j; u.e = item; u.x = h; return true; }
    __device__ __forceinline__ unsigned arow(const pg::Unit&, int) const { return 0u; }
};
__device__ __forceinline__ void acc_scale(pg::Acc& acc, float s) {
#pragma unroll
    for (int a = 0; a < 2; ++a)
#pragma unroll
        for (int b = 0; b < 2; ++b)
#pragma unroll
            for (int m = 0; m < 4; ++m)
#pragma unroll
                for (int n = 0; n < 2; ++n) acc[a][b][m][n] = acc[a][b][m][n] * s;
}
struct EpiSegTot : pg::EpiBase {
    static constexpr bool PERM = true;
    float* L;
    __device__ __forceinline__ void operator()(pg::Acc& acc, const pg::Unit& u, int wr, int wc, int fr, int fq) const { EPI_OPAQUE();
        if (u.pn < 3) { acc_scale(acc, __builtin_amdgcn_exp2f(256.0f * lg2gamma(u.x))); return; }
        float* dst = L + ((size_t)(u.e >> 1) * 512 + u.pm * 256) * 256;
#pragma unroll
        for (int ai = 0; ai < 2; ++ai)
#pragma unroll
            for (int m = 0; m < 4; ++m) { const int r = ai * 128 + wr * 64 + m * 16 + fr;
#pragma unroll
                for (int bj = 0; bj < 2; ++bj) { const int c0 = bj * 128 + wc * 32 + 8 * fq;
                    *(f32x4*)(dst + (size_t)r * 256 + c0) = acc[ai][bj][m][0]; *(f32x4*)(dst + (size_t)r * 256 + c0 + 4) = acc[ai][bj][m][1]; } }
    }
    __device__ __forceinline__ void reinit(pg::Acc& acc, const pg::Unit& cur, const pg::Unit& nxt, int, int, int, int) const { if (nxt.e != cur.e) pg::acc_zero(acc); }
};
struct EpiSnap : pg::EpiBase {
    static constexpr bool PERM = true;
    const float* L; h16* st;
    __device__ __forceinline__ void snap(const pg::Acc& acc, const pg::Unit& u, int j, int wr, int wc, int fr, int fq) const { EPI_OPAQUE();
        const int seg = (u.e >> 1) & 7, bh = u.e >> 4; h16* dst = st + ((size_t)(bh * 32 + seg * 4 + j) * 512 + u.pm * 256) * 256;
#pragma unroll
        for (int ai = 0; ai < 2; ++ai)
#pragma unroll
            for (int m = 0; m < 4; ++m) { const int r = ai * 128 + wr * 64 + m * 16 + fr;
#pragma unroll
                for (int bj = 0; bj < 2; ++bj) { const int c0 = bj * 128 + wc * 32 + 8 * fq; const f32x4 a = acc[ai][bj][m][0], b = acc[ai][bj][m][1];
                    v4u w; w.x = pkh(a[0], a[1]); w.y = pkh(a[2], a[3]); w.z = pkh(b[0], b[1]); w.w = pkh(b[2], b[3]);
                    *(v4u*)(dst + (size_t)r * 256 + c0) = w; } }
    }
    __device__ __forceinline__ void load(pg::Acc& acc, const pg::Unit& u, int wr, int wc, int fr, int fq) const { EPI_OPAQUE();
        const float* src = L + ((size_t)(u.e >> 1) * 512 + u.pm * 256) * 256;
#pragma unroll
        for (int ai = 0; ai < 2; ++ai)
#pragma unroll
            for (int m = 0; m < 4; ++m) { const int r = ai * 128 + wr * 64 + m * 16 + fr;
#pragma unroll
                for (int bj = 0; bj < 2; ++bj) { const int c0 = bj * 128 + wc * 32 + 8 * fq;
                    acc[ai][bj][m][0] = *(const f32x4*)(src + (size_t)r * 256 + c0); acc[ai][bj][m][1] = *(const f32x4*)(src + (size_t)r * 256 + c0 + 4); } }
    }
    __device__ __forceinline__ void init(pg::Acc& acc, const pg::Unit& u, int wr, int wc, int fr, int fq) const { EPI_OPAQUE(); load(acc, u, wr, wc, fr, fq); snap(acc, u, 0, wr, wc, fr, fq); acc_scale(acc, __builtin_amdgcn_exp2f(256.0f * lg2gamma(u.x))); }
    __device__ __forceinline__ void operator()(pg::Acc& acc, const pg::Unit& u, int wr, int wc, int fr, int fq) const { EPI_OPAQUE(); snap(acc, u, u.pn + 1, wr, wc, fr, fq); }
    __device__ __forceinline__ void reinit(pg::Acc& acc, const pg::Unit& cur, const pg::Unit& nxt, int wr, int wc, int fr, int fq) const { EPI_OPAQUE();
        if (nxt.e != cur.e) { load(acc, nxt, wr, wc, fr, fq); snap(acc, nxt, 0, wr, wc, fr, fq); }
        acc_scale(acc, __builtin_amdgcn_exp2f(256.0f * lg2gamma(nxt.x))); }
};
__device__ __forceinline__ void ph_carry(float* L, Frame& F) {
    const size_t n = (size_t)16 * 131072;
    int tid_o = F.tid; asm volatile("" : "+v"(tid_o));
    for (size_t i = ((size_t)blockIdx.x * 512 + tid_o) * 4; i < n; i += (size_t)F.G * 512 * 4) {
        const int bh = (int)(i >> 17); const size_t el = i & 131071; const float g = __builtin_amdgcn_exp2f(1024.0f * lg2gamma(bh & 3));
        f32x4 s = {0.f, 0.f, 0.f, 0.f}, l[8];
#pragma unroll
        for (int sgm = 0; sgm < 8; ++sgm) l[sgm] = *(const GAS f32x4*)(L + ((size_t)(bh * 8 + sgm) << 17) + el);
#pragma unroll
        for (int sgm = 0; sgm < 8; ++sgm) { *(GAS f32x4*)(L + ((size_t)(bh * 8 + sgm) << 17) + el) = s; s = s * g + l[sgm]; }
    }
}
struct R2Sched {
    const h16 *pp, *vt, *q, *st; int G, c;
    __device__ __forceinline__ bool next(int i, pg::Unit& u) const {
        const int ch = (i >> 2) * G + c, pn = (i >> 1) & 1, x = i & 1; if (ch >= 512) return false;
        const int cch = ch & 31, bh = ch >> 5, b = bh >> 2, h = bh & 3; const size_t tok0 = (size_t)b * 8192 + cch * 256;
        if (x == 0) { u.a = (const char*)pp + (size_t)ch * 65536 * 2; u.b = (const char*)vt + (((tok0 >> 8) * 2048 + h * 512 + pn * 256) * 256) * 2; }
        else { u.a = (const char*)q + (tok0 * 1024 + h * 256) * 2; u.b = (const char*)st + ((size_t)ch * 512 + pn * 256) * 256 * 2; }
        u.pm = ch; u.pn = pn; u.e = (int)tok0; u.x = x; return true; }
    __device__ __forceinline__ unsigned arow(const pg::Unit&, int) const { return 0u; }
};
struct EpiRetOut : pg::EpiBase {
    static constexpr bool PERM = true;
    h16* __restrict__ o; const h16* __restrict__ sg; h16* __restrict__ og;
    __device__ __forceinline__ void operator()(const pg::Acc& acc, const pg::Unit& u, int wr, int wc, int fr, int fq) const { EPI_OPAQUE();
        if (u.x == 0) return;
        const int h = (u.pm >> 5) & 3; const float lg = lg2gamma(h);
#pragma unroll
        for (int ai = 0; ai < 2; ++ai)
#pragma unroll
            for (int m = 0; m < 4; ++m) { const int i = ai * 128 + wr * 64 + m * 16 + fr; const float qd = __builtin_amdgcn_exp2f((float)(i + 1) * lg);
                h16* dst = o + (size_t)(u.e + i) * 2048 + h * 512 + u.pn * 256;
#pragma unroll
                for (int bj = 0; bj < 2; ++bj) { const int c0 = bj * 128 + wc * 32 + 8 * fq; const f32x4 a = acc[ai][bj][m][0] * qd, b = acc[ai][bj][m][1] * qd;
                    v4u w; w.x = pkh(a[0], a[1]); w.y = pkh(a[2], a[3]); w.z = pkh(b[0], b[1]); w.w = pkh(b[2], b[3]);
                    *(v4u*)(dst + c0) = w; } }
        if (u.pn == 0) return;
        asm volatile("s_waitcnt vmcnt(0)" ::: "memory");
        __builtin_amdgcn_s_barrier(); asm volatile("" ::: "memory");
        const int wid = __builtin_amdgcn_readfirstlane((int)threadIdx.x >> 6), lane = (fq << 4) | fr;
#pragma unroll 1
        for (int r0 = 0; r0 < 32; r0 += 8) {
            v4u ow[8], gv[8];
#pragma unroll
            for (int q = 0; q < 8; ++q) { const size_t off = (size_t)(u.e + 32 * wid + r0 + q) * 2048 + h * 512 + 8 * lane; ow[q] = *(const GAS v4u*)(o + off); gv[q] = *(const GAS v4u*)(sg + off); }
#pragma unroll
            for (int q = 0; q < 8; ++q) { const size_t off = (size_t)(u.e + 32 * wid + r0 + q) * 2048 + h * 512 + 8 * lane; const v4u o4 = ow[q], g4 = gv[q];
                float v[8] = {h2f(o4.x & 0xffff), h2f(o4.x >> 16), h2f(o4.y & 0xffff), h2f(o4.y >> 16), h2f(o4.z & 0xffff), h2f(o4.z >> 16), h2f(o4.w & 0xffff), h2f(o4.w >> 16)};
                const float g[8] = {h2f(g4.x & 0xffff), h2f(g4.x >> 16), h2f(g4.y & 0xffff), h2f(g4.y >> 16), h2f(g4.z & 0xffff), h2f(g4.z >> 16), h2f(g4.w & 0xffff), h2f(g4.w >> 16)};
                float s = 0.f;
#pragma unroll
                for (int j = 0; j < 8; ++j) s += v[j];
                const float mean = wave_sum(s) * (1.0f / 512.0f); float qq = 0.f;
#pragma unroll
                for (int j = 0; j < 8; ++j) { v[j] -= mean; qq += v[j] * v[j]; }
                const float rstd = 1.0f / sqrtf(wave_sum(qq) * (1.0f / 512.0f) + 1e-6f);
                v4u w; w.x = pkh(g[0] * v[0] * rstd, g[1] * v[1] * rstd); w.y = pkh(g[2] * v[2] * rstd, g[3] * v[3] * rstd); w.z = pkh(g[4] * v[4] * rstd, g[5] * v[5] * rstd); w.w = pkh(g[6] * v[6] * rstd, g[7] * v[7] * rstd);
                *(GAS v4u*)(og + off) = w; }
        }
    }
    __device__ __forceinline__ void reinit(pg::Acc& acc, const pg::Unit&, const pg::Unit& nxt, int, int, int, int) const { if (nxt.x == 0) pg::acc_zero(acc); }
};
__device__ __forceinline__ void ph_gn_gate(const Params& p, Frame& F) {
    const int gw = F.vcu * NWAVES + F.wave, NGW = F.G * NWAVES, lane = F.lane;
    for (int it0 = gw * 4; it0 < T_ * 4; it0 += NGW * 4) {
        v4u ow[4], gv[4];
#pragma unroll
        for (int u = 0; u < 4; ++u) { const size_t off = (size_t)(it0 + u) * 512 + 8 * lane; ow[u] = *(const GAS v4u*)(p.o + off); gv[u] = *(const GAS v4u*)(p.sg + off); }
#pragma unroll
        for (int u = 0; u < 4; ++u) { const size_t off = (size_t)(it0 + u) * 512 + 8 * lane; const v4u o4 = ow[u], g4 = gv[u];
            float v[8] = {h2f(o4.x & 0xffff), h2f(o4.x >> 16), h2f(o4.y & 0xffff), h2f(o4.y >> 16), h2f(o4.z & 0xffff), h2f(o4.z >> 16), h2f(o4.w & 0xffff), h2f(o4.w >> 16)};
            const float g[8] = {h2f(g4.x & 0xffff), h2f(g4.x >> 16), h2f(g4.y & 0xffff), h2f(g4.y >> 16), h2f(g4.z & 0xffff), h2f(g4.z >> 16), h2f(g4.w & 0xffff), h2f(g4.w >> 16)};
            float s = 0.f;
#pragma unroll
            for (int j = 0; j < 8; ++j) s += v[j];
            const float mean = wave_sum(s) * (1.0f / 512.0f); float q = 0.f;
#pragma unroll
            for (int j = 0; j < 8; ++j) { v[j] -= mean; q += v[j] * v[j]; }
            const float rstd = 1.0f / sqrtf(wave_sum(q) * (1.0f / 512.0f) + 1e-6f);
            v4u w; w.x = pkh(g[0] * v[0] * rstd, g[1] * v[1] * rstd); w.y = pkh(g[2] * v[2] * rstd, g[3] * v[3] * rstd); w.z = pkh(g[4] * v[4] * rstd, g[5] * v[5] * rstd); w.w = pkh(g[6] * v[6] * rstd, g[7] * v[7] * rstd);
            *(GAS v4u*)(p.og + off) = w; }
    }
}
constexpr float SWA_C2 = 0.125f * 1.4426950408889634f;
struct EpiSwaTok : pg::EpiBase {
    static constexpr bool PERM = true;
    h16 *sq, *skv; const float* bias;
    __device__ __forceinline__ void operator()(const pg::Acc& acc, const pg::Unit& u, int wr, int wc, int fr, int fq) const { EPI_OPAQUE();
        const bool isq = u.pn < 4; h16* dst = isq ? sq : skv; const int ld = isq ? 1024 : 256, cb = isq ? u.pn * 256 : 0; const float sc = isq ? SWA_C2 : 1.0f;
#pragma unroll
        for (int bj = 0; bj < 2; ++bj) { const int ct = bj * 128 + wc * 32 + 8 * fq; const float* bp = bias + u.pn * 256 + ct;
            const f32x4 b0 = *(const f32x4*)bp, b1 = *(const f32x4*)(bp + 4);
#pragma unroll
            for (int ai = 0; ai < 2; ++ai)
#pragma unroll
                for (int m = 0; m < 4; ++m) { const size_t row = (size_t)u.pm * 256 + ai * 128 + wr * 64 + m * 16 + fr;
                    const f32x4 a = (acc[ai][bj][m][0] + b0) * sc, b = (acc[ai][bj][m][1] + b1) * sc;
                    v4u w; w.x = pkh(a[0], a[1]); w.y = pkh(a[2], a[3]); w.z = pkh(b[0], b[1]); w.w = pkh(b[2], b[3]);
                    *(v4u*)(dst + row * ld + cb + ct) = w; } }
    }
};
struct EpiSwaFeat : pg::EpiBase {
    static constexpr bool PERM = true;
    h16* __restrict__ kvt; const float* __restrict__ bias;
    __device__ __forceinline__ void operator()(const pg::Acc& acc, const pg::Unit& u, int wr, int wc, int fr, int fq) const { EPI_OPAQUE();
        float bv[2][4];
#pragma unroll
        for (int ai = 0; ai < 2; ++ai)
#pragma unroll
            for (int m = 0; m < 4; ++m) bv[ai][m] = bias[1024 + ai * 128 + wr * 64 + m * 16 + fr];
#pragma unroll
        for (int ai = 0; ai < 2; ++ai)
#pragma unroll
            for (int m = 0; m < 4; ++m) { const int r = ai * 128 + wr * 64 + m * 16 + fr;
#pragma unroll
                for (int bj = 0; bj < 2; ++bj) { const int ct = bj * 128 + wc * 32 + 8 * fq; const f32x4 a = acc[ai][bj][m][0] + bv[ai][m], b = acc[ai][bj][m][1] + bv[ai][m];
                    v4u w; w.x = pkh(a[0], a[1]); w.y = pkh(a[2], a[3]); w.z = pkh(b[0], b[1]); w.w = pkh(b[2], b[3]);
                    *(v4u*)(kvt + (size_t)r * T_ + (size_t)u.pn * 256 + ct) = w; } }
    }
};
typedef float f32x16 __attribute__((ext_vector_type(16)));
typedef _Float16 f16x8v __attribute__((ext_vector_type(8)));
typedef _Float16 f16x4v __attribute__((ext_vector_type(4)));
constexpr int KP = 144, VP = 520;
__device__ __forceinline__ void ph_swa_attn(const Params& p, Frame& F) {
    LAS unsigned char* Ks = F.lds; LAS unsigned char* Vs = F.lds + 256 * KP;
    const int lane = F.lane, w = F.wave, l31 = lane & 31, hh = lane >> 5;
    for (int unit = F.vcu; unit < 512; unit += F.G) {
        const int g = unit & 1, n = (unit >> 1) & 63, b = unit >> 7; const size_t tok0 = (size_t)b * SEQ_ + (size_t)n * 128;
        __syncthreads();
        for (int c = F.tid; c < 256 * 8; c += 512) { const int key = c >> 3, ch = c & 7; v4u val = {0u, 0u, 0u, 0u};
            if (n > 0 || key >= 128) val = *(const GAS v4u*)(p.skv + (tok0 - 128 + key) * 256 + g * 64 + ch * 8);
            *(LAS v4u*)(Ks + key * KP + ch * 16) = val; }
        for (int c = F.tid; c < 64 * 32; c += 512) { const int d = c >> 5, ch = c & 31; v4u val = {0u, 0u, 0u, 0u};
            if (n > 0 || ch >= 16) val = *(const GAS v4u*)(p.kvt + (size_t)(128 + g * 64 + d) * T_ + tok0 - 128 + ch * 8);
            v2u lo2; lo2.x = val.x; lo2.y = val.y; v2u hi2; hi2.x = val.z; hi2.y = val.w;
            *(LAS v2u*)(Vs + d * VP + ch * 16) = lo2; *(LAS v2u*)(Vs + d * VP + ch * 16 + 8) = hi2; }
        __syncthreads();
        const int hq = g * 8 + w; const float slope = __builtin_amdgcn_exp2f(-0.5f * (float)(hq + 1)) * 1.4426950408889634f, sink = p.sinks[hq] * 1.4426950408889634f;
#pragma nounroll
        for (int qi = 0; qi < 4; ++qi) {
            f16x8v qf[4];
            const h16* qrow = p.sq + (tok0 + qi * 32 + l31) * 1024 + hq * 64 + 8 * hh;
#pragma unroll
            for (int s = 0; s < 4; ++s) qf[s] = *(const GAS f16x8v*)(qrow + 16 * s);
            f32x16 sc[5];
#pragma unroll
            for (int t = 0; t < 5; ++t) {
                sc[t] = (f32x16){0.f, 0.f, 0.f, 0.f, 0.f, 0.f, 0.f, 0.f, 0.f, 0.f, 0.f, 0.f, 0.f, 0.f, 0.f, 0.f};
                const LAS unsigned char* kp = Ks + ((qi + t) * 32 + l31) * KP + 16 * hh;
#pragma unroll
                for (int s = 0; s < 4; ++s) { const f16x8v kf = *(const LAS f16x8v*)(kp + 32 * s); sc[t] = __builtin_amdgcn_mfma_f32_32x32x16_f16(kf, qf[s], sc[t], 0, 0, 0); }
            }
            float mx = sink;
            float basef = (float)(l31 + 128 - 4 * hh); asm volatile("" : "+v"(basef));
#pragma unroll
            for (int t = 0; t < 5; ++t) { const bool tile_ok = (n > 0) || (qi + t >= 4);
#pragma unroll
                for (int r = 0; r < 16; ++r) { const float distf = basef - (float)(32 * t + (r & 3) + 8 * (r >> 2));
                    bool ok = tile_ok; if (t == 0) ok = ok && (distf < 128.0f); if (t == 4) ok = ok && (distf >= 0.0f);
                    const float v = ok ? sc[t][r] - slope * distf : -INFINITY; sc[t][r] = v; mx = fmaxf(mx, v); } }
            mx = fmaxf(mx, __shfl_xor(mx, 32));
            float ls = 0.f; f16x8v pf[5][2];
#pragma unroll
            for (int t = 0; t < 5; ++t)
#pragma unroll
                for (int s2 = 0; s2 < 2; ++s2) { float e[8];
#pragma unroll
                    for (int j = 0; j < 8; ++j) { e[j] = __builtin_amdgcn_exp2f(sc[t][8 * s2 + j] - mx); ls += e[j]; }
                    v4u pw; pw.x = pkh(e[0], e[1]); pw.y = pkh(e[2], e[3]); pw.z = pkh(e[4], e[5]); pw.w = pkh(e[6], e[7]); pf[t][s2] = __builtin_bit_cast(f16x8v, pw); }
            ls += __shfl_xor(ls, 32); ls += __builtin_amdgcn_exp2f(sink - mx);
            const float rl = 1.0f / ls;
            f32x16 oa[2];
#pragma unroll
            for (int dt = 0; dt < 2; ++dt) { oa[dt] = (f32x16){0.f, 0.f, 0.f, 0.f, 0.f, 0.f, 0.f, 0.f, 0.f, 0.f, 0.f, 0.f, 0.f, 0.f, 0.f, 0.f};
                const LAS unsigned char* vp = Vs + (32 * dt + l31) * VP + (qi * 32 + 4 * hh) * 2;
#pragma unroll
                for (int t = 0; t < 5; ++t)
#pragma unroll
                    for (int s2 = 0; s2 < 2; ++s2) { const f16x4v v0 = *(const LAS f16x4v*)(vp + (t * 32 + s2 * 16) * 2), v1 = *(const LAS f16x4v*)(vp + (t * 32 + s2 * 16 + 8) * 2);
                        const f16x8v vf = __builtin_shufflevector(v0, v1, 0, 1, 2, 3, 4, 5, 6, 7);
                        oa[dt] = __builtin_amdgcn_mfma_f32_32x32x16_f16(vf, pf[t][s2], oa[dt], 0, 0, 0); } }
            h16* orow = p.so + (tok0 + qi * 32 + l31) * 1024 + hq * 64 + 4 * hh;
#pragma unroll
            for (int dt = 0; dt < 2; ++dt)
#pragma unroll
                for (int gq = 0; gq < 4; ++gq) { v2u ow; ow.x = pkh(oa[dt][4 * gq] * rl, oa[dt][4 * gq + 1] * rl); ow.y = pkh(oa[dt][4 * gq + 2] * rl, oa[dt][4 * gq + 3] * rl);
                    *(GAS v2u*)(orow + 32 * dt + 8 * gq) = ow; }
        }
    }
}

struct EpiNull : pg::EpiBase {
    static constexpr bool PERM = true;
    __device__ __forceinline__ void operator()(const pg::Acc& acc, const pg::Unit& u, int wr, int wc, int fr, int fq) const { asm volatile("" :: "v"(acc[0][0][0][0][0]), "v"(acc[1][1][3][1][3])); }
};

struct EpiSwigluQ : pg::EpiBase {
    static constexpr bool PERM = true;
    unsigned char* __restrict__ actq; const float* __restrict__ b1;
    typedef _Float16 h2 __attribute__((ext_vector_type(2)));
    typedef short s2 __attribute__((ext_vector_type(2)));
    __device__ __forceinline__ h2 act2(f32x2v g32, f32x2v l32) const {
        h2 g = __builtin_convertvector(g32, h2), l = __builtin_convertvector(l32, h2);
        g = __builtin_elementwise_min(g, (h2){7.0f16, 7.0f16});
        l = __builtin_elementwise_max(__builtin_elementwise_min(l, (h2){7.0f16, 7.0f16}), (h2){-7.0f16, -7.0f16});
        const h2 e = __builtin_elementwise_exp2(g * (h2){-2.4554f16, -2.4554f16});
        const h2 d = e + (h2){1.0f16, 1.0f16};
        const h2 r = {(_Float16)__builtin_amdgcn_rcph(d.x), (_Float16)__builtin_amdgcn_rcph(d.y)};
        return (g * r) * (l * (h2){4.0f16, 4.0f16} + (h2){4.0f16, 4.0f16});
    }
    __device__ __forceinline__ void operator()(const pg::Acc& acc, const pg::Unit& u, int wr, int wc, int fr, int fq) const { EPI_OPAQUE();
        const int c0 = u.pn * 128 + wc * 32 + 8 * fq;
        const float* bg = b1 + (size_t)u.e * 2048 + c0; const float* bl = bg + 1024;
        const f32x4 g0 = *(const f32x4*)bg, g1 = *(const f32x4*)(bg + 4), l0 = *(const f32x4*)bl, l1 = *(const f32x4*)(bl + 4);
#pragma unroll
        for (int ai = 0; ai < 2; ++ai)
#pragma unroll
            for (int m = 0; m < 4; ++m) {
                const size_t row = (size_t)u.pm * 256 + ai * 128 + wr * 64 + m * 16 + fr;
                const f32x4 ga = acc[ai][0][m][0] * 0.03125f + g0, gb = acc[ai][0][m][1] * 0.03125f + g1, la = acc[ai][1][m][0] * 0.03125f + l0, lb = acc[ai][1][m][1] * 0.03125f + l1;
                s2 lo = {0, 0}, hi = {0, 0};
                lo = __builtin_amdgcn_cvt_scalef32_pk_fp8_f16(lo, act2((f32x2v){ga.x, ga.y}, (f32x2v){la.x, la.y}), 1.0f, false);
                lo = __builtin_amdgcn_cvt_scalef32_pk_fp8_f16(lo, act2((f32x2v){ga.z, ga.w}, (f32x2v){la.z, la.w}), 1.0f, true);
                hi = __builtin_amdgcn_cvt_scalef32_pk_fp8_f16(hi, act2((f32x2v){gb.x, gb.y}, (f32x2v){lb.x, lb.y}), 1.0f, false);
                hi = __builtin_amdgcn_cvt_scalef32_pk_fp8_f16(hi, act2((f32x2v){gb.z, gb.w}, (f32x2v){lb.z, lb.w}), 1.0f, true);
                v2u w; w.x = __builtin_bit_cast(unsigned, lo); w.y = __builtin_bit_cast(unsigned, hi);
                *(v2u*)(actq + row * 1024 + c0) = w;
            }
    }
};
template <int VAR> struct EpiSwigluQP : pg::EpiBase {
    static constexpr bool PERM = true;
    unsigned char* __restrict__ actq; const float* __restrict__ b1;
    typedef _Float16 h2 __attribute__((ext_vector_type(2)));
    typedef short s2 __attribute__((ext_vector_type(2)));
    __device__ __forceinline__ h2 act2(f32x2v g32, f32x2v l32) const {
        h2 g = __builtin_convertvector(g32, h2), l = __builtin_convertvector(l32, h2);
        g = __builtin_elementwise_min(g, (h2){7.0f16, 7.0f16});
        l = __builtin_elementwise_max(__builtin_elementwise_min(l, (h2){7.0f16, 7.0f16}), (h2){-7.0f16, -7.0f16});
        const h2 e = __builtin_elementwise_exp2(g * (h2){-2.4554f16, -2.4554f16});
        const h2 d = e + (h2){1.0f16, 1.0f16};
        const h2 r = {(_Float16)__builtin_amdgcn_rcph(d.x), (_Float16)__builtin_amdgcn_rcph(d.y)};
        return (g * r) * (l * (h2){4.0f16, 4.0f16} + (h2){4.0f16, 4.0f16});
    }
    __device__ __forceinline__ void operator()(const pg::Acc& acc, const pg::Unit& u, int wr, int wc, int fr, int fq) const { EPI_OPAQUE();
        const int c0 = u.pn * 128 + wc * 32 + 8 * fq;
        const float* bg = b1 + (size_t)u.e * 2048 + c0; const float* bl = bg + 1024;
        const f32x4 g0 = *(const f32x4*)bg, g1 = *(const f32x4*)(bg + 4), l0 = *(const f32x4*)bl, l1 = *(const f32x4*)(bl + 4);
        if (VAR == 1) { asm volatile("" :: "v"(g0), "v"(g1), "v"(l0), "v"(l1));
#pragma unroll
            for (int ai = 0; ai < 2; ++ai)
#pragma unroll
                for (int bj = 0; bj < 2; ++bj)
#pragma unroll
                    for (int m = 0; m < 4; ++m) asm volatile("" :: "v"(acc[ai][bj][m][0]), "v"(acc[ai][bj][m][1]));
            return; }
#pragma unroll
        for (int ai = 0; ai < 2; ++ai)
#pragma unroll
            for (int m = 0; m < 4; ++m) {
                const size_t row = (size_t)u.pm * 256 + ai * 128 + wr * 64 + m * 16 + fr;
                const f32x4 ga = acc[ai][0][m][0] * 0.03125f + g0, gb = acc[ai][0][m][1] * 0.03125f + g1, la = acc[ai][1][m][0] * 0.03125f + l0, lb = acc[ai][1][m][1] * 0.03125f + l1;
                s2 lo = {0, 0}, hi = {0, 0};
                lo = __builtin_amdgcn_cvt_scalef32_pk_fp8_f16(lo, act2((f32x2v){ga.x, ga.y}, (f32x2v){la.x, la.y}), 1.0f, false);
                lo = __builtin_amdgcn_cvt_scalef32_pk_fp8_f16(lo, act2((f32x2v){ga.z, ga.w}, (f32x2v){la.z, la.w}), 1.0f, true);
                hi = __builtin_amdgcn_cvt_scalef32_pk_fp8_f16(hi, act2((f32x2v){gb.x, gb.y}, (f32x2v){lb.x, lb.y}), 1.0f, false);
                hi = __builtin_amdgcn_cvt_scalef32_pk_fp8_f16(hi, act2((f32x2v){gb.z, gb.w}, (f32x2v){lb.z, lb.w}), 1.0f, true);
                v2u w; w.x = __builtin_bit_cast(unsigned, lo); w.y = __builtin_bit_cast(unsigned, hi);
                if (VAR == 2) asm volatile("" :: "v"(w.x), "v"(w.y)); else *(v2u*)(actq + row * 1024 + c0) = w;
            }
    }
};
template <bool Y8> struct EpiMoeOutQ : pg::EpiBase {
    static constexpr bool PERM = true;
    unsigned char* __restrict__ y8; const float* __restrict__ b2; const float* __restrict__ gate;
    __device__ __forceinline__ void operator()(const pg::Acc& acc, const pg::Unit& u, int wr, int wc, int fr, int fq) const { EPI_OPAQUE();
        float gt[2][4]; f32x4 bv[2][2];
#pragma unroll
        for (int ai = 0; ai < 2; ++ai)
#pragma unroll
            for (int m = 0; m < 4; ++m) gt[ai][m] = gate[(size_t)u.pm * 256 + ai * 128 + wr * 64 + m * 16 + fr];
#pragma unroll
        for (int bj = 0; bj < 2; ++bj) { const float* bp = b2 + (size_t)u.e * 1024 + u.pn * 256 + bj * 128 + wc * 32 + 8 * fq; bv[bj][0] = *(const f32x4*)bp; bv[bj][1] = *(const f32x4*)(bp + 4); }
#pragma unroll
        for (int ai = 0; ai < 2; ++ai)
#pragma unroll
            for (int m = 0; m < 4; ++m) {
                const size_t row = (size_t)u.pm * 256 + ai * 128 + wr * 64 + m * 16 + fr;
#pragma unroll
                for (int bj = 0; bj < 2; ++bj) {
                    const int c0 = u.pn * 256 + bj * 128 + wc * 32 + 8 * fq;
                    const float gs = gt[ai][m] * (Y8 ? 32.0f : 1.0f);
                    const f32x4 v0 = (acc[ai][bj][m][0] * 0.0078125f + bv[bj][0]) * gs, v1 = (acc[ai][bj][m][1] * 0.0078125f + bv[bj][1]) * gs;
                    if (Y8) { int lo = 0, hi = 0;
                        lo = __builtin_amdgcn_cvt_pk_fp8_f32(v0[0], v0[1], lo, false); lo = __builtin_amdgcn_cvt_pk_fp8_f32(v0[2], v0[3], lo, true);
                        hi = __builtin_amdgcn_cvt_pk_fp8_f32(v1[0], v1[1], hi, false); hi = __builtin_amdgcn_cvt_pk_fp8_f32(v1[2], v1[3], hi, true);
                        v2u w; w.x = (unsigned)lo; w.y = (unsigned)hi; *(v2u*)(y8 + row * 1024 + c0) = w; }
                    else { v4u w; w.x = pkh(v0[0], v0[1]); w.y = pkh(v0[2], v0[3]); w.z = pkh(v1[0], v1[1]); w.w = pkh(v1[2], v1[3]); *(v4u*)((h16*)y8 + row * 1024 + c0) = w; }
                }
            }
    }
};

struct MoeSchedHot : MoeSched {
    __device__ __forceinline__ bool next(int i, pg::Unit& u) const { const bool ok = MoeSched::next(i, u); if (ok) { u.a = abase; u.b = wbase; } return ok; }
    __device__ __forceinline__ unsigned arow(const pg::Unit&, int r) const { return (unsigned)r; }
};

struct EpiKeep : pg::EpiBase {
    static constexpr bool PERM = true;
    __device__ __forceinline__ void operator()(const pg::Acc& acc, const pg::Unit& u, int wr, int wc, int fr, int fq) const {
#pragma unroll
        for (int ai = 0; ai < 2; ++ai)
#pragma unroll
            for (int bj = 0; bj < 2; ++bj)
#pragma unroll
                for (int m = 0; m < 4; ++m) asm volatile("" :: "v"(acc[ai][bj][m][0]), "v"(acc[ai][bj][m][1]));
    }
};
#ifndef PROBE_DBL
#define PROBE_DBL 0
#endif
#ifndef SKEW_STEP
#define SKEW_STEP 0
#endif
#define SKEW(F) (((F).vcu & 3) * SKEW_STEP)
#define DBL(bit, body) do { body; if ((PROBE_DBL >> (bit)) & 1) { GRID_BAR(); body; } } while (0)
template <int layer>
__device__ __forceinline__ void layer_tail(const Params& p, Frame& F, const XcdBarrier& bar) {
#define GRID_BAR() xcd_barrier(bar)
    {
        if (layer == 0) { DenseSched S; S.init(p.og, 2048, p.wro_t, 2048, T_, 1024, F.G, (int)blockIdx.x); EpiResid E; E.yh = p.yh; E.xprevh = p.xh0; E.bias = nullptr;
            pg::gemm_phase<EpiResid, DenseSched, 0, true>(F.lds + RING_OFF, 2048, 2048, 32, S, E); }
        else { DenseSched S; S.init(p.so, 1024, p.wso_t, 1024, T_, 1024, F.G, (int)blockIdx.x); EpiResid E; E.yh = p.yh; E.xprevh = p.x2h; E.bias = p.b_swa_out;
            pg::gemm_phase<EpiResid, DenseSched, 0, true>(F.lds + RING_OFF, 1024, 1024, 16, S, E); }
    }
    GRID_BAR();
    DBL(1, ph_ln_router(p, F, p.ln_mix_g + layer * 1024, p.ln_mix_b + layer * 1024, p.w_router + layer * 1024 * 32, p.b_router + layer * 32, (layer == 1 || MOE_F8_L0) ? p.x1q : (unsigned char*)nullptr));
#if (PROBE_DBL >> 19) & 1
    GRID_BAR();
    ph_ln_router(p, F, p.ln_mix_g + layer * 1024, p.ln_mix_b + layer * 1024, p.w_router + layer * 1024 * 32, p.b_router + layer * 32, layer == 1 ? p.x1q : (unsigned char*)nullptr, (PROBE_DBL >> 19) & 1);
#endif
    GRID_BAR();
    DBL(5, ph_assign(p, F, layer));
    GRID_BAR();
    {
        const int ntiles = (int)__hip_atomic_load(F.ctl + CW_NTILES + 64 * layer, RLX_AGENT);
        moe_tables(F, p.tile_e, p.slot_tok, ntiles, 3, true);
        if (layer == 0 && !MOE_F8_L0) {
            MoeSched S{(const char*)p.x1h, (const char*)p.w1_t, (LAS const int*)(F.lds + TAB_OFF), (LAS const int*)(F.lds + TAB_OFF) + 32, ntiles, 3, F.G, F.vcu, 0, (size_t)2048 * 1024 * 2, (size_t)256 * 1024 * 2};
            EpiSwiglu E; E.act = p.act; E.b1 = p.b_exp_in;
            pg::gemm_phase<EpiSwiglu, MoeSched, 1, true>(F.lds + RING_OFF, 1024, 1024, 16, S, E);
        } else {
            MoeSched S{(const char*)p.x1q, (const char*)(p.w1q + (size_t)layer * 32 * 2048 * 1024), (LAS const int*)(F.lds + TAB_OFF), (LAS const int*)(F.lds + TAB_OFF) + 32, ntiles, 3, F.G, F.vcu, 0, (size_t)2048 * 1024, (size_t)256 * 1024};
            EpiSwigluQ E; E.actq = p.actq; E.b1 = p.b_exp_in + (size_t)layer * 32 * 2048;
            pg::gemm_phase<EpiSwigluQ, MoeSched, 1, true, 1>(F.lds + RING_OFF, 1024, 1024, 8, S, E, 0, 0, SKEW(F));
        }
    }
    GRID_BAR();
#if (PROBE_DBL >> 21) & 3
    GRID_BAR();
    if (layer == 0) {
        const int ntiles = (int)__hip_atomic_load(F.ctl + CW_NTILES + 64 * layer, RLX_AGENT);
        moe_tables(F, p.tile_e, p.slot_tok, ntiles, 3, true);
        EpiSwigluP<1> E; E.act = p.yy; E.b1 = p.b_exp_in;
        if ((PROBE_DBL >> 22) & 1) { MoeSchedHot S{{((PROBE_DBL >> 23) & 1) ? (const char*)p.ctl : (const char*)p.x1h, ((PROBE_DBL >> 23) & 1) ? (const char*)p.ctl + 524288 : (const char*)p.w1_t, (LAS const int*)(F.lds + TAB_OFF), (LAS const int*)(F.lds + TAB_OFF) + 32, ntiles, 3, F.G, F.vcu, 0, (size_t)2048 * 1024 * 2, (size_t)256 * 1024 * 2}};
            pg::gemm_phase<EpiSwigluP<1>, MoeSchedHot, 1, true, 2, ((PROBE_DBL >> 24) & 1) != 0>(F.lds + RING_OFF, 1024, 1024, 16, S, E); }
        else { MoeSched S{(const char*)p.x1h, (const char*)p.w1_t, (LAS const int*)(F.lds + TAB_OFF), (LAS const int*)(F.lds + TAB_OFF) + 32, ntiles, 3, F.G, F.vcu, 0, (size_t)2048 * 1024 * 2, (size_t)256 * 1024 * 2};
            pg::gemm_phase<EpiSwigluP<1>, MoeSched, 1, true, 2, ((PROBE_DBL >> 24) & 1) != 0>(F.lds + RING_OFF, 1024, 1024, 16, S, E); }
    }
#endif
#if (PROBE_DBL >> 29) & 3
    GRID_BAR();
    {
        const int ntiles = (int)__hip_atomic_load(F.ctl + CW_NTILES + 64 * layer, RLX_AGENT);
        moe_tables(F, p.tile_e, p.slot_tok, ntiles, 3, true);
        MoeSched S{(const char*)p.x1q, (const char*)(p.w1q + (size_t)layer * 32 * 2048 * 1024), (LAS const int*)(F.lds + TAB_OFF), (LAS const int*)(F.lds + TAB_OFF) + 32, ntiles, 3, F.G, F.vcu, 0, (size_t)2048 * 1024, (size_t)256 * 1024};
        EpiSwigluQP<((PROBE_DBL >> 29) & 3)> E; E.actq = p.actq; E.b1 = p.b_exp_in + (size_t)layer * 32 * 2048;
        pg::gemm_phase<EpiSwigluQP<((PROBE_DBL >> 29) & 3)>, MoeSched, 1, true, 1>(F.lds + RING_OFF, 1024, 1024, 8, S, E);
    }
#endif
#if (PROBE_DBL >> 25) & 1
    GRID_BAR();
    {
        const int ntiles = (int)__hip_atomic_load(F.ctl + CW_NTILES + 64 * layer, RLX_AGENT);
        moe_tables(F, p.tile_e, p.slot_tok, ntiles, 3, true);
        MoeSched S{(const char*)p.x1q, (const char*)(p.w1q + (size_t)layer * 32 * 2048 * 1024), (LAS const int*)(F.lds + TAB_OFF), (LAS const int*)(F.lds + TAB_OFF) + 32, ntiles, 3, F.G, F.vcu, 0, (size_t)2048 * 1024, (size_t)256 * 1024};
        EpiKeep E;
        pg::gemm_phase<EpiKeep, MoeSched, 1, true, 1>(F.lds + RING_OFF, 1024, 1024, 8, S, E);
    }
#endif
#if (PROBE_DBL >> 26) & 1
    GRID_BAR();
    {
        const int ntiles = (int)__hip_atomic_load(F.ctl + CW_NTILES + 64 * layer, RLX_AGENT);
        moe_tables(F, p.tile_e, p.slot_tok, ntiles, 3, true);
        MoeSched S{(const char*)p.x1q, (const char*)(p.w1q + (size_t)layer * 32 * 2048 * 1024), (LAS const int*)(F.lds + TAB_OFF), (LAS const int*)(F.lds + TAB_OFF) + 32, ntiles, 3, F.G, F.vcu, 0, (size_t)2048 * 1024, (size_t)256 * 1024};
        EpiSwigluQ E; E.actq = p.actq; E.b1 = p.b_exp_in + (size_t)layer * 32 * 2048;
        pg::gemm_phase<EpiSwigluQ, MoeSched, 1, true, 1>(F.lds + RING_OFF, 1024, 1024, 8, S, E);
    }
#endif
    {
        const int ntiles = (int)__hip_atomic_load(F.ctl + CW_NTILES + 64 * layer, RLX_AGENT);
        moe_tables(F, p.tile_e, p.slot_tok, ntiles, 2, false);
        if (layer == 0 && !MOE_F8_L0) {
            MoeSched S{(const char*)p.act, (const char*)p.w2_t, (LAS const int*)(F.lds + TAB_OFF), (LAS const int*)(F.lds + TAB_OFF) + 32, ntiles, 2, F.G, F.vcu, (size_t)256 * 1024 * 2, (size_t)1024 * 1024 * 2, (size_t)256 * 1024 * 2};
            EpiMoeOut E; E.y = p.yy; E.b2 = p.b_exp_out; E.gate = p.slot_gate;
            pg::gemm_phase<EpiMoeOut, MoeSched, 0, true>(F.lds + RING_OFF, 1024, 1024, 16, S, E);
        } else {
            MoeSched S{(const char*)p.actq, (const char*)(p.w2q + (size_t)layer * 32 * 1024 * 1024), (LAS const int*)(F.lds + TAB_OFF), (LAS const int*)(F.lds + TAB_OFF) + 32, ntiles, 2, F.G, F.vcu, (size_t)256 * 1024, (size_t)1024 * 1024, (size_t)256 * 1024};
            EpiMoeOutQ<layer == 1> E; E.y8 = (unsigned char*)p.yy; E.b2 = p.b_exp_out + (size_t)layer * 32 * 1024; E.gate = p.slot_gate;
            pg::gemm_phase<EpiMoeOutQ<layer == 1>, MoeSched, 0, true, 1>(F.lds + RING_OFF, 1024, 1024, 8, S, E, 0, 0, SKEW(F));
        }
    }
#if (PROBE_DBL >> 27) & 1
    GRID_BAR();
    {
        const int ntiles = (int)__hip_atomic_load(F.ctl + CW_NTILES + 64 * layer, RLX_AGENT);
        moe_tables(F, p.tile_e, p.slot_tok, ntiles, 2, false);
        MoeSched S{(const char*)p.actq, (const char*)(p.w2q + (size_t)layer * 32 * 1024 * 1024), (LAS const int*)(F.lds + TAB_OFF), (LAS const int*)(F.lds + TAB_OFF) + 32, ntiles, 2, F.G, F.vcu, (size_t)256 * 1024, (size_t)1024 * 1024, (size_t)256 * 1024};
        EpiMoeOutQ<layer == 1> E; E.y8 = (unsigned char*)p.yy; E.b2 = p.b_exp_out + (size_t)layer * 32 * 1024; E.gate = p.slot_gate;
        pg::gemm_phase<EpiMoeOutQ<layer == 1>, MoeSched, 0, true, 1>(F.lds + RING_OFF, 1024, 1024, 8, S, E);
    }
#endif
#if (PROBE_DBL >> 28) & 1
    GRID_BAR();
    {
        const int ntiles = (int)__hip_atomic_load(F.ctl + CW_NTILES + 64 * layer, RLX_AGENT);
        moe_tables(F, p.tile_e, p.slot_tok, ntiles, 2, false);
        MoeSched S{(const char*)p.actq, (const char*)(p.w2q + (size_t)layer * 32 * 1024 * 1024), (LAS const int*)(F.lds + TAB_OFF), (LAS const int*)(F.lds + TAB_OFF) + 32, ntiles, 2, F.G, F.vcu, (size_t)256 * 1024, (size_t)1024 * 1024, (size_t)256 * 1024};
        EpiKeep E;
        pg::gemm_phase<EpiKeep, MoeSched, 0, true, 1>(F.lds + RING_OFF, 1024, 1024, 8, S, E);
    }
#endif
    GRID_BAR();
    DBL(2, ph_combine_ln<layer == 1>(p, F, p.x1h, p.ln_ffn_g + layer * 1024, p.ln_ffn_b + layer * 1024, layer == 0 ? (float*)nullptr : p.out, layer == 0 ? p.x2h : (h16*)nullptr));
#undef GRID_BAR
}
__global__ void __launch_bounds__(NWAVES * 64, 2) mk_fwd(Params p) {
    extern __shared__ __attribute__((aligned(16))) unsigned char lds[];
    Frame F;
    F.lds = (LAS unsigned char*)lds;
    F.MISC = (volatile LAS unsigned*)(F.lds + MISC_OFF);
    F.tid = threadIdx.x; F.lane = F.tid & 63; F.wave = __builtin_amdgcn_readfirstlane(F.tid >> 6);
    F.G = gridDim.x; { const int bx = blockIdx.x; F.vcu = (F.G % 8 == 0) ? (bx % 8) * (F.G / 8) + bx / 8 : bx; }
    F.ctl = (gu32*)p.ctl;
    for (int u = F.tid; u < (LDS_BYTES - LDSCTL_OFF) / 4; u += NWAVES * 64) ((LAS unsigned*)(F.lds + LDSCTL_OFF))[u] = 0u;
    __syncthreads();
    XcdBarrier bar = xcd_barrier_post((unsigned*)p.ctl + CW_BAR, F.MISC + 8);
#define GRID_BAR() xcd_barrier(bar)
    DBL(0, ph_prologue(p, F));
    GRID_BAR();
    {
        { DenseSched S; S.init(p.xh0, 1024, p.wri_t, 1024, T_, 4096, F.G, (int)blockIdx.x); EpiInTok E; E.q = p.q; E.k = p.k; E.sg = p.sg;
          pg::gemm_phase<EpiInTok, DenseSched, 0, true>(F.lds + RING_OFF, 1024, 1024, 16, S, E, 0, 0, SKEW(F)); }
        { DenseSched S; S.init(p.wfm_t, 1024, p.xh0, 1024, 2048, T_, F.G, (int)blockIdx.x); EpiInFeat E; E.vt = p.vt;
          pg::gemm_phase<EpiInFeat, DenseSched, 0, true>(F.lds + RING_OFF, 1024, 1024, 16, S, E); }
    }
#if (PROBE_DBL >> 17) & 1
    GRID_BAR();
    { DenseSched S; S.init(p.xh0, 1024, p.wri_t, 1024, T_, 4096, F.G, (int)blockIdx.x); EpiInTok E; E.q = p.q; E.k = p.k; E.sg = p.sg;
      pg::gemm_phase<EpiInTok, DenseSched, 0, true>(F.lds + RING_OFF, 1024, 1024, 16, S, E); }
#endif
#if (PROBE_DBL >> 6) & 1
    GRID_BAR();
    {
        { DenseSched S; S.init(p.xh0, 1024, p.wri_t, 1024, T_, 4096, F.G, (int)blockIdx.x); EpiInTok E; E.q = p.q; E.k = p.k; E.sg = p.sg;
          pg::gemm_phase<EpiInTok, DenseSched, 0, true>(F.lds + RING_OFF, 1024, 1024, 16, S, E); }
        { DenseSched S; S.init(p.wfm_t, 1024, p.xh0, 1024, 2048, T_, F.G, (int)blockIdx.x); EpiInFeat E; E.vt = p.vt;
          pg::gemm_phase<EpiInFeat, DenseSched, 0, true>(F.lds + RING_OFF, 1024, 1024, 16, S, E); }
    }
#endif
    GRID_BAR();
    {
        ph_ktranspose(p, F);
        { RaSched S{p.q, p.k, F.G, F.vcu}; EpiPP E; E.pp = p.pp; pg::gemm_phase<EpiPP, RaSched, 0, true>(F.lds + RING_OFF, 1024, 1024, 4, S, E); }
    }
    GRID_BAR();
    {
        { R1Sched S{p.vt, p.kdt, 4, F.G, F.vcu}; EpiSegTot E; E.L = p.ltot; pg::gemm_phase<EpiSegTot, R1Sched, 0, false>(F.lds + RING_OFF, 256, 256, 4, S, E); }
    }
    GRID_BAR();
    ph_carry(p.ltot, F);
    GRID_BAR();
    { R1Sched S{p.vt, p.kdt, 3, F.G, F.vcu}; EpiSnap E; E.L = p.ltot; E.st = p.st; pg::gemm_phase<EpiSnap, R1Sched, 0, false>(F.lds + RING_OFF, 256, 256, 4, S, E); }
#if (PROBE_DBL >> 8) & 1
    GRID_BAR();
    { R1Sched S{p.vt, p.kdt, 3, F.G, F.vcu}; EpiSnap E; E.L = p.ltot; E.st = p.st; pg::gemm_phase<EpiSnap, R1Sched, 0, false>(F.lds + RING_OFF, 256, 256, 4, S, E); }
#endif
    GRID_BAR();
    { R2Sched S{p.pp, p.vt, p.q, p.st, F.G, F.vcu}; EpiRetOut E; E.o = p.o; E.sg = p.sg; E.og = p.og; pg::gemm_phase<EpiRetOut, R2Sched, 2, true>(F.lds + RING_OFF, 256, 256, 4, S, E, 1024, 256); }
    GRID_BAR();
    layer_tail<0>(p, F, bar);
    GRID_BAR();
    {
        { DenseSched S; S.init(p.x2h, 1024, p.wsi_t, 1024, T_, 1280, F.G, (int)blockIdx.x); EpiSwaTok E; E.sq = p.sq; E.skv = p.skv; E.bias = p.b_swa_in;
          pg::gemm_phase<EpiSwaTok, DenseSched, 0, true>(F.lds + RING_OFF, 1024, 1024, 16, S, E); }
        { DenseSched S; S.init(p.wsi_t + (size_t)1024 * 1024, 1024, p.x2h, 1024, 256, T_, F.G, (int)blockIdx.x, 128); EpiSwaFeat E; E.kvt = p.kvt; E.bias = p.b_swa_in;
          pg::gemm_phase<EpiSwaFeat, DenseSched, 0, true>(F.lds + RING_OFF, 1024, 1024, 16, S, E); }
    }
#if (PROBE_DBL >> 13) & 1
    GRID_BAR();
    {
        { DenseSched S; S.init(p.x2h, 1024, p.wsi_t, 1024, T_, 1280, F.G, (int)blockIdx.x); EpiSwaTok E; E.sq = p.sq; E.skv = p.skv; E.bias = p.b_swa_in;
          pg::gemm_phase<EpiSwaTok, DenseSched, 0, true>(F.lds + RING_OFF, 1024, 1024, 16, S, E); }
        { DenseSched S; S.init(p.wsi_t + (size_t)1024 * 1024, 1024, p.x2h, 1024, 256, T_, F.G, (int)blockIdx.x, 128); EpiSwaFeat E; E.kvt = p.kvt; E.bias = p.b_swa_in;
          pg::gemm_phase<EpiSwaFeat, DenseSched, 0, true>(F.lds + RING_OFF, 1024, 1024, 16, S, E); }
    }
#endif
    GRID_BAR();
    DBL(3, ph_swa_attn(p, F));
    GRID_BAR();
    layer_tail<1>(p, F, bar);
    if (__hip_atomic_load((gu32*)((unsigned*)p.ctl + CW_BAR + XB_TMO), RLX_AGENT) != 0u) {
        __syncthreads();
        for (size_t i = (size_t)blockIdx.x * 512 + F.tid; i < (size_t)T_ * D_; i += (size_t)F.G * 512) p.out[i] = __builtin_nanf("");
    }
#undef GRID_BAR
}

namespace host {
constexpr size_t MiB = 1u << 20;
static int g_grid = 0;
static bool setup() {
    if (g_grid) return g_grid > 0;
    int dev = 0, cus = 0;
    if (hipGetDevice(&dev) != hipSuccess || hipDeviceGetAttribute(&cus, hipDeviceAttributeMultiprocessorCount, dev) != hipSuccess) { g_grid = -1; return false; }
    if (hipFuncSetAttribute((const void*)mk_fwd, hipFuncAttributeMaxDynamicSharedMemorySize, LDS_BYTES) != hipSuccess) { g_grid = -1; return false; }
    (void)hipGetLastError();
    g_grid = cus;
    return true;
}
static void launch(hipStream_t st, Params p) {
    p.ph_lo = 0; p.ph_hi = 0; p.li = 0; p.layer = 0;
    hipLaunchKernelGGL(mk_fwd, dim3(g_grid), dim3(NWAVES * 64), LDS_BYTES, st, p);
}
static void fill_params(Params& p, void* const* d_in, float* out, unsigned char* ws) {
    const float** in = (const float**)&p.x;
    for (int i = 0; i < 18; ++i) in[i] = (const float*)d_in[i];
    p.out = out; p.ctl = (unsigned*)ws;
    const size_t M = MiB;
    p.top_e = (int*)(ws + 1 * M); p.top_g = (float*)(ws + 2 * M); p.rankp = (int*)(ws + 3 * M); p.inv = (int*)(ws + 4 * M); p.slot_tok = (int*)(ws + 5 * M); p.slot_gate = (float*)(ws + 6 * M);
    p.wg_cnt = (int*)(ws + 7 * M); p.tile_e = (int*)(ws + 8 * M);
    p.wri_t = (h16*)(ws + 17 * M); p.wfm_t = (h16*)(ws + 25 * M); p.wro_t = (h16*)(ws + 31 * M); p.wsi_t = (h16*)(ws + 35 * M); p.wso_t = (h16*)(ws + 38 * M);
    p.w1_t = (h16*)(ws + 40 * M); p.w2_t = (h16*)(ws + 296 * M);
    p.xh0 = (h16*)(ws + 424 * M); p.x1h = (h16*)(ws + 488 * M); p.x2h = (h16*)(ws + 552 * M);
    p.x1f = (float*)(ws + 616 * M); p.x2f = (float*)(ws + 744 * M); p.yf = (float*)(ws + 872 * M);
    p.act = (h16*)(ws + 1000 * M); p.yy = (h16*)(ws + 1272 * M);
}
}
extern "C" void kernel_launch(void* const* d_in, const int* in_sizes, int n_in, void* d_out, int out_size, void* d_ws, size_t ws_size, hipStream_t stream) {
    const size_t M = host::MiB;
    if (n_in != 18 || out_size != T_ * D_ || ws_size < 2040 * M) { fprintf(stderr, "kernel_launch: unexpected shapes / workspace (%d inputs, out %d, ws %zu)\n", n_in, out_size, ws_size); return; }
    if (!host::setup()) return;
    unsigned char* ws = (unsigned char*)d_ws; hipStream_t st = stream;
    (void)hipMemsetAsync(ws, 0, CTL_ZERO_BYTES, st);
    Params p{}; host::fill_params(p, d_in, (float*)d_out, ws);
    p.q = (h16*)(ws + 1000 * M); p.k = (h16*)(ws + 1064 * M); p.sg = (h16*)(ws + 1128 * M); p.kdt = (h16*)(ws + 1256 * M); p.vt = (h16*)(ws + 1320 * M);
    p.pp = (h16*)(ws + 1448 * M); p.st = (h16*)(ws + 1512 * M); p.ltot = (float*)(ws + 1640 * M); p.o = (h16*)(ws + 1704 * M); p.og = (h16*)(ws + 1832 * M);
    p.sq = (h16*)(ws + 1000 * M); p.skv = (h16*)(ws + 1064 * M); p.kvt = (h16*)(ws + 1080 * M); p.so = (h16*)(ws + 1096 * M);
    p.w1q = (unsigned char*)p.w1_t + (size_t)32 * 2048 * 1024 * 2; p.w2q = (unsigned char*)p.w2_t + (size_t)32 * 1024 * 1024 * 2;
    p.x1q = ws + 1560 * M; p.actq = (unsigned char*)p.act;
    p.yh = (h16*)p.yf;
    host::launch(st, p);
}
```

```cpp
#include <hip/hip_runtime.h>
#include <cstdio>
#include <cstdint>
#include <cmath>
#define GAS __attribute__((address_space(1)))
#define LAS __attribute__((address_space(3)))
typedef unsigned short bf16;
typedef unsigned v4u __attribute__((ext_vector_type(4)));
typedef float f32x4 __attribute__((ext_vector_type(4)));
typedef short bf16x8 __attribute__((ext_vector_type(8)));
typedef GAS unsigned gu32;
typedef GAS unsigned long long gu64;
#define RLX_AGENT __ATOMIC_RELAXED, __HIP_MEMORY_SCOPE_AGENT
#define LDS_WAIT() asm volatile("s_waitcnt lgkmcnt(0)" ::: "memory")
#define VM_WAIT() asm volatile("s_waitcnt vmcnt(0)" ::: "memory")
__device__ __forceinline__ unsigned long long rt() { return __builtin_amdgcn_s_memrealtime(); }
#define XB_TMO      128
#define XB_XCNT(j)  (256  + 64 * (j))
#define XB_XSUB(j)  (1280 + 64 * (j))
#define XB_XGEN(j)  (2304 + 64 * (j))
#define XB_TOP      3328
#define XB_TOPGEN   3392
#define XCD_BAR_WORDS 3456
#define XB_SPIN_CAP (1u << 18)

__device__ __forceinline__ unsigned xb_ld(unsigned* p)              { return __hip_atomic_load(p, __ATOMIC_RELAXED, __HIP_MEMORY_SCOPE_AGENT); }
__device__ __forceinline__ unsigned xb_add(unsigned* p, unsigned v) { return __hip_atomic_fetch_add(p, v, __ATOMIC_RELAXED, __HIP_MEMORY_SCOPE_AGENT); }
__device__ __forceinline__ unsigned xb_xcc_id() { return (unsigned)__builtin_amdgcn_s_getreg((3 << 11) | 20) & 0xFu; }
#define XB_SPIN(cond, bar) do { unsigned _sp = 0; while (cond) { __builtin_amdgcn_s_sleep(1); \
    if ((++_sp & 255u) == 0u) { if (xb_ld(&(bar)[XB_TMO])) break; if (_sp > XB_SPIN_CAP) { atomicAdd(&(bar)[XB_TMO], 1u); break; } } } } while (0)

struct XcdBarrier {
    unsigned* bar; unsigned x;
    volatile LAS unsigned* st;
};

__device__ __forceinline__ XcdBarrier xcd_barrier_post(unsigned* bar, volatile LAS unsigned* st) {
    XcdBarrier b; b.bar = bar; b.x = xb_xcc_id(); b.st = st;
    if (threadIdx.x == 0) (void)xb_add(&bar[XB_XCNT(b.x)], 1u);
    return b;
}
__device__ __forceinline__ void xcd_barrier_complete(unsigned* bar, unsigned x, unsigned& nloc, unsigned& nx) {
    const unsigned G = gridDim.x * gridDim.y * gridDim.z;
    unsigned sum, cnt, mine, sp = 0u;
    for (;;) {
        sum = 0u; cnt = 0u; mine = 0u;
#pragma unroll
        for (unsigned j = 0; j < 16; ++j) { const unsigned c = xb_ld(&bar[XB_XCNT(j)]); sum += c; cnt += (c > 0u) ? 1u : 0u; mine = (j == x) ? c : mine; }
        if (sum == G) break;
        __builtin_amdgcn_s_sleep(1);
        if ((++sp & 255u) == 0u) { if (xb_ld(&bar[XB_TMO])) break; if (sp > XB_SPIN_CAP) { atomicAdd(&bar[XB_TMO], 1u); break; } }
    }
    nloc = mine > 0u ? mine : 1u; nx = cnt > 0u ? cnt : 1u;
}

__device__ __forceinline__ void xcd_barrier(const XcdBarrier& b) {
    asm volatile("s_waitcnt vmcnt(0)" ::: "memory");
    __syncthreads();
    if (threadIdx.x == 0) {
        unsigned* bar = b.bar;
        __builtin_amdgcn_s_waitcnt(0);
        unsigned nloc = b.st[0], nx = b.st[1];
        if (nloc == 0u) { xcd_barrier_complete(bar, b.x, nloc, nx); b.st[0] = nloc; b.st[1] = nx; }
        const unsigned old = xb_add(&bar[XB_XSUB(b.x)], 1u);
        const unsigned gen = old / nloc;
        if (old + 1u == (gen + 1u) * nloc) {
            __builtin_amdgcn_fence(__ATOMIC_RELEASE, "agent");
            asm volatile("s_waitcnt vmcnt(0)" ::: "memory");
            const unsigned og = xb_add(&bar[XB_TOP], 1u);
            const unsigned tg = og / nx;
            if (og + 1u == (tg + 1u) * nx) xb_add(&bar[XB_TOPGEN], 1u);
            else XB_SPIN(xb_ld(&bar[XB_TOPGEN]) == tg, bar);
            __builtin_amdgcn_fence(__ATOMIC_ACQUIRE, "agent");
            xb_add(&bar[XB_XGEN(b.x)], 1u);
            asm volatile("s_waitcnt vmcnt(0)" ::: "memory");
        } else {
            XB_SPIN(xb_ld(&bar[XB_XGEN(b.x)]) == gen, bar);
            __builtin_amdgcn_fence(__ATOMIC_ACQUIRE, "agent");
            asm volatile("s_waitcnt vmcnt(0)" ::: "memory");
        }
    }
    __syncthreads();
}
namespace pg {
#define PG_LAS __attribute__((address_space(3)))
typedef unsigned short h16;
typedef _Float16 f16x8 __attribute__((ext_vector_type(8)));
typedef __bf16 bf16x8 __attribute__((ext_vector_type(8)));
typedef _Float16 f16x2 __attribute__((ext_vector_type(2)));
typedef float f32x4 __attribute__((ext_vector_type(4)));
typedef float f32x2 __attribute__((ext_vector_type(2)));
typedef unsigned u32x4 __attribute__((ext_vector_type(4)));
typedef unsigned u32x2 __attribute__((ext_vector_type(2)));
constexpr int BM = 256, BK = 64, HALF = 128, HTB = HALF * BK * 2  , STAGE_BYTES = 8 * HTB;

__host__ __device__ __forceinline__ int lds_byte(int r, int c) { const int st = (r >> 4) * 2 + (c >> 5), rr = r & 15, cc = c & 31, ob = rr * 64 + cc * 2; return st * 1024 + (ob ^ (((ob >> 9) & 1) << 5)); }
__host__ __device__ __forceinline__ void stage_rc(int b, int& R, int& C) { const int st = b / 1024, sb = b % 1024, swz = sb ^ (((sb >> 9) & 1) << 5); R = (st >> 1) * 16 + swz / 64; C = (st & 1) * 32 + (swz % 64) / 2; }
__host__ __device__ __forceinline__ int perm32(int rho) { const int n = rho >> 4, i = rho & 15; return 8 * (i >> 2) + 4 * n + (i & 3); }
__device__ __forceinline__ unsigned pkh(float lo, float hi) { const f32x2 v = {lo, hi}; const f16x2 h = __builtin_convertvector(v, f16x2); return __builtin_bit_cast(unsigned, h); }

typedef int i32x8 __attribute__((ext_vector_type(8)));
typedef int i32x4 __attribute__((ext_vector_type(4)));
__device__ __forceinline__ i32x8 cat8(f16x8 lo, f16x8 hi) { return __builtin_shufflevector(__builtin_bit_cast(i32x4, lo), __builtin_bit_cast(i32x4, hi), 0, 1, 2, 3, 4, 5, 6, 7); }
__device__ __forceinline__ void mfma_f8(f32x4& c, const i32x8& a, const i32x8& b, int scale) {
    asm volatile("v_mfma_scale_f32_16x16x128_f8f6f4 %0, %1, %2, %0, %3, %3 op_sel_hi:[0,0,0]" : "+v"(c) : "v"(a), "v"(b), "v"(scale)); }
struct Unit { const char* a; const char* b; int pm, pn, e, x; };
typedef f32x4 Acc[2][2][4][2];
__device__ __forceinline__ void acc_zero(Acc& acc) {
#pragma unroll
    for (int a = 0; a < 2; ++a)
#pragma unroll
        for (int b = 0; b < 2; ++b)
#pragma unroll
            for (int m = 0; m < 4; ++m)
#pragma unroll
                for (int n = 0; n < 2; ++n) acc[a][b][m][n] = (f32x4){0.f, 0.f, 0.f, 0.f};
}
struct EpiBase {
    static constexpr bool PERM = false;
    __device__ __forceinline__ void init(Acc& acc, const Unit&, int, int, int, int) const { acc_zero(acc); }
    __device__ __forceinline__ void reinit(Acc& acc, const Unit&, const Unit&, int, int, int, int) const { acc_zero(acc); }
};

template <class Epi, class Sched, int MODE  , bool ALIGN_EPI, int ES = 2  , bool BF = false  , int ILV = 2  >
__device__ __forceinline__ void gemm_phase(PG_LAS unsigned char* lds, const int lda, const int ldb, const int nt_, const Sched& S, const Epi& E, const int lda1 = 0, const int ldb1 = 0, const int skew_ticks = 0  ) {
    constexpr bool GATHER = (MODE == 1), DUAL = (MODE == 2);
    int nt = nt_; asm volatile("" : "+s"(nt));
    int tid_ = threadIdx.x; asm volatile("" : "+v"(tid_));
    const int tid = tid_, wid = __builtin_amdgcn_readfirstlane(tid >> 6), lane = tid & 63, wr = wid >> 2, wc = wid & 3, fr = lane & 15, fq = lane >> 4;
    unsigned voffA[2], voffB[2]; int sR[2], sC[2];
#pragma unroll
    for (int i = 0; i < 2; ++i) { int R, C; stage_rc(tid * 16 + i * 8192, R, C); sR[i] = R; sC[i] = C; const int Rb = Epi::PERM ? ((R & ~31) + perm32(R & 31)) : R;
        voffA[i] = (unsigned)(R * lda * ES + C * 2); voffB[i] = (unsigned)(Rb * ldb * ES + C * 2); }
    const size_t kstep = (size_t)(BK * 2);
    const size_t hstepA0 = GATHER ? 0 : (size_t)HALF * lda * ES, hstepB0 = (size_t)HALF * ldb * ES, hstepA1 = (size_t)HALF * lda1 * ES, hstepB1 = (size_t)HALF * ldb1 * ES;
    unsigned wA1[2], wB1[2];
#pragma unroll
    for (int i = 0; i < 2; ++i) { const int Rb = Epi::PERM ? ((sR[i] & ~31) + perm32(sR[i] & 31)) : sR[i]; wA1[i] = (unsigned)(sR[i] * lda1 * ES + sC[i] * 2); wB1[i] = (unsigned)(Rb * ldb1 * ES + sC[i] * 2); }
    unsigned vAc[2], vBc[2], vAn[2], vBn[2], vA2[2], vB2[2];
    size_t hAc = hstepA0, hBc = hstepB0, hAn = hstepA0, hBn = hstepB0, hA2 = hstepA0, hB2 = hstepB0;
    const unsigned ldsw = (unsigned)wid * 1024u;
    const int aoff = (ES == 2) ? lds_byte(wr * 64 + fr, fq * 8) : lds_byte(wr * 64 + fr, fq * 16), boff = (ES == 2) ? lds_byte(wc * 32 + fr, fq * 8) : lds_byte(wc * 32 + fr, fq * 16);
    unsigned gc[2][2], gn[2][2], g2[2][2];
#define PG_SA(b, h) (((b) * 2 + (h)) * HTB)
#define PG_SB(b, h) ((4 + (b) * 2 + (h)) * HTB)
#if !defined(PG_GLOBAL_DMA)
#define PG_STAGE(bufoff, gbase, voff) do { const __amdgpu_buffer_rsrc_t _r = __builtin_amdgcn_make_buffer_rsrc((void*)(gbase), 0, 0x7fffffff, 0x00020000); _Pragma("unroll") for (int _i = 0; _i < 2; ++_i) \
        __builtin_amdgcn_raw_ptr_buffer_load_lds(_r, (PG_LAS unsigned*)(lds + (bufoff) + ldsw + _i * 8192), 16, (int)(voff)[_i], 0, 0, 0); } while (0)
#else
#define PG_STAGE(bufoff, gbase, voff) do { _Pragma("unroll") for (int _i = 0; _i < 2; ++_i) \
        __builtin_amdgcn_global_load_lds((const unsigned*)((const char*)(gbase) + (voff)[_i]), (PG_LAS unsigned*)(lds + (bufoff) + ldsw + _i * 8192), 16, 0, 0); } while (0)
#endif
#define PG_STAGE_A(bufoff, kptr, h, G, VA, HA) do { if constexpr (GATHER) { PG_STAGE(bufoff, kptr, G[h]); } else { PG_STAGE(bufoff, (kptr) + (h) * (HA), VA); } } while (0)
#define PG_CFG(u, VA, VB, HA, HB) do { if constexpr (DUAL) { const bool _x = (u).x != 0; _Pragma("unroll") for (int _i = 0; _i < 2; ++_i) { VA[_i] = _x ? wA1[_i] : voffA[_i]; VB[_i] = _x ? wB1[_i] : voffB[_i]; } \
        HA = _x ? hstepA1 : hstepA0; HB = _x ? hstepB1 : hstepB0; } else { _Pragma("unroll") for (int _i = 0; _i < 2; ++_i) { VA[_i] = voffA[_i]; VB[_i] = voffB[_i]; } HA = hstepA0; HB = hstepB0; } } while (0)
#define PG_GLOAD(dst, u) do { _Pragma("unroll") for (int _h = 0; _h < 2; ++_h) _Pragma("unroll") for (int _i = 0; _i < 2; ++_i) \
        dst[_h][_i] = S.arow(u, _h * HALF + sR[_i]) * (unsigned)(lda * ES) + (unsigned)(sC[_i] * 2); } while (0)
#define PG_LDF(p) (*(const PG_LAS f16x8*)(p))
#define PG_LDA(dst, b, h) do { if constexpr (ES == 2) { _Pragma("unroll") for (int m = 0; m < 4; ++m) _Pragma("unroll") for (int k = 0; k < 2; ++k) dst[m][k] = PG_LDF(lds + PG_SA(b, h) + aoff + m * 2048 + k * 1024); } \
        else { _Pragma("unroll") for (int m = 0; m < 4; ++m) dst##8[m] = cat8(PG_LDF(lds + PG_SA(b, h) + aoff + m * 2048), PG_LDF(lds + PG_SA(b, h) + aoff + m * 2048 + 16)); } } while (0)
#define PG_LDB(dst, b, h) do { if constexpr (ES == 2) { _Pragma("unroll") for (int n = 0; n < 2; ++n) _Pragma("unroll") for (int k = 0; k < 2; ++k) dst[n][k] = PG_LDF(lds + PG_SB(b, h) + boff + n * 2048 + k * 1024); } \
        else { _Pragma("unroll") for (int n = 0; n < 2; ++n) dst##8[n] = cat8(PG_LDF(lds + PG_SB(b, h) + boff + n * 2048), PG_LDF(lds + PG_SB(b, h) + boff + n * 2048 + 16)); } } while (0)
#define PG_MMA(ai, bj, At, Bt) do { __builtin_amdgcn_s_setprio(1); if constexpr (ES == 2) { _Pragma("unroll") for (int m = 0; m < 4; ++m) _Pragma("unroll") for (int n = 0; n < 2; ++n) _Pragma("unroll") for (int k = 0; k < 2; ++k) \
        acc[ai][bj][m][n] = BF ? __builtin_amdgcn_mfma_f32_16x16x32_bf16(__builtin_bit_cast(bf16x8, Bt[n][k]), __builtin_bit_cast(bf16x8, At[m][k]), acc[ai][bj][m][n], 0, 0, 0) : __builtin_amdgcn_mfma_f32_16x16x32_f16(Bt[n][k], At[m][k], acc[ai][bj][m][n], 0, 0, 0); } else { _Pragma("unroll") for (int m = 0; m < 4; ++m) _Pragma("unroll") for (int n = 0; n < 2; ++n) \
        mfma_f8(acc[ai][bj][m][n], Bt##8[n], At##8[m], f8scale); } \
        __builtin_amdgcn_s_setprio(0); } while (0)
#define PG_MMH(ai, bj, At, Bt, M0) do { __builtin_amdgcn_s_setprio(1); if constexpr (ES == 2) { _Pragma("unroll") for (int m = (M0); m < (M0) + 2; ++m) _Pragma("unroll") for (int n = 0; n < 2; ++n) _Pragma("unroll") for (int k = 0; k < 2; ++k) \
        acc[ai][bj][m][n] = BF ? __builtin_amdgcn_mfma_f32_16x16x32_bf16(__builtin_bit_cast(bf16x8, Bt[n][k]), __builtin_bit_cast(bf16x8, At[m][k]), acc[ai][bj][m][n], 0, 0, 0) : __builtin_amdgcn_mfma_f32_16x16x32_f16(Bt[n][k], At[m][k], acc[ai][bj][m][n], 0, 0, 0); } else { _Pragma("unroll") for (int m = (M0); m < (M0) + 2; ++m) _Pragma("unroll") for (int n = 0; n < 2; ++n) \
        mfma_f8(acc[ai][bj][m][n], Bt##8[n], At##8[m], f8scale); } \
        __builtin_amdgcn_s_setprio(0); } while (0)
#define PG_WAIT_V(n) asm volatile("s_waitcnt vmcnt(" #n ")" ::: "memory")
#define PG_WAIT_L(n) asm volatile("s_waitcnt lgkmcnt(" #n ")" ::: "memory")
#define PG_BAR __builtin_amdgcn_s_barrier()
#define PG_SCHED __builtin_amdgcn_sched_barrier(0)
    if (skew_ticks > 0) { const unsigned long long t0 = __builtin_amdgcn_s_memrealtime(); while (__builtin_amdgcn_s_memrealtime() - t0 < (unsigned long long)skew_ticks) __builtin_amdgcn_s_sleep(8); }
    Unit cur, nxt; int ui = 0;
    if (!S.next(0, cur)) return;
    Acc acc;
    E.init(acc, cur, wr, wc, fr, fq);
    f16x8 At[4][2], B0[2][2], B1[2][2];
    int f8scale = 0x7f7f7f7f; asm volatile("" : "+v"(f8scale));
    i32x8 At8[4], B08[2], B18[2];
    const char* cA = cur.a; const char* cB = cur.b;
    if constexpr (GATHER) { PG_GLOAD(gc, cur); }
    PG_CFG(cur, vAc, vBc, hAc, hBc);
    PG_STAGE(PG_SB(0, 0), cB, vBc); PG_STAGE(PG_SB(0, 1), cB + hBc, vBc); PG_STAGE_A(PG_SA(0, 0), cA, 0, gc, vAc, hAc); PG_STAGE_A(PG_SA(0, 1), cA, 1, gc, vAc, hAc);
    if (wr == 1) PG_BAR;
    PG_WAIT_V(2); PG_BAR;
    if constexpr (ILV >= 2 && ILV <= 4) { PG_STAGE(PG_SB(1, 0), cB + kstep, vBc); PG_STAGE(PG_SB(1, 1), cB + hBc + kstep, vBc); PG_WAIT_V(4); PG_BAR; }
    else { PG_STAGE(PG_SB(1, 0), cB + kstep, vBc); PG_STAGE_A(PG_SA(1, 0), cA + kstep, 0, gc, vAc, hAc); PG_STAGE(PG_SB(1, 1), cB + hBc + kstep, vBc);
    PG_WAIT_V(6); PG_BAR; }
    for (;;) {
        const bool has_next = S.next(ui + 1, nxt);
        const char* nA = has_next ? nxt.a : cA; const char* nB = has_next ? nxt.b : cB;
        if constexpr (GATHER) { if (has_next) { PG_GLOAD(gn, nxt); } else {
#pragma unroll
            for (int h = 0; h < 2; ++h)
#pragma unroll
                for (int i = 0; i < 2; ++i) gn[h][i] = gc[h][i]; } }
        if (has_next) { PG_CFG(nxt, vAn, vBn, hAn, hBn); } else { PG_CFG(cur, vAn, vBn, hAn, hBn); }
        for (int t = 0; t < nt; t += 2) {
            const bool last = (t == nt - 2);
            const char* a1 = cA + (size_t)(t + 1) * kstep;
            const char* a2 = last ? nA : cA + (size_t)(t + 2) * kstep; const char* b2 = last ? nB : cB + (size_t)(t + 2) * kstep;
            const char* a3 = a2 + kstep; const char* b3 = b2 + kstep;
            if constexpr (GATHER) {
#pragma unroll
                for (int h = 0; h < 2; ++h)
#pragma unroll
                    for (int i = 0; i < 2; ++i) g2[h][i] = last ? gn[h][i] : gc[h][i]; }
            if constexpr (DUAL) {
#pragma unroll
                for (int i = 0; i < 2; ++i) { vA2[i] = last ? vAn[i] : vAc[i]; vB2[i] = last ? vBn[i] : vBc[i]; }
                hA2 = last ? hAn : hAc; hB2 = last ? hBn : hBc;
            } else {
#pragma unroll
                for (int i = 0; i < 2; ++i) { vA2[i] = vAc[i]; vB2[i] = vBc[i]; }
                hA2 = hAc; hB2 = hBc; }
            if constexpr (ILV == 5) {
            PG_LDB(B0, 0, 0); PG_SCHED; PG_LDA(At, 0, 0); PG_STAGE_A(PG_SA(1, 1), a1, 1, gc, vAc, hAc);
            PG_WAIT_L(8); PG_BAR; PG_WAIT_L(0); PG_MMA(0, 0, At, B0); PG_BAR; PG_SCHED;
            PG_LDB(B1, 0, 1); PG_STAGE(PG_SB(0, 0), b2, vB2);
            PG_BAR; PG_WAIT_L(0); PG_MMA(0, 1, At, B1); PG_BAR; PG_SCHED;
            PG_LDA(At, 0, 1); PG_STAGE_A(PG_SA(0, 0), a2, 0, g2, vA2, hA2);
            PG_BAR; PG_WAIT_L(0); PG_MMA(1, 0, At, B0); PG_BAR; PG_SCHED;
            PG_STAGE(PG_SB(0, 1), b2 + hB2, vB2);
            PG_WAIT_V(6); PG_BAR; PG_MMA(1, 1, At, B1); PG_BAR; PG_SCHED;
            PG_LDB(B0, 1, 0); PG_SCHED; PG_LDA(At, 1, 0); PG_STAGE_A(PG_SA(0, 1), a2, 1, g2, vA2, hA2);
            PG_WAIT_L(8); PG_BAR; PG_WAIT_L(0); PG_MMA(0, 0, At, B0); PG_BAR; PG_SCHED;
            PG_LDB(B1, 1, 1); PG_STAGE(PG_SB(1, 0), b3, vB2);
            PG_BAR; PG_WAIT_L(0); PG_MMA(0, 1, At, B1); PG_BAR; PG_SCHED;
            PG_LDA(At, 1, 1); PG_STAGE_A(PG_SA(1, 0), a3, 0, g2, vA2, hA2);
            PG_BAR; PG_WAIT_L(0); PG_MMA(1, 0, At, B0); PG_BAR; PG_SCHED;
            PG_STAGE(PG_SB(1, 1), b3 + hB2, vB2);
            PG_WAIT_V(6); PG_BAR; PG_MMA(1, 1, At, B1); PG_BAR; PG_SCHED;
            } else if constexpr (ILV == 3) {
            PG_LDB(B0, 0, 0); PG_LDB(B1, 0, 1); PG_SCHED; PG_LDA(At, 0, 0); PG_STAGE_A(PG_SA(1, 0), a1, 0, gc, vAc, hAc);
            PG_WAIT_V(6); PG_WAIT_L(0); PG_BAR; PG_MMA(0, 0, At, B0); PG_SCHED; PG_STAGE_A(PG_SA(1, 1), a1, 1, gc, vAc, hAc); PG_SCHED; PG_MMA(0, 1, At, B1); PG_BAR; PG_SCHED;
            PG_LDA(At, 0, 1); PG_STAGE(PG_SB(0, 0), b2, vB2);
            PG_WAIT_V(4); PG_WAIT_L(0); PG_BAR; PG_MMA(1, 0, At, B0); PG_SCHED; PG_STAGE(PG_SB(0, 1), b2 + hB2, vB2); PG_SCHED; PG_MMA(1, 1, At, B1); PG_BAR; PG_SCHED;
            PG_LDB(B0, 1, 0); PG_LDB(B1, 1, 1); PG_SCHED; PG_LDA(At, 1, 0); PG_STAGE_A(PG_SA(0, 0), a2, 0, g2, vA2, hA2);
            PG_WAIT_V(6); PG_WAIT_L(0); PG_BAR; PG_MMA(0, 0, At, B0); PG_SCHED; PG_STAGE_A(PG_SA(0, 1), a2, 1, g2, vA2, hA2); PG_SCHED; PG_MMA(0, 1, At, B1); PG_BAR; PG_SCHED;
            PG_LDA(At, 1, 1); PG_STAGE(PG_SB(1, 0), b3, vB2);
            PG_WAIT_V(4); PG_WAIT_L(0); PG_BAR; PG_MMA(1, 0, At, B0); PG_SCHED; PG_STAGE(PG_SB(1, 1), b3 + hB2, vB2); PG_SCHED; PG_MMA(1, 1, At, B1); PG_BAR; PG_SCHED;
            } else if constexpr (ILV == 4) {
            PG_LDB(B0, 0, 0); PG_SCHED; PG_STAGE_A(PG_SA(1, 0), a1, 0, gc, vAc, hAc); PG_SCHED; PG_LDA(At, 0, 0); PG_SCHED; PG_STAGE_A(PG_SA(1, 1), a1, 1, gc, vAc, hAc);
            PG_WAIT_V(8); PG_BAR; PG_WAIT_L(0); PG_MMA(0, 0, At, B0); PG_SCHED; PG_LDB(B1, 0, 1); PG_WAIT_L(0); PG_SCHED; PG_MMA(0, 1, At, B1); PG_BAR; PG_SCHED;
            PG_LDA(At, 0, 1); PG_STAGE(PG_SB(0, 0), b2, vB2); PG_STAGE(PG_SB(0, 1), b2 + hB2, vB2);
            PG_WAIT_V(6); PG_BAR; PG_WAIT_L(0); PG_MMA(1, 0, At, B0); PG_MMA(1, 1, At, B1); PG_BAR; PG_SCHED;
            PG_LDB(B0, 1, 0); PG_SCHED; PG_STAGE_A(PG_SA(0, 0), a2, 0, g2, vA2, hA2); PG_SCHED; PG_LDA(At, 1, 0); PG_SCHED; PG_STAGE_A(PG_SA(0, 1), a2, 1, g2, vA2, hA2);
            PG_WAIT_V(8); PG_BAR; PG_WAIT_L(0); PG_MMA(0, 0, At, B0); PG_SCHED; PG_LDB(B1, 1, 1); PG_WAIT_L(0); PG_SCHED; PG_MMA(0, 1, At, B1); PG_BAR; PG_SCHED;
            PG_LDA(At, 1, 1); PG_STAGE(PG_SB(1, 0), b3, vB2); PG_STAGE(PG_SB(1, 1), b3 + hB2, vB2);
            PG_WAIT_V(6); PG_BAR; PG_WAIT_L(0); PG_MMA(1, 0, At, B0); PG_MMA(1, 1, At, B1); PG_BAR; PG_SCHED;
            } else if constexpr (ILV == 2) {
            PG_LDB(B0, 0, 0); PG_LDB(B1, 0, 1); PG_SCHED; PG_STAGE_A(PG_SA(1, 0), a1, 0, gc, vAc, hAc); PG_SCHED; PG_LDA(At, 0, 0); PG_SCHED; PG_STAGE_A(PG_SA(1, 1), a1, 1, gc, vAc, hAc);
            PG_WAIT_V(8); PG_BAR; PG_WAIT_L(0); PG_MMA(0, 0, At, B0); PG_MMA(0, 1, At, B1); PG_BAR; PG_SCHED;
            PG_LDA(At, 0, 1); PG_STAGE(PG_SB(0, 0), b2, vB2); PG_STAGE(PG_SB(0, 1), b2 + hB2, vB2);
            PG_WAIT_V(6); PG_BAR; PG_WAIT_L(0); PG_MMA(1, 0, At, B0); PG_MMA(1, 1, At, B1); PG_BAR; PG_SCHED;
            PG_LDB(B0, 1, 0); PG_LDB(B1, 1, 1); PG_SCHED; PG_STAGE_A(PG_SA(0, 0), a2, 0, g2, vA2, hA2); PG_SCHED; PG_LDA(At, 1, 0); PG_SCHED; PG_STAGE_A(PG_SA(0, 1), a2, 1, g2, vA2, hA2);
            PG_WAIT_V(8); PG_BAR; PG_WAIT_L(0); PG_MMA(0, 0, At, B0); PG_MMA(0, 1, At, B1); PG_BAR; PG_SCHED;
            PG_LDA(At, 1, 1); PG_STAGE(PG_SB(1, 0), b3, vB2); PG_STAGE(PG_SB(1, 1), b3 + hB2, vB2);
            PG_WAIT_V(6); PG_BAR; PG_WAIT_L(0); PG_MMA(1, 0, At, B0); PG_MMA(1, 1, At, B1); PG_BAR; PG_SCHED;
            } else if constexpr (ILV == 1) {
            PG_LDB(B0, 0, 0); PG_LDB(B1, 0, 1); PG_SCHED; PG_LDA(At, 0, 0);
            PG_WAIT_V(6); PG_WAIT_L(0); PG_BAR; PG_MMA(0, 0, At, B0); PG_SCHED; PG_STAGE_A(PG_SA(1, 1), a1, 1, gc, vAc, hAc); PG_SCHED; PG_MMA(0, 1, At, B1); PG_BAR; PG_SCHED;
            PG_LDA(At, 0, 1);
            PG_WAIT_V(2); PG_WAIT_L(0); PG_BAR; PG_MMH(1, 0, At, B0, 0); PG_SCHED; PG_STAGE(PG_SB(0, 0), b2, vB2); PG_SCHED; PG_MMH(1, 0, At, B0, 2); PG_SCHED; PG_STAGE(PG_SB(0, 1), b2 + hB2, vB2); PG_SCHED;
                PG_MMH(1, 1, At, B1, 0); PG_SCHED; PG_STAGE_A(PG_SA(0, 0), a2, 0, g2, vA2, hA2); PG_SCHED; PG_MMH(1, 1, At, B1, 2); PG_BAR; PG_SCHED;
            PG_LDB(B0, 1, 0); PG_LDB(B1, 1, 1); PG_SCHED; PG_LDA(At, 1, 0);
            PG_WAIT_V(6); PG_WAIT_L(0); PG_BAR; PG_MMA(0, 0, At, B0); PG_SCHED; PG_STAGE_A(PG_SA(0, 1), a2, 1, g2, vA2, hA2); PG_SCHED; PG_MMA(0, 1, At, B1); PG_BAR; PG_SCHED;
            PG_LDA(At, 1, 1);
            PG_WAIT_V(2); PG_WAIT_L(0); PG_BAR; PG_MMH(1, 0, At, B0, 0); PG_SCHED; PG_STAGE(PG_SB(1, 0), b3, vB2); PG_SCHED; PG_MMH(1, 0, At, B0, 2); PG_SCHED; PG_STAGE(PG_SB(1, 1), b3 + hB2, vB2); PG_SCHED;
                PG_MMH(1, 1, At, B1, 0); PG_SCHED; PG_STAGE_A(PG_SA(1, 0), a3, 0, g2, vA2, hA2); PG_SCHED; PG_MMH(1, 1, At, B1, 2); PG_BAR; PG_SCHED;
            } else {
            PG_LDB(B0, 0, 0); PG_LDB(B1, 0, 1); PG_SCHED; PG_LDA(At, 0, 0); PG_STAGE_A(PG_SA(1, 1), a1, 1, gc, vAc, hAc);
            PG_WAIT_V(8); PG_WAIT_L(0); PG_BAR; PG_MMA(0, 0, At, B0); PG_MMA(0, 1, At, B1); PG_BAR; PG_SCHED;
            PG_LDA(At, 0, 1); PG_STAGE(PG_SB(0, 0), b2, vB2); PG_STAGE(PG_SB(0, 1), b2 + hB2, vB2); PG_STAGE_A(PG_SA(0, 0), a2, 0, g2, vA2, hA2);
            PG_WAIT_V(8); PG_WAIT_L(0); PG_BAR; PG_MMA(1, 0, At, B0); PG_MMA(1, 1, At, B1); PG_BAR; PG_SCHED;
            PG_LDB(B0, 1, 0); PG_LDB(B1, 1, 1); PG_SCHED; PG_LDA(At, 1, 0); PG_STAGE_A(PG_SA(0, 1), a2, 1, g2, vA2, hA2);
            PG_WAIT_V(8); PG_WAIT_L(0); PG_BAR; PG_MMA(0, 0, At, B0); PG_MMA(0, 1, At, B1); PG_BAR; PG_SCHED;
            PG_LDA(At, 1, 1); PG_STAGE(PG_SB(1, 0), b3, vB2); PG_STAGE(PG_SB(1, 1), b3 + hB2, vB2); PG_STAGE_A(PG_SA(1, 0), a3, 0, g2, vA2, hA2);
            PG_WAIT_V(8); PG_WAIT_L(0); PG_BAR; PG_MMA(1, 0, At, B0); PG_MMA(1, 1, At, B1); PG_BAR; PG_SCHED;
            }
        }
        if constexpr (ES == 1) asm volatile("s_nop 15\n\ts_nop 15" ::: "memory");
        if constexpr (ALIGN_EPI) { if (wr == 0) PG_BAR; }
        E(acc, cur, wr, wc, fr, fq);
        if (!has_next) break;
        E.reinit(acc, cur, nxt, wr, wc, fr, fq);
        cur = nxt; cA = nA; cB = nB; ++ui;
        if constexpr (GATHER) {
#pragma unroll
            for (int h = 0; h < 2; ++h)
#pragma unroll
                for (int i = 0; i < 2; ++i) gc[h][i] = gn[h][i]; }
        if constexpr (DUAL) {
#pragma unroll
            for (int i = 0; i < 2; ++i) { vAc[i] = vAn[i]; vBc[i] = vBn[i]; }
            hAc = hAn; hBc = hBn; }
        if constexpr (ALIGN_EPI) { if (wr == 1) PG_BAR; }
    }
    PG_WAIT_V(0);
    if constexpr (!ALIGN_EPI) { if (wr == 0) PG_BAR; }
    PG_BAR;
#undef PG_SA
#undef PG_SB
#undef PG_STAGE
#undef PG_STAGE_A
#undef PG_GLOAD
#undef PG_CFG
#undef PG_LDA
#undef PG_LDF
#undef PG_LDB
#undef PG_MMA
#undef PG_MMH
#undef PG_WAIT_V
#undef PG_WAIT_L
#undef PG_BAR
#undef PG_SCHED
}
}
constexpr int NWAVES = 8;
constexpr int T_ = 32768, D_ = 1024, SEQ_ = 8192;
constexpr int NSLOT_MAX = (512 + 32) * 256, NTILE_MAX = 544;
constexpr float ALPHA_ = 1.4142135623730951f, LN_EPS_ = 1e-5f;
constexpr int RING_OFF = 0, RING_BYTES = 131072;
constexpr int TAB_OFF = RING_BYTES, TAB_BYTES = 24576;
constexpr int LDSCTL_OFF = TAB_OFF + TAB_BYTES, MISC_OFF = LDSCTL_OFF + 320;
constexpr int LDS_BYTES = 159744;
constexpr int CW_TMO = 0, CW_CODE = 1, CW_NTILES = 64, CW_BAR = 4096;
constexpr int N_BAR_REGIONS = 12;
constexpr size_t CTL_ZERO_BYTES = 1u << 20;
static_assert((CW_BAR + N_BAR_REGIONS * XCD_BAR_WORDS) * 4 <= (int)CTL_ZERO_BYTES, "barrier regions inside the memset region");
typedef unsigned short h16;
typedef float f32x2v __attribute__((ext_vector_type(2)));
typedef unsigned v2u __attribute__((ext_vector_type(2)));
#define EPI_OPAQUE() asm volatile("" : "+v"(fr), "+v"(fq))

struct Params {
    const float *x, *w_ret_in, *w_ret_out, *w_swa_in, *b_swa_in, *w_swa_out, *b_swa_out, *sinks, *ln_mix_g, *ln_mix_b, *w_router, *b_router, *w_exp_in, *b_exp_in, *w_exp_out, *b_exp_out, *ln_ffn_g, *ln_ffn_b;
    float* out;
    unsigned* ctl;
    int *top_e, *rankp, *inv, *slot_tok, *wg_cnt, *tile_e; float *top_g, *slot_gate;
    h16 *wri_t, *wfm_t, *wro_t, *wsi_t, *wso_t, *w1_t, *w2_t;
    h16 *xh0, *x1h, *x2h, *yh; float *x1f, *x2f, *yf;
    h16 *act, *yy;
    h16 *q, *k, *sg, *kdt, *vt, *pp, *st, *o, *og; float* ltot;
    h16 *sq, *skv, *kvt, *so;
    const float* cv_src; h16* cv_dst; size_t cv_n; float* projf;
    unsigned char *w1q, *w2q, *x1q, *actq;
    int ph_lo, ph_hi, li, layer;
};

struct Frame {
    LAS unsigned char* lds; volatile LAS unsigned* MISC; gu32* ctl;
    int tid, lane, wave, vcu, G;
};
__device__ __forceinline__ float wave_sum(float v) {
    v += __builtin_bit_cast(float, __builtin_amdgcn_update_dpp(0, __builtin_bit_cast(int, v), 0x111, 0xf, 0xf, true));
    v += __builtin_bit_cast(float, __builtin_amdgcn_update_dpp(0, __builtin_bit_cast(int, v), 0x112, 0xf, 0xf, true));
    v += __builtin_bit_cast(float, __builtin_amdgcn_update_dpp(0, __builtin_bit_cast(int, v), 0x114, 0xf, 0xf, true));
    v += __builtin_bit_cast(float, __builtin_amdgcn_update_dpp(0, __builtin_bit_cast(int, v), 0x118, 0xf, 0xf, true));
    v += __builtin_bit_cast(float, __builtin_amdgcn_update_dpp(0, __builtin_bit_cast(int, v), 0x142, 0xa, 0xf, true));
    v += __builtin_bit_cast(float, __builtin_amdgcn_update_dpp(0, __builtin_bit_cast(int, v), 0x143, 0xc, 0xf, true));
    return __builtin_bit_cast(float, __builtin_amdgcn_readlane(__builtin_bit_cast(int, v), 63));
}
__device__ __forceinline__ unsigned pkh(float lo, float hi) { return pg::pkh(lo, hi); }
__device__ __forceinline__ float h2f(unsigned short h) { return (float)__builtin_bit_cast(_Float16, h); }

template <class RowMap>
__device__ __forceinline__ void transpose_item(const float* W, int K, int N, h16* WT, const RowMap& rm, LAS float* scr, int item, int lane) {
    const int nblk = N / 32, kb = item / nblk, nb = item % nblk, k0 = 64 * kb, n0 = 32 * nb;
#pragma unroll 8
    for (int i = 0; i < 32; ++i) { const int kk = 2 * i + (lane >> 5); scr[kk * 33 + (lane & 31)] = W[(size_t)(k0 + kk) * N + n0 + (lane & 31)]; }
    LDS_WAIT(); asm volatile("" ::: "memory");
    const int c = lane & 7;
#pragma unroll
    for (int j = 0; j < 4; ++j) { const int n = (lane >> 3) + 8 * j; const LAS float* s = scr + (8 * c) * 33 + n;
        v4u o; o.x = pkh(s[0 * 33], s[1 * 33]); o.y = pkh(s[2 * 33], s[3 * 33]); o.z = pkh(s[4 * 33], s[5 * 33]); o.w = pkh(s[6 * 33], s[7 * 33]);
        const long dr = rm(n0 + n);
        if (dr >= 0) *(GAS v4u*)(WT + (size_t)dr * K + k0 + 8 * c) = o; }
    LDS_WAIT(); asm volatile("" ::: "memory");
}
struct RmIdent { int off; __device__ __forceinline__ long operator()(int n) const { return off + n; } };
struct RmW1 { __device__ __forceinline__ long operator()(int n) const { const int j = n & 1023; return 256 * (j >> 7) + (n >> 10) * 128 + (j & 127); } };
struct RmRange { int lo, hi, off; __device__ __forceinline__ long operator()(int n) const { return (n >= lo && n < hi) ? (long)(off + n - lo) : -1; } };

__device__ __forceinline__ void ph_convert_moe(const Params& p, Frame& F, int layer) {
    LAS float* scr = (LAS float*)(F.lds + RING_OFF + F.wave * 16384);
    const int gw = F.vcu * NWAVES + F.wave, NGW = F.G * NWAVES;
    constexpr int I1 = (1024 / 64) * (2048 / 32), I2 = (1024 / 64) * (1024 / 32);
    const float* w1 = p.w_exp_in + (size_t)layer * 32 * 1024 * 2048; const float* w2 = p.w_exp_out + (size_t)layer * 32 * 1024 * 1024;
    h16* w1t = p.w1_t + (size_t)layer * 32 * 2048 * 1024; h16* w2t = p.w2_t + (size_t)layer * 32 * 1024 * 1024;
    for (int it = gw; it < 32 * (I1 + I2); it += NGW) {
        if (it < 32 * I1) { const int e = it / I1, r = it % I1; transpose_item(w1 + (size_t)e * 1024 * 2048, 1024, 2048, w1t + (size_t)e * 2048 * 1024, RmW1{}, scr, r, F.lane); }
        else { const int q = it - 32 * I1, e = q / I2, r = q % I2; transpose_item(w2 + (size_t)e * 1024 * 1024, 1024, 1024, w2t + (size_t)e * 1024 * 1024, RmIdent{0}, scr, r, F.lane); }
    }
}
__device__ __forceinline__ void ph_cvt_rows(const float* src, h16* dst, size_t n, Frame& F) {
    const size_t stride = (size_t)F.G * 512 * 8;
    for (size_t i0 = ((size_t)blockIdx.x * 512 + F.tid) * 8; i0 < n; i0 += 4 * stride) {
        f32x4 a[4], b[4];
#pragma unroll
        for (int u = 0; u < 4; ++u) { const size_t i = i0 + u * stride; if (i < n) { a[u] = __builtin_nontemporal_load((const GAS f32x4*)(src + i)); b[u] = __builtin_nontemporal_load((const GAS f32x4*)(src + i + 4)); } }
#pragma unroll
        for (int u = 0; u < 4; ++u) { const size_t i = i0 + u * stride; if (i < n) { v4u o; o.x = pkh(a[u].x, a[u].y); o.y = pkh(a[u].z, a[u].w); o.z = pkh(b[u].x, b[u].y); o.w = pkh(b[u].z, b[u].w); *(GAS v4u*)(dst + i) = o; } }
    }
}

__device__ __forceinline__ void ph_rank(const Params& p, Frame& F) {
    LAS int* se = (LAS int*)(F.lds + RING_OFF);
    for (int cc = blockIdx.x; cc < T_ / 128; cc += F.G) {
        __syncthreads();
        const int j = F.tid; const int e = p.top_e[cc * 512 + j];
        se[j] = e;
        __syncthreads();
        int r = 0;
        for (int q = 0; q < j; ++q) r += (se[q] == e) ? 1 : 0;
        p.rankp[cc * 512 + j] = r;
        if (j < 32) { int c = 0; for (int q = 0; q < 512; ++q) c += (se[q] == j) ? 1 : 0; p.wg_cnt[cc * 32 + j] = c; }
    }
}
__device__ __forceinline__ void ph_assign(const Params& p, Frame& F, int layer) {
    int tid_o = F.tid; asm volatile("" : "+v"(tid_o));
    LAS int* tot = (LAS int*)(F.lds + RING_OFF);
    LAS int* bef = tot + 512;
    LAS int* tst = bef + 512;
    LAS int* bas = tst + 64;
    LAS int* ttl = bas + 32;
    for (int cc = blockIdx.x; cc < T_ / 128; cc += F.G) {
        __syncthreads();
        { const int e = tid_o & 31, part = tid_o >> 5; int s = 0, b = 0;
          for (int c2 = part * 16; c2 < part * 16 + 16; ++c2) { const int v = p.wg_cnt[c2 * 32 + e]; s += v; b += (c2 < cc) ? v : 0; }
          tot[part * 32 + e] = s; bef[part * 32 + e] = b; }
        __syncthreads();
        if (tid_o < 32) { int s = 0, b = 0; for (int q = 0; q < 16; ++q) { s += tot[q * 32 + tid_o]; b += bef[q * 32 + tid_o]; } ttl[tid_o] = s; bas[tid_o] = b; }
        __syncthreads();
        if (tid_o == 0) { int ts = 0; for (int e = 0; e < 32; ++e) { tst[e] = ts; ts += (ttl[e] + 255) >> 8; } tst[32] = ts; }
        __syncthreads();
        { const int j = tid_o, ent = cc * 512 + j, e = p.top_e[ent]; const int sl = 256 * tst[e] + bas[e] + p.rankp[ent];
          p.slot_tok[sl] = ent >> 2; p.slot_gate[sl] = p.top_g[ent]; p.inv[ent] = sl; }
        if (cc < 32) { const int e = cc; for (int sl = 256 * tst[e] + ttl[e] + tid_o; sl < 256 * tst[e + 1]; sl += 512) { p.slot_tok[sl] = 0; p.slot_gate[sl] = 0.f; } }
        if (cc == 0) { for (int rt = tid_o; rt < tst[32]; rt += 512) { int e = 0; for (int q = 1; q < 32; ++q) e += (tst[q] <= rt) ? 1 : 0; p.tile_e[rt] = e; }
            if (tid_o == 0) __hip_atomic_store(F.ctl + CW_NTILES + 64 * layer, (unsigned)tst[32], RLX_AGENT); }
    }
}

constexpr int MOE_MAXU = 20;
#ifndef MOE_F8_L0
#define MOE_F8_L0 1
#endif
constexpr int F8_FROM = MOE_F8_L0 ? 0 : 32;
struct MoeSched {
    const char* abase; const char* wbase; LAS const int* lt_e; LAS const int* lt_tok; int ntiles, nct_log, G, c; size_t a_tile_bytes, w_expert_bytes, w_tile_bytes;
    __device__ __forceinline__ bool next(int i, pg::Unit& u) const {
        const int L = i * G + c; if (L >= (ntiles << nct_log) || i >= MOE_MAXU) return false;
        const int rt = L >> nct_log, ct = L & ((1 << nct_log) - 1);
        const int e = __builtin_amdgcn_readfirstlane(lt_e[i]);
        u.a = abase + (size_t)rt * a_tile_bytes; u.b = wbase + (size_t)e * w_expert_bytes + (size_t)ct * w_tile_bytes; u.pm = rt; u.pn = ct; u.e = e; u.x = i; return true;
    }
    __device__ __forceinline__ unsigned arow(const pg::Unit& u, int r) const { return (unsigned)lt_tok[u.x * 256 + r]; }
};
__device__ __forceinline__ void moe_tables(Frame& F, const int* tile_e, const int* slot_tok, int ntiles, int nct_log, bool gather) {
    LAS int* lt_e = (LAS int*)(F.lds + TAB_OFF); LAS int* lt_tok = lt_e + 32;
    __syncthreads();
    for (int i = 0; i < MOE_MAXU; ++i) { const int L = i * F.G + F.vcu; if (L >= (ntiles << nct_log)) break; const int rt = L >> nct_log;
        if (F.tid == 0) lt_e[i] = tile_e[rt];
        if (gather && F.tid < 256) lt_tok[i * 256 + F.tid] = slot_tok[rt * 256 + F.tid]; }
    __syncthreads();
}
struct EpiSwiglu : pg::EpiBase {
    static constexpr bool PERM = true;
    h16* act; const float* b1;
    __device__ __forceinline__ void operator()(const pg::Acc& acc, const pg::Unit& u, int wr, int wc, int fr, int fq) const { EPI_OPAQUE();
        const int c0 = u.pn * 128 + wc * 32 + 8 * fq;
        const float* bg = b1 + (size_t)u.e * 2048 + c0; const float* bl = bg + 1024;
        const f32x4 g0 = *(const f32x4*)bg, g1 = *(const f32x4*)(bg + 4), l0 = *(const f32x4*)bl, l1 = *(const f32x4*)(bl + 4);
#pragma unroll
        for (int ai = 0; ai < 2; ++ai)
#pragma unroll
            for (int m = 0; m < 4; ++m) {
                const size_t row = (size_t)u.pm * 256 + ai * 128 + wr * 64 + m * 16 + fr;
                float r[8];
#pragma unroll
                for (int n = 0; n < 2; ++n)
#pragma unroll
                    for (int j = 0; j < 4; ++j) {
                        const float glu = fminf(acc[ai][0][m][n][j] + (n ? g1[j] : g0[j]), 7.0f);
                        const float lin = fminf(fmaxf(acc[ai][1][m][n][j] + (n ? l1[j] : l0[j]), -7.0f), 7.0f);
                        r[n * 4 + j] = glu * __builtin_amdgcn_rcpf(1.0f + __builtin_amdgcn_exp2f(-1.702f * 1.4426950408889634f * glu)) * (lin + 1.0f);
                    }
                v4u w; w.x = pkh(r[0], r[1]); w.y = pkh(r[2], r[3]); w.z = pkh(r[4], r[5]); w.w = pkh(r[6], r[7]);
                *(v4u*)(act + row * 1024 + c0) = w;
            }
    }
};
template <int VAR> struct EpiSwigluP : pg::EpiBase {
    static constexpr bool PERM = true;
    h16* act; const float* b1;
    __device__ __forceinline__ void operator()(const pg::Acc& acc, const pg::Unit& u, int wr, int wc, int fr, int fq) const { EPI_OPAQUE();
        const int c0 = u.pn * 128 + wc * 32 + 8 * fq;
        const float* bg = b1 + (size_t)u.e * 2048 + c0; const float* bl = bg + 1024;
        const f32x4 g0 = *(const f32x4*)bg, g1 = *(const f32x4*)(bg + 4), l0 = *(const f32x4*)bl, l1 = *(const f32x4*)(bl + 4);
#pragma unroll
        for (int ai = 0; ai < 2; ++ai)
#pragma unroll
            for (int m = 0; m < 4; ++m) {
                const size_t row = (size_t)u.pm * 256 + ai * 128 + wr * 64 + m * 16 + fr;
                float r[8];
#pragma unroll
                for (int n = 0; n < 2; ++n)
#pragma unroll
                    for (int j = 0; j < 4; ++j) {
                        const float glu = fminf(acc[ai][0][m][n][j] + (n ? g1[j] : g0[j]), 7.0f);
                        const float lin = fminf(fmaxf(acc[ai][1][m][n][j] + (n ? l1[j] : l0[j]), -7.0f), 7.0f);
                        r[n * 4 + j] = (VAR == 2) ? glu + lin : glu * __builtin_amdgcn_rcpf(1.0f + __builtin_amdgcn_exp2f(-1.702f * 1.4426950408889634f * glu)) * (lin + 1.0f);
                    }
                v4u w; w.x = pkh(r[0], r[1]); w.y = pkh(r[2], r[3]); w.z = pkh(r[4], r[5]); w.w = pkh(r[6], r[7]);
                if (VAR == 1) { asm volatile("" :: "v"(w.x), "v"(w.y), "v"(w.z), "v"(w.w)); } else { *(v4u*)(act + row * 1024 + c0) = w; }
            }
    }
};
struct EpiMoeOut : pg::EpiBase {
    static constexpr bool PERM = true;
    h16* __restrict__ y; const float* __restrict__ b2; const float* __restrict__ gate;
    __device__ __forceinline__ void operator()(const pg::Acc& acc, const pg::Unit& u, int wr, int wc, int fr, int fq) const { EPI_OPAQUE();
        float gt[2][4]; f32x4 bv[2][2];
#pragma unroll
        for (int ai = 0; ai < 2; ++ai)
#pragma unroll
            for (int m = 0; m < 4; ++m) gt[ai][m] = gate[(size_t)u.pm * 256 + ai * 128 + wr * 64 + m * 16 + fr];
#pragma unroll
        for (int bj = 0; bj < 2; ++bj) { const float* bp = b2 + (size_t)u.e * 1024 + u.pn * 256 + bj * 128 + wc * 32 + 8 * fq; bv[bj][0] = *(const f32x4*)bp; bv[bj][1] = *(const f32x4*)(bp + 4); }
#pragma unroll
        for (int ai = 0; ai < 2; ++ai)
#pragma unroll
            for (int m = 0; m < 4; ++m) {
                const size_t row = (size_t)u.pm * 256 + ai * 128 + wr * 64 + m * 16 + fr;
#pragma unroll
                for (int bj = 0; bj < 2; ++bj) {
                    const int c0 = u.pn * 256 + bj * 128 + wc * 32 + 8 * fq;
                    const f32x4 v0 = (acc[ai][bj][m][0] + bv[bj][0]) * gt[ai][m], v1 = (acc[ai][bj][m][1] + bv[bj][1]) * gt[ai][m];
                    v4u w; w.x = pkh(v0[0], v0[1]); w.y = pkh(v0[2], v0[3]); w.z = pkh(v1[0], v1[1]); w.w = pkh(v1[2], v1[3]);
                    *(v4u*)(y + row * 1024 + c0) = w;
                }
            }
    }
};
template <bool Y8> __device__ __forceinline__ void ph_combine_ln(const Params& p, Frame& F, const h16* xprev, const float* gam, const float* bet, float* outf, h16* outh) {
    int lane = F.lane; asm volatile("" : "+v"(lane));
    const int gw = F.vcu * NWAVES + F.wave, NGW = F.G * NWAVES;
    constexpr int NT = Y8 ? 4 : 3;
    for (int tb = gw * NT; tb < T_; tb += NGW * NT) {
        v4u xw[NT][2], yw[Y8 ? 1 : NT][2][4]; v2u yq[Y8 ? NT : 1][2][4];
#pragma unroll
        for (int u = 0; u < NT; ++u) { const int t = tb + u < T_ ? tb + u : T_ - 1; int sl[4];
#pragma unroll
            for (int k = 0; k < 4; ++k) sl[k] = p.inv[t * 4 + k];
#pragma unroll
            for (int j = 0; j < 2; ++j) { const int c = 8 * lane + 512 * j; xw[u][j] = *(const GAS v4u*)(xprev + (size_t)t * 1024 + c);
#pragma unroll
                for (int k = 0; k < 4; ++k) { if constexpr (Y8) yq[u][j][k] = *(const GAS v2u*)((const unsigned char*)p.yy + (size_t)sl[k] * 1024 + c); else yw[u][j][k] = *(const GAS v4u*)(p.yy + (size_t)sl[k] * 1024 + c); } } }
#pragma unroll
        for (int u = 0; u < NT; ++u) { const int t = tb + u; if (t >= T_) break;
            float v[16]; float s = 0.f;
#pragma unroll
            for (int j = 0; j < 2; ++j) { const v4u x4 = xw[u][j];
                float a[8] = {h2f(x4.x & 0xffff) * ALPHA_, h2f(x4.x >> 16) * ALPHA_, h2f(x4.y & 0xffff) * ALPHA_, h2f(x4.y >> 16) * ALPHA_, h2f(x4.z & 0xffff) * ALPHA_, h2f(x4.z >> 16) * ALPHA_, h2f(x4.w & 0xffff) * ALPHA_, h2f(x4.w >> 16) * ALPHA_};
#pragma unroll
                for (int k = 0; k < 4; ++k) {
                    if constexpr (Y8) { const v2u w8 = yq[u][j][k]; const f32x2v p0 = __builtin_amdgcn_cvt_pk_f32_fp8((int)w8.x, false), p1 = __builtin_amdgcn_cvt_pk_f32_fp8((int)w8.x, true), p2 = __builtin_amdgcn_cvt_pk_f32_fp8((int)w8.y, false), p3 = __builtin_amdgcn_cvt_pk_f32_fp8((int)w8.y, true);
                        a[0] += p0.x * 0.03125f; a[1] += p0.y * 0.03125f; a[2] += p1.x * 0.03125f; a[3] += p1.y * 0.03125f; a[4] += p2.x * 0.03125f; a[5] += p2.y * 0.03125f; a[6] += p3.x * 0.03125f; a[7] += p3.y * 0.03125f; }
                    else { const v4u w = yw[u][j][k];
                    a[0] += h2f(w.x & 0xffff); a[1] += h2f(w.x >> 16); a[2] += h2f(w.y & 0xffff); a[3] += h2f(w.y >> 16);
                    a[4] += h2f(w.z & 0xffff); a[5] += h2f(w.z >> 16); a[6] += h2f(w.w & 0xffff); a[7] += h2f(w.w >> 16); } }
#pragma unroll
                for (int q = 0; q < 8; ++q) { v[j * 8 + q] = a[q]; s += a[q]; } }
            const float mean = wave_sum(s) * (1.0f / 1024.0f); float qq = 0.f;
#pragma unroll
            for (int q = 0; q < 16; ++q) { v[q] -= mean; qq += v[q] * v[q]; }
            const float rstd = 1.0f / sqrtf(wave_sum(qq) * (1.0f / 1024.0f) + LN_EPS_);
#pragma unroll
            for (int j = 0; j < 2; ++j) {
                const int c = 8 * lane + 512 * j;
                const f32x4 ga = *(const GAS f32x4*)(gam + c), gb = *(const GAS f32x4*)(gam + c + 4), ba = *(const GAS f32x4*)(bet + c), bb = *(const GAS f32x4*)(bet + c + 4);
                f32x4 oa, ob;
                oa.x = v[j * 8 + 0] * rstd * ga.x + ba.x; oa.y = v[j * 8 + 1] * rstd * ga.y + ba.y; oa.z = v[j * 8 + 2] * rstd * ga.z + ba.z; oa.w = v[j * 8 + 3] * rstd * ga.w + ba.w;
                ob.x = v[j * 8 + 4] * rstd * gb.x + bb.x; ob.y = v[j * 8 + 5] * rstd * gb.y + bb.y; ob.z = v[j * 8 + 6] * rstd * gb.z + bb.z; ob.w = v[j * 8 + 7] * rstd * gb.w + bb.w;
                if (outf) { __builtin_nontemporal_store(oa, (GAS f32x4*)(outf + (size_t)t * 1024 + c)); __builtin_nontemporal_store(ob, (GAS f32x4*)(outf + (size_t)t * 1024 + c + 4)); }
                if (outh) { v4u w; w.x = pkh(oa.x, oa.y); w.y = pkh(oa.z, oa.w); w.z = pkh(ob.x, ob.y); w.w = pkh(ob.z, ob.w); *(GAS v4u*)(outh + (size_t)t * 1024 + c) = w; }
            } }
    }
}
struct CvJob { const float* src; h16* dst; int K, N, n_off, n_cnt, row_off, w1map, f8; };
__device__ __forceinline__ void cv_load(const CvJob& j, int item, int lane, float (&ld)[32]) {
    const int nblk = j.n_cnt / 32, kb = item / nblk, nb = item % nblk, k0 = 64 * kb, n0 = j.n_off + 32 * nb;
#pragma unroll
    for (int i = 0; i < 32; ++i) { const int kk = 2 * i + (lane >> 5); ld[i] = __builtin_nontemporal_load(j.src + (size_t)(k0 + kk) * j.N + n0 + (lane & 31)); }
}
__device__ __forceinline__ void cv_finish(const CvJob& j, LAS float* scr, int item, int lane, const float (&ld)[32]) {
    const int nblk = j.n_cnt / 32, kb = item / nblk, nb = item % nblk, k0 = 64 * kb, n0 = j.n_off + 32 * nb;
#pragma unroll
    for (int i = 0; i < 32; ++i) { const int kk = 2 * i + (lane >> 5); scr[kk * 33 + (lane & 31)] = ld[i]; }
    LDS_WAIT(); asm volatile("" ::: "memory");
    const int c = lane & 7;
#pragma unroll
    for (int q = 0; q < 4; ++q) { const int n = (lane >> 3) + 8 * q; const LAS float* s = scr + (8 * c) * 33 + n;
        const int nn = n0 + n - j.n_off; const int jj = nn & 1023;
        const long dr = j.w1map ? (long)(256 * (jj >> 7) + (nn >> 10) * 128 + (jj & 127)) : (long)(j.row_off + nn);
        if (j.f8) { int lo = 0, hi = 0;
            lo = __builtin_amdgcn_cvt_pk_fp8_f32(s[0 * 33] * 32.f, s[1 * 33] * 32.f, lo, false); lo = __builtin_amdgcn_cvt_pk_fp8_f32(s[2 * 33] * 32.f, s[3 * 33] * 32.f, lo, true);
            hi = __builtin_amdgcn_cvt_pk_fp8_f32(s[4 * 33] * 32.f, s[5 * 33] * 32.f, hi, false); hi = __builtin_amdgcn_cvt_pk_fp8_f32(s[6 * 33] * 32.f, s[7 * 33] * 32.f, hi, true);
            v2u o8; o8.x = (unsigned)lo; o8.y = (unsigned)hi; *(GAS v2u*)((unsigned char*)j.dst + (size_t)dr * j.K + k0 + 8 * c) = o8; }
        else { v4u o; o.x = pkh(s[0 * 33], s[1 * 33]); o.y = pkh(s[2 * 33], s[3 * 33]); o.z = pkh(s[4 * 33], s[5 * 33]); o.w = pkh(s[6 * 33], s[7 * 33]);
            *(GAS v4u*)(j.dst + (size_t)dr * j.K + k0 + 8 * c) = o; } }
    LDS_WAIT(); asm volatile("" ::: "memory");
}
__device__ __forceinline__ int cv_decode(const Params& p, int it, CvJob& j) {
    constexpr int J1 = 1024, J2 = 1024, J3 = 1024, J4 = 1024, J5 = 640, J6 = 512, I1 = 1024, I2 = 512;
    int r = it;
    if (r < J1) { j = CvJob{p.w_ret_in, p.wri_t, 1024, 6144, 0, 2048, 0, 0, 0}; }
    else if ((r -= J1) < J2) { j = CvJob{p.w_ret_in, p.wri_t, 1024, 6144, 4096, 2048, 2048, 0, 0}; }
    else if ((r -= J2) < J3) { j = CvJob{p.w_ret_in, p.wfm_t, 1024, 6144, 2048, 2048, 0, 0, 0}; }
    else if ((r -= J3) < J4) { j = CvJob{p.w_ret_out, p.wro_t, 2048, 1024, 0, 1024, 0, 0, 0}; }
    else if ((r -= J4) < J5) { j = CvJob{p.w_swa_in, p.wsi_t, 1024, 1280, 0, 1280, 0, 0, 0}; }
    else if ((r -= J5) < J6) { j = CvJob{p.w_swa_out, p.wso_t, 1024, 1024, 0, 1024, 0, 0, 0}; }
    else if ((r -= J6) < 64 * I1) { const int e = r / I1; r %= I1; if (e < F8_FROM) j = CvJob{p.w_exp_in + (size_t)e * 1024 * 2048, p.w1_t + (size_t)e * 2048 * 1024, 1024, 2048, 0, 2048, 0, 1, 0};
        else j = CvJob{p.w_exp_in + (size_t)e * 1024 * 2048, (h16*)(p.w1q + (size_t)e * 2048 * 1024), 1024, 2048, 0, 2048, 0, 1, 1}; }
    else { r -= 64 * I1; const int e = r / I2; r %= I2; if (e < F8_FROM) j = CvJob{p.w_exp_out + (size_t)e * 1024 * 1024, p.w2_t + (size_t)e * 1024 * 1024, 1024, 1024, 0, 1024, 0, 0, 0};
        else j = CvJob{p.w_exp_out + (size_t)e * 1024 * 1024, (h16*)(p.w2q + (size_t)e * 1024 * 1024), 1024, 1024, 0, 1024, 0, 0, 1}; }
    return r;
}
__device__ __forceinline__ void ph_prologue(const Params& p, Frame& F) {
    LAS float* scr = (LAS float*)(F.lds + RING_OFF + F.wave * 16384);
    const int gw = F.vcu * NWAVES + F.wave, NGW = F.G * NWAVES;
    constexpr int NITEMS = 1024 + 1024 + 1024 + 1024 + 640 + 512 + 64 * (1024 + 512);
    int it = gw; CvJob j0, j1; int r0 = 0, r1 = 0; float ld0[32], ld1[32];
    if (it < NITEMS) { r0 = cv_decode(p, it, j0); cv_load(j0, r0, F.lane, ld0); }
    while (it < NITEMS) {
        const int nit = it + NGW; const bool hn = nit < NITEMS;
        if (hn) { r1 = cv_decode(p, nit, j1); cv_load(j1, r1, F.lane, ld1); }
        cv_finish(j0, scr, r0, F.lane, ld0);
        j0 = j1; r0 = r1;
#pragma unroll
        for (int i = 0; i < 32; ++i) ld0[i] = ld1[i];
        it = nit;
    }
    ph_cvt_rows(p.x, p.xh0, (size_t)T_ * D_, F);
}

struct DenseSched {
    const char* A; const char* B; size_t a_tile_bytes, b_tile_bytes; int nM, nN, nwg, G, c;
    __device__ __forceinline__ void init(const void* A_, int lda, const void* B_, int ldb, int M, int N, int G_, int c_, int rot = 0  ) {
        A = (const char*)A_; B = (const char*)B_; a_tile_bytes = (size_t)256 * lda * 2; b_tile_bytes = (size_t)256 * ldb * 2; nM = M / 256; nN = N / 256; nwg = nM * nN; G = G_; c = (c_ + G_ - rot) % G_; }
    __device__ __forceinline__ bool next(int i, pg::Unit& u) const {
        const long L = (long)i * G + c; if (L >= nwg) return false;
        int wgid = (int)L; { const int q = nwg / 8, r = nwg % 8, xcd = wgid % 8, off = wgid / 8; wgid = (xcd < r ? xcd * (q + 1) : r * (q + 1) + (xcd - r) * q) + off; }
        const int nig = 8 * nN, gid = wgid / nig, fm = gid * 8, gsz = (nM - fm) < 8 ? (nM - fm) : 8;
        u.pm = fm + ((wgid % nig) % gsz); u.pn = (wgid % nig) / gsz; u.e = 0; u.x = 0;
        u.a = A + (size_t)u.pm * a_tile_bytes; u.b = B + (size_t)u.pn * b_tile_bytes; return true;
    }
    __device__ __forceinline__ unsigned arow(const pg::Unit&, int) const { return 0u; }
};
struct EpiResid : pg::EpiBase {
    static constexpr bool PERM = true;
    const h16* __restrict__ xprevh; const float* __restrict__ bias; h16* __restrict__ yh;
    __device__ __forceinline__ void operator()(const pg::Acc& acc, const pg::Unit& u, int wr, int wc, int fr, int fq) const { EPI_OPAQUE();
        f32x4 bv[2][2];
#pragma unroll
        for (int bj = 0; bj < 2; ++bj) { const int col = u.pn * 256 + bj * 128 + wc * 32 + 8 * fq;
            bv[bj][0] = bias ? *(const f32x4*)(bias + col) : (f32x4){0.f, 0.f, 0.f, 0.f}; bv[bj][1] = bias ? *(const f32x4*)(bias + col + 4) : (f32x4){0.f, 0.f, 0.f, 0.f}; }
#pragma unroll
        for (int ai = 0; ai < 2; ++ai) {
            v4u xw[4][2];
#pragma unroll
            for (int m = 0; m < 4; ++m)
#pragma unroll
                for (int bj = 0; bj < 2; ++bj) { const size_t row = (size_t)u.pm * 256 + ai * 128 + wr * 64 + m * 16 + fr; xw[m][bj] = *(const v4u*)(xprevh + row * 1024 + u.pn * 256 + bj * 128 + wc * 32 + 8 * fq); }
#pragma unroll
            for (int m = 0; m < 4; ++m)
#pragma unroll
                for (int bj = 0; bj < 2; ++bj) { const size_t row = (size_t)u.pm * 256 + ai * 128 + wr * 64 + m * 16 + fr; const int col = u.pn * 256 + bj * 128 + wc * 32 + 8 * fq; const v4u x4 = xw[m][bj];
                    const f32x4 a = (f32x4){h2f(x4.x & 0xffff), h2f(x4.x >> 16), h2f(x4.y & 0xffff), h2f(x4.y >> 16)} * ALPHA_ + acc[ai][bj][m][0] + bv[bj][0];
                    const f32x4 b = (f32x4){h2f(x4.z & 0xffff), h2f(x4.z >> 16), h2f(x4.w & 0xffff), h2f(x4.w >> 16)} * ALPHA_ + acc[ai][bj][m][1] + bv[bj][1];
                    v4u w; w.x = pkh(a[0], a[1]); w.y = pkh(a[2], a[3]); w.z = pkh(b[0], b[1]); w.w = pkh(b[2], b[3]);
                    *(v4u*)(yh + row * 1024 + col) = w; } }
    }
};
struct EpiF32 : pg::EpiBase {
    const float* bias; float* c; int ldc;
    __device__ __forceinline__ void operator()(const pg::Acc& acc, const pg::Unit& u, int wr, int wc, int fr, int fq) const { EPI_OPAQUE();
#pragma unroll
        for (int ai = 0; ai < 2; ++ai)
#pragma unroll
            for (int m = 0; m < 4; ++m) { const size_t row = (size_t)u.pm * 256 + ai * 128 + wr * 64 + m * 16 + fr;
#pragma unroll
                for (int bj = 0; bj < 2; ++bj)
#pragma unroll
                    for (int n = 0; n < 2; ++n) { const int col = u.pn * 256 + bj * 128 + wc * 32 + n * 16 + 4 * fq;
                        f32x4 o = acc[ai][bj][m][n]; if (bias) o += *(const f32x4*)(bias + col);
                        *(f32x4*)(c + row * ldc + col) = o; } }
    }
};

constexpr int XROW16 = 1032;
typedef _Float16 f16x8r __attribute__((ext_vector_type(8)));
__device__ __forceinline__ void ph_ln_router(const Params& p, Frame& F, const float* gam, const float* bet, const float* wr, const float* br, unsigned char* xq, const int pmode = 0  ) {
    LAS unsigned short* X = (LAS unsigned short*)(F.lds);
    LAS float* PART = (LAS float*)(X + 32 * XROW16);
    LAS int* se = (LAS int*)(PART + 8 * 32 * 32);
    LAS float* LG = (LAS float*)(se + 512);
    LAS float* TV = LG + 1024;
    LAS int* cnt = (LAS int*)(TV + 128);
    int tid_o = F.tid; asm volatile("" : "+v"(tid_o));
    const int lane = tid_o & 63, w = F.wave, l15 = lane & 15, kg = lane >> 4;
    f16x8r wh[2][4], wl[2][4];
#pragma unroll
    for (int nt = 0; nt < 2; ++nt)
#pragma unroll
        for (int s = 0; s < 4; ++s) {
#pragma unroll
            for (int j = 0; j < 8; ++j) { const float v = wr[(size_t)(128 * w + 32 * s + 8 * kg + j) * 32 + 16 * nt + l15]; const _Float16 h = (_Float16)v; wh[nt][s][j] = h; wl[nt][s][j] = (_Float16)(v - (float)h); } }
    const float bias_e = br[tid_o & 31];
    for (int cc = blockIdx.x; cc < T_ / 128; cc += F.G) {
        v4u pre[4][2];
#pragma unroll
        for (int r = 0; r < 4; ++r)
#pragma unroll
            for (int j = 0; j < 2; ++j) pre[r][j] = *(const GAS v4u*)(p.yh + (size_t)(cc * 128 + 4 * w + r) * 1024 + 8 * lane + 512 * j);
        for (int blk = 0; blk < 4; ++blk) {
            const int t0 = cc * 128 + blk * 32;
            v4u cur[4][2];
#pragma unroll
            for (int r = 0; r < 4; ++r)
#pragma unroll
                for (int j = 0; j < 2; ++j) { cur[r][j] = pre[r][j]; if (blk < 3) pre[r][j] = *(const GAS v4u*)(p.yh + (size_t)(t0 + 32 + 4 * w + r) * 1024 + 8 * lane + 512 * j); }
#pragma unroll
            for (int r = 0; r < 4; ++r) {
                const int tl = 4 * w + r; const size_t t = (size_t)(t0 + tl);
                f32x4 v[4]; float s = 0.f;
#pragma unroll
                for (int j = 0; j < 2; ++j) { const v4u pw = cur[r][j]; v[2 * j] = (f32x4){h2f(pw.x & 0xffff), h2f(pw.x >> 16), h2f(pw.y & 0xffff), h2f(pw.y >> 16)}; v[2 * j + 1] = (f32x4){h2f(pw.z & 0xffff), h2f(pw.z >> 16), h2f(pw.w & 0xffff), h2f(pw.w >> 16)}; }
#pragma unroll
                for (int j = 0; j < 4; ++j) s += (v[j].x + v[j].y) + (v[j].z + v[j].w);
                const float mean = wave_sum(s) * (1.0f / 1024.0f); float q = 0.f;
#pragma unroll
                for (int j = 0; j < 4; ++j) { v[j] = v[j] - mean; q += (v[j].x * v[j].x + v[j].y * v[j].y) + (v[j].z * v[j].z + v[j].w * v[j].w); }
                const float rstd = 1.0f / sqrtf(wave_sum(q) * (1.0f / 1024.0f) + LN_EPS_);
#pragma unroll
                for (int j = 0; j < 2; ++j) { const int c = 8 * lane + 512 * j;
                    const f32x4 o0 = v[2 * j] * rstd * *(const GAS f32x4*)(gam + c) + *(const GAS f32x4*)(bet + c), o1 = v[2 * j + 1] * rstd * *(const GAS f32x4*)(gam + c + 4) + *(const GAS f32x4*)(bet + c + 4);
                    v4u hw; hw.x = pkh(o0.x, o0.y); hw.y = pkh(o0.z, o0.w); hw.z = pkh(o1.x, o1.y); hw.w = pkh(o1.z, o1.w);
                    *(GAS v4u*)(p.x1h + t * 1024 + c) = hw;
                    if (xq) { int qa = 0, qb = 0; qa = __builtin_amdgcn_cvt_pk_fp8_f32(o0.x, o0.y, qa, false); qa = __builtin_amdgcn_cvt_pk_fp8_f32(o0.z, o0.w, qa, true); qb = __builtin_amdgcn_cvt_pk_fp8_f32(o1.x, o1.y, qb, false); qb = __builtin_amdgcn_cvt_pk_fp8_f32(o1.z, o1.w, qb, true);
                        v2u q8; q8.x = (unsigned)qa; q8.y = (unsigned)qb; *(GAS v2u*)(xq + t * 1024 + c) = q8; }
                    *(LAS v4u*)(X + tl * XROW16 + c) = hw; }
            }
            if (pmode == 1) continue;
            __syncthreads();
            {
                f32x4 acc[2][2];
#pragma unroll
                for (int mt = 0; mt < 2; ++mt)
#pragma unroll
                    for (int nt = 0; nt < 2; ++nt) acc[mt][nt] = (f32x4){0.f, 0.f, 0.f, 0.f};
#pragma unroll
                for (int s = 0; s < 4; ++s)
#pragma unroll
                    for (int mt = 0; mt < 2; ++mt) { const f16x8r a = *(const LAS f16x8r*)(X + (16 * mt + l15) * XROW16 + 128 * w + 32 * s + 8 * kg);
#pragma unroll
                        for (int nt = 0; nt < 2; ++nt) { acc[mt][nt] = __builtin_amdgcn_mfma_f32_16x16x32_f16(a, wh[nt][s], acc[mt][nt], 0, 0, 0); acc[mt][nt] = __builtin_amdgcn_mfma_f32_16x16x32_f16(a, wl[nt][s], acc[mt][nt], 0, 0, 0); } }
#pragma unroll
                for (int mt = 0; mt < 2; ++mt)
#pragma unroll
                    for (int nt = 0; nt < 2; ++nt)
#pragma unroll
                        for (int r = 0; r < 4; ++r) PART[(w * 32 + 16 * mt + 4 * kg + r) * 32 + 16 * nt + l15] = acc[mt][nt][r];
            }
            __syncthreads();
#pragma unroll
            for (int ps = 0; ps < 2; ++ps) {
                const int tok = (tid_o >> 5) + 16 * ps, e = tid_o & 31; float val = bias_e;
#pragma unroll
                for (int q = 0; q < 8; ++q) val += PART[(q * 32 + tok) * 32 + e];
                LG[tok * 32 + e] = val;
                LDS_WAIT(); asm volatile("" ::: "memory");
                int rank = 0;
#pragma unroll
                for (int q4 = 0; q4 < 8; ++q4) { const f32x4 o = *(const LAS f32x4*)(LG + tok * 32 + 4 * q4);
                    rank += ((o.x > val) || (o.x == val && 4 * q4 < e)) ? 1 : 0; rank += ((o.y > val) || (o.y == val && 4 * q4 + 1 < e)) ? 1 : 0;
                    rank += ((o.z > val) || (o.z == val && 4 * q4 + 2 < e)) ? 1 : 0; rank += ((o.w > val) || (o.w == val && 4 * q4 + 3 < e)) ? 1 : 0; }
                const int t = t0 + tok;
                if (rank < 4) { TV[tok * 4 + rank] = val; p.top_e[t * 4 + rank] = e; se[(blk * 32 + tok) * 4 + rank] = e; }
                LDS_WAIT(); asm volatile("" ::: "memory");
                if (e < 4) { const f32x4 tv = *(const LAS f32x4*)(TV + tok * 4);
                    const float e1 = __expf(tv.y - tv.x), e2 = __expf(tv.z - tv.x), e3 = __expf(tv.w - tv.x); const float inv = 1.0f / (1.0f + e1 + e2 + e3);
                    p.top_g[t * 4 + e] = (e == 0 ? 1.0f : (e == 1 ? e1 : (e == 2 ? e2 : e3))) * inv; }
            }
        }
        __syncthreads();
        if (pmode == 0) {
            const int j = tid_o; const int e = se[j]; int r = 0;
            if (j < 32) cnt[j] = 0;
            __syncthreads();
#pragma unroll 8
            for (int q4 = 0; q4 < 128; ++q4) { const v4u sv = *(const LAS v4u*)(se + 4 * q4);
                r += ((int)sv.x == e && 4 * q4 < j) ? 1 : 0; r += ((int)sv.y == e && 4 * q4 + 1 < j) ? 1 : 0; r += ((int)sv.z == e && 4 * q4 + 2 < j) ? 1 : 0; r += ((int)sv.w == e && 4 * q4 + 3 < j) ? 1 : 0; }
            p.rankp[cc * 512 + j] = r;
            atomicAdd((int*)(cnt + e), 1);
            __syncthreads();
            if (j < 32) p.wg_cnt[cc * 32 + j] = cnt[j];
        }
        __syncthreads();
    }
}

__device__ __forceinline__ float lg2gamma(int h) { return h == 0 ? -0.04580368961312479f : (h == 1 ? -0.02272007650008353f : (h == 2 ? -0.011315313227834146f : -0.005646563141142063f)); }
struct EpiInTok : pg::EpiBase {
    static constexpr bool PERM = true;
    h16 *q, *k, *sg;
    __device__ __forceinline__ void operator()(const pg::Acc& acc, const pg::Unit& u, int wr, int wc, int fr, int fq) const { EPI_OPAQUE();
        const int pn = u.pn; h16* dst; int ld, cb; int mode;
        if (pn < 4) { dst = q; ld = 1024; cb = pn * 256; mode = 0; } else if (pn < 8) { dst = k; ld = 1024; cb = (pn - 4) * 256; mode = 1; } else { dst = sg; ld = 2048; cb = (pn - 8) * 256; mode = 2; }
#pragma unroll
        for (int ai = 0; ai < 2; ++ai)
#pragma unroll
            for (int m = 0; m < 4; ++m) { const size_t row = (size_t)u.pm * 256 + ai * 128 + wr * 64 + m * 16 + fr;
#pragma unroll
                for (int bj = 0; bj < 2; ++bj) { const int c0 = cb + bj * 128 + wc * 32 + 8 * fq; float r[8];
#pragma unroll
                    for (int n = 0; n < 2; ++n)
#pragma unroll
                        for (int j = 0; j < 4; ++j) { float v = acc[ai][bj][m][n][j];
                            if (mode == 1) v *= 0.0625f;
                            if (mode == 2) v = v * __builtin_amdgcn_rcpf(1.0f + __builtin_amdgcn_exp2f(-1.4426950408889634f * v));
                            r[n * 4 + j] = v; }
                    v4u w; w.x = pkh(r[0], r[1]); w.y = pkh(r[2], r[3]); w.z = pkh(r[4], r[5]); w.w = pkh(r[6], r[7]);
                    *(v4u*)(dst + row * ld + c0) = w; } }
    }
};
struct EpiInFeat : pg::EpiBase {
    static constexpr bool PERM = true;
    h16* __restrict__ vt;
    __device__ __forceinline__ void operator()(const pg::Acc& acc, const pg::Unit& u, int wr, int wc, int fr, int fq) const { EPI_OPAQUE();
        h16* dst = vt + ((size_t)u.pn * 2048 + (size_t)u.pm * 256) * 256;
#pragma unroll
        for (int bj = 0; bj < 2; ++bj) { const int c0 = bj * 128 + wc * 32 + 8 * fq;
#pragma unroll
            for (int ai = 0; ai < 2; ++ai)
#pragma unroll
                for (int m = 0; m < 4; ++m) { const size_t row = (size_t)(ai * 128 + wr * 64 + m * 16 + fr);
                    const f32x4 a = acc[ai][bj][m][0], b = acc[ai][bj][m][1];
                    v4u w; w.x = pkh(a[0], a[1]); w.y = pkh(a[2], a[3]); w.z = pkh(b[0], b[1]); w.w = pkh(b[2], b[3]);
                    *(v4u*)(dst + row * 256 + c0) = w; } }
    }
};
constexpr int KT_PITCH = 520;
__device__ __forceinline__ void ph_ktranspose(const Params& p, Frame& F) {
    LAS unsigned char* img = F.lds;
    for (int item = F.vcu; item < 512; item += F.G) {
        const int chunk = item >> 2, h = item & 3;
        __syncthreads();
        v4u ld[16];
#pragma unroll
        for (int i = 0; i < 16; ++i) { const int pc = F.tid + 512 * i, row = pc >> 5, c16 = pc & 31; ld[i] = *(const GAS v4u*)(p.k + ((size_t)(chunk * 256 + row)) * 1024 + h * 256 + c16 * 8); }
#pragma unroll
        for (int i = 0; i < 16; ++i) { const int pc = F.tid + 512 * i, row = pc >> 5, c16 = pc & 31; v2u lo; lo.x = ld[i].x; lo.y = ld[i].y; v2u hi; hi.x = ld[i].z; hi.y = ld[i].w;
            *(LAS v2u*)(img + row * KT_PITCH + c16 * 16) = lo; *(LAS v2u*)(img + row * KT_PITCH + c16 * 16 + 8) = hi; }
        __syncthreads();
        const int tg = F.tid & 31; const float lg = lg2gamma(h); float sc[8];
#pragma unroll
        for (int j = 0; j < 8; ++j) sc[j] = __builtin_amdgcn_exp2f((float)(255 - (8 * tg + j)) * lg);
        h16* dst = p.kdt + ((size_t)chunk * 1024 + h * 256) * 256;
#pragma unroll 4
        for (int r = 0; r < 16; ++r) { const int dk = (F.tid >> 5) + 16 * r; float v[8];
#pragma unroll
            for (int j = 0; j < 8; ++j) v[j] = h2f(*(const LAS unsigned short*)(img + (8 * tg + j) * KT_PITCH + dk * 2)) * sc[j];
            v4u w; w.x = pkh(v[0], v[1]); w.y = pkh(v[2], v[3]); w.z = pkh(v[4], v[5]); w.w = pkh(v[6], v[7]);
            *(GAS v4u*)(dst + (size_t)dk * 256 + 8 * tg) = w; }
    }
    __syncthreads();
}
struct RaSched {
    const h16 *q, *k; int G, c;
    __device__ __forceinline__ bool next(int i, pg::Unit& u) const {
        const int L = i * G + c; if (L >= 512) return false;
        const int bh = L >> 5, cch = L & 31, b = bh >> 2, h = bh & 3; const size_t off = ((size_t)(b * 8192 + cch * 256) * 1024 + h * 256) * 2;
        u.a = (const char*)q + off; u.b = (const char*)k + off; u.pm = L; u.pn = 0; u.e = L; u.x = h; return true; }
    __device__ __forceinline__ unsigned arow(const pg::Unit&, int) const { return 0u; }
};
struct EpiPP : pg::EpiBase {
    static constexpr bool PERM = true;
    h16* pp;
    __device__ __forceinline__ void operator()(const pg::Acc& acc, const pg::Unit& u, int wr, int wc, int fr, int fq) const { EPI_OPAQUE();
        const float lg = lg2gamma(u.x); h16* dst = pp + (size_t)u.e * 65536;
#pragma unroll
        for (int bj = 0; bj < 2; ++bj) { const int c0 = bj * 128 + wc * 32 + 8 * fq; float sc[8];
#pragma unroll
            for (int j = 0; j < 8; ++j) sc[j] = __builtin_amdgcn_exp2f(-(float)(c0 + j + 1) * lg);
#pragma unroll
            for (int ai = 0; ai < 2; ++ai)
#pragma unroll
                for (int m = 0; m < 4; ++m) { const int i = ai * 128 + wr * 64 + m * 16 + fr; float r[8];
#pragma unroll
                    for (int n = 0; n < 2; ++n)
#pragma unroll
                        for (int j = 0; j < 4; ++j) r[n * 4 + j] = (c0 + n * 4 + j <= i) ? acc[ai][bj][m][n][j] * sc[n * 4 + j] : 0.f;
                    v4u w; w.x = pkh(r[0], r[1]); w.y = pkh(r[2], r[3]); w.z = pkh(r[4], r[5]); w.w = pkh(r[6], r[7]);
                    *(v4u*)(dst + (size_t)i * 256 + c0) = w; } }
    }
};
struct R1Sched {
    const h16 *vt, *kdt; int nsub, G, c;
    __device__ __forceinline__ bool next(int i, pg::Unit& u) const {
        const int item = (i / nsub) * G + c, j = i % nsub; if (item >= 256) return false;
        if (nsub == 4 && ((item >> 1) & 7) == 7) return false;
        const int pm = item & 1, seg = (item >> 1) & 7, bh = item >> 4, b = bh >> 2, h = bh & 3; const size_t chunk = (size_t)b * 32 + seg * 4 + j;
        u.a = (const char*)vt + ((chunk * 2048 + h * 512 + pm * 256) * 256) * 2; u.b = (const char*)kdt + ((chunk * 1024 + h * 256) * 256) * 2;
        u.pm = pm; u.pn = j; u.e = item; u.x = h; return true; }
    __device__ __forceinline__ unsigned arow(const pg::Unit&, int) const { return 0u; }
};
__device__ __forceinline__ void acc_scale(pg::Acc& acc, float s) {
#pragma unroll
    for (int a = 0; a < 2; ++a)
#pragma unroll
        for (int b = 0; b < 2; ++b)
#pragma unroll
            for (int m = 0; m < 4; ++m)
#pragma unroll
                for (int n = 0; n < 2; ++n) acc[a][b][m][n] = acc[a][b][m][n] * s;
}
struct EpiSegTot : pg::EpiBase {
    static constexpr bool PERM = true;
    float* L;
    __device__ __forceinline__ void operator()(pg::Acc& acc, const pg::Unit& u, int wr, int wc, int fr, int fq) const { EPI_OPAQUE();
        if (u.pn < 3) { acc_scale(acc, __builtin_amdgcn_exp2f(256.0f * lg2gamma(u.x))); return; }
        float* dst = L + ((size_t)(u.e >> 1) * 512 + u.pm * 256) * 256;
#pragma unroll
        for (int ai = 0; ai < 2; ++ai)
#pragma unroll
            for (int m = 0; m < 4; ++m) { const int r = ai * 128 + wr * 64 + m * 16 + fr;
#pragma unroll
                for (int bj = 0; bj < 2; ++bj) { const int c0 = bj * 128 + wc * 32 + 8 * fq;
                    *(f32x4*)(dst + (size_t)r * 256 + c0) = acc[ai][bj][m][0]; *(f32x4*)(dst + (size_t)r * 256 + c0 + 4) = acc[ai][bj][m][1]; } }
    }
    __device__ __forceinline__ void reinit(pg::Acc& acc, const pg::Unit& cur, const pg::Unit& nxt, int, int, int, int) const { if (nxt.e != cur.e) pg::acc_zero(acc); }
};
struct EpiSnap : pg::EpiBase {
    static constexpr bool PERM = true;
    const float* L; h16* st;
    __device__ __forceinline__ void snap(const pg::Acc& acc, const pg::Unit& u, int j, int wr, int wc, int fr, int fq) const { EPI_OPAQUE();
        const int seg = (u.e >> 1) & 7, bh = u.e >> 4; h16* dst = st + ((size_t)(bh * 32 + seg * 4 + j) * 512 + u.pm * 256) * 256;
#pragma unroll
        for (int ai = 0; ai < 2; ++ai)
#pragma unroll
            for (int m = 0; m < 4; ++m) { const int r = ai * 128 + wr * 64 + m * 16 + fr;
#pragma unroll
                for (int bj = 0; bj < 2; ++bj) { const int c0 = bj * 128 + wc * 32 + 8 * fq; const f32x4 a = acc[ai][bj][m][0], b = acc[ai][bj][m][1];
                    v4u w; w.x = pkh(a[0], a[1]); w.y = pkh(a[2], a[3]); w.z = pkh(b[0], b[1]); w.w = pkh(b[2], b[3]);
                    *(v4u*)(dst + (size_t)r * 256 + c0) = w; } }
    }
    __device__ __forceinline__ void load(pg::Acc& acc, const pg::Unit& u, int wr, int wc, int fr, int fq) const { EPI_OPAQUE();
        const float* src = L + ((size_t)(u.e >> 1) * 512 + u.pm * 256) * 256;
#pragma unroll
        for (int ai = 0; ai < 2; ++ai)
#pragma unroll
            for (int m = 0; m < 4; ++m) { const int r = ai * 128 + wr * 64 + m * 16 + fr;
#pragma unroll
                for (int bj = 0; bj < 2; ++bj) { const int c0 = bj * 128 + wc * 32 + 8 * fq;
                    acc[ai][bj][m][0] = *(const f32x4*)(src + (size_t)r * 256 + c0); acc[ai][bj][m][1] = *(const f32x4*)(src + (size_t)r * 256 + c0 + 4); } }
    }
    __device__ __forceinline__ void init(pg::Acc& acc, const pg::Unit& u, int wr, int wc, int fr, int fq) const { EPI_OPAQUE(); load(acc, u, wr, wc, fr, fq); snap(acc, u, 0, wr, wc, fr, fq); acc_scale(acc, __builtin_amdgcn_exp2f(256.0f * lg2gamma(u.x))); }
    __device__ __forceinline__ void operator()(pg::Acc& acc, const pg::Unit& u, int wr, int wc, int fr, int fq) const { EPI_OPAQUE(); snap(acc, u, u.pn + 1, wr, wc, fr, fq); }
    __device__ __forceinline__ void reinit(pg::Acc& acc, const pg::Unit& cur, const pg::Unit& nxt, int wr, int wc, int fr, int fq) const { EPI_OPAQUE();
        if (nxt.e != cur.e) { load(acc, nxt, wr, wc, fr, fq); snap(acc, nxt, 0, wr, wc, fr, fq); }
        acc_scale(acc, __builtin_amdgcn_exp2f(256.0f * lg2gamma(nxt.x))); }
};
__device__ __forceinline__ void ph_carry(float* L, Frame& F) {
    const size_t n = (size_t)16 * 131072;
    int tid_o = F.tid; asm volatile("" : "+v"(tid_o));
    for (size_t i = ((size_t)blockIdx.x * 512 + tid_o) * 4; i < n; i += (size_t)F.G * 512 * 4) {
        const int bh = (int)(i >> 17); const size_t el = i & 131071; const float g = __builtin_amdgcn_exp2f(1024.0f * lg2gamma(bh & 3));
        f32x4 s = {0.f, 0.f, 0.f, 0.f}, l[8];
#pragma unroll
        for (int sgm = 0; sgm < 8; ++sgm) l[sgm] = *(const GAS f32x4*)(L + ((size_t)(bh * 8 + sgm) << 17) + el);
#pragma unroll
        for (int sgm = 0; sgm < 8; ++sgm) { *(GAS f32x4*)(L + ((size_t)(bh * 8 + sgm) << 17) + el) = s; s = s * g + l[sgm]; }
    }
}
struct R2Sched {
    const h16 *pp, *vt, *q, *st; int G, c;
    __device__ __forceinline__ bool next(int i, pg::Unit& u) const {
        const int ch = (i >> 2) * G + c, pn = (i >> 1) & 1, x = i & 1; if (ch >= 512) return false;
        const int cch = ch & 31, bh = ch >> 5, b = bh >> 2, h = bh & 3; const size_t tok0 = (size_t)b * 8192 + cch * 256;
        if (x == 0) { u.a = (const char*)pp + (size_t)ch * 65536 * 2; u.b = (const char*)vt + (((tok0 >> 8) * 2048 + h * 512 + pn * 256) * 256) * 2; }
        else { u.a = (const char*)q + (tok0 * 1024 + h * 256) * 2; u.b = (const char*)st + ((size_t)ch * 512 + pn * 256) * 256 * 2; }
        u.pm = ch; u.pn = pn; u.e = (int)tok0; u.x = x; return true; }
    __device__ __forceinline__ unsigned arow(const pg::Unit&, int) const { return 0u; }
};
struct EpiRetOut : pg::EpiBase {
    static constexpr bool PERM = true;
    h16* __restrict__ o; const h16* __restrict__ sg; h16* __restrict__ og;
    __device__ __forceinline__ void operator()(const pg::Acc& acc, const pg::Unit& u, int wr, int wc, int fr, int fq) const { EPI_OPAQUE();
        if (u.x == 0) return;
        const int h = (u.pm >> 5) & 3; const float lg = lg2gamma(h);
#pragma unroll
        for (int ai = 0; ai < 2; ++ai)
#pragma unroll
            for (int m = 0; m < 4; ++m) { const int i = ai * 128 + wr * 64 + m * 16 + fr; const float qd = __builtin_amdgcn_exp2f((float)(i + 1) * lg);
                h16* dst = o + (size_t)(u.e + i) * 2048 + h * 512 + u.pn * 256;
#pragma unroll
                for (int bj = 0; bj < 2; ++bj) { const int c0 = bj * 128 + wc * 32 + 8 * fq; const f32x4 a = acc[ai][bj][m][0] * qd, b = acc[ai][bj][m][1] * qd;
                    v4u w; w.x = pkh(a[0], a[1]); w.y = pkh(a[2], a[3]); w.z = pkh(b[0], b[1]); w.w = pkh(b[2], b[3]);
                    *(v4u*)(dst + c0) = w; } }
        if (u.pn == 0) return;
        asm volatile("s_waitcnt vmcnt(0)" ::: "memory");
        __builtin_amdgcn_s_barrier(); asm volatile("" ::: "memory");
        const int wid = __builtin_amdgcn_readfirstlane((int)threadIdx.x >> 6), lane = (fq << 4) | fr;
#pragma unroll 1
        for (int r0 = 0; r0 < 32; r0 += 8) {
            v4u ow[8], gv[8];
#pragma unroll
            for (int q = 0; q < 8; ++q) { const size_t off = (size_t)(u.e + 32 * wid + r0 + q) * 2048 + h * 512 + 8 * lane; ow[q] = *(const GAS v4u*)(o + off); gv[q] = *(const GAS v4u*)(sg + off); }
#pragma unroll
            for (int q = 0; q < 8; ++q) { const size_t off = (size_t)(u.e + 32 * wid + r0 + q) * 2048 + h * 512 + 8 * lane; const v4u o4 = ow[q], g4 = gv[q];
                float v[8] = {h2f(o4.x & 0xffff), h2f(o4.x >> 16), h2f(o4.y & 0xffff), h2f(o4.y >> 16), h2f(o4.z & 0xffff), h2f(o4.z >> 16), h2f(o4.w & 0xffff), h2f(o4.w >> 16)};
                const float g[8] = {h2f(g4.x & 0xffff), h2f(g4.x >> 16), h2f(g4.y & 0xffff), h2f(g4.y >> 16), h2f(g4.z & 0xffff), h2f(g4.z >> 16), h2f(g4.w & 0xffff), h2f(g4.w >> 16)};
                float s = 0.f;
#pragma unroll
                for (int j = 0; j < 8; ++j) s += v[j];
                const float mean = wave_sum(s) * (1.0f / 512.0f); float qq = 0.f;
#pragma unroll
                for (int j = 0; j < 8; ++j) { v[j] -= mean; qq += v[j] * v[j]; }
                const float rstd = 1.0f / sqrtf(wave_sum(qq) * (1.0f / 512.0f) + 1e-6f);
                v4u w; w.x = pkh(g[0] * v[0] * rstd, g[1] * v[1] * rstd); w.y = pkh(g[2] * v[2] * rstd, g[3] * v[3] * rstd); w.z = pkh(g[4] * v[4] * rstd, g[5] * v[5] * rstd); w.w = pkh(g[6] * v[6] * rstd, g[7] * v[7] * rstd);
                *(GAS v4u*)(og + off) = w; }
        }
    }
    __device__ __forceinline__ void reinit(pg::Acc& acc, const pg::Unit&, const pg::Unit& nxt, int, int, int, int) const { if (nxt.x == 0) pg::acc_zero(acc); }
};
__device__ __forceinline__ void ph_gn_gate(const Params& p, Frame& F) {
    const int gw = F.vcu * NWAVES + F.wave, NGW = F.G * NWAVES, lane = F.lane;
    for (int it0 = gw * 4; it0 < T_ * 4; it0 += NGW * 4) {
        v4u ow[4], gv[4];
#pragma unroll
        for (int u = 0; u < 4; ++u) { const size_t off = (size_t)(it0 + u) * 512 + 8 * lane; ow[u] = *(const GAS v4u*)(p.o + off); gv[u] = *(const GAS v4u*)(p.sg + off); }
#pragma unroll
        for (int u = 0; u < 4; ++u) { const size_t off = (size_t)(it0 + u) * 512 + 8 * lane; const v4u o4 = ow[u], g4 = gv[u];
            float v[8] = {h2f(o4.x & 0xffff), h2f(o4.x >> 16), h2f(o4.y & 0xffff), h2f(o4.y >> 16), h2f(o4.z & 0xffff), h2f(o4.z >> 16), h2f(o4.w & 0xffff), h2f(o4.w >> 16)};
            const float g[8] = {h2f(g4.x & 0xffff), h2f(g4.x >> 16), h2f(g4.y & 0xffff), h2f(g4.y >> 16), h2f(g4.z & 0xffff), h2f(g4.z >> 16), h2f(g4.w & 0xffff), h2f(g4.w >> 16)};
            float s = 0.f;
#pragma unroll
            for (int j = 0; j < 8; ++j) s += v[j];
            const float mean = wave_sum(s) * (1.0f / 512.0f); float q = 0.f;
#pragma unroll
            for (int j = 0; j < 8; ++j) { v[j] -= mean; q += v[j] * v[j]; }
            const float rstd = 1.0f / sqrtf(wave_sum(q) * (1.0f / 512.0f) + 1e-6f);
            v4u w; w.x = pkh(g[0] * v[0] * rstd, g[1] * v[1] * rstd); w.y = pkh(g[2] * v[2] * rstd, g[3] * v[3] * rstd); w.z = pkh(g[4] * v[4] * rstd, g[5] * v[5] * rstd); w.w = pkh(g[6] * v[6] * rstd, g[7] * v[7] * rstd);
            *(GAS v4u*)(p.og + off) = w; }
    }
}
constexpr float SWA_C2 = 0.125f * 1.4426950408889634f;
struct EpiSwaTok : pg::EpiBase {
    static constexpr bool PERM = true;
    h16 *sq, *skv; const float* bias;
    __device__ __forceinline__ void operator()(const pg::Acc& acc, const pg::Unit& u, int wr, int wc, int fr, int fq) const { EPI_OPAQUE();
        const bool isq = u.pn < 4; h16* dst = isq ? sq : skv; const int ld = isq ? 1024 : 256, cb = isq ? u.pn * 256 : 0; const float sc = isq ? SWA_C2 : 1.0f;
#pragma unroll
        for (int bj = 0; bj < 2; ++bj) { const int ct = bj * 128 + wc * 32 + 8 * fq; const float* bp = bias + u.pn * 256 + ct;
            const f32x4 b0 = *(const f32x4*)bp, b1 = *(const f32x4*)(bp + 4);
#pragma unroll
            for (int ai = 0; ai < 2; ++ai)
#pragma unroll
                for (int m = 0; m < 4; ++m) { const size_t row = (size_t)u.pm * 256 + ai * 128 + wr * 64 + m * 16 + fr;
                    const f32x4 a = (acc[ai][bj][m][0] + b0) * sc, b = (acc[ai][bj][m][1] + b1) * sc;
                    v4u w; w.x = pkh(a[0], a[1]); w.y = pkh(a[2], a[3]); w.z = pkh(b[0], b[1]); w.w = pkh(b[2], b[3]);
                    *(v4u*)(dst + row * ld + cb + ct) = w; } }
    }
};
struct EpiSwaFeat : pg::EpiBase {
    static constexpr bool PERM = true;
    h16* __restrict__ kvt; const float* __restrict__ bias;
    __device__ __forceinline__ void operator()(const pg::Acc& acc, const pg::Unit& u, int wr, int wc, int fr, int fq) const { EPI_OPAQUE();
        float bv[2][4];
#pragma unroll
        for (int ai = 0; ai < 2; ++ai)
#pragma unroll
            for (int m = 0; m < 4; ++m) bv[ai][m] = bias[1024 + ai * 128 + wr * 64 + m * 16 + fr];
#pragma unroll
        for (int ai = 0; ai < 2; ++ai)
#pragma unroll
            for (int m = 0; m < 4; ++m) { const int r = ai * 128 + wr * 64 + m * 16 + fr;
#pragma unroll
                for (int bj = 0; bj < 2; ++bj) { const int ct = bj * 128 + wc * 32 + 8 * fq; const f32x4 a = acc[ai][bj][m][0] + bv[ai][m], b = acc[ai][bj][m][1] + bv[ai][m];
                    v4u w; w.x = pkh(a[0], a[1]); w.y = pkh(a[2], a[3]); w.z = pkh(b[0], b[1]); w.w = pkh(b[2], b[3]);
                    *(v4u*)(kvt + (size_t)r * T_ + (size_t)u.pn * 256 + ct) = w; } }
    }
};
typedef float f32x16 __attribute__((ext_vector_type(16)));
typedef _Float16 f16x8v __attribute__((ext_vector_type(8)));
typedef _Float16 f16x4v __attribute__((ext_vector_type(4)));
constexpr int KP = 144, VP = 520;
__device__ __forceinline__ void ph_swa_attn(const Params& p, Frame& F) {
    LAS unsigned char* Ks = F.lds; LAS unsigned char* Vs = F.lds + 256 * KP;
    const int lane = F.lane, w = F.wave, l31 = lane & 31, hh = lane >> 5;
    for (int unit = F.vcu; unit < 512; unit += F.G) {
        const int g = unit & 1, n = (unit >> 1) & 63, b = unit >> 7; const size_t tok0 = (size_t)b * SEQ_ + (size_t)n * 128;
        __syncthreads();
        for (int c = F.tid; c < 256 * 8; c += 512) { const int key = c >> 3, ch = c & 7; v4u val = {0u, 0u, 0u, 0u};
            if (n > 0 || key >= 128) val = *(const GAS v4u*)(p.skv + (tok0 - 128 + key) * 256 + g * 64 + ch * 8);
            *(LAS v4u*)(Ks + key * KP + ch * 16) = val; }
        for (int c = F.tid; c < 64 * 32; c += 512) { const int d = c >> 5, ch = c & 31; v4u val = {0u, 0u, 0u, 0u};
            if (n > 0 || ch >= 16) val = *(const GAS v4u*)(p.kvt + (size_t)(128 + g * 64 + d) * T_ + tok0 - 128 + ch * 8);
            v2u lo2; lo2.x = val.x; lo2.y = val.y; v2u hi2; hi2.x = val.z; hi2.y = val.w;
            *(LAS v2u*)(Vs + d * VP + ch * 16) = lo2; *(LAS v2u*)(Vs + d * VP + ch * 16 + 8) = hi2; }
        __syncthreads();
        const int hq = g * 8 + w; const float slope = __builtin_amdgcn_exp2f(-0.5f * (float)(hq + 1)) * 1.4426950408889634f, sink = p.sinks[hq] * 1.4426950408889634f;
#pragma nounroll
        for (int qi = 0; qi < 4; ++qi) {
            f16x8v qf[4];
            const h16* qrow = p.sq + (tok0 + qi * 32 + l31) * 1024 + hq * 64 + 8 * hh;
#pragma unroll
            for (int s = 0; s < 4; ++s) qf[s] = *(const GAS f16x8v*)(qrow + 16 * s);
            f32x16 sc[5];
#pragma unroll
            for (int t = 0; t < 5; ++t) {
                sc[t] = (f32x16){0.f, 0.f, 0.f, 0.f, 0.f, 0.f, 0.f, 0.f, 0.f, 0.f, 0.f, 0.f, 0.f, 0.f, 0.f, 0.f};
                const LAS unsigned char* kp = Ks + ((qi + t) * 32 + l31) * KP + 16 * hh;
#pragma unroll
                for (int s = 0; s < 4; ++s) { const f16x8v kf = *(const LAS f16x8v*)(kp + 32 * s); sc[t] = __builtin_amdgcn_mfma_f32_32x32x16_f16(kf, qf[s], sc[t], 0, 0, 0); }
            }
            float mx = sink;
            float basef = (float)(l31 + 128 - 4 * hh); asm volatile("" : "+v"(basef));
#pragma unroll
            for (int t = 0; t < 5; ++t) { const bool tile_ok = (n > 0) || (qi + t >= 4);
#pragma unroll
                for (int r = 0; r < 16; ++r) { const float distf = basef - (float)(32 * t + (r & 3) + 8 * (r >> 2));
                    bool ok = tile_ok; if (t == 0) ok = ok && (distf < 128.0f); if (t == 4) ok = ok && (distf >= 0.0f);
                    const float v = ok ? sc[t][r] - slope * distf : -INFINITY; sc[t][r] = v; mx = fmaxf(mx, v); } }
            mx = fmaxf(mx, __shfl_xor(mx, 32));
            float ls = 0.f; f16x8v pf[5][2];
#pragma unroll
            for (int t = 0; t < 5; ++t)
#pragma unroll
                for (int s2 = 0; s2 < 2; ++s2) { float e[8];
#pragma unroll
                    for (int j = 0; j < 8; ++j) { e[j] = __builtin_amdgcn_exp2f(sc[t][8 * s2 + j] - mx); ls += e[j]; }
                    v4u pw; pw.x = pkh(e[0], e[1]); pw.y = pkh(e[2], e[3]); pw.z = pkh(e[4], e[5]); pw.w = pkh(e[6], e[7]); pf[t][s2] = __builtin_bit_cast(f16x8v, pw); }
            ls += __shfl_xor(ls, 32); ls += __builtin_amdgcn_exp2f(sink - mx);
            const float rl = 1.0f / ls;
            f32x16 oa[2];
#pragma unroll
            for (int dt = 0; dt < 2; ++dt) { oa[dt] = (f32x16){0.f, 0.f, 0.f, 0.f, 0.f, 0.f, 0.f, 0.f, 0.f, 0.f, 0.f, 0.f, 0.f, 0.f, 0.f, 0.f};
                const LAS unsigned char* vp = Vs + (32 * dt + l31) * VP + (qi * 32 + 4 * hh) * 2;
#pragma unroll
                for (int t = 0; t < 5; ++t)
#pragma unroll
                    for (int s2 = 0; s2 < 2; ++s2) { const f16x4v v0 = *(const LAS f16x4v*)(vp + (t * 32 + s2 * 16) * 2), v1 = *(const LAS f16x4v*)(vp + (t * 32 + s2 * 16 + 8) * 2);
                        const f16x8v vf = __builtin_shufflevector(v0, v1, 0, 1, 2, 3, 4, 5, 6, 7);
                        oa[dt] = __builtin_amdgcn_mfma_f32_32x32x16_f16(vf, pf[t][s2], oa[dt], 0, 0, 0); } }
            h16* orow = p.so + (tok0 + qi * 32 + l31) * 1024 + hq * 64 + 4 * hh;
#pragma unroll
            for (int dt = 0; dt < 2; ++dt)
#pragma unroll
                for (int gq = 0; gq < 4; ++gq) { v2u ow; ow.x = pkh(oa[dt][4 * gq] * rl, oa[dt][4 * gq + 1] * rl); ow.y = pkh(oa[dt][4 * gq + 2] * rl, oa[dt][4 * gq + 3] * rl);
                    *(GAS v2u*)(orow + 32 * dt + 8 * gq) = ow; }
        }
    }
}

struct EpiNull : pg::EpiBase {
    static constexpr bool PERM = true;
    __device__ __forceinline__ void operator()(const pg::Acc& acc, const pg::Unit& u, int wr, int wc, int fr, int fq) const { asm volatile("" :: "v"(acc[0][0][0][0][0]), "v"(acc[1][1][3][1][3])); }
};

struct EpiSwigluQ : pg::EpiBase {
    static constexpr bool PERM = true;
    unsigned char* __restrict__ actq; const float* __restrict__ b1;
    typedef _Float16 h2 __attribute__((ext_vector_type(2)));
    typedef short s2 __attribute__((ext_vector_type(2)));
    __device__ __forceinline__ h2 act2(f32x2v g32, f32x2v l32) const {
        h2 g = __builtin_convertvector(g32, h2), l = __builtin_convertvector(l32, h2);
        g = __builtin_elementwise_min(g, (h2){7.0f16, 7.0f16});
        l = __builtin_elementwise_max(__builtin_elementwise_min(l, (h2){7.0f16, 7.0f16}), (h2){-7.0f16, -7.0f16});
        const h2 e = __builtin_elementwise_exp2(g * (h2){-2.4554f16, -2.4554f16});
        const h2 d = e + (h2){1.0f16, 1.0f16};
        const h2 r = {(_Float16)__builtin_amdgcn_rcph(d.x), (_Float16)__builtin_amdgcn_rcph(d.y)};
        return (g * r) * (l * (h2){4.0f16, 4.0f16} + (h2){4.0f16, 4.0f16});
    }
    __device__ __forceinline__ void operator()(const pg::Acc& acc, const pg::Unit& u, int wr, int wc, int fr, int fq) const { EPI_OPAQUE();
        const int c0 = u.pn * 128 + wc * 32 + 8 * fq;
        const float* bg = b1 + (size_t)u.e * 2048 + c0; const float* bl = bg + 1024;
        const f32x4 g0 = *(const f32x4*)bg, g1 = *(const f32x4*)(bg + 4), l0 = *(const f32x4*)bl, l1 = *(const f32x4*)(bl + 4);
#pragma unroll
        for (int ai = 0; ai < 2; ++ai)
#pragma unroll
            for (int m = 0; m < 4; ++m) {
                const size_t row = (size_t)u.pm * 256 + ai * 128 + wr * 64 + m * 16 + fr;
                const f32x4 ga = acc[ai][0][m][0] * 0.03125f + g0, gb = acc[ai][0][m][1] * 0.03125f + g1, la = acc[ai][1][m][0] * 0.03125f + l0, lb = acc[ai][1][m][1] * 0.03125f + l1;
                s2 lo = {0, 0}, hi = {0, 0};
                lo = __builtin_amdgcn_cvt_scalef32_pk_fp8_f16(lo, act2((f32x2v){ga.x, ga.y}, (f32x2v){la.x, la.y}), 1.0f, false);
                lo = __builtin_amdgcn_cvt_scalef32_pk_fp8_f16(lo, act2((f32x2v){ga.z, ga.w}, (f32x2v){la.z, la.w}), 1.0f, true);
                hi = __builtin_amdgcn_cvt_scalef32_pk_fp8_f16(hi, act2((f32x2v){gb.x, gb.y}, (f32x2v){lb.x, lb.y}), 1.0f, false);
                hi = __builtin_amdgcn_cvt_scalef32_pk_fp8_f16(hi, act2((f32x2v){gb.z, gb.w}, (f32x2v){lb.z, lb.w}), 1.0f, true);
                v2u w; w.x = __builtin_bit_cast(unsigned, lo); w.y = __builtin_bit_cast(unsigned, hi);
                *(v2u*)(actq + row * 1024 + c0) = w;
            }
    }
};
template <int VAR> struct EpiSwigluQP : pg::EpiBase {
    static constexpr bool PERM = true;
    unsigned char* __restrict__ actq; const float* __restrict__ b1;
    typedef _Float16 h2 __attribute__((ext_vector_type(2)));
    typedef short s2 __attribute__((ext_vector_type(2)));
    __device__ __forceinline__ h2 act2(f32x2v g32, f32x2v l32) const {
        h2 g = __builtin_convertvector(g32, h2), l = __builtin_convertvector(l32, h2);
        g = __builtin_elementwise_min(g, (h2){7.0f16, 7.0f16});
        l = __builtin_elementwise_max(__builtin_elementwise_min(l, (h2){7.0f16, 7.0f16}), (h2){-7.0f16, -7.0f16});
        const h2 e = __builtin_elementwise_exp2(g * (h2){-2.4554f16, -2.4554f16});
        const h2 d = e + (h2){1.0f16, 1.0f16};
        const h2 r = {(_Float16)__builtin_amdgcn_rcph(d.x), (_Float16)__builtin_amdgcn_rcph(d.y)};
        return (g * r) * (l * (h2){4.0f16, 4.0f16} + (h2){4.0f16, 4.0f16});
    }
    __device__ __forceinline__ void operator()(const pg::Acc& acc, const pg::Unit& u, int wr, int wc, int fr, int fq) const { EPI_OPAQUE();
        const int c0 = u.pn * 128 + wc * 32 + 8 * fq;
        const float* bg = b1 + (size_t)u.e * 2048 + c0; const float* bl = bg + 1024;
        const f32x4 g0 = *(const f32x4*)bg, g1 = *(const f32x4*)(bg + 4), l0 = *(const f32x4*)bl, l1 = *(const f32x4*)(bl + 4);
        if (VAR == 1) { asm volatile("" :: "v"(g0), "v"(g1), "v"(l0), "v"(l1));
#pragma unroll
            for (int ai = 0; ai < 2; ++ai)
#pragma unroll
                for (int bj = 0; bj < 2; ++bj)
#pragma unroll
                    for (int m = 0; m < 4; ++m) asm volatile("" :: "v"(acc[ai][bj][m][0]), "v"(acc[ai][bj][m][1]));
            return; }
#pragma unroll
        for (int ai = 0; ai < 2; ++ai)
#pragma unroll
            for (int m = 0; m < 4; ++m) {
                const size_t row = (size_t)u.pm * 256 + ai * 128 + wr * 64 + m * 16 + fr;
                const f32x4 ga = acc[ai][0][m][0] * 0.03125f + g0, gb = acc[ai][0][m][1] * 0.03125f + g1, la = acc[ai][1][m][0] * 0.03125f + l0, lb = acc[ai][1][m][1] * 0.03125f + l1;
                s2 lo = {0, 0}, hi = {0, 0};
                lo = __builtin_amdgcn_cvt_scalef32_pk_fp8_f16(lo, act2((f32x2v){ga.x, ga.y}, (f32x2v){la.x, la.y}), 1.0f, false);
                lo = __builtin_amdgcn_cvt_scalef32_pk_fp8_f16(lo, act2((f32x2v){ga.z, ga.w}, (f32x2v){la.z, la.w}), 1.0f, true);
                hi = __builtin_amdgcn_cvt_scalef32_pk_fp8_f16(hi, act2((f32x2v){gb.x, gb.y}, (f32x2v){lb.x, lb.y}), 1.0f, false);
                hi = __builtin_amdgcn_cvt_scalef32_pk_fp8_f16(hi, act2((f32x2v){gb.z, gb.w}, (f32x2v){lb.z, lb.w}), 1.0f, true);
                v2u w; w.x = __builtin_bit_cast(unsigned, lo); w.y = __builtin_bit_cast(unsigned, hi);
                if (VAR == 2) asm volatile("" :: "v"(w.x), "v"(w.y)); else *(v2u*)(actq + row * 1024 + c0) = w;
            }
    }
};
template <bool Y8> struct EpiMoeOutQ : pg::EpiBase {
    static constexpr bool PERM = true;
    unsigned char* __restrict__ y8; const float* __restrict__ b2; const float* __restrict__ gate;
    __device__ __forceinline__ void operator()(const pg::Acc& acc, const pg::Unit& u, int wr, int wc, int fr, int fq) const { EPI_OPAQUE();
        float gt[2][4]; f32x4 bv[2][2];
#pragma unroll
        for (int ai = 0; ai < 2; ++ai)
#pragma unroll
            for (int m = 0; m < 4; ++m) gt[ai][m] = gate[(size_t)u.pm * 256 + ai * 128 + wr * 64 + m * 16 + fr];
#pragma unroll
        for (int bj = 0; bj < 2; ++bj) { const float* bp = b2 + (size_t)u.e * 1024 + u.pn * 256 + bj * 128 + wc * 32 + 8 * fq; bv[bj][0] = *(const f32x4*)bp; bv[bj][1] = *(const f32x4*)(bp + 4); }
#pragma unroll
        for (int ai = 0; ai < 2; ++ai)
#pragma unroll
            for (int m = 0; m < 4; ++m) {
                const size_t row = (size_t)u.pm * 256 + ai * 128 + wr * 64 + m * 16 + fr;
#pragma unroll
                for (int bj = 0; bj < 2; ++bj) {
                    const int c0 = u.pn * 256 + bj * 128 + wc * 32 + 8 * fq;
                    const float gs = gt[ai][m] * (Y8 ? 32.0f : 1.0f);
                    const f32x4 v0 = (acc[ai][bj][m][0] * 0.0078125f + bv[bj][0]) * gs, v1 = (acc[ai][bj][m][1] * 0.0078125f + bv[bj][1]) * gs;
                    if (Y8) { int lo = 0, hi = 0;
                        lo = __builtin_amdgcn_cvt_pk_fp8_f32(v0[0], v0[1], lo, false); lo = __builtin_amdgcn_cvt_pk_fp8_f32(v0[2], v0[3], lo, true);
                        hi = __builtin_amdgcn_cvt_pk_fp8_f32(v1[0], v1[1], hi, false); hi = __builtin_amdgcn_cvt_pk_fp8_f32(v1[2], v1[3], hi, true);
                        v2u w; w.x = (unsigned)lo; w.y = (unsigned)hi; *(v2u*)(y8 + row * 1024 + c0) = w; }
                    else { v4u w; w.x = pkh(v0[0], v0[1]); w.y = pkh(v0[2], v0[3]); w.z = pkh(v1[0], v1[1]); w.w = pkh(v1[2], v1[3]); *(v4u*)((h16*)y8 + row * 1024 + c0) = w; }
                }
            }
    }
};

struct MoeSchedHot : MoeSched {
    __device__ __forceinline__ bool next(int i, pg::Unit& u) const { const bool ok = MoeSched::next(i, u); if (ok) { u.a = abase; u.b = wbase; } return ok; }
    __device__ __forceinline__ unsigned arow(const pg::Unit&, int r) const { return (unsigned)r; }
};

struct EpiKeep : pg::EpiBase {
    static constexpr bool PERM = true;
    __device__ __forceinline__ void operator()(const pg::Acc& acc, const pg::Unit& u, int wr, int wc, int fr, int fq) const {
#pragma unroll
        for (int ai = 0; ai < 2; ++ai)
#pragma unroll
            for (int bj = 0; bj < 2; ++bj)
#pragma unroll
                for (int m = 0; m < 4; ++m) asm volatile("" :: "v"(acc[ai][bj][m][0]), "v"(acc[ai][bj][m][1]));
    }
};
#ifndef PROBE_DBL
#define PROBE_DBL 0
#endif
#ifndef SKEW_STEP
#define SKEW_STEP 0
#endif
#define SKEW(F) (((F).vcu & 3) * SKEW_STEP)
#define DBL(bit, body) do { body; if ((PROBE_DBL >> (bit)) & 1) { GRID_BAR(); body; } } while (0)
template <int layer>
__device__ __forceinline__ void layer_tail(const Params& p, Frame& F, const XcdBarrier& bar) {
#define GRID_BAR() xcd_barrier(bar)
    {
        if (layer == 0) { DenseSched S; S.init(p.og, 2048, p.wro_t, 2048, T_, 1024, F.G, (int)blockIdx.x); EpiResid E; E.yh = p.yh; E.xprevh = p.xh0; E.bias = nullptr;
            pg::gemm_phase<EpiResid, DenseSched, 0, true>(F.lds + RING_OFF, 2048, 2048, 32, S, E); }
        else { DenseSched S; S.init(p.so, 1024, p.wso_t, 1024, T_, 1024, F.G, (int)blockIdx.x); EpiResid E; E.yh = p.yh; E.xprevh = p.x2h; E.bias = p.b_swa_out;
            pg::gemm_phase<EpiResid, DenseSched, 0, true>(F.lds + RING_OFF, 1024, 1024, 16, S, E); }
    }
    GRID_BAR();
    DBL(1, ph_ln_router(p, F, p.ln_mix_g + layer * 1024, p.ln_mix_b + layer * 1024, p.w_router + layer * 1024 * 32, p.b_router + layer * 32, (layer == 1 || MOE_F8_L0) ? p.x1q : (unsigned char*)nullptr));
#if (PROBE_DBL >> 19) & 1
    GRID_BAR();
    ph_ln_router(p, F, p.ln_mix_g + layer * 1024, p.ln_mix_b + layer * 1024, p.w_router + layer * 1024 * 32, p.b_router + layer * 32, layer == 1 ? p.x1q : (unsigned char*)nullptr, (PROBE_DBL >> 19) & 1);
#endif
    GRID_BAR();
    DBL(5, ph_assign(p, F, layer));
    GRID_BAR();
    {
        const int ntiles = (int)__hip_atomic_load(F.ctl + CW_NTILES + 64 * layer, RLX_AGENT);
        moe_tables(F, p.tile_e, p.slot_tok, ntiles, 3, true);
        if (layer == 0 && !MOE_F8_L0) {
            MoeSched S{(const char*)p.x1h, (const char*)p.w1_t, (LAS const int*)(F.lds + TAB_OFF), (LAS const int*)(F.lds + TAB_OFF) + 32, ntiles, 3, F.G, F.vcu, 0, (size_t)2048 * 1024 * 2, (size_t)256 * 1024 * 2};
            EpiSwiglu E; E.act = p.act; E.b1 = p.b_exp_in;
            pg::gemm_phase<EpiSwiglu, MoeSched, 1, true>(F.lds + RING_OFF, 1024, 1024, 16, S, E);
        } else {
            MoeSched S{(const char*)p.x1q, (const char*)(p.w1q + (size_t)layer * 32 * 2048 * 1024), (LAS const int*)(F.lds + TAB_OFF), (LAS const int*)(F.lds + TAB_OFF) + 32, ntiles, 3, F.G, F.vcu, 0, (size_t)2048 * 1024, (size_t)256 * 1024};
            EpiSwigluQ E; E.actq = p.actq; E.b1 = p.b_exp_in + (size_t)layer * 32 * 2048;
            pg::gemm_phase<EpiSwigluQ, MoeSched, 1, true, 1>(F.lds + RING_OFF, 1024, 1024, 8, S, E, 0, 0, SKEW(F));
        }
    }
    GRID_BAR();
#if (PROBE_DBL >> 21) & 3
    GRID_BAR();
    if (layer == 0) {
        const int ntiles = (int)__hip_atomic_load(F.ctl + CW_NTILES + 64 * layer, RLX_AGENT);
        moe_tables(F, p.tile_e, p.slot_tok, ntiles, 3, true);
        EpiSwigluP<1> E; E.act = p.yy; E.b1 = p.b_exp_in;
        if ((PROBE_DBL >> 22) & 1) { MoeSchedHot S{{((PROBE_DBL >> 23) & 1) ? (const char*)p.ctl : (const char*)p.x1h, ((PROBE_DBL >> 23) & 1) ? (const char*)p.ctl + 524288 : (const char*)p.w1_t, (LAS const int*)(F.lds + TAB_OFF), (LAS const int*)(F.lds + TAB_OFF) + 32, ntiles, 3, F.G, F.vcu, 0, (size_t)2048 * 1024 * 2, (size_t)256 * 1024 * 2}};
            pg::gemm_phase<EpiSwigluP<1>, MoeSchedHot, 1, true, 2, ((PROBE_DBL >> 24) & 1) != 0>(F.lds + RING_OFF, 1024, 1024, 16, S, E); }
        else { MoeSched S{(const char*)p.x1h, (const char*)p.w1_t, (LAS const int*)(F.lds + TAB_OFF), (LAS const int*)(F.lds + TAB_OFF) + 32, ntiles, 3, F.G, F.vcu, 0, (size_t)2048 * 1024 * 2, (size_t)256 * 1024 * 2};
            pg::gemm_phase<EpiSwigluP<1>, MoeSched, 1, true, 2, ((PROBE_DBL >> 24) & 1) != 0>(F.lds + RING_OFF, 1024, 1024, 16, S, E); }
    }
#endif
#if (PROBE_DBL >> 29) & 3
    GRID_BAR();
    {
        const int ntiles = (int)__hip_atomic_load(F.ctl + CW_NTILES + 64 * layer, RLX_AGENT);
        moe_tables(F, p.tile_e, p.slot_tok, ntiles, 3, true);
        MoeSched S{(const char*)p.x1q, (const char*)(p.w1q + (size_t)layer * 32 * 2048 * 1024), (LAS const int*)(F.lds + TAB_OFF), (LAS const int*)(F.lds + TAB_OFF) + 32, ntiles, 3, F.G, F.vcu, 0, (size_t)2048 * 1024, (size_t)256 * 1024};
        EpiSwigluQP<((PROBE_DBL >> 29) & 3)> E; E.actq = p.actq; E.b1 = p.b_exp_in + (size_t)layer * 32 * 2048;
        pg::gemm_phase<EpiSwigluQP<((PROBE_DBL >> 29) & 3)>, MoeSched, 1, true, 1>(F.lds + RING_OFF, 1024, 1024, 8, S, E);
    }
#endif
#if (PROBE_DBL >> 25) & 1
    GRID_BAR();
    {
        const int ntiles = (int)__hip_atomic_load(F.ctl + CW_NTILES + 64 * layer, RLX_AGENT);
        moe_tables(F, p.tile_e, p.slot_tok, ntiles, 3, true);
        MoeSched S{(const char*)p.x1q, (const char*)(p.w1q + (size_t)layer * 32 * 2048 * 1024), (LAS const int*)(F.lds + TAB_OFF), (LAS const int*)(F.lds + TAB_OFF) + 32, ntiles, 3, F.G, F.vcu, 0, (size_t)2048 * 1024, (size_t)256 * 1024};
        EpiKeep E;
        pg::gemm_phase<EpiKeep, MoeSched, 1, true, 1>(F.lds + RING_OFF, 1024, 1024, 8, S, E);
    }
#endif
#if (PROBE_DBL >> 26) & 1
    GRID_BAR();
    {
        const int ntiles = (int)__hip_atomic_load(F.ctl + CW_NTILES + 64 * layer, RLX_AGENT);
        moe_tables(F, p.tile_e, p.slot_tok, ntiles, 3, true);
        MoeSched S{(const char*)p.x1q, (const char*)(p.w1q + (size_t)layer * 32 * 2048 * 1024), (LAS const int*)(F.lds + TAB_OFF), (LAS const int*)(F.lds + TAB_OFF) + 32, ntiles, 3, F.G, F.vcu, 0, (size_t)2048 * 1024, (size_t)256 * 1024};
        EpiSwigluQ E; E.actq = p.actq; E.b1 = p.b_exp_in + (size_t)layer * 32 * 2048;
        pg::gemm_phase<EpiSwigluQ, MoeSched, 1, true, 1>(F.lds + RING_OFF, 1024, 1024, 8, S, E);
    }
#endif
    {
        const int ntiles = (int)__hip_atomic_load(F.ctl + CW_NTILES + 64 * layer, RLX_AGENT);
        moe_tables(F, p.tile_e, p.slot_tok, ntiles, 2, false);
        if (layer == 0 && !MOE_F8_L0) {
            MoeSched S{(const char*)p.act, (const char*)p.w2_t, (LAS const int*)(F.lds + TAB_OFF), (LAS const int*)(F.lds + TAB_OFF) + 32, ntiles, 2, F.G, F.vcu, (size_t)256 * 1024 * 2, (size_t)1024 * 1024 * 2, (size_t)256 * 1024 * 2};
            EpiMoeOut E; E.y = p.yy; E.b2 = p.b_exp_out; E.gate = p.slot_gate;
            pg::gemm_phase<EpiMoeOut, MoeSched, 0, true>(F.lds + RING_OFF, 1024, 1024, 16, S, E);
        } else {
            MoeSched S{(const char*)p.actq, (const char*)(p.w2q + (size_t)layer * 32 * 1024 * 1024), (LAS const int*)(F.lds + TAB_OFF), (LAS const int*)(F.lds + TAB_OFF) + 32, ntiles, 2, F.G, F.vcu, (size_t)256 * 1024, (size_t)1024 * 1024, (size_t)256 * 1024};
            EpiMoeOutQ<layer == 1> E; E.y8 = (unsigned char*)p.yy; E.b2 = p.b_exp_out + (size_t)layer * 32 * 1024; E.gate = p.slot_gate;
            pg::gemm_phase<EpiMoeOutQ<layer == 1>, MoeSched, 0, true, 1>(F.lds + RING_OFF, 1024, 1024, 8, S, E, 0, 0, SKEW(F));
        }
    }
#if (PROBE_DBL >> 27) & 1
    GRID_BAR();
    {
        const int ntiles = (int)__hip_atomic_load(F.ctl + CW_NTILES + 64 * layer, RLX_AGENT);
        moe_tables(F, p.tile_e, p.slot_tok, ntiles, 2, false);
        MoeSched S{(const char*)p.actq, (const char*)(p.w2q + (size_t)layer * 32 * 1024 * 1024), (LAS const int*)(F.lds + TAB_OFF), (LAS const int*)(F.lds + TAB_OFF) + 32, ntiles, 2, F.G, F.vcu, (size_t)256 * 1024, (size_t)1024 * 1024, (size_t)256 * 1024};
        EpiMoeOutQ<layer == 1> E; E.y8 = (unsigned char*)p.yy; E.b2 = p.b_exp_out + (size_t)layer * 32 * 1024; E.gate = p.slot_gate;
        pg::gemm_phase<EpiMoeOutQ<layer == 1>, MoeSched, 0, true, 1>(F.lds + RING_OFF, 1024, 1024, 8, S, E);
    }
#endif
#if (PROBE_DBL >> 28) & 1
    GRID_BAR();
    {
        const int ntiles = (int)__hip_atomic_load(F.ctl + CW_NTILES + 64 * layer, RLX_AGENT);
        moe_tables(F, p.tile_e, p.slot_tok, ntiles, 2, false);
        MoeSched S{(const char*)p.actq, (const char*)(p.w2q + (size_t)layer * 32 * 1024 * 1024), (LAS const int*)(F.lds + TAB_OFF), (LAS const int*)(F.lds + TAB_OFF) + 32, ntiles, 2, F.G, F.vcu, (size_t)256 * 1024, (size_t)1024 * 1024, (size_t)256 * 1024};
        EpiKeep E;
        pg::gemm_phase<EpiKeep, MoeSched, 0, true, 1>(F.lds + RING_OFF, 1024, 1024, 8, S, E);
    }
#endif
    GRID_BAR();
    DBL(2, ph_combine_ln<layer == 1>(p, F, p.x1h, p.ln_ffn_g + layer * 1024, p.ln_ffn_b + layer * 1024, layer == 0 ? (float*)nullptr : p.out, layer == 0 ? p.x2h : (h16*)nullptr));
#undef GRID_BAR
}
__global__ void __launch_bounds__(NWAVES * 64, 2) mk_fwd(Params p) {
    extern __shared__ __attribute__((aligned(16))) unsigned char lds[];
    Frame F;
    F.lds = (LAS unsigned char*)lds;
    F.MISC = (volatile LAS unsigned*)(F.lds + MISC_OFF);
    F.tid = threadIdx.x; F.lane = F.tid & 63; F.wave = __builtin_amdgcn_readfirstlane(F.tid >> 6);
    F.G = gridDim.x; { const int bx = blockIdx.x; F.vcu = (F.G % 8 == 0) ? (bx % 8) * (F.G / 8) + bx / 8 : bx; }
    F.ctl = (gu32*)p.ctl;
    for (int u = F.tid; u < (LDS_BYTES - LDSCTL_OFF) / 4; u += NWAVES * 64) ((LAS unsigned*)(F.lds + LDSCTL_OFF))[u] = 0u;
    __syncthreads();
    XcdBarrier bar = xcd_barrier_post((unsigned*)p.ctl + CW_BAR, F.MISC + 8);
#define GRID_BAR() xcd_barrier(bar)
    DBL(0, ph_prologue(p, F));
    GRID_BAR();
    {
        { DenseSched S; S.init(p.xh0, 1024, p.wri_t, 1024, T_, 4096, F.G, (int)blockIdx.x); EpiInTok E; E.q = p.q; E.k = p.k; E.sg = p.sg;
          pg::gemm_phase<EpiInTok, DenseSched, 0, true>(F.lds + RING_OFF, 1024, 1024, 16, S, E, 0, 0, SKEW(F)); }
        { DenseSched S; S.init(p.wfm_t, 1024, p.xh0, 1024, 2048, T_, F.G, (int)blockIdx.x); EpiInFeat E; E.vt = p.vt;
          pg::gemm_phase<EpiInFeat, DenseSched, 0, true>(F.lds + RING_OFF, 1024, 1024, 16, S, E); }
    }
#if (PROBE_DBL >> 17) & 1
    GRID_BAR();
    { DenseSched S; S.init(p.xh0, 1024, p.wri_t, 1024, T_, 4096, F.G, (int)blockIdx.x); EpiInTok E; E.q = p.q; E.k = p.k; E.sg = p.sg;
      pg::gemm_phase<EpiInTok, DenseSched, 0, true>(F.lds + RING_OFF, 1024, 1024, 16, S, E); }
#endif
#if (PROBE_DBL >> 6) & 1
    GRID_BAR();
    {
        { DenseSched S; S.init(p.xh0, 1024, p.wri_t, 1024, T_, 4096, F.G, (int)blockIdx.x); EpiInTok E; E.q = p.q; E.k = p.k; E.sg = p.sg;
          pg::gemm_phase<EpiInTok, DenseSched, 0, true>(F.lds + RING_OFF, 1024, 1024, 16, S, E); }
        { DenseSched S; S.init(p.wfm_t, 1024, p.xh0, 1024, 2048, T_, F.G, (int)blockIdx.x); EpiInFeat E; E.vt = p.vt;
          pg::gemm_phase<EpiInFeat, DenseSched, 0, true>(F.lds + RING_OFF, 1024, 1024, 16, S, E); }
    }
#endif
    GRID_BAR();
    {
        ph_ktranspose(p, F);
        { RaSched S{p.q, p.k, F.G, F.vcu}; EpiPP E; E.pp = p.pp; pg::gemm_phase<EpiPP, RaSched, 0, true>(F.lds + RING_OFF, 1024, 1024, 4, S, E); }
    }
    GRID_BAR();
    {
        { R1Sched S{p.vt, p.kdt, 4, F.G, F.vcu}; EpiSegTot E; E.L = p.ltot; pg::gemm_phase<EpiSegTot, R1Sched, 0, false>(F.lds + RING_OFF, 256, 256, 4, S, E); }
    }
    GRID_BAR();
    ph_carry(p.ltot, F);
    GRID_BAR();
    { R1Sched S{p.vt, p.kdt, 3, F.G, F.vcu}; EpiSnap E; E.L = p.ltot; E.st = p.st; pg::gemm_phase<EpiSnap, R1Sched, 0, false>(F.lds + RING_OFF, 256, 256, 4, S, E); }
#if (PROBE_DBL >> 8) & 1
    GRID_BAR();
    { R1Sched S{p.vt, p.kdt, 3, F.G, F.vcu}; EpiSnap E; E.L = p.ltot; E.st = p.st; pg::gemm_phase<EpiSnap, R1Sched, 0, false>(F.lds + RING_OFF, 256, 256, 4, S, E); }
#endif
    GRID_BAR();
    { R2Sched S{p.pp, p.vt, p.q, p.st, F.G, F.vcu}; EpiRetOut E; E.o = p.o; E.sg = p.sg; E.og = p.og; pg::gemm_phase<EpiRetOut, R2Sched, 2, true>(F.lds + RING_OFF, 256, 256, 4, S, E, 1024, 256); }
    GRID_BAR();
    layer_tail<0>(p, F, bar);
    GRID_BAR();
    {
        { DenseSched S; S.init(p.x2h, 1024, p.wsi_t, 1024, T_, 1280, F.G, (int)blockIdx.x); EpiSwaTok E; E.sq = p.sq; E.skv = p.skv; E.bias = p.b_swa_in;
          pg::gemm_phase<EpiSwaTok, DenseSched, 0, true>(F.lds + RING_OFF, 1024, 1024, 16, S, E); }
        { DenseSched S; S.init(p.wsi_t + (size_t)1024 * 1024, 1024, p.x2h, 1024, 256, T_, F.G, (int)blockIdx.x, 128); EpiSwaFeat E; E.kvt = p.kvt; E.bias = p.b_swa_in;
          pg::gemm_phase<EpiSwaFeat, DenseSched, 0, true>(F.lds + RING_OFF, 1024, 1024, 16, S, E); }
    }
#if (PROBE_DBL >> 13) & 1
    GRID_BAR();
    {
        { DenseSched S; S.init(p.x2h, 1024, p.wsi_t, 1024, T_, 1280, F.G, (int)blockIdx.x); EpiSwaTok E; E.sq = p.sq; E.skv = p.skv; E.bias = p.b_swa_in;
          pg::gemm_phase<EpiSwaTok, DenseSched, 0, true>(F.lds + RING_OFF, 1024, 1024, 16, S, E); }
        { DenseSched S; S.init(p.wsi_t + (size_t)1024 * 1024, 1024, p.x2h, 1024, 256, T_, F.G, (int)blockIdx.x, 128); EpiSwaFeat E; E.kvt = p.kvt; E.bias = p.b_swa_in;
          pg::gemm_phase<EpiSwaFeat, DenseSched, 0, true>(F.lds + RING_OFF, 1024, 1024, 16, S, E); }
    }
#endif
    GRID_BAR();
    DBL(3, ph_swa_attn(p, F));
    GRID_BAR();
    layer_tail<1>(p, F, bar);
    if (__hip_atomic_load((gu32*)((unsigned*)p.ctl + CW_BAR + XB_TMO), RLX_AGENT) != 0u) {
        __syncthreads();
        for (size_t i = (size_t)blockIdx.x * 512 + F.tid; i < (size_t)T_ * D_; i += (size_t)F.G * 512) p.out[i] = __builtin_nanf("");
    }
#undef GRID_BAR
}

namespace host {
constexpr size_t MiB = 1u << 20;
static int g_grid = 0;
static bool setup() {
    if (g_grid) return g_grid > 0;
    int dev = 0, cus = 0;
    if (hipGetDevice(&dev) != hipSuccess || hipDeviceGetAttribute(&cus, hipDeviceAttributeMultiprocessorCount, dev) != hipSuccess) { g_grid = -1; return false; }
    if (hipFuncSetAttribute((const void*)mk_fwd, hipFuncAttributeMaxDynamicSharedMemorySize, LDS_BYTES) != hipSuccess) { g_grid = -1; return false; }
    (void)hipGetLastError();
    g_grid = cus;
    return true;
}
static void launch(hipStream_t st, Params p) {
    p.ph_lo = 0; p.ph_hi = 0; p.li = 0; p.layer = 0;
    hipLaunchKernelGGL(mk_fwd, dim3(g_grid), dim3(NWAVES * 64), LDS_BYTES, st, p);
}
static void fill_params(Params& p, void* const* d_in, float* out, unsigned char* ws) {
    const float** in = (const float**)&p.x;
    for (int i = 0; i < 18; ++i) in[i] = (const float*)d_in[i];
    p.out = out; p.ctl = (unsigned*)ws;
    const size_t M = MiB;
    p.top_e = (int*)(ws + 1 * M); p.top_g = (float*)(ws + 2 * M); p.rankp = (int*)(ws + 3 * M); p.inv = (int*)(ws + 4 * M); p.slot_tok = (int*)(ws + 5 * M); p.slot_gate = (float*)(ws + 6 * M);
    p.wg_cnt = (int*)(ws + 7 * M); p.tile_e = (int*)(ws + 8 * M);
    p.wri_t = (h16*)(ws + 17 * M); p.wfm_t = (h16*)(ws + 25 * M); p.wro_t = (h16*)(ws + 31 * M); p.wsi_t = (h16*)(ws + 35 * M); p.wso_t = (h16*)(ws + 38 * M);
    p.w1_t = (h16*)(ws + 40 * M); p.w2_t = (h16*)(ws + 296 * M);
    p.xh0 = (h16*)(ws + 424 * M); p.x1h = (h16*)(ws + 488 * M); p.x2h = (h16*)(ws + 552 * M);
    p.x1f = (float*)(ws + 616 * M); p.x2f = (float*)(ws + 744 * M); p.yf = (float*)(ws + 872 * M);
    p.act = (h16*)(ws + 1000 * M); p.yy = (h16*)(ws + 1272 * M);
}
}
extern "C" void kernel_launch(void* const* d_in, const int* in_sizes, int n_in, void* d_out, int out_size, void* d_ws, size_t ws_size, hipStream_t stream) {
    const size_t M = host::MiB;
    if (n_in != 18 || out_size != T_ * D_ || ws_size < 2040 * M) { fprintf(stderr, "kernel_launch: unexpected shapes / workspace (%d inputs, out %d, ws %zu)\n", n_in, out_size, ws_size); return; }
    if (!host::setup()) return;
    unsigned char* ws = (unsigned char*)d_ws; hipStream_t st = stream;
    (void)hipMemsetAsync(ws, 0, CTL_ZERO_BYTES, st);
    Params p{}; host::fill_params(p, d_in, (float*)d_out, ws);
    p.q = (h16*)(ws + 1000 * M); p.k = (h16*)(ws + 1064 * M); p.sg = (h16*)(ws + 1128 * M); p.kdt = (h16*)(ws + 1256 * M); p.vt = (h16*)(ws + 1320 * M);
    p.pp = (h16*)(ws + 1448 * M); p.st = (h16*)(ws + 1512 * M); p.ltot = (float*)(ws + 1640 * M); p.o = (h16*)(ws + 1704 * M); p.og = (h16*)(ws + 1832 * M);
    p.sq = (h16*)(ws + 1000 * M); p.skv = (h16*)(ws + 1064 * M); p.kvt = (h16*)(ws + 1080 * M); p.so = (h16*)(ws + 1096 * M);
    p.w1q = (unsigned char*)p.w1_t + (size_t)32 * 2048 * 1024 * 2; p.w2q = (unsigned char*)p.w2_t + (size_t)32 * 1024 * 1024 * 2;
    p.x1q = ws + 1560 * M; p.actq = (unsigned char*)p.act;
    p.yh = (h16*)p.yf;
    host::launch(st, p);
}
```

```cpp
#include <hip/hip_runtime.h>
#include <cstdio>
#include <cstdint>
#include <cmath>
#define GAS __attribute__((address_space(1)))
#define LAS __attribute__((address_space(3)))
typedef unsigned short bf16;
typedef unsigned v4u __attribute__((ext_vector_type(4)));
typedef float f32x4 __attribute__((ext_vector_type(4)));
typedef short bf16x8 __attribute__((ext_vector_type(8)));
typedef GAS unsigned gu32;
typedef GAS unsigned long long gu64;
#define RLX_AGENT __ATOMIC_RELAXED, __HIP_MEMORY_SCOPE_AGENT
#define LDS_WAIT() asm volatile("s_waitcnt lgkmcnt(0)" ::: "memory")
#define VM_WAIT() asm volatile("s_waitcnt vmcnt(0)" ::: "memory")
__device__ __forceinline__ unsigned long long rt() { return __builtin_amdgcn_s_memrealtime(); }
#define XB_TMO      128
#define XB_XCNT(j)  (256  + 64 * (j))
#define XB_XSUB(j)  (1280 + 64 * (j))
#define XB_XGEN(j)  (2304 + 64 * (j))
#define XB_TOP      3328
#define XB_TOPGEN   3392
#define XCD_BAR_WORDS 3456
#define XB_SPIN_CAP (1u << 18)

__device__ __forceinline__ unsigned xb_ld(unsigned* p)              { return __hip_atomic_load(p, __ATOMIC_RELAXED, __HIP_MEMORY_SCOPE_AGENT); }
__device__ __forceinline__ unsigned xb_add(unsigned* p, unsigned v) { return __hip_atomic_fetch_add(p, v, __ATOMIC_RELAXED, __HIP_MEMORY_SCOPE_AGENT); }
__device__ __forceinline__ unsigned xb_xcc_id() { return (unsigned)__builtin_amdgcn_s_getreg((3 << 11) | 20) & 0xFu; }
#define XB_SPIN(cond, bar) do { unsigned _sp = 0; while (cond) { __builtin_amdgcn_s_sleep(1); \
    if ((++_sp & 255u) == 0u) { if (xb_ld(&(bar)[XB_TMO])) break; if (_sp > XB_SPIN_CAP) { atomicAdd(&(bar)[XB_TMO], 1u); break; } } } } while (0)

struct XcdBarrier {
    unsigned* bar; unsigned x;
    volatile LAS unsigned* st;
};

__device__ __forceinline__ XcdBarrier xcd_barrier_post(unsigned* bar, volatile LAS unsigned* st) {
    XcdBarrier b; b.bar = bar; b.x = xb_xcc_id(); b.st = st;
    if (threadIdx.x == 0) (void)xb_add(&bar[XB_XCNT(b.x)], 1u);
    return b;
}
__device__ __forceinline__ void xcd_barrier_complete(unsigned* bar, unsigned x, unsigned& nloc, unsigned& nx) {
    const unsigned G = gridDim.x * gridDim.y * gridDim.z;
    unsigned sum, cnt, mine, sp = 0u;
    for (;;) {
        sum = 0u; cnt = 0u; mine = 0u;
#pragma unroll
        for (unsigned j = 0; j < 16; ++j) { const unsigned c = xb_ld(&bar[XB_XCNT(j)]); sum += c; cnt += (c > 0u) ? 1u : 0u; mine = (j == x) ? c : mine; }
        if (sum == G) break;
        __builtin_amdgcn_s_sleep(1);
        if ((++sp & 255u) == 0u) { if (xb_ld(&bar[XB_TMO])) break; if (sp > XB_SPIN_CAP) { atomicAdd(&bar[XB_TMO], 1u); break; } }
    }
    nloc = mine > 0u ? mine : 1u; nx = cnt > 0u ? cnt : 1u;
}

__device__ __forceinline__ void xcd_barrier(const XcdBarrier& b) {
    asm volatile("s_waitcnt vmcnt(0)" ::: "memory");
    __syncthreads();
    if (threadIdx.x == 0) {
        unsigned* bar = b.bar;
        __builtin_amdgcn_s_waitcnt(0);
        unsigned nloc = b.st[0], nx = b.st[1];
        if (nloc == 0u) { xcd_barrier_complete(bar, b.x, nloc, nx); b.st[0] = nloc; b.st[1] = nx; }
        const unsigned old = xb_add(&bar[XB_XSUB(b.x)], 1u);
        const unsigned gen = old / nloc;
        if (old + 1u == (gen + 1u) * nloc) {
            __builtin_amdgcn_fence(__ATOMIC_RELEASE, "agent");
            asm volatile("s_waitcnt vmcnt(0)" ::: "memory");
            const unsigned og = xb_add(&bar[XB_TOP], 1u);
            const unsigned tg = og / nx;
            if (og + 1u == (tg + 1u) * nx) xb_add(&bar[XB_TOPGEN], 1u);
            else XB_SPIN(xb_ld(&bar[XB_TOPGEN]) == tg, bar);
            __builtin_amdgcn_fence(__ATOMIC_ACQUIRE, "agent");
            xb_add(&bar[XB_XGEN(b.x)], 1u);
            asm volatile("s_waitcnt vmcnt(0)" ::: "memory");
        } else {
            XB_SPIN(xb_ld(&bar[XB_XGEN(b.x)]) == gen, bar);
            __builtin_amdgcn_fence(__ATOMIC_ACQUIRE, "agent");
            asm volatile("s_waitcnt vmcnt(0)" ::: "memory");
        }
    }
    __syncthreads();
}
namespace pg {
#define PG_LAS __attribute__((address_space(3)))
typedef unsigned short h16;
typedef _Float16 f16x8 __attribute__((ext_vector_type(8)));
typedef __bf16 bf16x8 __attribute__((ext_vector_type(8)));
typedef _Float16 f16x2 __attribute__((ext_vector_type(2)));
typedef float f32x4 __attribute__((ext_vector_type(4)));
typedef float f32x2 __attribute__((ext_vector_type(2)));
typedef unsigned u32x4 __attribute__((ext_vector_type(4)));
typedef unsigned u32x2 __attribute__((ext_vector_type(2)));
constexpr int BM = 256, BK = 64, HALF = 128, HTB = HALF * BK * 2  , STAGE_BYTES = 8 * HTB;

__host__ __device__ __forceinline__ int lds_byte(int r, int c) { const int st = (r >> 4) * 2 + (c >> 5), rr = r & 15, cc = c & 31, ob = rr * 64 + cc * 2; return st * 1024 + (ob ^ (((ob >> 9) & 1) << 5)); }
__host__ __device__ __forceinline__ void stage_rc(int b, int& R, int& C) { const int st = b / 1024, sb = b % 1024, swz = sb ^ (((sb >> 9) & 1) << 5); R = (st >> 1) * 16 + swz / 64; C = (st & 1) * 32 + (swz % 64) / 2; }
__host__ __device__ __forceinline__ int perm32(int rho) { const int n = rho >> 4, i = rho & 15; return 8 * (i >> 2) + 4 * n + (i & 3); }
__device__ __forceinline__ unsigned pkh(float lo, float hi) { const f32x2 v = {lo, hi}; const f16x2 h = __builtin_convertvector(v, f16x2); return __builtin_bit_cast(unsigned, h); }

typedef int i32x8 __attribute__((ext_vector_type(8)));
typedef int i32x4 __attribute__((ext_vector_type(4)));
__device__ __forceinline__ i32x8 cat8(f16x8 lo, f16x8 hi) { return __builtin_shufflevector(__builtin_bit_cast(i32x4, lo), __builtin_bit_cast(i32x4, hi), 0, 1, 2, 3, 4, 5, 6, 7); }
__device__ __forceinline__ void mfma_f8(f32x4& c, const i32x8& a, const i32x8& b, int scale) {
    asm volatile("v_mfma_scale_f32_16x16x128_f8f6f4 %0, %1, %2, %0, %3, %3 op_sel_hi:[0,0,0]" : "+v"(c) : "v"(a), "v"(b), "v"(scale)); }
struct Unit { const char* a; const char* b; int pm, pn, e, x; };
typedef f32x4 Acc[2][2][4][2];
__device__ __forceinline__ void acc_zero(Acc& acc) {
#pragma unroll
    for (int a = 0; a < 2; ++a)
#pragma unroll
        for (int b = 0; b < 2; ++b)
#pragma unroll
            for (int m = 0; m < 4; ++m)
#pragma unroll
                for (int n = 0; n < 2; ++n) acc[a][b][m][n] = (f32x4){0.f, 0.f, 0.f, 0.f};
}
struct EpiBase {
    static constexpr bool PERM = false;
    __device__ __forceinline__ void init(Acc& acc, const Unit&, int, int, int, int) const { acc_zero(acc); }
    __device__ __forceinline__ void reinit(Acc& acc, const Unit&, const Unit&, int, int, int, int) const { acc_zero(acc); }
};

template <class Epi, class Sched, int MODE  , bool ALIGN_EPI, int ES = 2  , bool BF = false  , int ILV = 2  >
__device__ __forceinline__ void gemm_phase(PG_LAS unsigned char* lds, const int lda, const int ldb, const int nt_, const Sched& S, const Epi& E, const int lda1 = 0, const int ldb1 = 0, const int skew_ticks = 0  ) {
    constexpr bool GATHER = (MODE == 1), DUAL = (MODE == 2);
    int nt = nt_; asm volatile("" : "+s"(nt));
    int tid_ = threadIdx.x; asm volatile("" : "+v"(tid_));
    const int tid = tid_, wid = __builtin_amdgcn_readfirstlane(tid >> 6), lane = tid & 63, wr = wid >> 2, wc = wid & 3, fr = lane & 15, fq = lane >> 4;
    unsigned voffA[2], voffB[2]; int sR[2], sC[2];
#pragma unroll
    for (int i = 0; i < 2; ++i) { int R, C; stage_rc(tid * 16 + i * 8192, R, C); sR[i] = R; sC[i] = C; const int Rb = Epi::PERM ? ((R & ~31) + perm32(R & 31)) : R;
        voffA[i] = (unsigned)(R * lda * ES + C * 2); voffB[i] = (unsigned)(Rb * ldb * ES + C * 2); }
    const size_t kstep = (size_t)(BK * 2);
    const size_t hstepA0 = GATHER ? 0 : (size_t)HALF * lda * ES, hstepB0 = (size_t)HALF * ldb * ES, hstepA1 = (size_t)HALF * lda1 * ES, hstepB1 = (size_t)HALF * ldb1 * ES;
    unsigned wA1[2], wB1[2];
#pragma unroll
    for (int i = 0; i < 2; ++i) { const int Rb = Epi::PERM ? ((sR[i] & ~31) + perm32(sR[i] & 31)) : sR[i]; wA1[i] = (unsigned)(sR[i] * lda1 * ES + sC[i] * 2); wB1[i] = (unsigned)(Rb * ldb1 * ES + sC[i] * 2); }
    unsigned vAc[2], vBc[2], vAn[2], vBn[2], vA2[2], vB2[2];
    size_t hAc = hstepA0, hBc = hstepB0, hAn = hstepA0, hBn = hstepB0, hA2 = hstepA0, hB2 = hstepB0;
    const unsigned ldsw = (unsigned)wid * 1024u;
    const int aoff = (ES == 2) ? lds_byte(wr * 64 + fr, fq * 8) : lds_byte(wr * 64 + fr, fq * 16), boff = (ES == 2) ? lds_byte(wc * 32 + fr, fq * 8) : lds_byte(wc * 32 + fr, fq * 16);
    unsigned gc[2][2], gn[2][2], g2[2][2];
#define PG_SA(b, h) (((b) * 2 + (h)) * HTB)
#define PG_SB(b, h) ((4 + (b) * 2 + (h)) * HTB)
#if !defined(PG_GLOBAL_DMA)
#define PG_STAGE(bufoff, gbase, voff) do { const __amdgpu_buffer_rsrc_t _r = __builtin_amdgcn_make_buffer_rsrc((void*)(gbase), 0, 0x7fffffff, 0x00020000); _Pragma("unroll") for (int _i = 0; _i < 2; ++_i) \
        __builtin_amdgcn_raw_ptr_buffer_load_lds(_r, (PG_LAS unsigned*)(lds + (bufoff) + ldsw + _i * 8192), 16, (int)(voff)[_i], 0, 0, 0); } while (0)
#else
#define PG_STAGE(bufoff, gbase, voff) do { _Pragma("unroll") for (int _i = 0; _i < 2; ++_i) \
        __builtin_amdgcn_global_load_lds((const unsigned*)((const char*)(gbase) + (voff)[_i]), (PG_LAS unsigned*)(lds + (bufoff) + ldsw + _i * 8192), 16, 0, 0); } while (0)
#endif
#define PG_STAGE_A(bufoff, kptr, h, G, VA, HA) do { if constexpr (GATHER) { PG_STAGE(bufoff, kptr, G[h]); } else { PG_STAGE(bufoff, (kptr) + (h) * (HA), VA); } } while (0)
#define PG_CFG(u, VA, VB, HA, HB) do { if constexpr (DUAL) { const bool _x = (u).x != 0; _Pragma("unroll") for (int _i = 0; _i < 2; ++_i) { VA[_i] = _x ? wA1[_i] : voffA[_i]; VB[_i] = _x ? wB1[_i] : voffB[_i]; } \
        HA = _x ? hstepA1 : hstepA0; HB = _x ? hstepB1 : hstepB0; } else { _Pragma("unroll") for (int _i = 0; _i < 2; ++_i) { VA[_i] = voffA[_i]; VB[_i] = voffB[_i]; } HA = hstepA0; HB = hstepB0; } } while (0)
#define PG_GLOAD(dst, u) do { _Pragma("unroll") for (int _h = 0; _h < 2; ++_h) _Pragma("unroll") for (int _i = 0; _i < 2; ++_i) \
        dst[_h][_i] = S.arow(u, _h * HALF + sR[_i]) * (unsigned)(lda * ES) + (unsigned)(sC[_i] * 2); } while (0)
#define PG_LDF(p) (*(const PG_LAS f16x8*)(p))
#define PG_LDA(dst, b, h) do { if constexpr (ES == 2) { _Pragma("unroll") for (int m = 0; m < 4; ++m) _Pragma("unroll") for (int k = 0; k < 2; ++k) dst[m][k] = PG_LDF(lds + PG_SA(b, h) + aoff + m * 2048 + k * 1024); } \
        else { _Pragma("unroll") for (int m = 0; m < 4; ++m) dst##8[m] = cat8(PG_LDF(lds + PG_SA(b, h) + aoff + m * 2048), PG_LDF(lds + PG_SA(b, h) + aoff + m * 2048 + 16)); } } while (0)
#define PG_LDB(dst, b, h) do { if constexpr (ES == 2) { _Pragma("unroll") for (int n = 0; n < 2; ++n) _Pragma("unroll") for (int k = 0; k < 2; ++k) dst[n][k] = PG_LDF(lds + PG_SB(b, h) + boff + n * 2048 + k * 1024); } \
        else { _Pragma("unroll") for (int n = 0; n < 2; ++n) dst##8[n] = cat8(PG_LDF(lds + PG_SB(b, h) + boff + n * 2048), PG_LDF(lds + PG_SB(b, h) + boff + n * 2048 + 16)); } } while (0)
#define PG_MMA(ai, bj, At, Bt) do { __builtin_amdgcn_s_setprio(1); if constexpr (ES == 2) { _Pragma("unroll") for (int m = 0; m < 4; ++m) _Pragma("unroll") for (int n = 0; n < 2; ++n) _Pragma("unroll") for (int k = 0; k < 2; ++k) \
        acc[ai][bj][m][n] = BF ? __builtin_amdgcn_mfma_f32_16x16x32_bf16(__builtin_bit_cast(bf16x8, Bt[n][k]), __builtin_bit_cast(bf16x8, At[m][k]), acc[ai][bj][m][n], 0, 0, 0) : __builtin_amdgcn_mfma_f32_16x16x32_f16(Bt[n][k], At[m][k], acc[ai][bj][m][n], 0, 0, 0); } else { _Pragma("unroll") for (int m = 0; m < 4; ++m) _Pragma("unroll") for (int n = 0; n < 2; ++n) \
        mfma_f8(acc[ai][bj][m][n], Bt##8[n], At##8[m], f8scale); } \
        __builtin_amdgcn_s_setprio(0); } while (0)
#define PG_MMH(ai, bj, At, Bt, M0) do { __builtin_amdgcn_s_setprio(1); if constexpr (ES == 2) { _Pragma("unroll") for (int m = (M0); m < (M0) + 2; ++m) _Pragma("unroll") for (int n = 0; n < 2; ++n) _Pragma("unroll") for (int k = 0; k < 2; ++k) \
        acc[ai][bj][m][n] = BF ? __builtin_amdgcn_mfma_f32_16x16x32_bf16(__builtin_bit_cast(bf16x8, Bt[n][k]), __builtin_bit_cast(bf16x8, At[m][k]), acc[ai][bj][m][n], 0, 0, 0) : __builtin_amdgcn_mfma_f32_16x16x32_f16(Bt[n][k], At[m][k], acc[ai][bj][m][n], 0, 0, 0); } else { _Pragma("unroll") for (int m = (M0); m < (M0) + 2; ++m) _Pragma("unroll") for (int n = 0; n < 2; ++n) \
        mfma_f8(acc[ai][bj][m][n], Bt##8[n], At##8[m], f8scale); } \
        __builtin_amdgcn_s_setprio(0); } while (0)
#define PG_WAIT_V(n) asm volatile("s_waitcnt vmcnt(" #n ")" ::: "memory")
#define PG_WAIT_L(n) asm volatile("s_waitcnt lgkmcnt(" #n ")" ::: "memory")
#define PG_BAR __builtin_amdgcn_s_barrier()
#define PG_SCHED __builtin_amdgcn_sched_barrier(0)
    if (skew_ticks > 0) { const unsigned long long t0 = __builtin_amdgcn_s_memrealtime(); while (__builtin_amdgcn_s_memrealtime() - t0 < (unsigned long long)skew_ticks) __builtin_amdgcn_s_sleep(8); }
    Unit cur, nxt; int ui = 0;
    if (!S.next(0, cur)) return;
    Acc acc;
    E.init(acc, cur, wr, wc, fr, fq);
    f16x8 At[4][2], B0[2][2], B1[2][2];
    int f8scale = 0x7f7f7f7f; asm volatile("" : "+v"(f8scale));
    i32x8 At8[4], B08[2], B18[2];
    const char* cA = cur.a; const char* cB = cur.b;
    if constexpr (GATHER) { PG_GLOAD(gc, cur); }
    PG_CFG(cur, vAc, vBc, hAc, hBc);
    PG_STAGE(PG_SB(0, 0), cB, vBc); PG_STAGE(PG_SB(0, 1), cB + hBc, vBc); PG_STAGE_A(PG_SA(0, 0), cA, 0, gc, vAc, hAc); PG_STAGE_A(PG_SA(0, 1), cA, 1, gc, vAc, hAc);
    if (wr == 1) PG_BAR;
    PG_WAIT_V(2); PG_BAR;
    if constexpr (ILV >= 2 && ILV <= 4) { PG_STAGE(PG_SB(1, 0), cB + kstep, vBc); PG_STAGE(PG_SB(1, 1), cB + hBc + kstep, vBc); PG_WAIT_V(4); PG_BAR; }
    else { PG_STAGE(PG_SB(1, 0), cB + kstep, vBc); PG_STAGE_A(PG_SA(1, 0), cA + kstep, 0, gc, vAc, hAc); PG_STAGE(PG_SB(1, 1), cB + hBc + kstep, vBc);
    PG_WAIT_V(6); PG_BAR; }
    for (;;) {
        const bool has_next = S.next(ui + 1, nxt);
        const char* nA = has_next ? nxt.a : cA; const char* nB = has_next ? nxt.b : cB;
        if constexpr (GATHER) { if (has_next) { PG_GLOAD(gn, nxt); } else {
#pragma unroll
            for (int h = 0; h < 2; ++h)
#pragma unroll
                for (int i = 0; i < 2; ++i) gn[h][i] = gc[h][i]; } }
        if (has_next) { PG_CFG(nxt, vAn, vBn, hAn, hBn); } else { PG_CFG(cur, vAn, vBn, hAn, hBn); }
        for (int t = 0; t < nt; t += 2) {
            const bool last = (t == nt - 2);
            const char* a1 = cA + (size_t)(t + 1) * kstep;
            const char* a2 = last ? nA : cA + (size_t)(t + 2) * kstep; const char* b2 = last ? nB : cB + (size_t)(t + 2) * kstep;
            const char* a3 = a2 + kstep; const char* b3 = b2 + kstep;
            if constexpr (GATHER) {
#pragma unroll
                for (int h = 0; h < 2; ++h)
#pragma unroll
                    for (int i = 0; i < 2; ++i) g2[h][i] = last ? gn[h][i] : gc[h][i]; }
            if constexpr (DUAL) {
#pragma unroll
                for (int i = 0; i < 2; ++i) { vA2[i] = last ? vAn[i] : vAc[i]; vB2[i] = last ? vBn[i] : vBc[i]; }
                hA2 = last ? hAn : hAc; hB2 = last ? hBn : hBc;
            } else {
#pragma unroll
                for (int i = 0; i < 2; ++i) { vA2[i] = vAc[i]; vB2[i] = vBc[i]; }
                hA2 = hAc; hB2 = hBc; }
            if constexpr (ILV == 5) {
            PG_LDB(B0, 0, 0); PG_SCHED; PG_LDA(At, 0, 0); PG_STAGE_A(PG_SA(1, 1), a1, 1, gc, vAc, hAc);
            PG_WAIT_L(8); PG_BAR; PG_WAIT_L(0); PG_MMA(0, 0, At, B0); PG_BAR; PG_SCHED;
            PG_LDB(B1, 0, 1); PG_STAGE(PG_SB(0, 0), b2, vB2);
            PG_BAR; PG_WAIT_L(0); PG_MMA(0, 1, At, B1); PG_BAR; PG_SCHED;
            PG_LDA(At, 0, 1); PG_STAGE_A(PG_SA(0, 0), a2, 0, g2, vA2, hA2);
            PG_BAR; PG_WAIT_L(0); PG_MMA(1, 0, At, B0); PG_BAR; PG_SCHED;
            PG_STAGE(PG_SB(0, 1), b2 + hB2, vB2);
            PG_WAIT_V(6); PG_BAR; PG_MMA(1, 1, At, B1); PG_BAR; PG_SCHED;
            PG_LDB(B0, 1, 0); PG_SCHED; PG_LDA(At, 1, 0); PG_STAGE_A(PG_SA(0, 1), a2, 1, g2, vA2, hA2);
            PG_WAIT_L(8); PG_BAR; PG_WAIT_L(0); PG_MMA(0, 0, At, B0); PG_BAR; PG_SCHED;
            PG_LDB(B1, 1, 1); PG_STAGE(PG_SB(1, 0), b3, vB2);
            PG_BAR; PG_WAIT_L(0); PG_MMA(0, 1, At, B1); PG_BAR; PG_SCHED;
            PG_LDA(At, 1, 1); PG_STAGE_A(PG_SA(1, 0), a3, 0, g2, vA2, hA2);
            PG_BAR; PG_WAIT_L(0); PG_MMA(1, 0, At, B0); PG_BAR; PG_SCHED;
            PG_STAGE(PG_SB(1, 1), b3 + hB2, vB2);
            PG_WAIT_V(6); PG_BAR; PG_MMA(1, 1, At, B1); PG_BAR; PG_SCHED;
            } else if constexpr (ILV == 3) {
            PG_LDB(B0, 0, 0); PG_LDB(B1, 0, 1); PG_SCHED; PG_LDA(At, 0, 0); PG_STAGE_A(PG_SA(1, 0), a1, 0, gc, vAc, hAc);
            PG_WAIT_V(6); PG_WAIT_L(0); PG_BAR; PG_MMA(0, 0, At, B0); PG_SCHED; PG_STAGE_A(PG_SA(1, 1), a1, 1, gc, vAc, hAc); PG_SCHED; PG_MMA(0, 1, At, B1); PG_BAR; PG_SCHED;
            PG_LDA(At, 0, 1); PG_STAGE(PG_SB(0, 0), b2, vB2);
            PG_WAIT_V(4); PG_WAIT_L(0); PG_BAR; PG_MMA(1, 0, At, B0); PG_SCHED; PG_STAGE(PG_SB(0, 1), b2 + hB2, vB2); PG_SCHED; PG_MMA(1, 1, At, B1); PG_BAR; PG_SCHED;
            PG_LDB(B0, 1, 0); PG_LDB(B1, 1, 1); PG_SCHED; PG_LDA(At, 1, 0); PG_STAGE_A(PG_SA(0, 0), a2, 0, g2, vA2, hA2);
            PG_WAIT_V(6); PG_WAIT_L(0); PG_BAR; PG_MMA(0, 0, At, B0); PG_SCHED; PG_STAGE_A(PG_SA(0, 1), a2, 1, g2, vA2, hA2); PG_SCHED; PG_MMA(0, 1, At, B1); PG_BAR; PG_SCHED;
            PG_LDA(At, 1, 1); PG_STAGE(PG_SB(1, 0), b3, vB2);
            PG_WAIT_V(4); PG_WAIT_L(0); PG_BAR; PG_MMA(1, 0, At, B0); PG_SCHED; PG_STAGE(PG_SB(1, 1), b3 + hB2, vB2); PG_SCHED; PG_MMA(1, 1, At, B1); PG_BAR; PG_SCHED;
            } else if constexpr (ILV == 4) {
            PG_LDB(B0, 0, 0); PG_SCHED; PG_STAGE_A(PG_SA(1, 0), a1, 0, gc, vAc, hAc); PG_SCHED; PG_LDA(At, 0, 0); PG_SCHED; PG_STAGE_A(PG_SA(1, 1), a1, 1, gc, vAc, hAc);
            PG_WAIT_V(8); PG_BAR; PG_WAIT_L(0); PG_MMA(0, 0, At, B0); PG_SCHED; PG_LDB(B1, 0, 1); PG_WAIT_L(0); PG_SCHED; PG_MMA(0, 1, At, B1); PG_BAR; PG_SCHED;
            PG_LDA(At, 0, 1); PG_STAGE(PG_SB(0, 0), b2, vB2); PG_STAGE(PG_SB(0, 1), b2 + hB2, vB2);
            PG_WAIT_V(6); PG_BAR; PG_WAIT_L(0); PG_MMA(1, 0, At, B0); PG_MMA(1, 1, At, B1); PG_BAR; PG_SCHED;
            PG_LDB(B0, 1, 0); PG_SCHED; PG_STAGE_A(PG_SA(0, 0), a2, 0, g2, vA2, hA2); PG_SCHED; PG_LDA(At, 1, 0); PG_SCHED; PG_STAGE_A(PG_SA(0, 1), a2, 1, g2, vA2, hA2);
            PG_WAIT_V(8); PG_BAR; PG_WAIT_L(0); PG_MMA(0, 0, At, B0); PG_SCHED; PG_LDB(B1, 1, 1); PG_WAIT_L(0); PG_SCHED; PG_MMA(0, 1, At, B1); PG_BAR; PG_SCHED;
            PG_LDA(At, 1, 1); PG_STAGE(PG_SB(1, 0), b3, vB2); PG_STAGE(PG_SB(1, 1), b3 + hB2, vB2);
            PG_WAIT_V(6); PG_BAR; PG_WAIT_L(0); PG_MMA(1, 0, At, B0); PG_MMA(1, 1, At, B1); PG_BAR; PG_SCHED;
            } else if constexpr (ILV == 2) {
            PG_LDB(B0, 0, 0); PG_LDB(B1, 0, 1); PG_SCHED; PG_STAGE_A(PG_SA(1, 0), a1, 0, gc, vAc, hAc); PG_SCHED; PG_LDA(At, 0, 0); PG_SCHED; PG_STAGE_A(PG_SA(1, 1), a1, 1, gc, vAc, hAc);
            PG_WAIT_V(8); PG_BAR; PG_WAIT_L(0); PG_MMA(0, 0, At, B0); PG_MMA(0, 1, At, B1); PG_BAR; PG_SCHED;
            PG_LDA(At, 0, 1); PG_STAGE(PG_SB(0, 0), b2, vB2); PG_STAGE(PG_SB(0, 1), b2 + hB2, vB2);
            PG_WAIT_V(6); PG_BAR; PG_WAIT_L(0); PG_MMA(1, 0, At, B0); PG_MMA(1, 1, At, B1); PG_BAR; PG_SCHED;
            PG_LDB(B0, 1, 0); PG_LDB(B1, 1, 1); PG_SCHED; PG_STAGE_A(PG_SA(0, 0), a2, 0, g2, vA2, hA2); PG_SCHED; PG_LDA(At, 1, 0); PG_SCHED; PG_STAGE_A(PG_SA(0, 1), a2, 1, g2, vA2, hA2);
            PG_WAIT_V(8); PG_BAR; PG_WAIT_L(0); PG_MMA(0, 0, At, B0); PG_MMA(0, 1, At, B1); PG_BAR; PG_SCHED;
            PG_LDA(At, 1, 1); PG_STAGE(PG_SB(1, 0), b3, vB2); PG_STAGE(PG_SB(1, 1), b3 + hB2, vB2);
            PG_WAIT_V(6); PG_BAR; PG_WAIT_L(0); PG_MMA(1, 0, At, B0); PG_MMA(1, 1, At, B1); PG_BAR; PG_SCHED;
            } else if constexpr (ILV == 1) {
            PG_LDB(B0, 0, 0); PG_LDB(B1, 0, 1); PG_SCHED; PG_LDA(At, 0, 0);
            PG_WAIT_V(6); PG_WAIT_L(0); PG_BAR; PG_MMA(0, 0, At, B0); PG_SCHED; PG_STAGE_A(PG_SA(1, 1), a1, 1, gc, vAc, hAc); PG_SCHED; PG_MMA(0, 1, At, B1); PG_BAR; PG_SCHED;
            PG_LDA(At, 0, 1);
            PG_WAIT_V(2); PG_WAIT_L(0); PG_BAR; PG_MMH(1, 0, At, B0, 0); PG_SCHED; PG_STAGE(PG_SB(0, 0), b2, vB2); PG_SCHED; PG_MMH(1, 0, At, B0, 2); PG_SCHED; PG_STAGE(PG_SB(0, 1), b2 + hB2, vB2); PG_SCHED;
                PG_MMH(1, 1, At, B1, 0); PG_SCHED; PG_STAGE_A(PG_SA(0, 0), a2, 0, g2, vA2, hA2); PG_SCHED; PG_MMH(1, 1, At, B1, 2); PG_BAR; PG_SCHED;
            PG_LDB(B0, 1, 0); PG_LDB(B1, 1, 1); PG_SCHED; PG_LDA(At, 1, 0);
            PG_WAIT_V(6); PG_WAIT_L(0); PG_BAR; PG_MMA(0, 0, At, B0); PG_SCHED; PG_STAGE_A(PG_SA(0, 1), a2, 1, g2, vA2, hA2); PG_SCHED; PG_MMA(0, 1, At, B1); PG_BAR; PG_SCHED;
            PG_LDA(At, 1, 1);
            PG_WAIT_V(2); PG_WAIT_L(0); PG_BAR; PG_MMH(1, 0, At, B0, 0); PG_SCHED; PG_STAGE(PG_SB(1, 0), b3, vB2); PG_SCHED; PG_MMH(1, 0, At, B0, 2); PG_SCHED; PG_STAGE(PG_SB(1, 1), b3 + hB2, vB2); PG_SCHED;
                PG_MMH(1, 1, At, B1, 0); PG_SCHED; PG_STAGE_A(PG_SA(1, 0), a3, 0, g2, vA2, hA2); PG_SCHED; PG_MMH(1, 1, At, B1, 2); PG_BAR; PG_SCHED;
            } else {
            PG_LDB(B0, 0, 0); PG_LDB(B1, 0, 1); PG_SCHED; PG_LDA(At, 0, 0); PG_STAGE_A(PG_SA(1, 1), a1, 1, gc, vAc, hAc);
            PG_WAIT_V(8); PG_WAIT_L(0); PG_BAR; PG_MMA(0, 0, At, B0); PG_MMA(0, 1, At, B1); PG_BAR; PG_SCHED;
            PG_LDA(At, 0, 1); PG_STAGE(PG_SB(0, 0), b2, vB2); PG_STAGE(PG_SB(0, 1), b2 + hB2, vB2); PG_STAGE_A(PG_SA(0, 0), a2, 0, g2, vA2, hA2);
            PG_WAIT_V(8); PG_WAIT_L(0); PG_BAR; PG_MMA(1, 0, At, B0); PG_MMA(1, 1, At, B1); PG_BAR; PG_SCHED;
            PG_LDB(B0, 1, 0); PG_LDB(B1, 1, 1); PG_SCHED; PG_LDA(At, 1, 0); PG_STAGE_A(PG_SA(0, 1), a2, 1, g2, vA2, hA2);
            PG_WAIT_V(8); PG_WAIT_L(0); PG_BAR; PG_MMA(0, 0, At, B0); PG_MMA(0, 1, At, B1); PG_BAR; PG_SCHED;
            PG_LDA(At, 1, 1); PG_STAGE(PG_SB(1, 0), b3, vB2); PG_STAGE(PG_SB(1, 1), b3 + hB2, vB2); PG_STAGE_A(PG_SA(1, 0), a3, 0, g2, vA2, hA2);
            PG_WAIT_V(8); PG_WAIT_L(0); PG_BAR; PG_MMA(1, 0, At, B0); PG_MMA(1, 1, At, B1); PG_BAR; PG_SCHED;
            }
        }
        if constexpr (ES == 1) asm volatile("s_nop 15\n\ts_nop 15" ::: "memory");
        if constexpr (ALIGN_EPI) { if (wr == 0) PG_BAR; }
        E(acc, cur, wr, wc, fr, fq);
        if (!has_next) break;
        E.reinit(acc, cur, nxt, wr, wc, fr, fq);
        cur = nxt; cA = nA; cB = nB; ++ui;
        if constexpr (GATHER) {
#pragma unroll
            for (int h = 0; h < 2; ++h)
#pragma unroll
                for (int i = 0; i < 2; ++i) gc[h][i] = gn[h][i]; }
        if constexpr (DUAL) {
#pragma unroll
            for (int i = 0; i < 2; ++i) { vAc[i] = vAn[i]; vBc[i] = vBn[i]; }
            hAc = hAn; hBc = hBn; }
        if constexpr (ALIGN_EPI) { if (wr == 1) PG_BAR; }
    }
    PG_WAIT_V(0);
    if constexpr (!ALIGN_EPI) { if (wr == 0) PG_BAR; }
    PG_BAR;
#undef PG_SA
#undef PG_SB
#undef PG_STAGE
#undef PG_STAGE_A
#undef PG_GLOAD
#undef PG_CFG
#undef PG_LDA
#undef PG_LDF
#undef PG_LDB
#undef PG_MMA
#undef PG_MMH
#undef PG_WAIT_V
#undef PG_WAIT_L
#undef PG_BAR
#undef PG_SCHED
}
}
constexpr int NWAVES = 8;
constexpr int T_ = 32768, D_ = 1024, SEQ_ = 8192;
constexpr int NSLOT_MAX = (512 + 32) * 256, NTILE_MAX = 544;
constexpr float ALPHA_ = 1.4142135623730951f, LN_EPS_ = 1e-5f;
constexpr int RING_OFF = 0, RING_BYTES = 131072;
constexpr int TAB_OFF = RING_BYTES, TAB_BYTES = 24576;
constexpr int LDSCTL_OFF = TAB_OFF + TAB_BYTES, MISC_OFF = LDSCTL_OFF + 320;
constexpr int LDS_BYTES = 159744;
constexpr int CW_TMO = 0, CW_CODE = 1, CW_NTILES = 64, CW_BAR = 4096;
constexpr int N_BAR_REGIONS = 12;
constexpr size_t CTL_ZERO_BYTES = 1u << 20;
static_assert((CW_BAR + N_BAR_REGIONS * XCD_BAR_WORDS) * 4 <= (int)CTL_ZERO_BYTES, "barrier regions inside the memset region");
typedef unsigned short h16;
typedef float f32x2v __attribute__((ext_vector_type(2)));
typedef unsigned v2u __attribute__((ext_vector_type(2)));
#define EPI_OPAQUE() asm volatile("" : "+v"(fr), "+v"(fq))

struct Params {
    const float *x, *w_ret_in, *w_ret_out, *w_swa_in, *b_swa_in, *w_swa_out, *b_swa_out, *sinks, *ln_mix_g, *ln_mix_b, *w_router, *b_router, *w_exp_in, *b_exp_in, *w_exp_out, *b_exp_out, *ln_ffn_g, *ln_ffn_b;
    float* out;
    unsigned* ctl;
    int *top_e, *rankp, *inv, *slot_tok, *wg_cnt, *tile_e; float *top_g, *slot_gate;
    h16 *wri_t, *wfm_t, *wro_t, *wsi_t, *wso_t, *w1_t, *w2_t;
    h16 *xh0, *x1h, *x2h, *yh; float *x1f, *x2f, *yf;
    h16 *act, *yy;
    h16 *q, *k, *sg, *kdt, *vt, *pp, *st, *o, *og; float* ltot;
    h16 *sq, *skv, *kvt, *so;
    const float* cv_src; h16* cv_dst; size_t cv_n; float* projf;
    unsigned char *w1q, *w2q, *x1q, *actq;
    int ph_lo, ph_hi, li, layer;
};

struct Frame {
    LAS unsigned char* lds; volatile LAS unsigned* MISC; gu32* ctl;
    int tid, lane, wave, vcu, G;
};
__device__ __forceinline__ float wave_sum(float v) {
    v += __builtin_bit_cast(float, __builtin_amdgcn_update_dpp(0, __builtin_bit_cast(int, v), 0x111, 0xf, 0xf, true));
    v += __builtin_bit_cast(float, __builtin_amdgcn_update_dpp(0, __builtin_bit_cast(int, v), 0x112, 0xf, 0xf, true));
    v += __builtin_bit_cast(float, __builtin_amdgcn_update_dpp(0, __builtin_bit_cast(int, v), 0x114, 0xf, 0xf, true));
    v += __builtin_bit_cast(float, __builtin_amdgcn_update_dpp(0, __builtin_bit_cast(int, v), 0x118, 0xf, 0xf, true));
    v += __builtin_bit_cast(float, __builtin_amdgcn_update_dpp(0, __builtin_bit_cast(int, v), 0x142, 0xa, 0xf, true));
    v += __builtin_bit_cast(float, __builtin_amdgcn_update_dpp(0, __builtin_bit_cast(int, v), 0x143, 0xc, 0xf, true));
    return __builtin_bit_cast(float, __builtin_amdgcn_readlane(__builtin_bit_cast(int, v), 63));
}
__device__ __forceinline__ unsigned pkh(float lo, float hi) { return pg::pkh(lo, hi); }
__device__ __forceinline__ float h2f(unsigned short h) { return (float)__builtin_bit_cast(_Float16, h); }

template <class RowMap>
__device__ __forceinline__ void transpose_item(const float* W, int K, int N, h16* WT, const RowMap& rm, LAS float* scr, int item, int lane) {
    const int nblk = N / 32, kb = item / nblk, nb = item % nblk, k0 = 64 * kb, n0 = 32 * nb;
#pragma unroll 8
    for (int i = 0; i < 32; ++i) { const int kk = 2 * i + (lane >> 5); scr[kk * 33 + (lane & 31)] = W[(size_t)(k0 + kk) * N + n0 + (lane & 31)]; }
    LDS_WAIT(); asm volatile("" ::: "memory");
    const int c = lane & 7;
#pragma unroll
    for (int j = 0; j < 4; ++j) { const int n = (lane >> 3) + 8 * j; const LAS float* s = scr + (8 * c) * 33 + n;
        v4u o; o.x = pkh(s[0 * 33], s[1 * 33]); o.y = pkh(s[2 * 33], s[3 * 33]); o.z = pkh(s[4 * 33], s[5 * 33]); o.w = pkh(s[6 * 33], s[7 * 33]);
        const long dr = rm(n0 + n);
        if (dr >= 0) *(GAS v4u*)(WT + (size_t)dr * K + k0 + 8 * c) = o; }
    LDS_WAIT(); asm volatile("" ::: "memory");
}
struct RmIdent { int off; __device__ __forceinline__ long operator()(int n) const { return off + n; } };
struct RmW1 { __device__ __forceinline__ long operator()(int n) const { const int j = n & 1023; return 256 * (j >> 7) + (n >> 10) * 128 + (j & 127); } };
struct RmRange { int lo, hi, off; __device__ __forceinline__ long operator()(int n) const { return (n >= lo && n < hi) ? (long)(off + n - lo) : -1; } };

__device__ __forceinline__ void ph_convert_moe(const Params& p, Frame& F, int layer) {
    LAS float* scr = (LAS float*)(F.lds + RING_OFF + F.wave * 16384);
    const int gw = F.vcu * NWAVES + F.wave, NGW = F.G * NWAVES;
    constexpr int I1 = (1024 / 64) * (2048 / 32), I2 = (1024 / 64) * (1024 / 32);
    const float* w1 = p.w_exp_in + (size_t)layer * 32 * 1024 * 2048; const float* w2 = p.w_exp_out + (size_t)layer * 32 * 1024 * 1024;
    h16* w1t = p.w1_t + (size_t)layer * 32 * 2048 * 1024; h16* w2t = p.w2_t + (size_t)layer * 32 * 1024 * 1024;
    for (int it = gw; it < 32 * (I1 + I2); it += NGW) {
        if (it < 32 * I1) { const int e = it / I1, r = it % I1; transpose_item(w1 + (size_t)e * 1024 * 2048, 1024, 2048, w1t + (size_t)e * 2048 * 1024, RmW1{}, scr, r, F.lane); }
        else { const int q = it - 32 * I1, e = q / I2, r = q % I2; transpose_item(w2 + (size_t)e * 1024 * 1024, 1024, 1024, w2t + (size_t)e * 1024 * 1024, RmIdent{0}, scr, r, F.lane); }
    }
}
__device__ __forceinline__ void ph_cvt_rows(const float* src, h16* dst, size_t n, Frame& F) {
    const size_t stride = (size_t)F.G * 512 * 8;
    for (size_t i0 = ((size_t)blockIdx.x * 512 + F.tid) * 8; i0 < n; i0 += 4 * stride) {
        f32x4 a[4], b[4];
#pragma unroll
        for (int u = 0; u < 4; ++u) { const size_t i = i0 + u * stride; if (i < n) { a[u] = __builtin_nontemporal_load((const GAS f32x4*)(src + i)); b[u] = __builtin_nontemporal_load((const GAS f32x4*)(src + i + 4)); } }
#pragma unroll
        for (int u = 0; u < 4; ++u) { const size_t i = i0 + u * stride; if (i < n) { v4u o; o.x = pkh(a[u].x, a[u].y); o.y = pkh(a[u].z, a[u].w); o.z = pkh(b[u].x, b[u].y); o.w = pkh(b[u].z, b[u].w); *(GAS v4u*)(dst + i) = o; } }
    }
}

__device__ __forceinline__ void ph_rank(const Params& p, Frame& F) {
    LAS int* se = (LAS int*)(F.lds + RING_OFF);
    for (int cc = blockIdx.x; cc < T_ / 128; cc += F.G) {
        __syncthreads();
        const int j = F.tid; const int e = p.top_e[cc * 512 + j];
        se[j] = e;
        __syncthreads();
        int r = 0;
        for (int q = 0; q < j; ++q) r += (se[q] == e) ? 1 : 0;
        p.rankp[cc * 512 + j] = r;
        if (j < 32) { int c = 0; for (int q = 0; q < 512; ++q) c += (se[q] == j) ? 1 : 0; p.wg_cnt[cc * 32 + j] = c; }
    }
}
__device__ __forceinline__ void ph_assign(const Params& p, Frame& F, int layer) {
    int tid_o = F.tid; asm volatile("" : "+v"(tid_o));
    LAS int* tot = (LAS int*)(F.lds + RING_OFF);
    LAS int* bef = tot + 512;
    LAS int* tst = bef + 512;
    LAS int* bas = tst + 64;
    LAS int* ttl = bas + 32;
    for (int cc = blockIdx.x; cc < T_ / 128; cc += F.G) {
        __syncthreads();
        { const int e = tid_o & 31, part = tid_o >> 5; int s = 0, b = 0;
          for (int c2 = part * 16; c2 < part * 16 + 16; ++c2) { const int v = p.wg_cnt[c2 * 32 + e]; s += v; b += (c2 < cc) ? v : 0; }
          tot[part * 32 + e] = s; bef[part * 32 + e] = b; }
        __syncthreads();
        if (tid_o < 32) { int s = 0, b = 0; for (int q = 0; q < 16; ++q) { s += tot[q * 32 + tid_o]; b += bef[q * 32 + tid_o]; } ttl[tid_o] = s; bas[tid_o] = b; }
        __syncthreads();
        if (tid_o == 0) { int ts = 0; for (int e = 0; e < 32; ++e) { tst[e] = ts; ts += (ttl[e] + 255) >> 8; } tst[32] = ts; }
        __syncthreads();
        { const int j = tid_o, ent = cc * 512 + j, e = p.top_e[ent]; const int sl = 256 * tst[e] + bas[e] + p.rankp[ent];
          p.slot_tok[sl] = ent >> 2; p.slot_gate[sl] = p.top_g[ent]; p.inv[ent] = sl; }
        if (cc < 32) { const int e = cc; for (int sl = 256 * tst[e] + ttl[e] + tid_o; sl < 256 * tst[e + 1]; sl += 512) { p.slot_tok[sl] = 0; p.slot_gate[sl] = 0.f; } }
        if (cc == 0) { for (int rt = tid_o; rt < tst[32]; rt += 512) { int e = 0; for (int q = 1; q < 32; ++q) e += (tst[q] <= rt) ? 1 : 0; p.tile_e[rt] = e; }
            if (tid_o == 0) __hip_atomic_store(F.ctl + CW_NTILES + 64 * layer, (unsigned)tst[32], RLX_AGENT); }
    }
}

constexpr int MOE_MAXU = 20;
#ifndef MOE_F8_L0
#define MOE_F8_L0 1
#endif
constexpr int F8_FROM = MOE_F8_L0 ? 0 : 32;
struct MoeSched {
    const char* abase; const char* wbase; LAS const int* lt_e; LAS const int* lt_tok; int ntiles, nct_log, G, c; size_t a_tile_bytes, w_expert_bytes, w_tile_bytes;
    __device__ __forceinline__ bool next(int i, pg::Unit& u) const {
        const int L = i * G + c; if (L >= (ntiles << nct_log) || i >= MOE_MAXU) return false;
        const int rt = L >> nct_log, ct = L & ((1 << nct_log) - 1);
        const int e = __builtin_amdgcn_readfirstlane(lt_e[i]);
        u.a = abase + (size_t)rt * a_tile_bytes; u.b = wbase + (size_t)e * w_expert_bytes + (size_t)ct * w_tile_bytes; u.pm = rt; u.pn = ct; u.e = e; u.x = i; return true;
    }
    __device__ __forceinline__ unsigned arow(const pg::Unit& u, int r) const { return (unsigned)lt_tok[u.x * 256 + r]; }
};
__device__ __forceinline__ void moe_tables(Frame& F, const int* tile_e, const int* slot_tok, int ntiles, int nct_log, bool gather) {
    LAS int* lt_e = (LAS int*)(F.lds + TAB_OFF); LAS int* lt_tok = lt_e + 32;
    __syncthreads();
    for (int i = 0; i < MOE_MAXU; ++i) { const int L = i * F.G + F.vcu; if (L >= (ntiles << nct_log)) break; const int rt = L >> nct_log;
        if (F.tid == 0) lt_e[i] = tile_e[rt];
        if (gather && F.tid < 256) lt_tok[i * 256 + F.tid] = slot_tok[rt * 256 + F.tid]; }
    __syncthreads();
}
struct EpiSwiglu : pg::EpiBase {
    static constexpr bool PERM = true;
    h16* act; const float* b1;
    __device__ __forceinline__ void operator()(const pg::Acc& acc, const pg::Unit& u, int wr, int wc, int fr, int fq) const { EPI_OPAQUE();
        const int c0 = u.pn * 128 + wc * 32 + 8 * fq;
        const float* bg = b1 + (size_t)u.e * 2048 + c0; const float* bl = bg + 1024;
        const f32x4 g0 = *(const f32x4*)bg, g1 = *(const f32x4*)(bg + 4), l0 = *(const f32x4*)bl, l1 = *(const f32x4*)(bl + 4);
#pragma unroll
        for (int ai = 0; ai < 2; ++ai)
#pragma unroll
            for (int m = 0; m < 4; ++m) {
                const size_t row = (size_t)u.pm * 256 + ai * 128 + wr * 64 + m * 16 + fr;
                float r[8];
#pragma unroll
                for (int n = 0; n < 2; ++n)
#pragma unroll
                    for (int j = 0; j < 4; ++j) {
                        const float glu = fminf(acc[ai][0][m][n][j] + (n ? g1[j] : g0[j]), 7.0f);
                        const float lin = fminf(fmaxf(acc[ai][1][m][n][j] + (n ? l1[j] : l0[j]), -7.0f), 7.0f);
                        r[n * 4 + j] = glu * __builtin_amdgcn_rcpf(1.0f + __builtin_amdgcn_exp2f(-1.702f * 1.4426950408889634f * glu)) * (lin + 1.0f);
                    }
                v4u w; w.x = pkh(r[0], r[1]); w.y = pkh(r[2], r[3]); w.z = pkh(r[4], r[5]); w.w = pkh(r[6], r[7]);
                *(v4u*)(act + row * 1024 + c0) = w;
            }
    }
};
template <int VAR> struct EpiSwigluP : pg::EpiBase {
    static constexpr bool PERM = true;
    h16* act; const float* b1;
    __device__ __forceinline__ void operator()(const pg::Acc& acc, const pg::Unit& u, int wr, int wc, int fr, int fq) const { EPI_OPAQUE();
        const int c0 = u.pn * 128 + wc * 32 + 8 * fq;
        const float* bg = b1 + (size_t)u.e * 2048 + c0; const float* bl = bg + 1024;
        const f32x4 g0 = *(const f32x4*)bg, g1 = *(const f32x4*)(bg + 4), l0 = *(const f32x4*)bl, l1 = *(const f32x4*)(bl + 4);
#pragma unroll
        for (int ai = 0; ai < 2; ++ai)
#pragma unroll
            for (int m = 0; m < 4; ++m) {
                const size_t row = (size_t)u.pm * 256 + ai * 128 + wr * 64 + m * 16 + fr;
                float r[8];
#pragma unroll
                for (int n = 0; n < 2; ++n)
#pragma unroll
                    for (int j = 0; j < 4; ++j) {
                        const float glu = fminf(acc[ai][0][m][n][j] + (n ? g1[j] : g0[j]), 7.0f);
                        const float lin = fminf(fmaxf(acc[ai][1][m][n][j] + (n ? l1[j] : l0[j]), -7.0f), 7.0f);
                        r[n * 4 + j] = (VAR == 2) ? glu + lin : glu * __builtin_amdgcn_rcpf(1.0f + __builtin_amdgcn_exp2f(-1.702f * 1.4426950408889634f * glu)) * (lin + 1.0f);
                    }
                v4u w; w.x = pkh(r[0], r[1]); w.y = pkh(r[2], r[3]); w.z = pkh(r[4], r[5]); w.w = pkh(r[6], r[7]);
                if (VAR == 1) { asm volatile("" :: "v"(w.x), "v"(w.y), "v"(w.z), "v"(w.w)); } else { *(v4u*)(act + row * 1024 + c0) = w; }
            }
    }
};
struct EpiMoeOut : pg::EpiBase {
    static constexpr bool PERM = true;
    h16* __restrict__ y; const float* __restrict__ b2; const float* __restrict__ gate;
    __device__ __forceinline__ void operator()(const pg::Acc& acc, const pg::Unit& u, int wr, int wc, int fr, int fq) const { EPI_OPAQUE();
        float gt[2][4]; f32x4 bv[2][2];
#pragma unroll
        for (int ai = 0; ai < 2; ++ai)
#pragma unroll
            for (int m = 0; m < 4; ++m) gt[ai][m] = gate[(size_t)u.pm * 256 + ai * 128 + wr * 64 + m * 16 + fr];
#pragma unroll
        for (int bj = 0; bj < 2; ++bj) { const float* bp = b2 + (size_t)u.e * 1024 + u.pn * 256 + bj * 128 + wc * 32 + 8 * fq; bv[bj][0] = *(const f32x4*)bp; bv[bj][1] = *(const f32x4*)(bp + 4); }
#pragma unroll
        for (int ai = 0; ai < 2; ++ai)
#pragma unroll
            for (int m = 0; m < 4; ++m) {
                const size_t row = (size_t)u.pm * 256 + ai * 128 + wr * 64 + m * 16 + fr;
#pragma unroll
                for (int bj = 0; bj < 2; ++bj) {
                    const int c0 = u.pn * 256 + bj * 128 + wc * 32 + 8 * fq;
                    const f32x4 v0 = (acc[ai][bj][m][0] + bv[bj][0]) * gt[ai][m], v1 = (acc[ai][bj][m][1] + bv[bj][1]) * gt[ai][m];
                    v4u w; w.x = pkh(v0[0], v0[1]); w.y = pkh(v0[2], v0[3]); w.z = pkh(v1[0], v1[1]); w.w = pkh(v1[2], v1[3]);
                    *(v4u*)(y + row * 1024 + c0) = w;
                }
            }
    }
};
template <bool Y8> __device__ __forceinline__ void ph_combine_ln(const Params& p, Frame& F, const h16* xprev, const float* gam, const float* bet, float* outf, h16* outh) {
    int lane = F.lane; asm volatile("" : "+v"(lane));
    const int gw = F.vcu * NWAVES + F.wave, NGW = F.G * NWAVES;
    constexpr int NT = Y8 ? 4 : 3;
    for (int tb = gw * NT; tb < T_; tb += NGW * NT) {
        v4u xw[NT][2], yw[Y8 ? 1 : NT][2][4]; v2u yq[Y8 ? NT : 1][2][4];
#pragma unroll
        for (int u = 0; u < NT; ++u) { const int t = tb + u < T_ ? tb + u : T_ - 1; int sl[4];
#pragma unroll
            for (int k = 0; k < 4; ++k) sl[k] = p.inv[t * 4 + k];
#pragma unroll
            for (int j = 0; j < 2; ++j) { const int c = 8 * lane + 512 * j; xw[u][j] = __builtin_nontemporal_load((const GAS v4u*)(xprev + (size_t)t * 1024 + c));
#pragma unroll
                for (int k = 0; k < 4; ++k) { if constexpr (Y8) yq[u][j][k] = __builtin_nontemporal_load((const GAS v2u*)((const unsigned char*)p.yy + (size_t)sl[k] * 1024 + c)); else yw[u][j][k] = __builtin_nontemporal_load((const GAS v4u*)(p.yy + (size_t)sl[k] * 1024 + c)); } } }
#pragma unroll
        for (int u = 0; u < NT; ++u) { const int t = tb + u; if (t >= T_) break;
            float v[16]; float s = 0.f;
#pragma unroll
            for (int j = 0; j < 2; ++j) { const v4u x4 = xw[u][j];
                float a[8] = {h2f(x4.x & 0xffff) * ALPHA_, h2f(x4.x >> 16) * ALPHA_, h2f(x4.y & 0xffff) * ALPHA_, h2f(x4.y >> 16) * ALPHA_, h2f(x4.z & 0xffff) * ALPHA_, h2f(x4.z >> 16) * ALPHA_, h2f(x4.w & 0xffff) * ALPHA_, h2f(x4.w >> 16) * ALPHA_};
#pragma unroll
                for (int k = 0; k < 4; ++k) {
                    if constexpr (Y8) { const v2u w8 = yq[u][j][k]; const f32x2v p0 = __builtin_amdgcn_cvt_pk_f32_fp8((int)w8.x, false), p1 = __builtin_amdgcn_cvt_pk_f32_fp8((int)w8.x, true), p2 = __builtin_amdgcn_cvt_pk_f32_fp8((int)w8.y, false), p3 = __builtin_amdgcn_cvt_pk_f32_fp8((int)w8.y, true);
                        a[0] += p0.x * 0.03125f; a[1] += p0.y * 0.03125f; a[2] += p1.x * 0.03125f; a[3] += p1.y * 0.03125f; a[4] += p2.x * 0.03125f; a[5] += p2.y * 0.03125f; a[6] += p3.x * 0.03125f; a[7] += p3.y * 0.03125f; }
                    else { const v4u w = yw[u][j][k];
                    a[0] += h2f(w.x & 0xffff); a[1] += h2f(w.x >> 16); a[2] += h2f(w.y & 0xffff); a[3] += h2f(w.y >> 16);
                    a[4] += h2f(w.z & 0xffff); a[5] += h2f(w.z >> 16); a[6] += h2f(w.w & 0xffff); a[7] += h2f(w.w >> 16); } }
#pragma unroll
                for (int q = 0; q < 8; ++q) { v[j * 8 + q] = a[q]; s += a[q]; } }
            const float mean = wave_sum(s) * (1.0f / 1024.0f); float qq = 0.f;
#pragma unroll
            for (int q = 0; q < 16; ++q) { v[q] -= mean; qq += v[q] * v[q]; }
            const float rstd = 1.0f / sqrtf(wave_sum(qq) * (1.0f / 1024.0f) + LN_EPS_);
#pragma unroll
            for (int j = 0; j < 2; ++j) {
                const int c = 8 * lane + 512 * j;
                const f32x4 ga = *(const GAS f32x4*)(gam + c), gb = *(const GAS f32x4*)(gam + c + 4), ba = *(const GAS f32x4*)(bet + c), bb = *(const GAS f32x4*)(bet + c + 4);
                f32x4 oa, ob;
                oa.x = v[j * 8 + 0] * rstd * ga.x + ba.x; oa.y = v[j * 8 + 1] * rstd * ga.y + ba.y; oa.z = v[j * 8 + 2] * rstd * ga.z + ba.z; oa.w = v[j * 8 + 3] * rstd * ga.w + ba.w;
                ob.x = v[j * 8 + 4] * rstd * gb.x + bb.x; ob.y = v[j * 8 + 5] * rstd * gb.y + bb.y; ob.z = v[j * 8 + 6] * rstd * gb.z + bb.z; ob.w = v[j * 8 + 7] * rstd * gb.w + bb.w;
                if (outf) { __builtin_nontemporal_store(oa, (GAS f32x4*)(outf + (size_t)t * 1024 + c)); __builtin_nontemporal_store(ob, (GAS f32x4*)(outf + (size_t)t * 1024 + c + 4)); }
                if (outh) { v4u w; w.x = pkh(oa.x, oa.y); w.y = pkh(oa.z, oa.w); w.z = pkh(ob.x, ob.y); w.w = pkh(ob.z, ob.w); *(GAS v4u*)(outh + (size_t)t * 1024 + c) = w; }
            } }
    }
}
struct CvJob { const float* src; h16* dst; int K, N, n_off, n_cnt, row_off, w1map, f8; };
__device__ __forceinline__ void cv_load(const CvJob& j, int item, int lane, float (&ld)[32]) {
    const int nblk = j.n_cnt / 32, kb = item / nblk, nb = item % nblk, k0 = 64 * kb, n0 = j.n_off + 32 * nb;
#pragma unroll
    for (int i = 0; i < 32; ++i) { const int kk = 2 * i + (lane >> 5); ld[i] = __builtin_nontemporal_load(j.src + (size_t)(k0 + kk) * j.N + n0 + (lane & 31)); }
}
__device__ __forceinline__ void cv_finish(const CvJob& j, LAS float* scr, int item, int lane, const float (&ld)[32]) {
    const int nblk = j.n_cnt / 32, kb = item / nblk, nb = item % nblk, k0 = 64 * kb, n0 = j.n_off + 32 * nb;
#pragma unroll
    for (int i = 0; i < 32; ++i) { const int kk = 2 * i + (lane >> 5); scr[kk * 33 + (lane & 31)] = ld[i]; }
    LDS_WAIT(); asm volatile("" ::: "memory");
    const int c = lane & 7;
#pragma unroll
    for (int q = 0; q < 4; ++q) { const int n = (lane >> 3) + 8 * q; const LAS float* s = scr + (8 * c) * 33 + n;
        const int nn = n0 + n - j.n_off; const int jj = nn & 1023;
        const long dr = j.w1map ? (long)(256 * (jj >> 7) + (nn >> 10) * 128 + (jj & 127)) : (long)(j.row_off + nn);
        if (j.f8) { int lo = 0, hi = 0;
            lo = __builtin_amdgcn_cvt_pk_fp8_f32(s[0 * 33] * 32.f, s[1 * 33] * 32.f, lo, false); lo = __builtin_amdgcn_cvt_pk_fp8_f32(s[2 * 33] * 32.f, s[3 * 33] * 32.f, lo, true);
            hi = __builtin_amdgcn_cvt_pk_fp8_f32(s[4 * 33] * 32.f, s[5 * 33] * 32.f, hi, false); hi = __builtin_amdgcn_cvt_pk_fp8_f32(s[6 * 33] * 32.f, s[7 * 33] * 32.f, hi, true);
            v2u o8; o8.x = (unsigned)lo; o8.y = (unsigned)hi; *(GAS v2u*)((unsigned char*)j.dst + (size_t)dr * j.K + k0 + 8 * c) = o8; }
        else { v4u o; o.x = pkh(s[0 * 33], s[1 * 33]); o.y = pkh(s[2 * 33], s[3 * 33]); o.z = pkh(s[4 * 33], s[5 * 33]); o.w = pkh(s[6 * 33], s[7 * 33]);
            *(GAS v4u*)(j.dst + (size_t)dr * j.K + k0 + 8 * c) = o; } }
    LDS_WAIT(); asm volatile("" ::: "memory");
}
__device__ __forceinline__ int cv_decode(const Params& p, int it, CvJob& j) {
    constexpr int J1 = 1024, J2 = 1024, J3 = 1024, J4 = 1024, J5 = 640, J6 = 512, I1 = 1024, I2 = 512;
    int r = it;
    if (r < J1) { j = CvJob{p.w_ret_in, p.wri_t, 1024, 6144, 0, 2048, 0, 0, 0}; }
    else if ((r -= J1) < J2) { j = CvJob{p.w_ret_in, p.wri_t, 1024, 6144, 4096, 2048, 2048, 0, 0}; }
    else if ((r -= J2) < J3) { j = CvJob{p.w_ret_in, p.wfm_t, 1024, 6144, 2048, 2048, 0, 0, 0}; }
    else if ((r -= J3) < J4) { j = CvJob{p.w_ret_out, p.wro_t, 2048, 1024, 0, 1024, 0, 0, 0}; }
    else if ((r -= J4) < J5) { j = CvJob{p.w_swa_in, p.wsi_t, 1024, 1280, 0, 1280, 0, 0, 0}; }
    else if ((r -= J5) < J6) { j = CvJob{p.w_swa_out, p.wso_t, 1024, 1024, 0, 1024, 0, 0, 0}; }
    else if ((r -= J6) < 64 * I1) { const int e = r / I1; r %= I1; if (e < F8_FROM) j = CvJob{p.w_exp_in + (size_t)e * 1024 * 2048, p.w1_t + (size_t)e * 2048 * 1024, 1024, 2048, 0, 2048, 0, 1, 0};
        else j = CvJob{p.w_exp_in + (size_t)e * 1024 * 2048, (h16*)(p.w1q + (size_t)e * 2048 * 1024), 1024, 2048, 0, 2048, 0, 1, 1}; }
    else { r -= 64 * I1; const int e = r / I2; r %= I2; if (e < F8_FROM) j = CvJob{p.w_exp_out + (size_t)e * 1024 * 1024, p.w2_t + (size_t)e * 1024 * 1024, 1024, 1024, 0, 1024, 0, 0, 0};
        else j = CvJob{p.w_exp_out + (size_t)e * 1024 * 1024, (h16*)(p.w2q + (size_t)e * 1024 * 1024), 1024, 1024, 0, 1024, 0, 0, 1}; }
    return r;
}
__device__ __forceinline__ void ph_prologue(const Params& p, Frame& F) {
    LAS float* scr = (LAS float*)(F.lds + RING_OFF + F.wave * 16384);
    const int gw = F.vcu * NWAVES + F.wave, NGW = F.G * NWAVES;
    constexpr int NITEMS = 1024 + 1024 + 1024 + 1024 + 640 + 512 + 64 * (1024 + 512);
    int it = gw; CvJob j0, j1; int r0 = 0, r1 = 0; float ld0[32], ld1[32];
    if (it < NITEMS) { r0 = cv_decode(p, it, j0); cv_load(j0, r0, F.lane, ld0); }
    while (it < NITEMS) {
        const int nit = it + NGW; const bool hn = nit < NITEMS;
        if (hn) { r1 = cv_decode(p, nit, j1); cv_load(j1, r1, F.lane, ld1); }
        cv_finish(j0, scr, r0, F.lane, ld0);
        j0 = j1; r0 = r1;
#pragma unroll
        for (int i = 0; i < 32; ++i) ld0[i] = ld1[i];
        it = nit;
    }
    ph_cvt_rows(p.x, p.xh0, (size_t)T_ * D_, F);
}

struct DenseSched {
    const char* A; const char* B; size_t a_tile_bytes, b_tile_bytes; int nM, nN, nwg, G, c;
    __device__ __forceinline__ void init(const void* A_, int lda, const void* B_, int ldb, int M, int N, int G_, int c_, int rot = 0  ) {
        A = (const char*)A_; B = (const char*)B_; a_tile_bytes = (size_t)256 * lda * 2; b_tile_bytes = (size_t)256 * ldb * 2; nM = M / 256; nN = N / 256; nwg = nM * nN; G = G_; c = (c_ + G_ - rot) % G_; }
    __device__ __forceinline__ bool next(int i, pg::Unit& u) const {
        const long L = (long)i * G + c; if (L >= nwg) return false;
        int wgid = (int)L; { const int q = nwg / 8, r = nwg % 8, xcd = wgid % 8, off = wgid / 8; wgid = (xcd < r ? xcd * (q + 1) : r * (q + 1) + (xcd - r) * q) + off; }
        const int nig = 8 * nN, gid = wgid / nig, fm = gid * 8, gsz = (nM - fm) < 8 ? (nM - fm) : 8;
        u.pm = fm + ((wgid % nig) % gsz); u.pn = (wgid % nig) / gsz; u.e = 0; u.x = 0;
        u.a = A + (size_t)u.pm * a_tile_bytes; u.b = B + (size_t)u.pn * b_tile_bytes; return true;
    }
    __device__ __forceinline__ unsigned arow(const pg::Unit&, int) const { return 0u; }
};
struct EpiResid : pg::EpiBase {
    static constexpr bool PERM = true;
    const h16* __restrict__ xprevh; const float* __restrict__ bias; h16* __restrict__ yh;
    __device__ __forceinline__ void operator()(const pg::Acc& acc, const pg::Unit& u, int wr, int wc, int fr, int fq) const { EPI_OPAQUE();
        f32x4 bv[2][2];
#pragma unroll
        for (int bj = 0; bj < 2; ++bj) { const int col = u.pn * 256 + bj * 128 + wc * 32 + 8 * fq;
            bv[bj][0] = bias ? *(const f32x4*)(bias + col) : (f32x4){0.f, 0.f, 0.f, 0.f}; bv[bj][1] = bias ? *(const f32x4*)(bias + col + 4) : (f32x4){0.f, 0.f, 0.f, 0.f}; }
#pragma unroll
        for (int ai = 0; ai < 2; ++ai) {
            v4u xw[4][2];
#pragma unroll
            for (int m = 0; m < 4; ++m)
#pragma unroll
                for (int bj = 0; bj < 2; ++bj) { const size_t row = (size_t)u.pm * 256 + ai * 128 + wr * 64 + m * 16 + fr; xw[m][bj] = __builtin_nontemporal_load((const v4u*)(xprevh + row * 1024 + u.pn * 256 + bj * 128 + wc * 32 + 8 * fq)); }
#pragma unroll
            for (int m = 0; m < 4; ++m)
#pragma unroll
                for (int bj = 0; bj < 2; ++bj) { const size_t row = (size_t)u.pm * 256 + ai * 128 + wr * 64 + m * 16 + fr; const int col = u.pn * 256 + bj * 128 + wc * 32 + 8 * fq; const v4u x4 = xw[m][bj];
                    const f32x4 a = (f32x4){h2f(x4.x & 0xffff), h2f(x4.x >> 16), h2f(x4.y & 0xffff), h2f(x4.y >> 16)} * ALPHA_ + acc[ai][bj][m][0] + bv[bj][0];
                    const f32x4 b = (f32x4){h2f(x4.z & 0xffff), h2f(x4.z >> 16), h2f(x4.w & 0xffff), h2f(x4.w >> 16)} * ALPHA_ + acc[ai][bj][m][1] + bv[bj][1];
                    v4u w; w.x = pkh(a[0], a[1]); w.y = pkh(a[2], a[3]); w.z = pkh(b[0], b[1]); w.w = pkh(b[2], b[3]);
                    *(v4u*)(yh + row * 1024 + col) = w; } }
    }
};
struct EpiF32 : pg::EpiBase {
    const float* bias; float* c; int ldc;
    __device__ __forceinline__ void operator()(const pg::Acc& acc, const pg::Unit& u, int wr, int wc, int fr, int fq) const { EPI_OPAQUE();
#pragma unroll
        for (int ai = 0; ai < 2; ++ai)
#pragma unroll
            for (int m = 0; m < 4; ++m) { const size_t row = (size_t)u.pm * 256 + ai * 128 + wr * 64 + m * 16 + fr;
#pragma unroll
                for (int bj = 0; bj < 2; ++bj)
#pragma unroll
                    for (int n = 0; n < 2; ++n) { const int col = u.pn * 256 + bj * 128 + wc * 32 + n * 16 + 4 * fq;
                        f32x4 o = acc[ai][bj][m][n]; if (bias) o += *(const f32x4*)(bias + col);
                        *(f32x4*)(c + row * ldc + col) = o; } }
    }
};

constexpr int XROW16 = 1032;
typedef _Float16 f16x8r __attribute__((ext_vector_type(8)));
__device__ __forceinline__ void ph_ln_router(const Params& p, Frame& F, const float* gam, const float* bet, const float* wr, const float* br, unsigned char* xq, const int pmode = 0  ) {
    LAS unsigned short* X = (LAS unsigned short*)(F.lds);
    LAS float* PART = (LAS float*)(X + 32 * XROW16);
    LAS int* se = (LAS int*)(PART + 8 * 32 * 32);
    LAS float* LG = (LAS float*)(se + 512);
    LAS float* TV = LG + 1024;
    LAS int* cnt = (LAS int*)(TV + 128);
    int tid_o = F.tid; asm volatile("" : "+v"(tid_o));
    const int lane = tid_o & 63, w = F.wave, l15 = lane & 15, kg = lane >> 4;
    f16x8r wh[2][4], wl[2][4];
#pragma unroll
    for (int nt = 0; nt < 2; ++nt)
#pragma unroll
        for (int s = 0; s < 4; ++s) {
#pragma unroll
            for (int j = 0; j < 8; ++j) { const float v = wr[(size_t)(128 * w + 32 * s + 8 * kg + j) * 32 + 16 * nt + l15]; const _Float16 h = (_Float16)v; wh[nt][s][j] = h; wl[nt][s][j] = (_Float16)(v - (float)h); } }
    const float bias_e = br[tid_o & 31];
    for (int cc = blockIdx.x; cc < T_ / 128; cc += F.G) {
        v4u pre[4][2];
#pragma unroll
        for (int r = 0; r < 4; ++r)
#pragma unroll
            for (int j = 0; j < 2; ++j) pre[r][j] = __builtin_nontemporal_load((const GAS v4u*)(p.yh + (size_t)(cc * 128 + 4 * w + r) * 1024 + 8 * lane + 512 * j));
        for (int blk = 0; blk < 4; ++blk) {
            const int t0 = cc * 128 + blk * 32;
            v4u cur[4][2];
#pragma unroll
            for (int r = 0; r < 4; ++r)
#pragma unroll
                for (int j = 0; j < 2; ++j) { cur[r][j] = pre[r][j]; if (blk < 3) pre[r][j] = __builtin_nontemporal_load((const GAS v4u*)(p.yh + (size_t)(t0 + 32 + 4 * w + r) * 1024 + 8 * lane + 512 * j)); }
#pragma unroll
            for (int r = 0; r < 4; ++r) {
                const int tl = 4 * w + r; const size_t t = (size_t)(t0 + tl);
                f32x4 v[4]; float s = 0.f;
#pragma unroll
                for (int j = 0; j < 2; ++j) { const v4u pw = cur[r][j]; v[2 * j] = (f32x4){h2f(pw.x & 0xffff), h2f(pw.x >> 16), h2f(pw.y & 0xffff), h2f(pw.y >> 16)}; v[2 * j + 1] = (f32x4){h2f(pw.z & 0xffff), h2f(pw.z >> 16), h2f(pw.w & 0xffff), h2f(pw.w >> 16)}; }
#pragma unroll
                for (int j = 0; j < 4; ++j) s += (v[j].x + v[j].y) + (v[j].z + v[j].w);
                const float mean = wave_sum(s) * (1.0f / 1024.0f); float q = 0.f;
#pragma unroll
                for (int j = 0; j < 4; ++j) { v[j] = v[j] - mean; q += (v[j].x * v[j].x + v[j].y * v[j].y) + (v[j].z * v[j].z + v[j].w * v[j].w); }
                const float rstd = 1.0f / sqrtf(wave_sum(q) * (1.0f / 1024.0f) + LN_EPS_);
#pragma unroll
                for (int j = 0; j < 2; ++j) { const int c = 8 * lane + 512 * j;
                    const f32x4 o0 = v[2 * j] * rstd * *(const GAS f32x4*)(gam + c) + *(const GAS f32x4*)(bet + c), o1 = v[2 * j + 1] * rstd * *(const GAS f32x4*)(gam + c + 4) + *(const GAS f32x4*)(bet + c + 4);
                    v4u hw; hw.x = pkh(o0.x, o0.y); hw.y = pkh(o0.z, o0.w); hw.z = pkh(o1.x, o1.y); hw.w = pkh(o1.z, o1.w);
                    *(GAS v4u*)(p.x1h + t * 1024 + c) = hw;
                    if (xq) { int qa = 0, qb = 0; qa = __builtin_amdgcn_cvt_pk_fp8_f32(o0.x, o0.y, qa, false); qa = __builtin_amdgcn_cvt_pk_fp8_f32(o0.z, o0.w, qa, true); qb = __builtin_amdgcn_cvt_pk_fp8_f32(o1.x, o1.y, qb, false); qb = __builtin_amdgcn_cvt_pk_fp8_f32(o1.z, o1.w, qb, true);
                        v2u q8; q8.x = (unsigned)qa; q8.y = (unsigned)qb; *(GAS v2u*)(xq + t * 1024 + c) = q8; }
                    *(LAS v4u*)(X + tl * XROW16 + c) = hw; }
            }
            if (pmode == 1) continue;
            __syncthreads();
            {
                f32x4 acc[2][2];
#pragma unroll
                for (int mt = 0; mt < 2; ++mt)
#pragma unroll
                    for (int nt = 0; nt < 2; ++nt) acc[mt][nt] = (f32x4){0.f, 0.f, 0.f, 0.f};
#pragma unroll
                for (int s = 0; s < 4; ++s)
#pragma unroll
                    for (int mt = 0; mt < 2; ++mt) { const f16x8r a = *(const LAS f16x8r*)(X + (16 * mt + l15) * XROW16 + 128 * w + 32 * s + 8 * kg);
#pragma unroll
                        for (int nt = 0; nt < 2; ++nt) { acc[mt][nt] = __builtin_amdgcn_mfma_f32_16x16x32_f16(a, wh[nt][s], acc[mt][nt], 0, 0, 0); acc[mt][nt] = __builtin_amdgcn_mfma_f32_16x16x32_f16(a, wl[nt][s], acc[mt][nt], 0, 0, 0); } }
#pragma unroll
                for (int mt = 0; mt < 2; ++mt)
#pragma unroll
                    for (int nt = 0; nt < 2; ++nt)
#pragma unroll
                        for (int r = 0; r < 4; ++r) PART[(w * 32 + 16 * mt + 4 * kg + r) * 32 + 16 * nt + l15] = acc[mt][nt][r];
            }
            __syncthreads();
#pragma unroll
            for (int ps = 0; ps < 2; ++ps) {
                const int tok = (tid_o >> 5) + 16 * ps, e = tid_o & 31; float val = bias_e;
#pragma unroll
                for (int q = 0; q < 8; ++q) val += PART[(q * 32 + tok) * 32 + e];
                LG[tok * 32 + e] = val;
                LDS_WAIT(); asm volatile("" ::: "memory");
                int rank = 0;
#pragma unroll
                for (int q4 = 0; q4 < 8; ++q4) { const f32x4 o = *(const LAS f32x4*)(LG + tok * 32 + 4 * q4);
                    rank += ((o.x > val) || (o.x == val && 4 * q4 < e)) ? 1 : 0; rank += ((o.y > val) || (o.y == val && 4 * q4 + 1 < e)) ? 1 : 0;
                    rank += ((o.z > val) || (o.z == val && 4 * q4 + 2 < e)) ? 1 : 0; rank += ((o.w > val) || (o.w == val && 4 * q4 + 3 < e)) ? 1 : 0; }
                const int t = t0 + tok;
                if (rank < 4) { TV[tok * 4 + rank] = val; p.top_e[t * 4 + rank] = e; se[(blk * 32 + tok) * 4 + rank] = e; }
                LDS_WAIT(); asm volatile("" ::: "memory");
                if (e < 4) { const f32x4 tv = *(const LAS f32x4*)(TV + tok * 4);
                    const float e1 = __expf(tv.y - tv.x), e2 = __expf(tv.z - tv.x), e3 = __expf(tv.w - tv.x); const float inv = 1.0f / (1.0f + e1 + e2 + e3);
                    p.top_g[t * 4 + e] = (e == 0 ? 1.0f : (e == 1 ? e1 : (e == 2 ? e2 : e3))) * inv; }
            }
        }
        __syncthreads();
        if (pmode == 0) {
            const int j = tid_o; const int e = se[j]; int r = 0;
            if (j < 32) cnt[j] = 0;
            __syncthreads();
#pragma unroll 8
            for (int q4 = 0; q4 < 128; ++q4) { const v4u sv = *(const LAS v4u*)(se + 4 * q4);
                r += ((int)sv.x == e && 4 * q4 < j) ? 1 : 0; r += ((int)sv.y == e && 4 * q4 + 1 < j) ? 1 : 0; r += ((int)sv.z == e && 4 * q4 + 2 < j) ? 1 : 0; r += ((int)sv.w == e && 4 * q4 + 3 < j) ? 1 : 0; }
            p.rankp[cc * 512 + j] = r;
            atomicAdd((int*)(cnt + e), 1);
            __syncthreads();
            if (j < 32) p.wg_cnt[cc * 32 + j] = cnt[j];
        }
        __syncthreads();
    }
}

__device__ __forceinline__ float lg2gamma(int h) { return h == 0 ? -0.04580368961312479f : (h == 1 ? -0.02272007650008353f : (h == 2 ? -0.011315313227834146f : -0.005646563141142063f)); }
struct EpiInTok : pg::EpiBase {
    static constexpr bool PERM = true;
    h16 *q, *k, *sg;
    __device__ __forceinline__ void operator()(const pg::Acc& acc, const pg::Unit& u, int wr, int wc, int fr, int fq) const { EPI_OPAQUE();
        const int pn = u.pn; h16* dst; int ld, cb; int mode;
        if (pn < 4) { dst = q; ld = 1024; cb = pn * 256; mode = 0; } else if (pn < 8) { dst = k; ld = 1024; cb = (pn - 4) * 256; mode = 1; } else { dst = sg; ld = 2048; cb = (pn - 8) * 256; mode = 2; }
#pragma unroll
        for (int ai = 0; ai < 2; ++ai)
#pragma unroll
            for (int m = 0; m < 4; ++m) { const size_t row = (size_t)u.pm * 256 + ai * 128 + wr * 64 + m * 16 + fr;
#pragma unroll
                for (int bj = 0; bj < 2; ++bj) { const int c0 = cb + bj * 128 + wc * 32 + 8 * fq; float r[8];
#pragma unroll
                    for (int n = 0; n < 2; ++n)
#pragma unroll
                        for (int j = 0; j < 4; ++j) { float v = acc[ai][bj][m][n][j];
                            if (mode == 1) v *= 0.0625f;
                            if (mode == 2) v = v * __builtin_amdgcn_rcpf(1.0f + __builtin_amdgcn_exp2f(-1.4426950408889634f * v));
                            r[n * 4 + j] = v; }
                    v4u w; w.x = pkh(r[0], r[1]); w.y = pkh(r[2], r[3]); w.z = pkh(r[4], r[5]); w.w = pkh(r[6], r[7]);
                    *(v4u*)(dst + row * ld + c0) = w; } }
    }
};
struct EpiInFeat : pg::EpiBase {
    static constexpr bool PERM = true;
    h16* __restrict__ vt;
    __device__ __forceinline__ void operator()(const pg::Acc& acc, const pg::Unit& u, int wr, int wc, int fr, int fq) const { EPI_OPAQUE();
        h16* dst = vt + ((size_t)u.pn * 2048 + (size_t)u.pm * 256) * 256;
#pragma unroll
        for (int bj = 0; bj < 2; ++bj) { const int c0 = bj * 128 + wc * 32 + 8 * fq;
#pragma unroll
            for (int ai = 0; ai < 2; ++ai)
#pragma unroll
                for (int m = 0; m < 4; ++m) { const size_t row = (size_t)(ai * 128 + wr * 64 + m * 16 + fr);
                    const f32x4 a = acc[ai][bj][m][0], b = acc[ai][bj][m][1];
                    v4u w; w.x = pkh(a[0], a[1]); w.y = pkh(a[2], a[3]); w.z = pkh(b[0], b[1]); w.w = pkh(b[2], b[3]);
                    *(v4u*)(dst + row * 256 + c0) = w; } }
    }
};
constexpr int KT_PITCH = 520;
__device__ __forceinline__ void ph_ktranspose(const Params& p, Frame& F) {
    LAS unsigned char* img = F.lds;
    for (int item = F.vcu; item < 512; item += F.G) {
        const int chunk = item >> 2, h = item & 3;
        __syncthreads();
        v4u ld[16];
#pragma unroll
        for (int i = 0; i < 16; ++i) { const int pc = F.tid + 512 * i, row = pc >> 5, c16 = pc & 31; ld[i] = *(const GAS v4u*)(p.k + ((size_t)(chunk * 256 + row)) * 1024 + h * 256 + c16 * 8); }
#pragma unroll
        for (int i = 0; i < 16; ++i) { const int pc = F.tid + 512 * i, row = pc >> 5, c16 = pc & 31; v2u lo; lo.x = ld[i].x; lo.y = ld[i].y; v2u hi; hi.x = ld[i].z; hi.y = ld[i].w;
            *(LAS v2u*)(img + row * KT_PITCH + c16 * 16) = lo; *(LAS v2u*)(img + row * KT_PITCH + c16 * 16 + 8) = hi; }
        __syncthreads();
        const int tg = F.tid & 31; const float lg = lg2gamma(h); float sc[8];
#pragma unroll
        for (int j = 0; j < 8; ++j) sc[j] = __builtin_amdgcn_exp2f((float)(255 - (8 * tg + j)) * lg);
        h16* dst = p.kdt + ((size_t)chunk * 1024 + h * 256) * 256;
#pragma unroll 4
        for (int r = 0; r < 16; ++r) { const int dk = (F.tid >> 5) + 16 * r; float v[8];
#pragma unroll
            for (int j = 0; j < 8; ++j) v[j] = h2f(*(const LAS unsigned short*)(img + (8 * tg + j) * KT_PITCH + dk * 2)) * sc[j];
            v4u w; w.x = pkh(v[0], v[1]); w.y = pkh(v[2], v[3]); w.z = pkh(v[4], v[5]); w.w = pkh(v[6], v[7]);
            *(GAS v4u*)(dst + (size_t)dk * 256 + 8 * tg) = w; }
    }
    __syncthreads();
}
struct RaSched {
    const h16 *q, *k; int G, c;
    __device__ __forceinline__ bool next(int i, pg::Unit& u) const {
        const int L = i * G + c; if (L >= 512) return false;
        const int bh = L >> 5, cch = L & 31, b = bh >> 2, h = bh & 3; const size_t off = ((size_t)(b * 8192 + cch * 256) * 1024 + h * 256) * 2;
        u.a = (const char*)q + off; u.b = (const char*)k + off; u.pm = L; u.pn = 0; u.e = L; u.x = h; return true; }
    __device__ __forceinline__ unsigned arow(const pg::Unit&, int) const { return 0u; }
};
struct EpiPP : pg::EpiBase {
    static constexpr bool PERM = true;
    h16* pp;
    __device__ __forceinline__ void operator()(const pg::Acc& acc, const pg::Unit& u, int wr, int wc, int fr, int fq) const { EPI_OPAQUE();
        const float lg = lg2gamma(u.x); h16* dst = pp + (size_t)u.e * 65536;
#pragma unroll
        for (int bj = 0; bj < 2; ++bj) { const int c0 = bj * 128 + wc * 32 + 8 * fq; float sc[8];
#pragma unroll
            for (int j = 0; j < 8; ++j) sc[j] = __builtin_amdgcn_exp2f(-(float)(c0 + j + 1) * lg);
#pragma unroll
            for (int ai = 0; ai < 2; ++ai)
#pragma unroll
                for (int m = 0; m < 4; ++m) { const int i = ai * 128 + wr * 64 + m * 16 + fr; float r[8];
#pragma unroll
                    for (int n = 0; n < 2; ++n)
#pragma unroll
                        for (int j = 0; j < 4; ++j) r[n * 4 + j] = (c0 + n * 4 + j <= i) ? acc[ai][bj][m][n][j] * sc[n * 4 + j] : 0.f;
                    v4u w; w.x = pkh(r[0], r[1]); w.y = pkh(r[2], r[3]); w.z = pkh(r[4], r[5]); w.w = pkh(r[6], r[7]);
                    *(v4u*)(dst + (size_t)i * 256 + c0) = w; } }
    }
};
struct R1Sched {
    const h16 *vt, *kdt; int nsub, G, c;
    __device__ __forceinline__ bool next(int i, pg::Unit& u) const {
        const int item = (i / nsub) * G + c, j = i % nsub; if (item >= 256) return false;
        if (nsub == 4 && ((item >> 1) & 7) == 7) return false;
        const int pm = item & 1, seg = (item >> 1) & 7, bh = item >> 4, b = bh >> 2, h = bh & 3; const size_t chunk = (size_t)b * 32 + seg * 4 + j;
        u.a = (const char*)vt + ((chunk * 2048 + h * 512 + pm * 256) * 256) * 2; u.b = (const char*)kdt + ((chunk * 1024 + h * 256) * 256) * 2;
        u.pm = pm; u.pn = j; u.e = item; u.x = h; return true; }
    __device__ __forceinline__ unsigned arow(const pg::Unit&, int) const { return 0u; }
};
__device__ __forceinline__ void acc_scale(pg::Acc& acc, float s) {
#pragma unroll
    for (int a = 0; a < 2; ++a)
#pragma unroll
        for (int b = 0; b < 2; ++b)
#pragma unroll
            for (int m = 0; m < 4; ++m)
#pragma unroll
                for (int n = 0; n < 2; ++n) acc[a][b][m][n] = acc[a][b][m][n] * s;
}
struct EpiSegTot : pg::EpiBase {
    static constexpr bool PERM = true;
    float* L;
    __device__ __forceinline__ void operator()(pg::Acc& acc, const pg::Unit& u, int wr, int wc, int fr, int fq) const { EPI_OPAQUE();
        if (u.pn < 3) { acc_scale(acc, __builtin_amdgcn_exp2f(256.0f * lg2gamma(u.x))); return; }
        float* dst = L + ((size_t)(u.e >> 1) * 512 + u.pm * 256) * 256;
#pragma unroll
        for (int ai = 0; ai < 2; ++ai)
#pragma unroll
            for (int m = 0; m < 4; ++m) { const int r = ai * 128 + wr * 64 + m * 16 + fr;
#pragma unroll
                for (int bj = 0; bj < 2; ++bj) { const int c0 = bj * 128 + wc * 32 + 8 * fq;
                    *(f32x4*)(dst + (size_t)r * 256 + c0) = acc[ai][bj][m][0]; *(f32x4*)(dst + (size_t)r * 256 + c0 + 4) = acc[ai][bj][m][1]; } }
    }
    __device__ __forceinline__ void reinit(pg::Acc& acc, const pg::Unit& cur, const pg::Unit& nxt, int, int, int, int) const { if (nxt.e != cur.e) pg::acc_zero(acc); }
};
struct EpiSnap : pg::EpiBase {
    static constexpr bool PERM = true;
    const float* L; h16* st;
    __device__ __forceinline__ void snap(const pg::Acc& acc, const pg::Unit& u, int j, int wr, int wc, int fr, int fq) const { EPI_OPAQUE();
        const int seg = (u.e >> 1) & 7, bh = u.e >> 4; h16* dst = st + ((size_t)(bh * 32 + seg * 4 + j) * 512 + u.pm * 256) * 256;
#pragma unroll
        for (int ai = 0; ai < 2; ++ai)
#pragma unroll
            for (int m = 0; m < 4; ++m) { const int r = ai * 128 + wr * 64 + m * 16 + fr;
#pragma unroll
                for (int bj = 0; bj < 2; ++bj) { const int c0 = bj * 128 + wc * 32 + 8 * fq; const f32x4 a = acc[ai][bj][m][0], b = acc[ai][bj][m][1];
                    v4u w; w.x = pkh(a[0], a[1]); w.y = pkh(a[2], a[3]); w.z = pkh(b[0], b[1]); w.w = pkh(b[2], b[3]);
                    *(v4u*)(dst + (size_t)r * 256 + c0) = w; } }
    }
    __device__ __forceinline__ void load(pg::Acc& acc, const pg::Unit& u, int wr, int wc, int fr, int fq) const { EPI_OPAQUE();
        const float* src = L + ((size_t)(u.e >> 1) * 512 + u.pm * 256) * 256;
#pragma unroll
        for (int ai = 0; ai < 2; ++ai)
#pragma unroll
            for (int m = 0; m < 4; ++m) { const int r = ai * 128 + wr * 64 + m * 16 + fr;
#pragma unroll
                for (int bj = 0; bj < 2; ++bj) { const int c0 = bj * 128 + wc * 32 + 8 * fq;
                    acc[ai][bj][m][0] = *(const f32x4*)(src + (size_t)r * 256 + c0); acc[ai][bj][m][1] = *(const f32x4*)(src + (size_t)r * 256 + c0 + 4); } }
    }
    __device__ __forceinline__ void init(pg::Acc& acc, const pg::Unit& u, int wr, int wc, int fr, int fq) const { EPI_OPAQUE(); load(acc, u, wr, wc, fr, fq); snap(acc, u, 0, wr, wc, fr, fq); acc_scale(acc, __builtin_amdgcn_exp2f(256.0f * lg2gamma(u.x))); }
    __device__ __forceinline__ void operator()(pg::Acc& acc, const pg::Unit& u, int wr, int wc, int fr, int fq) const { EPI_OPAQUE(); snap(acc, u, u.pn + 1, wr, wc, fr, fq); }
    __device__ __forceinline__ void reinit(pg::Acc& acc, const pg::Unit& cur, const pg::Unit& nxt, int wr, int wc, int fr, int fq) const { EPI_OPAQUE();
        if (nxt.e != cur.e) { load(acc, nxt, wr, wc, fr, fq); snap(acc, nxt, 0, wr, wc, fr, fq); }
        acc_scale(acc, __builtin_amdgcn_exp2f(256.0f * lg2gamma(nxt.x))); }
};
__device__ __forceinline__ void ph_carry(float* L, Frame& F) {
    const size_t n = (size_t)16 * 131072;
    int tid_o = F.tid; asm volatile("" : "+v"(tid_o));
    for (size_t i = ((size_t)blockIdx.x * 512 + tid_o) * 4; i < n; i += (size_t)F.G * 512 * 4) {
        const int bh = (int)(i >> 17); const size_t el = i & 131071; const float g = __builtin_amdgcn_exp2f(1024.0f * lg2gamma(bh & 3));
        f32x4 s = {0.f, 0.f, 0.f, 0.f}, l[8];
#pragma unroll
        for (int sgm = 0; sgm < 8; ++sgm) l[sgm] = *(const GAS f32x4*)(L + ((size_t)(bh * 8 + sgm) << 17) + el);
#pragma unroll
        for (int sgm = 0; sgm < 8; ++sgm) { *(GAS f32x4*)(L + ((size_t)(bh * 8 + sgm) << 17) + el) = s; s = s * g + l[sgm]; }
    }
}
struct R2Sched {
    const h16 *pp, *vt, *q, *st; int G, c;
    __device__ __forceinline__ bool next(int i, pg::Unit& u) const {
        const int ch = (i >> 2) * G + c, pn = (i >> 1) & 1, x = i & 1; if (ch >= 512) return false;
        const int cch = ch & 31, bh = ch >> 5, b = bh >> 2, h = bh & 3; const size_t tok0 = (size_t)b * 8192 + cch * 256;
        if (x == 0) { u.a = (const char*)pp + (size_t)ch * 65536 * 2; u.b = (const char*)vt + (((tok0 >> 8) * 2048 + h * 512 + pn * 256) * 256) * 2; }
        else { u.a = (const char*)q + (tok0 * 1024 + h * 256) * 2; u.b = (const char*)st + ((size_t)ch * 512 + pn * 256) * 256 * 2; }
        u.pm = ch; u.pn = pn; u.e = (int)tok0; u.x = x; return true; }
    __device__ __forceinline__ unsigned arow(const pg::Unit&, int) const { return 0u; }
};
struct EpiRetOut : pg::EpiBase {
    static constexpr bool PERM = true;
    h16* __restrict__ o; const h16* __restrict__ sg; h16* __restrict__ og;
    __device__ __forceinline__ void operator()(const pg::Acc& acc, const pg::Unit& u, int wr, int wc, int fr, int fq) const { EPI_OPAQUE();
        if (u.x == 0) return;
        const int h = (u.pm >> 5) & 3; const float lg = lg2gamma(h);
#pragma unroll
        for (int ai = 0; ai < 2; ++ai)
#pragma unroll
            for (int m = 0; m < 4; ++m) { const int i = ai * 128 + wr * 64 + m * 16 + fr; const float qd = __builtin_amdgcn_exp2f((float)(i + 1) * lg);
                h16* dst = o + (size_t)(u.e + i) * 2048 + h * 512 + u.pn * 256;
#pragma unroll
                for (int bj = 0; bj < 2; ++bj) { const int c0 = bj * 128 + wc * 32 + 8 * fq; const f32x4 a = acc[ai][bj][m][0] * qd, b = acc[ai][bj][m][1] * qd;
                    v4u w; w.x = pkh(a[0], a[1]); w.y = pkh(a[2], a[3]); w.z = pkh(b[0], b[1]); w.w = pkh(b[2], b[3]);
                    *(v4u*)(dst + c0) = w; } }
        if (u.pn == 0) return;
        asm volatile("s_waitcnt vmcnt(0)" ::: "memory");
        __builtin_amdgcn_s_barrier(); asm volatile("" ::: "memory");
        const int wid = __builtin_amdgcn_readfirstlane((int)threadIdx.x >> 6), lane = (fq << 4) | fr;
#pragma unroll 1
        for (int r0 = 0; r0 < 32; r0 += 8) {
            v4u ow[8], gv[8];
#pragma unroll
            for (int q = 0; q < 8; ++q) { const size_t off = (size_t)(u.e + 32 * wid + r0 + q) * 2048 + h * 512 + 8 * lane; ow[q] = __builtin_nontemporal_load((const GAS v4u*)(o + off)); gv[q] = __builtin_nontemporal_load((const GAS v4u*)(sg + off)); }
#pragma unroll
            for (int q = 0; q < 8; ++q) { const size_t off = (size_t)(u.e + 32 * wid + r0 + q) * 2048 + h * 512 + 8 * lane; const v4u o4 = ow[q], g4 = gv[q];
                float v[8] = {h2f(o4.x & 0xffff), h2f(o4.x >> 16), h2f(o4.y & 0xffff), h2f(o4.y >> 16), h2f(o4.z & 0xffff), h2f(o4.z >> 16), h2f(o4.w & 0xffff), h2f(o4.w >> 16)};
                const float g[8] = {h2f(g4.x & 0xffff), h2f(g4.x >> 16), h2f(g4.y & 0xffff), h2f(g4.y >> 16), h2f(g4.z & 0xffff), h2f(g4.z >> 16), h2f(g4.w & 0xffff), h2f(g4.w >> 16)};
                float s = 0.f;
#pragma unroll
                for (int j = 0; j < 8; ++j) s += v[j];
                const float mean = wave_sum(s) * (1.0f / 512.0f); float qq = 0.f;
#pragma unroll
                for (int j = 0; j < 8; ++j) { v[j] -= mean; qq += v[j] * v[j]; }
                const float rstd = 1.0f / sqrtf(wave_sum(qq) * (1.0f / 512.0f) + 1e-6f);
                v4u w; w.x = pkh(g[0] * v[0] * rstd, g[1] * v[1] * rstd); w.y = pkh(g[2] * v[2] * rstd, g[3] * v[3] * rstd); w.z = pkh(g[4] * v[4] * rstd, g[5] * v[5] * rstd); w.w = pkh(g[6] * v[6] * rstd, g[7] * v[7] * rstd);
                *(GAS v4u*)(og + off) = w; }
        }
    }
    __device__ __forceinline__ void reinit(pg::Acc& acc, const pg::Unit&, const pg::Unit& nxt, int, int, int, int) const { if (nxt.x == 0) pg::acc_zero(acc); }
};
__device__ __forceinline__ void ph_gn_gate(const Params& p, Frame& F) {
    const int gw = F.vcu * NWAVES + F.wave, NGW = F.G * NWAVES, lane = F.lane;
    for (int it0 = gw * 4; it0 < T_ * 4; it0 += NGW * 4) {
        v4u ow[4], gv[4];
#pragma unroll
        for (int u = 0; u < 4; ++u) { const size_t off = (size_t)(it0 + u) * 512 + 8 * lane; ow[u] = *(const GAS v4u*)(p.o + off); gv[u] = *(const GAS v4u*)(p.sg + off); }
#pragma unroll
        for (int u = 0; u < 4; ++u) { const size_t off = (size_t)(it0 + u) * 512 + 8 * lane; const v4u o4 = ow[u], g4 = gv[u];
            float v[8] = {h2f(o4.x & 0xffff), h2f(o4.x >> 16), h2f(o4.y & 0xffff), h2f(o4.y >> 16), h2f(o4.z & 0xffff), h2f(o4.z >> 16), h2f(o4.w & 0xffff), h2f(o4.w >> 16)};
            const float g[8] = {h2f(g4.x & 0xffff), h2f(g4.x >> 16), h2f(g4.y & 0xffff), h2f(g4.y >> 16), h2f(g4.z & 0xffff), h2f(g4.z >> 16), h2f(g4.w & 0xffff), h2f(g4.w >> 16)};
            float s = 0.f;
#pragma unroll
            for (int j = 0; j < 8; ++j) s += v[j];
            const float mean = wave_sum(s) * (1.0f / 512.0f); float q = 0.f;
#pragma unroll
            for (int j = 0; j < 8; ++j) { v[j] -= mean; q += v[j] * v[j]; }
            const float rstd = 1.0f / sqrtf(wave_sum(q) * (1.0f / 512.0f) + 1e-6f);
            v4u w; w.x = pkh(g[0] * v[0] * rstd, g[1] * v[1] * rstd); w.y = pkh(g[2] * v[2] * rstd, g[3] * v[3] * rstd); w.z = pkh(g[4] * v[4] * rstd, g[5] * v[5] * rstd); w.w = pkh(g[6] * v[6] * rstd, g[7] * v[7] * rstd);
            *(GAS v4u*)(p.og + off) = w; }
    }
}
constexpr float SWA_C2 = 0.125f * 1.4426950408889634f;
struct EpiSwaTok : pg::EpiBase {
    static constexpr bool PERM = true;
    h16 *sq, *skv; const float* bias;
    __device__ __forceinline__ void operator()(const pg::Acc& acc, const pg::Unit& u, int wr, int wc, int fr, int fq) const { EPI_OPAQUE();
        const bool isq = u.pn < 4; h16* dst = isq ? sq : skv; const int ld = isq ? 1024 : 256, cb = isq ? u.pn * 256 : 0; const float sc = isq ? SWA_C2 : 1.0f;
#pragma unroll
        for (int bj = 0; bj < 2; ++bj) { const int ct = bj * 128 + wc * 32 + 8 * fq; const float* bp = bias + u.pn * 256 + ct;
            const f32x4 b0 = *(const f32x4*)bp, b1 = *(const f32x4*)(bp + 4);
#pragma unroll
            for (int ai = 0; ai < 2; ++ai)
#pragma unroll
                for (int m = 0; m < 4; ++m) { const size_t row = (size_t)u.pm * 256 + ai * 128 + wr * 64 + m * 16 + fr;
                    const f32x4 a = (acc[ai][bj][m][0] + b0) * sc, b = (acc[ai][bj][m][1] + b1) * sc;
                    v4u w; w.x = pkh(a[0], a[1]); w.y = pkh(a[2], a[3]); w.z = pkh(b[0], b[1]); w.w = pkh(b[2], b[3]);
                    *(v4u*)(dst + row * ld + cb + ct) = w; } }
    }
};
struct EpiSwaFeat : pg::EpiBase {
    static constexpr bool PERM = true;
    h16* __restrict__ kvt; const float* __restrict__ bias;
    __device__ __forceinline__ void operator()(const pg::Acc& acc, const pg::Unit& u, int wr, int wc, int fr, int fq) const { EPI_OPAQUE();
        float bv[2][4];
#pragma unroll
        for (int ai = 0; ai < 2; ++ai)
#pragma unroll
            for (int m = 0; m < 4; ++m) bv[ai][m] = bias[1024 + ai * 128 + wr * 64 + m * 16 + fr];
#pragma unroll
        for (int ai = 0; ai < 2; ++ai)
#pragma unroll
            for (int m = 0; m < 4; ++m) { const int r = ai * 128 + wr * 64 + m * 16 + fr;
#pragma unroll
                for (int bj = 0; bj < 2; ++bj) { const int ct = bj * 128 + wc * 32 + 8 * fq; const f32x4 a = acc[ai][bj][m][0] + bv[ai][m], b = acc[ai][bj][m][1] + bv[ai][m];
                    v4u w; w.x = pkh(a[0], a[1]); w.y = pkh(a[2], a[3]); w.z = pkh(b[0], b[1]); w.w = pkh(b[2], b[3]);
                    *(v4u*)(kvt + (size_t)r * T_ + (size_t)u.pn * 256 + ct) = w; } }
    }
};
typedef float f32x16 __attribute__((ext_vector_type(16)));
typedef _Float16 f16x8v __attribute__((ext_vector_type(8)));
typedef _Float16 f16x4v __attribute__((ext_vector_type(4)));
constexpr int KP = 144, VP = 520;
__device__ __forceinline__ void ph_swa_attn(const Params& p, Frame& F) {
    LAS unsigned char* Ks = F.lds; LAS unsigned char* Vs = F.lds + 256 * KP;
    const int lane = F.lane, w = F.wave, l31 = lane & 31, hh = lane >> 5;
    for (int unit = F.vcu; unit < 512; unit += F.G) {
        const int g = unit & 1, n = (unit >> 1) & 63, b = unit >> 7; const size_t tok0 = (size_t)b * SEQ_ + (size_t)n * 128;
        __syncthreads();
        for (int c = F.tid; c < 256 * 8; c += 512) { const int key = c >> 3, ch = c & 7; v4u val = {0u, 0u, 0u, 0u};
            if (n > 0 || key >= 128) val = *(const GAS v4u*)(p.skv + (tok0 - 128 + key) * 256 + g * 64 + ch * 8);
            *(LAS v4u*)(Ks + key * KP + ch * 16) = val; }
        for (int c = F.tid; c < 64 * 32; c += 512) { const int d = c >> 5, ch = c & 31; v4u val = {0u, 0u, 0u, 0u};
            if (n > 0 || ch >= 16) val = *(const GAS v4u*)(p.kvt + (size_t)(128 + g * 64 + d) * T_ + tok0 - 128 + ch * 8);
            v2u lo2; lo2.x = val.x; lo2.y = val.y; v2u hi2; hi2.x = val.z; hi2.y = val.w;
            *(LAS v2u*)(Vs + d * VP + ch * 16) = lo2; *(LAS v2u*)(Vs + d * VP + ch * 16 + 8) = hi2; }
        __syncthreads();
        const int hq = g * 8 + w; const float slope = __builtin_amdgcn_exp2f(-0.5f * (float)(hq + 1)) * 1.4426950408889634f, sink = p.sinks[hq] * 1.4426950408889634f;
#pragma nounroll
        for (int qi = 0; qi < 4; ++qi) {
            f16x8v qf[4];
            const h16* qrow = p.sq + (tok0 + qi * 32 + l31) * 1024 + hq * 64 + 8 * hh;
#pragma unroll
            for (int s = 0; s < 4; ++s) qf[s] = __builtin_nontemporal_load((const GAS f16x8v*)(qrow + 16 * s));
            f32x16 sc[5];
#pragma unroll
            for (int t = 0; t < 5; ++t) {
                sc[t] = (f32x16){0.f, 0.f, 0.f, 0.f, 0.f, 0.f, 0.f, 0.f, 0.f, 0.f, 0.f, 0.f, 0.f, 0.f, 0.f, 0.f};
                const LAS unsigned char* kp = Ks + ((qi + t) * 32 + l31) * KP + 16 * hh;
#pragma unroll
                for (int s = 0; s < 4; ++s) { const f16x8v kf = *(const LAS f16x8v*)(kp + 32 * s); sc[t] = __builtin_amdgcn_mfma_f32_32x32x16_f16(kf, qf[s], sc[t], 0, 0, 0); }
            }
            float mx = sink;
            float basef = (float)(l31 + 128 - 4 * hh); asm volatile("" : "+v"(basef));
#pragma unroll
            for (int t = 0; t < 5; ++t) { const bool tile_ok = (n > 0) || (qi + t >= 4);
#pragma unroll
                for (int r = 0; r < 16; ++r) { const float distf = basef - (float)(32 * t + (r & 3) + 8 * (r >> 2));
                    bool ok = tile_ok; if (t == 0) ok = ok && (distf < 128.0f); if (t == 4) ok = ok && (distf >= 0.0f);
                    const float v = ok ? sc[t][r] - slope * distf : -INFINITY; sc[t][r] = v; mx = fmaxf(mx, v); } }
            mx = fmaxf(mx, __shfl_xor(mx, 32));
            float ls = 0.f; f16x8v pf[5][2];
#pragma unroll
            for (int t = 0; t < 5; ++t)
#pragma unroll
                for (int s2 = 0; s2 < 2; ++s2) { float e[8];
#pragma unroll
                    for (int j = 0; j < 8; ++j) { e[j] = __builtin_amdgcn_exp2f(sc[t][8 * s2 + j] - mx); ls += e[j]; }
                    v4u pw; pw.x = pkh(e[0], e[1]); pw.y = pkh(e[2], e[3]); pw.z = pkh(e[4], e[5]); pw.w = pkh(e[6], e[7]); pf[t][s2] = __builtin_bit_cast(f16x8v, pw); }
            ls += __shfl_xor(ls, 32); ls += __builtin_amdgcn_exp2f(sink - mx);
            const float rl = 1.0f / ls;
            f32x16 oa[2];
#pragma unroll
            for (int dt = 0; dt < 2; ++dt) { oa[dt] = (f32x16){0.f, 0.f, 0.f, 0.f, 0.f, 0.f, 0.f, 0.f, 0.f, 0.f, 0.f, 0.f, 0.f, 0.f, 0.f, 0.f};
                const LAS unsigned char* vp = Vs + (32 * dt + l31) * VP + (qi * 32 + 4 * hh) * 2;
#pragma unroll
                for (int t = 0; t < 5; ++t)
#pragma unroll
                    for (int s2 = 0; s2 < 2; ++s2) { const f16x4v v0 = *(const LAS f16x4v*)(vp + (t * 32 + s2 * 16) * 2), v1 = *(const LAS f16x4v*)(vp + (t * 32 + s2 * 16 + 8) * 2);
                        const f16x8v vf = __builtin_shufflevector(v0, v1, 0, 1, 2, 3, 4, 5, 6, 7);
                        oa[dt] = __builtin_amdgcn_mfma_f32_32x32x16_f16(vf, pf[t][s2], oa[dt], 0, 0, 0); } }
            h16* orow = p.so + (tok0 + qi * 32 + l31) * 1024 + hq * 64 + 4 * hh;
#pragma unroll
            for (int dt = 0; dt < 2; ++dt)
#pragma unroll
                for (int gq = 0; gq < 4; ++gq) { v2u ow; ow.x = pkh(oa[dt][4 * gq] * rl, oa[dt][4 * gq + 1] * rl); ow.y = pkh(oa[dt][4 * gq + 2] * rl, oa[dt][4 * gq + 3] * rl);
                    *(GAS v2u*)(orow + 32 * dt + 8 * gq) = ow; }
        }
    }
}

struct EpiNull : pg::EpiBase {
    static constexpr bool PERM = true;
    __device__ __forceinline__ void operator()(const pg::Acc& acc, const pg::Unit& u, int wr, int wc, int fr, int fq) const { asm volatile("" :: "v"(acc[0][0][0][0][0]), "v"(acc[1][1][3][1][3])); }
};

struct EpiSwigluQ : pg::EpiBase {
    static constexpr bool PERM = true;
    unsigned char* __restrict__ actq; const float* __restrict__ b1;
    typedef _Float16 h2 __attribute__((ext_vector_type(2)));
    typedef short s2 __attribute__((ext_vector_type(2)));
    __device__ __forceinline__ h2 act2(f32x2v g32, f32x2v l32) const {
        h2 g = __builtin_convertvector(g32, h2), l = __builtin_convertvector(l32, h2);
        g = __builtin_elementwise_min(g, (h2){7.0f16, 7.0f16});
        l = __builtin_elementwise_max(__builtin_elementwise_min(l, (h2){7.0f16, 7.0f16}), (h2){-7.0f16, -7.0f16});
        const h2 e = __builtin_elementwise_exp2(g * (h2){-2.4554f16, -2.4554f16});
        const h2 d = e + (h2){1.0f16, 1.0f16};
        const h2 r = {(_Float16)__builtin_amdgcn_rcph(d.x), (_Float16)__builtin_amdgcn_rcph(d.y)};
        return (g * r) * (l * (h2){4.0f16, 4.0f16} + (h2){4.0f16, 4.0f16});
    }
    __device__ __forceinline__ void operator()(const pg::Acc& acc, const pg::Unit& u, int wr, int wc, int fr, int fq) const { EPI_OPAQUE();
        const int c0 = u.pn * 128 + wc * 32 + 8 * fq;
        const float* bg = b1 + (size_t)u.e * 2048 + c0; const float* bl = bg + 1024;
        const f32x4 g0 = *(const f32x4*)bg, g1 = *(const f32x4*)(bg + 4), l0 = *(const f32x4*)bl, l1 = *(const f32x4*)(bl + 4);
#pragma unroll
        for (int ai = 0; ai < 2; ++ai)
#pragma unroll
            for (int m = 0; m < 4; ++m) {
                const size_t row = (size_t)u.pm * 256 + ai * 128 + wr * 64 + m * 16 + fr;
                const f32x4 ga = acc[ai][0][m][0] * 0.03125f + g0, gb = acc[ai][0][m][1] * 0.03125f + g1, la = acc[ai][1][m][0] * 0.03125f + l0, lb = acc[ai][1][m][1] * 0.03125f + l1;
                s2 lo = {0, 0}, hi = {0, 0};
                lo = __builtin_amdgcn_cvt_scalef32_pk_fp8_f16(lo, act2((f32x2v){ga.x, ga.y}, (f32x2v){la.x, la.y}), 1.0f, false);
                lo = __builtin_amdgcn_cvt_scalef32_pk_fp8_f16(lo, act2((f32x2v){ga.z, ga.w}, (f32x2v){la.z, la.w}), 1.0f, true);
                hi = __builtin_amdgcn_cvt_scalef32_pk_fp8_f16(hi, act2((f32x2v){gb.x, gb.y}, (f32x2v){lb.x, lb.y}), 1.0f, false);
                hi = __builtin_amdgcn_cvt_scalef32_pk_fp8_f16(hi, act2((f32x2v){gb.z, gb.w}, (f32x2v){lb.z, lb.w}), 1.0f, true);
                v2u w; w.x = __builtin_bit_cast(unsigned, lo); w.y = __builtin_bit_cast(unsigned, hi);
                *(v2u*)(actq + row * 1024 + c0) = w;
            }
    }
};
template <int VAR> struct EpiSwigluQP : pg::EpiBase {
    static constexpr bool PERM = true;
    unsigned char* __restrict__ actq; const float* __restrict__ b1;
    typedef _Float16 h2 __attribute__((ext_vector_type(2)));
    typedef short s2 __attribute__((ext_vector_type(2)));
    __device__ __forceinline__ h2 act2(f32x2v g32, f32x2v l32) const {
        h2 g = __builtin_convertvector(g32, h2), l = __builtin_convertvector(l32, h2);
        g = __builtin_elementwise_min(g, (h2){7.0f16, 7.0f16});
        l = __builtin_elementwise_max(__builtin_elementwise_min(l, (h2){7.0f16, 7.0f16}), (h2){-7.0f16, -7.0f16});
        const h2 e = __builtin_elementwise_exp2(g * (h2){-2.4554f16, -2.4554f16});
        const h2 d = e + (h2){1.0f16, 1.0f16};
        const h2 r = {(_Float16)__builtin_amdgcn_rcph(d.x), (_Float16)__builtin_amdgcn_rcph(d.y)};
        return (g * r) * (l * (h2){4.0f16, 4.0f16} + (h2){4.0f16, 4.0f16});
    }
    __device__ __forceinline__ void operator()(const pg::Acc& acc, const pg::Unit& u, int wr, int wc, int fr, int fq) const { EPI_OPAQUE();
        const int c0 = u.pn * 128 + wc * 32 + 8 * fq;
        const float* bg = b1 + (size_t)u.e * 2048 + c0; const float* bl = bg + 1024;
        const f32x4 g0 = *(const f32x4*)bg, g1 = *(const f32x4*)(bg + 4), l0 = *(const f32x4*)bl, l1 = *(const f32x4*)(bl + 4);
        if (VAR == 1) { asm volatile("" :: "v"(g0), "v"(g1), "v"(l0), "v"(l1));
#pragma unroll
            for (int ai = 0; ai < 2; ++ai)
#pragma unroll
                for (int bj = 0; bj < 2; ++bj)
#pragma unroll
                    for (int m = 0; m < 4; ++m) asm volatile("" :: "v"(acc[ai][bj][m][0]), "v"(acc[ai][bj][m][1]));
            return; }
#pragma unroll
        for (int ai = 0; ai < 2; ++ai)
#pragma unroll
            for (int m = 0; m < 4; ++m) {
                const size_t row = (size_t)u.pm * 256 + ai * 128 + wr * 64 + m * 16 + fr;
                const f32x4 ga = acc[ai][0][m][0] * 0.03125f + g0, gb = acc[ai][0][m][1] * 0.03125f + g1, la = acc[ai][1][m][0] * 0.03125f + l0, lb = acc[ai][1][m][1] * 0.03125f + l1;
                s2 lo = {0, 0}, hi = {0, 0};
                lo = __builtin_amdgcn_cvt_scalef32_pk_fp8_f16(lo, act2((f32x2v){ga.x, ga.y}, (f32x2v){la.x, la.y}), 1.0f, false);
                lo = __builtin_amdgcn_cvt_scalef32_pk_fp8_f16(lo, act2((f32x2v){ga.z, ga.w}, (f32x2v){la.z, la.w}), 1.0f, true);
                hi = __builtin_amdgcn_cvt_scalef32_pk_fp8_f16(hi, act2((f32x2v){gb.x, gb.y}, (f32x2v){lb.x, lb.y}), 1.0f, false);
                hi = __builtin_amdgcn_cvt_scalef32_pk_fp8_f16(hi, act2((f32x2v){gb.z, gb.w}, (f32x2v){lb.z, lb.w}), 1.0f, true);
                v2u w; w.x = __builtin_bit_cast(unsigned, lo); w.y = __builtin_bit_cast(unsigned, hi);
                if (VAR == 2) asm volatile("" :: "v"(w.x), "v"(w.y)); else *(v2u*)(actq + row * 1024 + c0) = w;
            }
    }
};
template <bool Y8> struct EpiMoeOutQ : pg::EpiBase {
    static constexpr bool PERM = true;
    unsigned char* __restrict__ y8; const float* __restrict__ b2; const float* __restrict__ gate;
    __device__ __forceinline__ void operator()(const pg::Acc& acc, const pg::Unit& u, int wr, int wc, int fr, int fq) const { EPI_OPAQUE();
        float gt[2][4]; f32x4 bv[2][2];
#pragma unroll
        for (int ai = 0; ai < 2; ++ai)
#pragma unroll
            for (int m = 0; m < 4; ++m) gt[ai][m] = gate[(size_t)u.pm * 256 + ai * 128 + wr * 64 + m * 16 + fr];
#pragma unroll
        for (int bj = 0; bj < 2; ++bj) { const float* bp = b2 + (size_t)u.e * 1024 + u.pn * 256 + bj * 128 + wc * 32 + 8 * fq; bv[bj][0] = *(const f32x4*)bp; bv[bj][1] = *(const f32x4*)(bp + 4); }
#pragma unroll
        for (int ai = 0; ai < 2; ++ai)
#pragma unroll
            for (int m = 0; m < 4; ++m) {
                const size_t row = (size_t)u.pm * 256 + ai * 128 + wr * 64 + m * 16 + fr;
#pragma unroll
                for (int bj = 0; bj < 2; ++bj) {
                    const int c0 = u.pn * 256 + bj * 128 + wc * 32 + 8 * fq;
                    const float gs = gt[ai][m] * (Y8 ? 32.0f : 1.0f);
                    const f32x4 v0 = (acc[ai][bj][m][0] * 0.0078125f + bv[bj][0]) * gs, v1 = (acc[ai][bj][m][1] * 0.0078125f + bv[bj][1]) * gs;
                    if (Y8) { int lo = 0, hi = 0;
                        lo = __builtin_amdgcn_cvt_pk_fp8_f32(v0[0], v0[1], lo, false); lo = __builtin_amdgcn_cvt_pk_fp8_f32(v0[2], v0[3], lo, true);
                        hi = __builtin_amdgcn_cvt_pk_fp8_f32(v1[0], v1[1], hi, false); hi = __builtin_amdgcn_cvt_pk_fp8_f32(v1[2], v1[3], hi, true);
                        v2u w; w.x = (unsigned)lo; w.y = (unsigned)hi; *(v2u*)(y8 + row * 1024 + c0) = w; }
                    else { v4u w; w.x = pkh(v0[0], v0[1]); w.y = pkh(v0[2], v0[3]); w.z = pkh(v1[0], v1[1]); w.w = pkh(v1[2], v1[3]); *(v4u*)((h16*)y8 + row * 1024 + c0) = w; }
                }
            }
    }
};

struct MoeSchedHot : MoeSched {
    __device__ __forceinline__ bool next(int i, pg::Unit& u) const { const bool ok = MoeSched::next(i, u); if (ok) { u.a = abase; u.b = wbase; } return ok; }
    __device__ __forceinline__ unsigned arow(const pg::Unit&, int r) const { return (unsigned)r; }
};

struct EpiKeep : pg::EpiBase {
    static constexpr bool PERM = true;
    __device__ __forceinline__ void operator()(const pg::Acc& acc, const pg::Unit& u, int wr, int wc, int fr, int fq) const {
#pragma unroll
        for (int ai = 0; ai < 2; ++ai)
#pragma unroll
            for (int bj = 0; bj < 2; ++bj)
#pragma unroll
                for (int m = 0; m < 4; ++m) asm volatile("" :: "v"(acc[ai][bj][m][0]), "v"(acc[ai][bj][m][1]));
    }
};
#ifndef PROBE_DBL
#define PROBE_DBL 0
#endif
#ifndef SKEW_STEP
#define SKEW_STEP 0
#endif
#define SKEW(F) (((F).vcu & 3) * SKEW_STEP)
#define DBL(bit, body) do { body; if ((PROBE_DBL >> (bit)) & 1) { GRID_BAR(); body; } } while (0)
template <int layer>
__device__ __forceinline__ void layer_tail(const Params& p, Frame& F, const XcdBarrier& bar) {
#define GRID_BAR() xcd_barrier(bar)
    {
        if (layer == 0) { DenseSched S; S.init(p.og, 2048, p.wro_t, 2048, T_, 1024, F.G, (int)blockIdx.x); EpiResid E; E.yh = p.yh; E.xprevh = p.xh0; E.bias = nullptr;
            pg::gemm_phase<EpiResid, DenseSched, 0, true>(F.lds + RING_OFF, 2048, 2048, 32, S, E); }
        else { DenseSched S; S.init(p.so, 1024, p.wso_t, 1024, T_, 1024, F.G, (int)blockIdx.x); EpiResid E; E.yh = p.yh; E.xprevh = p.x2h; E.bias = p.b_swa_out;
            pg::gemm_phase<EpiResid, DenseSched, 0, true>(F.lds + RING_OFF, 1024, 1024, 16, S, E); }
    }
    GRID_BAR();
    DBL(1, ph_ln_router(p, F, p.ln_mix_g + layer * 1024, p.ln_mix_b + layer * 1024, p.w_router + layer * 1024 * 32, p.b_router + layer * 32, (layer == 1 || MOE_F8_L0) ? p.x1q : (unsigned char*)nullptr));
#if (PROBE_DBL >> 19) & 1
    GRID_BAR();
    ph_ln_router(p, F, p.ln_mix_g + layer * 1024, p.ln_mix_b + layer * 1024, p.w_router + layer * 1024 * 32, p.b_router + layer * 32, layer == 1 ? p.x1q : (unsigned char*)nullptr, (PROBE_DBL >> 19) & 1);
#endif
    GRID_BAR();
    DBL(5, ph_assign(p, F, layer));
    GRID_BAR();
    {
        const int ntiles = (int)__hip_atomic_load(F.ctl + CW_NTILES + 64 * layer, RLX_AGENT);
        moe_tables(F, p.tile_e, p.slot_tok, ntiles, 3, true);
        if (layer == 0 && !MOE_F8_L0) {
            MoeSched S{(const char*)p.x1h, (const char*)p.w1_t, (LAS const int*)(F.lds + TAB_OFF), (LAS const int*)(F.lds + TAB_OFF) + 32, ntiles, 3, F.G, F.vcu, 0, (size_t)2048 * 1024 * 2, (size_t)256 * 1024 * 2};
            EpiSwiglu E; E.act = p.act; E.b1 = p.b_exp_in;
            pg::gemm_phase<EpiSwiglu, MoeSched, 1, true>(F.lds + RING_OFF, 1024, 1024, 16, S, E);
        } else {
            MoeSched S{(const char*)p.x1q, (const char*)(p.w1q + (size_t)layer * 32 * 2048 * 1024), (LAS const int*)(F.lds + TAB_OFF), (LAS const int*)(F.lds + TAB_OFF) + 32, ntiles, 3, F.G, F.vcu, 0, (size_t)2048 * 1024, (size_t)256 * 1024};
            EpiSwigluQ E; E.actq = p.actq; E.b1 = p.b_exp_in + (size_t)layer * 32 * 2048;
            pg::gemm_phase<EpiSwigluQ, MoeSched, 1, true, 1>(F.lds + RING_OFF, 1024, 1024, 8, S, E, 0, 0, SKEW(F));
        }
    }
    GRID_BAR();
#if (PROBE_DBL >> 21) & 3
    GRID_BAR();
    if (layer == 0) {
        const int ntiles = (int)__hip_atomic_load(F.ctl + CW_NTILES + 64 * layer, RLX_AGENT);
        moe_tables(F, p.tile_e, p.slot_tok, ntiles, 3, true);
        EpiSwigluP<1> E; E.act = p.yy; E.b1 = p.b_exp_in;
        if ((PROBE_DBL >> 22) & 1) { MoeSchedHot S{{((PROBE_DBL >> 23) & 1) ? (const char*)p.ctl : (const char*)p.x1h, ((PROBE_DBL >> 23) & 1) ? (const char*)p.ctl + 524288 : (const char*)p.w1_t, (LAS const int*)(F.lds + TAB_OFF), (LAS const int*)(F.lds + TAB_OFF) + 32, ntiles, 3, F.G, F.vcu, 0, (size_t)2048 * 1024 * 2, (size_t)256 * 1024 * 2}};
            pg::gemm_phase<EpiSwigluP<1>, MoeSchedHot, 1, true, 2, ((PROBE_DBL >> 24) & 1) != 0>(F.lds + RING_OFF, 1024, 1024, 16, S, E); }
        else { MoeSched S{(const char*)p.x1h, (const char*)p.w1_t, (LAS const int*)(F.lds + TAB_OFF), (LAS const int*)(F.lds + TAB_OFF) + 32, ntiles, 3, F.G, F.vcu, 0, (size_t)2048 * 1024 * 2, (size_t)256 * 1024 * 2};
            pg::gemm_phase<EpiSwigluP<1>, MoeSched, 1, true, 2, ((PROBE_DBL >> 24) & 1) != 0>(F.lds + RING_OFF, 1024, 1024, 16, S, E); }
    }
#endif
#if (PROBE_DBL >> 29) & 3
    GRID_BAR();
    {
        const int ntiles = (int)__hip_atomic_load(F.ctl + CW_NTILES + 64 * layer, RLX_AGENT);
        moe_tables(F, p.tile_e, p.slot_tok, ntiles, 3, true);
        MoeSched S{(const char*)p.x1q, (const char*)(p.w1q + (size_t)layer * 32 * 2048 * 1024), (LAS const int*)(F.lds + TAB_OFF), (LAS const int*)(F.lds + TAB_OFF) + 32, ntiles, 3, F.G, F.vcu, 0, (size_t)2048 * 1024, (size_t)256 * 1024};
        EpiSwigluQP<((PROBE_DBL >> 29) & 3)> E; E.actq = p.actq; E.b1 = p.b_exp_in + (size_t)layer * 32 * 2048;
        pg::gemm_phase<EpiSwigluQP<((PROBE_DBL >> 29) & 3)>, MoeSched, 1, true, 1>(F.lds + RING_OFF, 1024, 1024, 8, S, E);
    }
#endif
#if (PROBE_DBL >> 25) & 1
    GRID_BAR();
    {
        const int ntiles = (int)__hip_atomic_load(F.ctl + CW_NTILES + 64 * layer, RLX_AGENT);
        moe_tables(F, p.tile_e, p.slot_tok, ntiles, 3, true);
        MoeSched S{(const char*)p.x1q, (const char*)(p.w1q + (size_t)layer * 32 * 2048 * 1024), (LAS const int*)(F.lds + TAB_OFF), (LAS const int*)(F.lds + TAB_OFF) + 32, ntiles, 3, F.G, F.vcu, 0, (size_t)2048 * 1024, (size_t)256 * 1024};
        EpiKeep E;
        pg::gemm_phase<EpiKeep, MoeSched, 1, true, 1>(F.lds + RING_OFF, 1024, 1024, 8, S, E);
    }
#endif
#if (PROBE_DBL >> 26) & 1
    GRID_BAR();
    {
        const int ntiles = (int)__hip_atomic_load(F.ctl + CW_NTILES + 64 * layer, RLX_AGENT);
        moe_tables(F, p.tile_e, p.slot_tok, ntiles, 3, true);
        MoeSched S{(const char*)p.x1q, (const char*)(p.w1q + (size_t)layer * 32 * 2048 * 1024), (LAS const int*)(F.lds + TAB_OFF), (LAS const int*)(F.lds + TAB_OFF) + 32, ntiles, 3, F.G, F.vcu, 0, (size_t)2048 * 1024, (size_t)256 * 1024};
        EpiSwigluQ E; E.actq = p.actq; E.b1 = p.b_exp_in + (size_t)layer * 32 * 2048;
        pg::gemm_phase<EpiSwigluQ, MoeSched, 1, true, 1>(F.lds + RING_OFF, 1024, 1024, 8, S, E);
    }
#endif
    {
        const int ntiles = (int)__hip_atomic_load(F.ctl + CW_NTILES + 64 * layer, RLX_AGENT);
        moe_tables(F, p.tile_e, p.slot_tok, ntiles, 2, false);
        if (layer == 0 && !MOE_F8_L0) {
            MoeSched S{(const char*)p.act, (const char*)p.w2_t, (LAS const int*)(F.lds + TAB_OFF), (LAS const int*)(F.lds + TAB_OFF) + 32, ntiles, 2, F.G, F.vcu, (size_t)256 * 1024 * 2, (size_t)1024 * 1024 * 2, (size_t)256 * 1024 * 2};
            EpiMoeOut E; E.y = p.yy; E.b2 = p.b_exp_out; E.gate = p.slot_gate;
            pg::gemm_phase<EpiMoeOut, MoeSched, 0, true>(F.lds + RING_OFF, 1024, 1024, 16, S, E);
        } else {
            MoeSched S{(const char*)p.actq, (const char*)(p.w2q + (size_t)layer * 32 * 1024 * 1024), (LAS const int*)(F.lds + TAB_OFF), (LAS const int*)(F.lds + TAB_OFF) + 32, ntiles, 2, F.G, F.vcu, (size_t)256 * 1024, (size_t)1024 * 1024, (size_t)256 * 1024};
            EpiMoeOutQ<layer == 1> E; E.y8 = (unsigned char*)p.yy; E.b2 = p.b_exp_out + (size_t)layer * 32 * 1024; E.gate = p.slot_gate;
            pg::gemm_phase<EpiMoeOutQ<layer == 1>, MoeSched, 0, true, 1>(F.lds + RING_OFF, 1024, 1024, 8, S, E, 0, 0, SKEW(F));
        }
    }
#if (PROBE_DBL >> 27) & 1
    GRID_BAR();
    {
        const int ntiles = (int)__hip_atomic_load(F.ctl + CW_NTILES + 64 * layer, RLX_AGENT);
        moe_tables(F, p.tile_e, p.slot_tok, ntiles, 2, false);
        MoeSched S{(const char*)p.actq, (const char*)(p.w2q + (size_t)layer * 32 * 1024 * 1024), (LAS const int*)(F.lds + TAB_OFF), (LAS const int*)(F.lds + TAB_OFF) + 32, ntiles, 2, F.G, F.vcu, (size_t)256 * 1024, (size_t)1024 * 1024, (size_t)256 * 1024};
        EpiMoeOutQ<layer == 1> E; E.y8 = (unsigned char*)p.yy; E.b2 = p.b_exp_out + (size_t)layer * 32 * 1024; E.gate = p.slot_gate;
        pg::gemm_phase<EpiMoeOutQ<layer == 1>, MoeSched, 0, true, 1>(F.lds + RING_OFF, 1024, 1024, 8, S, E);
    }
#endif
#if (PROBE_DBL >> 28) & 1
    GRID_BAR();
    {
        const int ntiles = (int)__hip_atomic_load(F.ctl + CW_NTILES + 64 * layer, RLX_AGENT);
        moe_tables(F, p.tile_e, p.slot_tok, ntiles, 2, false);
        MoeSched S{(const char*)p.actq, (const char*)(p.w2q + (size_t)layer * 32 * 1024 * 1024), (LAS const int*)(F.lds + TAB_OFF), (LAS const int*)(F.lds + TAB_OFF) + 32, ntiles, 2, F.G, F.vcu, (size_t)256 * 1024, (size_t)1024 * 1024, (size_t)256 * 1024};
        EpiKeep E;
        pg::gemm_phase<EpiKeep, MoeSched, 0, true, 1>(F.lds + RING_OFF, 1024, 1024, 8, S, E);
    }
#endif
    GRID_BAR();
    DBL(2, ph_combine_ln<layer == 1>(p, F, p.x1h, p.ln_ffn_g + layer * 1024, p.ln_ffn_b + layer * 1024, layer == 0 ? (float*)nullptr : p.out, layer == 0 ? p.x2h : (h16*)nullptr));
#undef GRID_BAR
}
__global__ void __launch_bounds__(NWAVES * 64, 2) mk_fwd(Params p) {
    extern __shared__ __attribute__((aligned(16))) unsigned char lds[];
    Frame F;
    F.lds = (LAS unsigned char*)lds;
    F.MISC = (volatile LAS unsigned*)(F.lds + MISC_OFF);
    F.tid = threadIdx.x; F.lane = F.tid & 63; F.wave = __builtin_amdgcn_readfirstlane(F.tid >> 6);
    F.G = gridDim.x; { const int bx = blockIdx.x; F.vcu = (F.G % 8 == 0) ? (bx % 8) * (F.G / 8) + bx / 8 : bx; }
    F.ctl = (gu32*)p.ctl;
    for (int u = F.tid; u < (LDS_BYTES - LDSCTL_OFF) / 4; u += NWAVES * 64) ((LAS unsigned*)(F.lds + LDSCTL_OFF))[u] = 0u;
    __syncthreads();
    XcdBarrier bar = xcd_barrier_post((unsigned*)p.ctl + CW_BAR, F.MISC + 8);
#define GRID_BAR() xcd_barrier(bar)
    DBL(0, ph_prologue(p, F));
    GRID_BAR();
    {
        { DenseSched S; S.init(p.xh0, 1024, p.wri_t, 1024, T_, 4096, F.G, (int)blockIdx.x); EpiInTok E; E.q = p.q; E.k = p.k; E.sg = p.sg;
          pg::gemm_phase<EpiInTok, DenseSched, 0, true>(F.lds + RING_OFF, 1024, 1024, 16, S, E, 0, 0, SKEW(F)); }
        { DenseSched S; S.init(p.wfm_t, 1024, p.xh0, 1024, 2048, T_, F.G, (int)blockIdx.x); EpiInFeat E; E.vt = p.vt;
          pg::gemm_phase<EpiInFeat, DenseSched, 0, true>(F.lds + RING_OFF, 1024, 1024, 16, S, E); }
    }
#if (PROBE_DBL >> 17) & 1
    GRID_BAR();
    { DenseSched S; S.init(p.xh0, 1024, p.wri_t, 1024, T_, 4096, F.G, (int)blockIdx.x); EpiInTok E; E.q = p.q; E.k = p.k; E.sg = p.sg;
      pg::gemm_phase<EpiInTok, DenseSched, 0, true>(F.lds + RING_OFF, 1024, 1024, 16, S, E); }
#endif
#if (PROBE_DBL >> 6) & 1
    GRID_BAR();
    {
        { DenseSched S; S.init(p.xh0, 1024, p.wri_t, 1024, T_, 4096, F.G, (int)blockIdx.x); EpiInTok E; E.q = p.q; E.k = p.k; E.sg = p.sg;
          pg::gemm_phase<EpiInTok, DenseSched, 0, true>(F.lds + RING_OFF, 1024, 1024, 16, S, E); }
        { DenseSched S; S.init(p.wfm_t, 1024, p.xh0, 1024, 2048, T_, F.G, (int)blockIdx.x); EpiInFeat E; E.vt = p.vt;
          pg::gemm_phase<EpiInFeat, DenseSched, 0, true>(F.lds + RING_OFF, 1024, 1024, 16, S, E); }
    }
#endif
    GRID_BAR();
    {
        ph_ktranspose(p, F);
        { RaSched S{p.q, p.k, F.G, F.vcu}; EpiPP E; E.pp = p.pp; pg::gemm_phase<EpiPP, RaSched, 0, true>(F.lds + RING_OFF, 1024, 1024, 4, S, E); }
    }
    GRID_BAR();
    {
        { R1Sched S{p.vt, p.kdt, 4, F.G, F.vcu}; EpiSegTot E; E.L = p.ltot; pg::gemm_phase<EpiSegTot, R1Sched, 0, false>(F.lds + RING_OFF, 256, 256, 4, S, E); }
    }
    GRID_BAR();
    ph_carry(p.ltot, F);
    GRID_BAR();
    { R1Sched S{p.vt, p.kdt, 3, F.G, F.vcu}; EpiSnap E; E.L = p.ltot; E.st = p.st; pg::gemm_phase<EpiSnap, R1Sched, 0, false>(F.lds + RING_OFF, 256, 256, 4, S, E); }
#if (PROBE_DBL >> 8) & 1
    GRID_BAR();
    { R1Sched S{p.vt, p.kdt, 3, F.G, F.vcu}; EpiSnap E; E.L = p.ltot; E.st = p.st; pg::gemm_phase<EpiSnap, R1Sched, 0, false>(F.lds + RING_OFF, 256, 256, 4, S, E); }
#endif
    GRID_BAR();
    { R2Sched S{p.pp, p.vt, p.q, p.st, F.G, F.vcu}; EpiRetOut E; E.o = p.o; E.sg = p.sg; E.og = p.og; pg::gemm_phase<EpiRetOut, R2Sched, 2, true>(F.lds + RING_OFF, 256, 256, 4, S, E, 1024, 256); }
    GRID_BAR();
    layer_tail<0>(p, F, bar);
    GRID_BAR();
    {
        { DenseSched S; S.init(p.x2h, 1024, p.wsi_t, 1024, T_, 1280, F.G, (int)blockIdx.x); EpiSwaTok E; E.sq = p.sq; E.skv = p.skv; E.bias = p.b_swa_in;
          pg::gemm_phase<EpiSwaTok, DenseSched, 0, true>(F.lds + RING_OFF, 1024, 1024, 16, S, E); }
        { DenseSched S; S.init(p.wsi_t + (size_t)1024 * 1024, 1024, p.x2h, 1024, 256, T_, F.G, (int)blockIdx.x, 128); EpiSwaFeat E; E.kvt = p.kvt; E.bias = p.b_swa_in;
          pg::gemm_phase<EpiSwaFeat, DenseSched, 0, true>(F.lds + RING_OFF, 1024, 1024, 16, S, E); }
    }
#if (PROBE_DBL >> 13) & 1
    GRID_BAR();
    {
        { DenseSched S; S.init(p.x2h, 1024, p.wsi_t, 1024, T_, 1280, F.G, (int)blockIdx.x); EpiSwaTok E; E.sq = p.sq; E.skv = p.skv; E.bias = p.b_swa_in;
          pg::gemm_phase<EpiSwaTok, DenseSched, 0, true>(F.lds + RING_OFF, 1024, 1024, 16, S, E); }
        { DenseSched S; S.init(p.wsi_t + (size_t)1024 * 1024, 1024, p.x2h, 1024, 256, T_, F.G, (int)blockIdx.x, 128); EpiSwaFeat E; E.kvt = p.kvt; E.bias = p.b_swa_in;
          pg::gemm_phase<EpiSwaFeat, DenseSched, 0, true>(F.lds + RING_OFF, 1024, 1024, 16, S, E); }
    }
#endif
    GRID_BAR();
    DBL(3, ph_swa_attn(p, F));
    GRID_BAR();
    layer_tail<1>(p, F, bar);
    if (__hip_atomic_load((gu32*)((unsigned*)p.ctl + CW_BAR + XB_TMO), RLX_AGENT) != 0u) {
        __syncthreads();
        for (size_t i = (size_t)blockIdx.x * 512 + F.tid; i < (size_t)T_ * D_; i += (size_t)F.G * 512) p.out[i] = __builtin_nanf("");
    }
#undef GRID_BAR
}

namespace host {
constexpr size_t MiB = 1u << 20;
static int g_grid = 0;
static bool setup() {
    if (g_grid) return g_grid > 0;
    int dev = 0, cus = 0;
    if (hipGetDevice(&dev) != hipSuccess || hipDeviceGetAttribute(&cus, hipDeviceAttributeMultiprocessorCount, dev) != hipSuccess) { g_grid = -1; return false; }
    if (hipFuncSetAttribute((const void*)mk_fwd, hipFuncAttributeMaxDynamicSharedMemorySize, LDS_BYTES) != hipSuccess) { g_grid = -1; return false; }
    (void)hipGetLastError();
    g_grid = cus;
    return true;
}
static void launch(hipStream_t st, Params p) {
    p.ph_lo = 0; p.ph_hi = 0; p.li = 0; p.layer = 0;
    hipLaunchKernelGGL(mk_fwd, dim3(g_grid), dim3(NWAVES * 64), LDS_BYTES, st, p);
}
static void fill_params(Params& p, void* const* d_in, float* out, unsigned char* ws) {
    const float** in = (const float**)&p.x;
    for (int i = 0; i < 18; ++i) in[i] = (const float*)d_in[i];
    p.out = out; p.ctl = (unsigned*)ws;
    const size_t M = MiB;
    p.top_e = (int*)(ws + 1 * M); p.top_g = (float*)(ws + 2 * M); p.rankp = (int*)(ws + 3 * M); p.inv = (int*)(ws + 4 * M); p.slot_tok = (int*)(ws + 5 * M); p.slot_gate = (float*)(ws + 6 * M);
    p.wg_cnt = (int*)(ws + 7 * M); p.tile_e = (int*)(ws + 8 * M);
    p.wri_t = (h16*)(ws + 17 * M); p.wfm_t = (h16*)(ws + 25 * M); p.wro_t = (h16*)(ws + 31 * M); p.wsi_t = (h16*)(ws + 35 * M); p.wso_t = (h16*)(ws + 38 * M);
    p.w1_t = (h16*)(ws + 40 * M); p.w2_t = (h16*)(ws + 296 * M);
    p.xh0 = (h16*)(ws + 424 * M); p.x1h = (h16*)(ws + 488 * M); p.x2h = (h16*)(ws + 552 * M);
    p.x1f = (float*)(ws + 616 * M); p.x2f = (float*)(ws + 744 * M); p.yf = (float*)(ws + 872 * M);
    p.act = (h16*)(ws + 1000 * M); p.yy = (h16*)(ws + 1272 * M);
}
}
extern "C" void kernel_launch(void* const* d_in, const int* in_sizes, int n_in, void* d_out, int out_size, void* d_ws, size_t ws_size, hipStream_t stream) {
    const size_t M = host::MiB;
    if (n_in != 18 || out_size != T_ * D_ || ws_size < 2040 * M) { fprintf(stderr, "kernel_launch: unexpected shapes / workspace (%d inputs, out %d, ws %zu)\n", n_in, out_size, ws_size); return; }
    if (!host::setup()) return;
    unsigned char* ws = (unsigned char*)d_ws; hipStream_t st = stream;
    (void)hipMemsetAsync(ws, 0, CTL_ZERO_BYTES, st);
    Params p{}; host::fill_params(p, d_in, (float*)d_out, ws);
    p.q = (h16*)(ws + 1000 * M); p.k = (h16*)(ws + 1064 * M); p.sg = (h16*)(ws + 1128 * M); p.kdt = (h16*)(ws + 1256 * M); p.vt = (h16*)(ws + 1320 * M);
    p.pp = (h16*)(ws + 1448 * M); p.st = (h16*)(ws + 1512 * M); p.ltot = (float*)(ws + 1640 * M); p.o = (h16*)(ws + 1704 * M); p.og = (h16*)(ws + 1832 * M);
    p.sq = (h16*)(ws + 1000 * M); p.skv = (h16*)(ws + 1064 * M); p.kvt = (h16*)(ws + 1080 * M); p.so = (h16*)(ws + 1096 * M);
    p.w1q = (unsigned char*)p.w1_t + (size_t)32 * 2048 * 1024 * 2; p.w2q = (unsigned char*)p.w2_t + (size_t)32 * 1024 * 1024 * 2;
    p.x1q = ws + 1560 * M; p.actq = (unsigned char*)p.act;
    p.yh = (h16*)p.yf;
    host::launch(st, p);
}
```

```cpp
#include <hip/hip_runtime.h>
#include <cstdio>
#include <cstdint>
#include <cmath>
#define GAS __attribute__((address_space(1)))
#define LAS __attribute__((address_space(3)))
typedef unsigned short bf16;
typedef unsigned v4u __attribute__((ext_vector_type(4)));
typedef float f32x4 __attribute__((ext_vector_type(4)));
typedef short bf16x8 __attribute__((ext_vector_type(8)));
typedef GAS unsigned gu32;
typedef GAS unsigned long long gu64;
#define RLX_AGENT __ATOMIC_RELAXED, __HIP_MEMORY_SCOPE_AGENT
#define LDS_WAIT() asm volatile("s_waitcnt lgkmcnt(0)" ::: "memory")
#define VM_WAIT() asm volatile("s_waitcnt vmcnt(0)" ::: "memory")
__device__ __forceinline__ unsigned long long rt() { return __builtin_amdgcn_s_memrealtime(); }
#define XB_TMO      128
#define XB_XCNT(j)  (256  + 64 * (j))
#define XB_XSUB(j)  (1280 + 64 * (j))
#define XB_XGEN(j)  (2304 + 64 * (j))
#define XB_TOP      3328
#define XB_TOPGEN   3392
#define XCD_BAR_WORDS 3456
#define XB_SPIN_CAP (1u << 18)

__device__ __forceinline__ unsigned xb_ld(unsigned* p)              { return __hip_atomic_load(p, __ATOMIC_RELAXED, __HIP_MEMORY_SCOPE_AGENT); }
__device__ __forceinline__ unsigned xb_add(unsigned* p, unsigned v) { return __hip_atomic_fetch_add(p, v, __ATOMIC_RELAXED, __HIP_MEMORY_SCOPE_AGENT); }
__device__ __forceinline__ unsigned xb_xcc_id() { return (unsigned)__builtin_amdgcn_s_getreg((3 << 11) | 20) & 0xFu; }
#define XB_SPIN(cond, bar) do { unsigned _sp = 0; while (cond) { __builtin_amdgcn_s_sleep(1); \
    if ((++_sp & 255u) == 0u) { if (xb_ld(&(bar)[XB_TMO])) break; if (_sp > XB_SPIN_CAP) { atomicAdd(&(bar)[XB_TMO], 1u); break; } } } } while (0)

struct XcdBarrier {
    unsigned* bar; unsigned x;
    volatile LAS unsigned* st;
};

__device__ __forceinline__ XcdBarrier xcd_barrier_post(unsigned* bar, volatile LAS unsigned* st) {
    XcdBarrier b; b.bar = bar; b.x = xb_xcc_id(); b.st = st;
    if (threadIdx.x == 0) (void)xb_add(&bar[XB_XCNT(b.x)], 1u);
    return b;
}
__device__ __forceinline__ void xcd_barrier_complete(unsigned* bar, unsigned x, unsigned& nloc, unsigned& nx) {
    const unsigned G = gridDim.x * gridDim.y * gridDim.z;
    unsigned sum, cnt, mine, sp = 0u;
    for (;;) {
        sum = 0u; cnt = 0u; mine = 0u;
#pragma unroll
        for (unsigned j = 0; j < 16; ++j) { const unsigned c = xb_ld(&bar[XB_XCNT(j)]); sum += c; cnt += (c > 0u) ? 1u : 0u; mine = (j == x) ? c : mine; }
        if (sum == G) break;
        __builtin_amdgcn_s_sleep(1);
        if ((++sp & 255u) == 0u) { if (xb_ld(&bar[XB_TMO])) break; if (sp > XB_SPIN_CAP) { atomicAdd(&bar[XB_TMO], 1u); break; } }
    }
    nloc = mine > 0u ? mine : 1u; nx = cnt > 0u ? cnt : 1u;
}

__device__ __forceinline__ void xcd_barrier(const XcdBarrier& b) {
    asm volatile("s_waitcnt vmcnt(0)" ::: "memory");
    __syncthreads();
    if (threadIdx.x == 0) {
        unsigned* bar = b.bar;
        __builtin_amdgcn_s_waitcnt(0);
        unsigned nloc = b.st[0], nx = b.st[1];
        if (nloc == 0u) { xcd_barrier_complete(bar, b.x, nloc, nx); b.st[0] = nloc; b.st[1] = nx; }
        const unsigned old = xb_add(&bar[XB_XSUB(b.x)], 1u);
        const unsigned gen = old / nloc;
        if (old + 1u == (gen + 1u) * nloc) {
            __builtin_amdgcn_fence(__ATOMIC_RELEASE, "agent");
            asm volatile("s_waitcnt vmcnt(0)" ::: "memory");
            const unsigned og = xb_add(&bar[XB_TOP], 1u);
            const unsigned tg = og / nx;
            if (og + 1u == (tg + 1u) * nx) xb_add(&bar[XB_TOPGEN], 1u);
            else XB_SPIN(xb_ld(&bar[XB_TOPGEN]) == tg, bar);
            __builtin_amdgcn_fence(__ATOMIC_ACQUIRE, "agent");
            xb_add(&bar[XB_XGEN(b.x)], 1u);
            asm volatile("s_waitcnt vmcnt(0)" ::: "memory");
        } else {
            XB_SPIN(xb_ld(&bar[XB_XGEN(b.x)]) == gen, bar);
            __builtin_amdgcn_fence(__ATOMIC_ACQUIRE, "agent");
            asm volatile("s_waitcnt vmcnt(0)" ::: "memory");
        }
    }
    __syncthreads();
}
namespace pg {
#define PG_LAS __attribute__((address_space(3)))
typedef unsigned short h16;
typedef _Float16 f16x8 __attribute__((ext_vector_type(8)));
typedef __bf16 bf16x8 __attribute__((ext_vector_type(8)));
typedef _Float16 f16x2 __attribute__((ext_vector_type(2)));
typedef float f32x4 __attribute__((ext_vector_type(4)));
typedef float f32x2 __attribute__((ext_vector_type(2)));
typedef unsigned u32x4 __attribute__((ext_vector_type(4)));
typedef unsigned u32x2 __attribute__((ext_vector_type(2)));
constexpr int BM = 256, BK = 64, HALF = 128, HTB = HALF * BK * 2  , STAGE_BYTES = 8 * HTB;

__host__ __device__ __forceinline__ int lds_byte(int r, int c) { const int st = (r >> 4) * 2 + (c >> 5), rr = r & 15, cc = c & 31, ob = rr * 64 + cc * 2; return st * 1024 + (ob ^ (((ob >> 9) & 1) << 5)); }
__host__ __device__ __forceinline__ void stage_rc(int b, int& R, int& C) { const int st = b / 1024, sb = b % 1024, swz = sb ^ (((sb >> 9) & 1) << 5); R = (st >> 1) * 16 + swz / 64; C = (st & 1) * 32 + (swz % 64) / 2; }
__host__ __device__ __forceinline__ int perm32(int rho) { const int n = rho >> 4, i = rho & 15; return 8 * (i >> 2) + 4 * n + (i & 3); }
__device__ __forceinline__ unsigned pkh(float lo, float hi) { const f32x2 v = {lo, hi}; const f16x2 h = __builtin_convertvector(v, f16x2); return __builtin_bit_cast(unsigned, h); }

typedef int i32x8 __attribute__((ext_vector_type(8)));
typedef int i32x4 __attribute__((ext_vector_type(4)));
__device__ __forceinline__ i32x8 cat8(f16x8 lo, f16x8 hi) { return __builtin_shufflevector(__builtin_bit_cast(i32x4, lo), __builtin_bit_cast(i32x4, hi), 0, 1, 2, 3, 4, 5, 6, 7); }
__device__ __forceinline__ void mfma_f8(f32x4& c, const i32x8& a, const i32x8& b, int scale) {
    asm volatile("v_mfma_scale_f32_16x16x128_f8f6f4 %0, %1, %2, %0, %3, %3 op_sel_hi:[0,0,0]" : "+v"(c) : "v"(a), "v"(b), "v"(scale)); }
struct Unit { const char* a; const char* b; int pm, pn, e, x; };
typedef f32x4 Acc[2][2][4][2];
__device__ __forceinline__ void acc_zero(Acc& acc) {
#pragma unroll
    for (int a = 0; a < 2; ++a)
#pragma unroll
        for (int b = 0; b < 2; ++b)
#pragma unroll
            for (int m = 0; m < 4; ++m)
#pragma unroll
                for (int n = 0; n < 2; ++n) acc[a][b][m][n] = (f32x4){0.f, 0.f, 0.f, 0.f};
}
struct EpiBase {
    static constexpr bool PERM = false;
    __device__ __forceinline__ void init(Acc& acc, const Unit&, int, int, int, int) const { acc_zero(acc); }
    __device__ __forceinline__ void reinit(Acc& acc, const Unit&, const Unit&, int, int, int, int) const { acc_zero(acc); }
};

template <class Epi, class Sched, int MODE  , bool ALIGN_EPI, int ES = 2  , bool BF = false  , int ILV = 2  >
__device__ __forceinline__ void gemm_phase(PG_LAS unsigned char* lds, const int lda, const int ldb, const int nt_, const Sched& S, const Epi& E, const int lda1 = 0, const int ldb1 = 0, const int skew_ticks = 0  ) {
    constexpr bool GATHER = (MODE == 1), DUAL = (MODE == 2);
    int nt = nt_; asm volatile("" : "+s"(nt));
    int tid_ = threadIdx.x; asm volatile("" : "+v"(tid_));
    const int tid = tid_, wid = __builtin_amdgcn_readfirstlane(tid >> 6), lane = tid & 63, wr = wid >> 2, wc = wid & 3, fr = lane & 15, fq = lane >> 4;
    unsigned voffA[2], voffB[2]; int sR[2], sC[2];
#pragma unroll
    for (int i = 0; i < 2; ++i) { int R, C; stage_rc(tid * 16 + i * 8192, R, C); sR[i] = R; sC[i] = C; const int Rb = Epi::PERM ? ((R & ~31) + perm32(R & 31)) : R;
        voffA[i] = (unsigned)(R * lda * ES + C * 2); voffB[i] = (unsigned)(Rb * ldb * ES + C * 2); }
    const size_t kstep = (size_t)(BK * 2);
    const size_t hstepA0 = GATHER ? 0 : (size_t)HALF * lda * ES, hstepB0 = (size_t)HALF * ldb * ES, hstepA1 = (size_t)HALF * lda1 * ES, hstepB1 = (size_t)HALF * ldb1 * ES;
    unsigned wA1[2], wB1[2];
#pragma unroll
    for (int i = 0; i < 2; ++i) { const int Rb = Epi::PERM ? ((sR[i] & ~31) + perm32(sR[i] & 31)) : sR[i]; wA1[i] = (unsigned)(sR[i] * lda1 * ES + sC[i] * 2); wB1[i] = (unsigned)(Rb * ldb1 * ES + sC[i] * 2); }
    unsigned vAc[2], vBc[2], vAn[2], vBn[2], vA2[2], vB2[2];
    size_t hAc = hstepA0, hBc = hstepB0, hAn = hstepA0, hBn = hstepB0, hA2 = hstepA0, hB2 = hstepB0;
    const unsigned ldsw = (unsigned)wid * 1024u;
    const int aoff = (ES == 2) ? lds_byte(wr * 64 + fr, fq * 8) : lds_byte(wr * 64 + fr, fq * 16), boff = (ES == 2) ? lds_byte(wc * 32 + fr, fq * 8) : lds_byte(wc * 32 + fr, fq * 16);
    unsigned gc[2][2], gn[2][2], g2[2][2];
#define PG_SA(b, h) (((b) * 2 + (h)) * HTB)
#define PG_SB(b, h) ((4 + (b) * 2 + (h)) * HTB)
#if !defined(PG_GLOBAL_DMA)
#define PG_STAGE(bufoff, gbase, voff) do { const __amdgpu_buffer_rsrc_t _r = __builtin_amdgcn_make_buffer_rsrc((void*)(gbase), 0, 0x7fffffff, 0x00020000); _Pragma("unroll") for (int _i = 0; _i < 2; ++_i) \
        __builtin_amdgcn_raw_ptr_buffer_load_lds(_r, (PG_LAS unsigned*)(lds + (bufoff) + ldsw + _i * 8192), 16, (int)(voff)[_i], 0, 0, 0); } while (0)
#else
#define PG_STAGE(bufoff, gbase, voff) do { _Pragma("unroll") for (int _i = 0; _i < 2; ++_i) \
        __builtin_amdgcn_global_load_lds((const unsigned*)((const char*)(gbase) + (voff)[_i]), (PG_LAS unsigned*)(lds + (bufoff) + ldsw + _i * 8192), 16, 0, 0); } while (0)
#endif
#define PG_STAGE_A(bufoff, kptr, h, G, VA, HA) do { if constexpr (GATHER) { PG_STAGE(bufoff, kptr, G[h]); } else { PG_STAGE(bufoff, (kptr) + (h) * (HA), VA); } } while (0)
#define PG_CFG(u, VA, VB, HA, HB) do { if constexpr (DUAL) { const bool _x = (u).x != 0; _Pragma("unroll") for (int _i = 0; _i < 2; ++_i) { VA[_i] = _x ? wA1[_i] : voffA[_i]; VB[_i] = _x ? wB1[_i] : voffB[_i]; } \
        HA = _x ? hstepA1 : hstepA0; HB = _x ? hstepB1 : hstepB0; } else { _Pragma("unroll") for (int _i = 0; _i < 2; ++_i) { VA[_i] = voffA[_i]; VB[_i] = voffB[_i]; } HA = hstepA0; HB = hstepB0; } } while (0)
#define PG_GLOAD(dst, u) do { _Pragma("unroll") for (int _h = 0; _h < 2; ++_h) _Pragma("unroll") for (int _i = 0; _i < 2; ++_i) \
        dst[_h][_i] = S.arow(u, _h * HALF + sR[_i]) * (unsigned)(lda * ES) + (unsigned)(sC[_i] * 2); } while (0)
#define PG_LDF(p) (*(const PG_LAS f16x8*)(p))
#define PG_LDA(dst, b, h) do { if constexpr (ES == 2) { _Pragma("unroll") for (int m = 0; m < 4; ++m) _Pragma("unroll") for (int k = 0; k < 2; ++k) dst[m][k] = PG_LDF(lds + PG_SA(b, h) + aoff + m * 2048 + k * 1024); } \
        else { _Pragma("unroll") for (int m = 0; m < 4; ++m) dst##8[m] = cat8(PG_LDF(lds + PG_SA(b, h) + aoff + m * 2048), PG_LDF(lds + PG_SA(b, h) + aoff + m * 2048 + 16)); } } while (0)
#define PG_LDB(dst, b, h) do { if constexpr (ES == 2) { _Pragma("unroll") for (int n = 0; n < 2; ++n) _Pragma("unroll") for (int k = 0; k < 2; ++k) dst[n][k] = PG_LDF(lds + PG_SB(b, h) + boff + n * 2048 + k * 1024); } \
        else { _Pragma("unroll") for (int n = 0; n < 2; ++n) dst##8[n] = cat8(PG_LDF(lds + PG_SB(b, h) + boff + n * 2048), PG_LDF(lds + PG_SB(b, h) + boff + n * 2048 + 16)); } } while (0)
#define PG_MMA(ai, bj, At, Bt) do { __builtin_amdgcn_s_setprio(1); if constexpr (ES == 2) { _Pragma("unroll") for (int m = 0; m < 4; ++m) _Pragma("unroll") for (int n = 0; n < 2; ++n) _Pragma("unroll") for (int k = 0; k < 2; ++k) \
        acc[ai][bj][m][n] = BF ? __builtin_amdgcn_mfma_f32_16x16x32_bf16(__builtin_bit_cast(bf16x8, Bt[n][k]), __builtin_bit_cast(bf16x8, At[m][k]), acc[ai][bj][m][n], 0, 0, 0) : __builtin_amdgcn_mfma_f32_16x16x32_f16(Bt[n][k], At[m][k], acc[ai][bj][m][n], 0, 0, 0); } else { _Pragma("unroll") for (int m = 0; m < 4; ++m) _Pragma("unroll") for (int n = 0; n < 2; ++n) \
        mfma_f8(acc[ai][bj][m][n], Bt##8[n], At##8[m], f8scale); } \
        __builtin_amdgcn_s_setprio(0); } while (0)
#define PG_MMH(ai, bj, At, Bt, M0) do { __builtin_amdgcn_s_setprio(1); if constexpr (ES == 2) { _Pragma("unroll") for (int m = (M0); m < (M0) + 2; ++m) _Pragma("unroll") for (int n = 0; n < 2; ++n) _Pragma("unroll") for (int k = 0; k < 2; ++k) \
        acc[ai][bj][m][n] = BF ? __builtin_amdgcn_mfma_f32_16x16x32_bf16(__builtin_bit_cast(bf16x8, Bt[n][k]), __builtin_bit_cast(bf16x8, At[m][k]), acc[ai][bj][m][n], 0, 0, 0) : __builtin_amdgcn_mfma_f32_16x16x32_f16(Bt[n][k], At[m][k], acc[ai][bj][m][n], 0, 0, 0); } else { _Pragma("unroll") for (int m = (M0); m < (M0) + 2; ++m) _Pragma("unroll") for (int n = 0; n < 2; ++n) \
        mfma_f8(acc[ai][bj][m][n], Bt##8[n], At##8[m], f8scale); } \
        __builtin_amdgcn_s_setprio(0); } while (0)
#define PG_WAIT_V(n) asm volatile("s_waitcnt vmcnt(" #n ")" ::: "memory")
#define PG_WAIT_L(n) asm volatile("s_waitcnt lgkmcnt(" #n ")" ::: "memory")
#define PG_BAR __builtin_amdgcn_s_barrier()
#define PG_SCHED __builtin_amdgcn_sched_barrier(0)
    if (skew_ticks > 0) { const unsigned long long t0 = __builtin_amdgcn_s_memrealtime(); while (__builtin_amdgcn_s_memrealtime() - t0 < (unsigned long long)skew_ticks) __builtin_amdgcn_s_sleep(8); }
    Unit cur, nxt; int ui = 0;
    if (!S.next(0, cur)) return;
    Acc acc;
    E.init(acc, cur, wr, wc, fr, fq);
    f16x8 At[4][2], B0[2][2], B1[2][2];
    int f8scale = 0x7f7f7f7f; asm volatile("" : "+v"(f8scale));
    i32x8 At8[4], B08[2], B18[2];
    const char* cA = cur.a; const char* cB = cur.b;
    if constexpr (GATHER) { PG_GLOAD(gc, cur); }
    PG_CFG(cur, vAc, vBc, hAc, hBc);
    PG_STAGE(PG_SB(0, 0), cB, vBc); PG_STAGE(PG_SB(0, 1), cB + hBc, vBc); PG_STAGE_A(PG_SA(0, 0), cA, 0, gc, vAc, hAc); PG_STAGE_A(PG_SA(0, 1), cA, 1, gc, vAc, hAc);
    if (wr == 1) PG_BAR;
    PG_WAIT_V(2); PG_BAR;
    if constexpr (ILV >= 2 && ILV <= 4) { PG_STAGE(PG_SB(1, 0), cB + kstep, vBc); PG_STAGE(PG_SB(1, 1), cB + hBc + kstep, vBc); PG_WAIT_V(4); PG_BAR; }
    else { PG_STAGE(PG_SB(1, 0), cB + kstep, vBc); PG_STAGE_A(PG_SA(1, 0), cA + kstep, 0, gc, vAc, hAc); PG_STAGE(PG_SB(1, 1), cB + hBc + kstep, vBc);
    PG_WAIT_V(6); PG_BAR; }
    for (;;) {
        const bool has_next = S.next(ui + 1, nxt);
        const char* nA = has_next ? nxt.a : cA; const char* nB = has_next ? nxt.b : cB;
        if constexpr (GATHER) { if (has_next) { PG_GLOAD(gn, nxt); } else {
#pragma unroll
            for (int h = 0; h < 2; ++h)
#pragma unroll
                for (int i = 0; i < 2; ++i) gn[h][i] = gc[h][i]; } }
        if (has_next) { PG_CFG(nxt, vAn, vBn, hAn, hBn); } else { PG_CFG(cur, vAn, vBn, hAn, hBn); }
        for (int t = 0; t < nt; t += 2) {
            const bool last = (t == nt - 2);
            const char* a1 = cA + (size_t)(t + 1) * kstep;
            const char* a2 = last ? nA : cA + (size_t)(t + 2) * kstep; const char* b2 = last ? nB : cB + (size_t)(t + 2) * kstep;
            const char* a3 = a2 + kstep; const char* b3 = b2 + kstep;
            if constexpr (GATHER) {
#pragma unroll
                for (int h = 0; h < 2; ++h)
#pragma unroll
                    for (int i = 0; i < 2; ++i) g2[h][i] = last ? gn[h][i] : gc[h][i]; }
            if constexpr (DUAL) {
#pragma unroll
                for (int i = 0; i < 2; ++i) { vA2[i] = last ? vAn[i] : vAc[i]; vB2[i] = last ? vBn[i] : vBc[i]; }
                hA2 = last ? hAn : hAc; hB2 = last ? hBn : hBc;
            } else {
#pragma unroll
                for (int i = 0; i < 2; ++i) { vA2[i] = vAc[i]; vB2[i] = vBc[i]; }
                hA2 = hAc; hB2 = hBc; }
            if constexpr (ILV == 5) {
            PG_LDB(B0, 0, 0); PG_SCHED; PG_LDA(At, 0, 0); PG_STAGE_A(PG_SA(1, 1), a1, 1, gc, vAc, hAc);
            PG_WAIT_L(8); PG_BAR; PG_WAIT_L(0); PG_MMA(0, 0, At, B0); PG_BAR; PG_SCHED;
            PG_LDB(B1, 0, 1); PG_STAGE(PG_SB(0, 0), b2, vB2);
            PG_BAR; PG_WAIT_L(0); PG_MMA(0, 1, At, B1); PG_BAR; PG_SCHED;
            PG_LDA(At, 0, 1); PG_STAGE_A(PG_SA(0, 0), a2, 0, g2, vA2, hA2);
            PG_BAR; PG_WAIT_L(0); PG_MMA(1, 0, At, B0); PG_BAR; PG_SCHED;
            PG_STAGE(PG_SB(0, 1), b2 + hB2, vB2);
            PG_WAIT_V(6); PG_BAR; PG_MMA(1, 1, At, B1); PG_BAR; PG_SCHED;
            PG_LDB(B0, 1, 0); PG_SCHED; PG_LDA(At, 1, 0); PG_STAGE_A(PG_SA(0, 1), a2, 1, g2, vA2, hA2);
            PG_WAIT_L(8); PG_BAR; PG_WAIT_L(0); PG_MMA(0, 0, At, B0); PG_BAR; PG_SCHED;
            PG_LDB(B1, 1, 1); PG_STAGE(PG_SB(1, 0), b3, vB2);
            PG_BAR; PG_WAIT_L(0); PG_MMA(0, 1, At, B1); PG_BAR; PG_SCHED;
            PG_LDA(At, 1, 1); PG_STAGE_A(PG_SA(1, 0), a3, 0, g2, vA2, hA2);
            PG_BAR; PG_WAIT_L(0); PG_MMA(1, 0, At, B0); PG_BAR; PG_SCHED;
            PG_STAGE(PG_SB(1, 1), b3 + hB2, vB2);
            PG_WAIT_V(6); PG_BAR; PG_MMA(1, 1, At, B1); PG_BAR; PG_SCHED;
            } else if constexpr (ILV == 3) {
            PG_LDB(B0, 0, 0); PG_LDB(B1, 0, 1); PG_SCHED; PG_LDA(At, 0, 0); PG_STAGE_A(PG_SA(1, 0), a1, 0, gc, vAc, hAc);
            PG_WAIT_V(6); PG_WAIT_L(0); PG_BAR; PG_MMA(0, 0, At, B0); PG_SCHED; PG_STAGE_A(PG_SA(1, 1), a1, 1, gc, vAc, hAc); PG_SCHED; PG_MMA(0, 1, At, B1); PG_BAR; PG_SCHED;
            PG_LDA(At, 0, 1); PG_STAGE(PG_SB(0, 0), b2, vB2);
            PG_WAIT_V(4); PG_WAIT_L(0); PG_BAR; PG_MMA(1, 0, At, B0); PG_SCHED; PG_STAGE(PG_SB(0, 1), b2 + hB2, vB2); PG_SCHED; PG_MMA(1, 1, At, B1); PG_BAR; PG_SCHED;
            PG_LDB(B0, 1, 0); PG_LDB(B1, 1, 1); PG_SCHED; PG_LDA(At, 1, 0); PG_STAGE_A(PG_SA(0, 0), a2, 0, g2, vA2, hA2);
            PG_WAIT_V(6); PG_WAIT_L(0); PG_BAR; PG_MMA(0, 0, At, B0); PG_SCHED; PG_STAGE_A(PG_SA(0, 1), a2, 1, g2, vA2, hA2); PG_SCHED; PG_MMA(0, 1, At, B1); PG_BAR; PG_SCHED;
            PG_LDA(At, 1, 1); PG_STAGE(PG_SB(1, 0), b3, vB2);
            PG_WAIT_V(4); PG_WAIT_L(0); PG_BAR; PG_MMA(1, 0, At, B0); PG_SCHED; PG_STAGE(PG_SB(1, 1), b3 + hB2, vB2); PG_SCHED; PG_MMA(1, 1, At, B1); PG_BAR; PG_SCHED;
            } else if constexpr (ILV == 4) {
            PG_LDB(B0, 0, 0); PG_SCHED; PG_STAGE_A(PG_SA(1, 0), a1, 0, gc, vAc, hAc); PG_SCHED; PG_LDA(At, 0, 0); PG_SCHED; PG_STAGE_A(PG_SA(1, 1), a1, 1, gc, vAc, hAc);
            PG_WAIT_V(8); PG_BAR; PG_WAIT_L(0); PG_MMA(0, 0, At, B0); PG_SCHED; PG_LDB(B1, 0, 1); PG_WAIT_L(0); PG_SCHED; PG_MMA(0, 1, At, B1); PG_BAR; PG_SCHED;
            PG_LDA(At, 0, 1); PG_STAGE(PG_SB(0, 0), b2, vB2); PG_STAGE(PG_SB(0, 1), b2 + hB2, vB2);
            PG_WAIT_V(6); PG_BAR; PG_WAIT_L(0); PG_MMA(1, 0, At, B0); PG_MMA(1, 1, At, B1); PG_BAR; PG_SCHED;
            PG_LDB(B0, 1, 0); PG_SCHED; PG_STAGE_A(PG_SA(0, 0), a2, 0, g2, vA2, hA2); PG_SCHED; PG_LDA(At, 1, 0); PG_SCHED; PG_STAGE_A(PG_SA(0, 1), a2, 1, g2, vA2, hA2);
            PG_WAIT_V(8); PG_BAR; PG_WAIT_L(0); PG_MMA(0, 0, At, B0); PG_SCHED; PG_LDB(B1, 1, 1); PG_WAIT_L(0); PG_SCHED; PG_MMA(0, 1, At, B1); PG_BAR; PG_SCHED;
            PG_LDA(At, 1, 1); PG_STAGE(PG_SB(1, 0), b3, vB2); PG_STAGE(PG_SB(1, 1), b3 + hB2, vB2);
            PG_WAIT_V(6); PG_BAR; PG_WAIT_L(0); PG_MMA(1, 0, At, B0); PG_MMA(1, 1, At, B1); PG_BAR; PG_SCHED;
            } else if constexpr (ILV == 2) {
            PG_LDB(B0, 0, 0); PG_LDB(B1, 0, 1); PG_SCHED; PG_STAGE_A(PG_SA(1, 0), a1, 0, gc, vAc, hAc); PG_SCHED; PG_LDA(At, 0, 0); PG_SCHED; PG_STAGE_A(PG_SA(1, 1), a1, 1, gc, vAc, hAc);
            PG_WAIT_V(8); PG_BAR; PG_WAIT_L(0); PG_MMA(0, 0, At, B0); PG_MMA(0, 1, At, B1); PG_BAR; PG_SCHED;
            PG_LDA(At, 0, 1); PG_STAGE(PG_SB(0, 0), b2, vB2); PG_STAGE(PG_SB(0, 1), b2 + hB2, vB2);
            PG_WAIT_V(6); PG_BAR; PG_WAIT_L(0); PG_MMA(1, 0, At, B0); PG_MMA(1, 1, At, B1); PG_BAR; PG_SCHED;
            PG_LDB(B0, 1, 0); PG_LDB(B1, 1, 1); PG_SCHED; PG_STAGE_A(PG_SA(0, 0), a2, 0, g2, vA2, hA2); PG_SCHED; PG_LDA(At, 1, 0); PG_SCHED; PG_STAGE_A(PG_SA(0, 1), a2, 1, g2, vA2, hA2);
            PG_WAIT_V(8); PG_BAR; PG_WAIT_L(0); PG_MMA(0, 0, At, B0); PG_MMA(0, 1, At, B1); PG_BAR; PG_SCHED;
            PG_LDA(At, 1, 1); PG_STAGE(PG_SB(1, 0), b3, vB2); PG_STAGE(PG_SB(1, 1), b3 + hB2, vB2);
            PG_WAIT_V(6); PG_BAR; PG_WAIT_L(0); PG_MMA(1, 0, At, B0); PG_MMA(1, 1, At, B1); PG_BAR; PG_SCHED;
            } else if constexpr (ILV == 1) {
            PG_LDB(B0, 0, 0); PG_LDB(B1, 0, 1); PG_SCHED; PG_LDA(At, 0, 0);
            PG_WAIT_V(6); PG_WAIT_L(0); PG_BAR; PG_MMA(0, 0, At, B0); PG_SCHED; PG_STAGE_A(PG_SA(1, 1), a1, 1, gc, vAc, hAc); PG_SCHED; PG_MMA(0, 1, At, B1); PG_BAR; PG_SCHED;
            PG_LDA(At, 0, 1);
            PG_WAIT_V(2); PG_WAIT_L(0); PG_BAR; PG_MMH(1, 0, At, B0, 0); PG_SCHED; PG_STAGE(PG_SB(0, 0), b2, vB2); PG_SCHED; PG_MMH(1, 0, At, B0, 2); PG_SCHED; PG_STAGE(PG_SB(0, 1), b2 + hB2, vB2); PG_SCHED;
                PG_MMH(1, 1, At, B1, 0); PG_SCHED; PG_STAGE_A(PG_SA(0, 0), a2, 0, g2, vA2, hA2); PG_SCHED; PG_MMH(1, 1, At, B1, 2); PG_BAR; PG_SCHED;
            PG_LDB(B0, 1, 0); PG_LDB(B1, 1, 1); PG_SCHED; PG_LDA(At, 1, 0);
            PG_WAIT_V(6); PG_WAIT_L(0); PG_BAR; PG_MMA(0, 0, At, B0); PG_SCHED; PG_STAGE_A(PG_SA(0, 1), a2, 1, g2, vA2, hA2); PG_SCHED; PG_MMA(0, 1, At, B1); PG_BAR; PG_SCHED;
            PG_LDA(At, 1, 1);
            PG_WAIT_V(2); PG_WAIT_L(0); PG_BAR; PG_MMH(1, 0, At, B0, 0); PG_SCHED; PG_STAGE(PG_SB(1, 0), b3, vB2); PG_SCHED; PG_MMH(1, 0, At, B0, 2); PG_SCHED; PG_STAGE(PG_SB(1, 1), b3 + hB2, vB2); PG_SCHED;
                PG_MMH(1, 1, At, B1, 0); PG_SCHED; PG_STAGE_A(PG_SA(1, 0), a3, 0, g2, vA2, hA2); PG_SCHED; PG_MMH(1, 1, At, B1, 2); PG_BAR; PG_SCHED;
            } else {
            PG_LDB(B0, 0, 0); PG_LDB(B1, 0, 1); PG_SCHED; PG_LDA(At, 0, 0); PG_STAGE_A(PG_SA(1, 1), a1, 1, gc, vAc, hAc);
            PG_WAIT_V(8); PG_WAIT_L(0); PG_BAR; PG_MMA(0, 0, At, B0); PG_MMA(0, 1, At, B1); PG_BAR; PG_SCHED;
            PG_LDA(At, 0, 1); PG_STAGE(PG_SB(0, 0), b2, vB2); PG_STAGE(PG_SB(0, 1), b2 + hB2, vB2); PG_STAGE_A(PG_SA(0, 0), a2, 0, g2, vA2, hA2);
            PG_WAIT_V(8); PG_WAIT_L(0); PG_BAR; PG_MMA(1, 0, At, B0); PG_MMA(1, 1, At, B1); PG_BAR; PG_SCHED;
            PG_LDB(B0, 1, 0); PG_LDB(B1, 1, 1); PG_SCHED; PG_LDA(At, 1, 0); PG_STAGE_A(PG_SA(0, 1), a2, 1, g2, vA2, hA2);
            PG_WAIT_V(8); PG_WAIT_L(0); PG_BAR; PG_MMA(0, 0, At, B0); PG_MMA(0, 1, At, B1); PG_BAR; PG_SCHED;
            PG_LDA(At, 1, 1); PG_STAGE(PG_SB(1, 0), b3, vB2); PG_STAGE(PG_SB(1, 1), b3 + hB2, vB2); PG_STAGE_A(PG_SA(1, 0), a3, 0, g2, vA2, hA2);
            PG_WAIT_V(8); PG_WAIT_L(0); PG_BAR; PG_MMA(1, 0, At, B0); PG_MMA(1, 1, At, B1); PG_BAR; PG_SCHED;
            }
        }
        if constexpr (ES == 1) asm volatile("s_nop 15\n\ts_nop 15" ::: "memory");
        if constexpr (ALIGN_EPI) { if (wr == 0) PG_BAR; }
        E(acc, cur, wr, wc, fr, fq);
        if (!has_next) break;
        E.reinit(acc, cur, nxt, wr, wc, fr, fq);
        cur = nxt; cA = nA; cB = nB; ++ui;
        if constexpr (GATHER) {
#pragma unroll
            for (int h = 0; h < 2; ++h)
#pragma unroll
                for (int i = 0; i < 2; ++i) gc[h][i] = gn[h][i]; }
        if constexpr (DUAL) {
#pragma unroll
            for (int i = 0; i < 2; ++i) { vAc[i] = vAn[i]; vBc[i] = vBn[i]; }
            hAc = hAn; hBc = hBn; }
        if constexpr (ALIGN_EPI) { if (wr == 1) PG_BAR; }
    }
    PG_WAIT_V(0);
    if constexpr (!ALIGN_EPI) { if (wr == 0) PG_BAR; }
    PG_BAR;
#undef PG_SA
#undef PG_SB
#undef PG_STAGE
#undef PG_STAGE_A
#undef PG_GLOAD
#undef PG_CFG
#undef PG_LDA
#undef PG_LDF
#undef PG_LDB
#undef PG_MMA
#undef PG_MMH
#undef PG_WAIT_V
#undef PG_WAIT_L
#undef PG_BAR
#undef PG_SCHED
}
}
constexpr int NWAVES = 8;
constexpr int T_ = 32768, D_ = 1024, SEQ_ = 8192;
constexpr int NSLOT_MAX = (512 + 32) * 256, NTILE_MAX = 544;
constexpr float ALPHA_ = 1.4142135623730951f, LN_EPS_ = 1e-5f;
constexpr int RING_OFF = 0, RING_BYTES = 131072;
constexpr int TAB_OFF = RING_BYTES, TAB_BYTES = 24576;
constexpr int LDSCTL_OFF = TAB_OFF + TAB_BYTES, MISC_OFF = LDSCTL_OFF + 320;
constexpr int LDS_BYTES = 159744;
constexpr int CW_TMO = 0, CW_CODE = 1, CW_NTILES = 64, CW_BAR = 4096;
constexpr int N_BAR_REGIONS = 12;
constexpr size_t CTL_ZERO_BYTES = 1u << 20;
static_assert((CW_BAR + N_BAR_REGIONS * XCD_BAR_WORDS) * 4 <= (int)CTL_ZERO_BYTES, "barrier regions inside the memset region");
typedef unsigned short h16;
typedef float f32x2v __attribute__((ext_vector_type(2)));
typedef unsigned v2u __attribute__((ext_vector_type(2)));
#define EPI_OPAQUE() asm volatile("" : "+v"(fr), "+v"(fq))

struct Params {
    const float *x, *w_ret_in, *w_ret_out, *w_swa_in, *b_swa_in, *w_swa_out, *b_swa_out, *sinks, *ln_mix_g, *ln_mix_b, *w_router, *b_router, *w_exp_in, *b_exp_in, *w_exp_out, *b_exp_out, *ln_ffn_g, *ln_ffn_b;
    float* out;
    unsigned* ctl;
    int *top_e, *rankp, *inv, *slot_tok, *wg_cnt, *tile_e; float *top_g, *slot_gate;
    h16 *wri_t, *wfm_t, *wro_t, *wsi_t, *wso_t, *w1_t, *w2_t;
    h16 *xh0, *x1h, *x2h, *yh; float *x1f, *x2f, *yf;
    h16 *act, *yy;
    h16 *q, *k, *sg, *kdt, *vt, *pp, *st, *o, *og; float* ltot;
    h16 *sq, *skv, *kvt, *so;
    const float* cv_src; h16* cv_dst; size_t cv_n; float* projf;
    unsigned char *w1q, *w2q, *x1q, *actq;
    int ph_lo, ph_hi, li, layer;
};

struct Frame {
    LAS unsigned char* lds; volatile LAS unsigned* MISC; gu32* ctl;
    int tid, lane, wave, vcu, G;
};
__device__ __forceinline__ float wave_sum(float v) {
    v += __builtin_bit_cast(float, __builtin_amdgcn_update_dpp(0, __builtin_bit_cast(int, v), 0x111, 0xf, 0xf, true));
    v += __builtin_bit_cast(float, __builtin_amdgcn_update_dpp(0, __builtin_bit_cast(int, v), 0x112, 0xf, 0xf, true));
    v += __builtin_bit_cast(float, __builtin_amdgcn_update_dpp(0, __builtin_bit_cast(int, v), 0x114, 0xf, 0xf, true));
    v += __builtin_bit_cast(float, __builtin_amdgcn_update_dpp(0, __builtin_bit_cast(int, v), 0x118, 0xf, 0xf, true));
    v += __builtin_bit_cast(float, __builtin_amdgcn_update_dpp(0, __builtin_bit_cast(int, v), 0x142, 0xa, 0xf, true));
    v += __builtin_bit_cast(float, __builtin_amdgcn_update_dpp(0, __builtin_bit_cast(int, v), 0x143, 0xc, 0xf, true));
    return __builtin_bit_cast(float, __builtin_amdgcn_readlane(__builtin_bit_cast(int, v), 63));
}
__device__ __forceinline__ unsigned pkh(float lo, float hi) { return pg::pkh(lo, hi); }
__device__ __forceinline__ float h2f(unsigned short h) { return (float)__builtin_bit_cast(_Float16, h); }

template <class RowMap>
__device__ __forceinline__ void transpose_item(const float* W, int K, int N, h16* WT, const RowMap& rm, LAS float* scr, int item, int lane) {
    const int nblk = N / 32, kb = item / nblk, nb = item % nblk, k0 = 64 * kb, n0 = 32 * nb;
#pragma unroll 8
    for (int i = 0; i < 32; ++i) { const int kk = 2 * i + (lane >> 5); scr[kk * 33 + (lane & 31)] = W[(size_t)(k0 + kk) * N + n0 + (lane & 31)]; }
    LDS_WAIT(); asm volatile("" ::: "memory");
    const int c = lane & 7;
#pragma unroll
    for (int j = 0; j < 4; ++j) { const int n = (lane >> 3) + 8 * j; const LAS float* s = scr + (8 * c) * 33 + n;
        v4u o; o.x = pkh(s[0 * 33], s[1 * 33]); o.y = pkh(s[2 * 33], s[3 * 33]); o.z = pkh(s[4 * 33], s[5 * 33]); o.w = pkh(s[6 * 33], s[7 * 33]);
        const long dr = rm(n0 + n);
        if (dr >= 0) *(GAS v4u*)(WT + (size_t)dr * K + k0 + 8 * c) = o; }
    LDS_WAIT(); asm volatile("" ::: "memory");
}
struct RmIdent { int off; __device__ __forceinline__ long operator()(int n) const { return off + n; } };
struct RmW1 { __device__ __forceinline__ long operator()(int n) const { const int j = n & 1023; return 256 * (j >> 7) + (n >> 10) * 128 + (j & 127); } };
struct RmRange { int lo, hi, off; __device__ __forceinline__ long operator()(int n) const { return (n >= lo && n < hi) ? (long)(off + n - lo) : -1; } };

__device__ __forceinline__ void ph_convert_moe(const Params& p, Frame& F, int layer) {
    LAS float* scr = (LAS float*)(F.lds + RING_OFF + F.wave * 16384);
    const int gw = F.vcu * NWAVES + F.wave, NGW = F.G * NWAVES;
    constexpr int I1 = (1024 / 64) * (2048 / 32), I2 = (1024 / 64) * (1024 / 32);
    const float* w1 = p.w_exp_in + (size_t)layer * 32 * 1024 * 2048; const float* w2 = p.w_exp_out + (size_t)layer * 32 * 1024 * 1024;
    h16* w1t = p.w1_t + (size_t)layer * 32 * 2048 * 1024; h16* w2t = p.w2_t + (size_t)layer * 32 * 1024 * 1024;
    for (int it = gw; it < 32 * (I1 + I2); it += NGW) {
        if (it < 32 * I1) { const int e = it / I1, r = it % I1; transpose_item(w1 + (size_t)e * 1024 * 2048, 1024, 2048, w1t + (size_t)e * 2048 * 1024, RmW1{}, scr, r, F.lane); }
        else { const int q = it - 32 * I1, e = q / I2, r = q % I2; transpose_item(w2 + (size_t)e * 1024 * 1024, 1024, 1024, w2t + (size_t)e * 1024 * 1024, RmIdent{0}, scr, r, F.lane); }
    }
}
__device__ __forceinline__ void ph_cvt_rows(const float* src, h16* dst, size_t n, Frame& F) {
    const size_t stride = (size_t)F.G * 512 * 8;
    for (size_t i0 = ((size_t)blockIdx.x * 512 + F.tid) * 8; i0 < n; i0 += 4 * stride) {
        f32x4 a[4], b[4];
#pragma unroll
        for (int u = 0; u < 4; ++u) { const size_t i = i0 + u * stride; if (i < n) { a[u] = __builtin_nontemporal_load((const GAS f32x4*)(src + i)); b[u] = __builtin_nontemporal_load((const GAS f32x4*)(src + i + 4)); } }
#pragma unroll
        for (int u = 0; u < 4; ++u) { const size_t i = i0 + u * stride; if (i < n) { v4u o; o.x = pkh(a[u].x, a[u].y); o.y = pkh(a[u].z, a[u].w); o.z = pkh(b[u].x, b[u].y); o.w = pkh(b[u].z, b[u].w); *(GAS v4u*)(dst + i) = o; } }
    }
}

__device__ __forceinline__ void ph_rank(const Params& p, Frame& F) {
    LAS int* se = (LAS int*)(F.lds + RING_OFF);
    for (int cc = blockIdx.x; cc < T_ / 128; cc += F.G) {
        __syncthreads();
        const int j = F.tid; const int e = p.top_e[cc * 512 + j];
        se[j] = e;
        __syncthreads();
        int r = 0;
        for (int q = 0; q < j; ++q) r += (se[q] == e) ? 1 : 0;
        p.rankp[cc * 512 + j] = r;
        if (j < 32) { int c = 0; for (int q = 0; q < 512; ++q) c += (se[q] == j) ? 1 : 0; p.wg_cnt[cc * 32 + j] = c; }
    }
}
__device__ __forceinline__ void ph_assign(const Params& p, Frame& F, int layer) {
    int tid_o = F.tid; asm volatile("" : "+v"(tid_o));
    LAS int* tot = (LAS int*)(F.lds + RING_OFF);
    LAS int* bef = tot + 512;
    LAS int* tst = bef + 512;
    LAS int* bas = tst + 64;
    LAS int* ttl = bas + 32;
    for (int cc = blockIdx.x; cc < T_ / 128; cc += F.G) {
        __syncthreads();
        { const int e = tid_o & 31, part = tid_o >> 5; int s = 0, b = 0;
          for (int c2 = part * 16; c2 < part * 16 + 16; ++c2) { const int v = p.wg_cnt[c2 * 32 + e]; s += v; b += (c2 < cc) ? v : 0; }
          tot[part * 32 + e] = s; bef[part * 32 + e] = b; }
        __syncthreads();
        if (tid_o < 32) { int s = 0, b = 0; for (int q = 0; q < 16; ++q) { s += tot[q * 32 + tid_o]; b += bef[q * 32 + tid_o]; } ttl[tid_o] = s; bas[tid_o] = b; }
        __syncthreads();
        if (tid_o == 0) { int ts = 0; for (int e = 0; e < 32; ++e) { tst[e] = ts; ts += (ttl[e] + 255) >> 8; } tst[32] = ts; }
        __syncthreads();
        { const int j = tid_o, ent = cc * 512 + j, e = p.top_e[ent]; const int sl = 256 * tst[e] + bas[e] + p.rankp[ent];
          p.slot_tok[sl] = ent >> 2; p.slot_gate[sl] = p.top_g[ent]; p.inv[ent] = sl; }
        if (cc < 32) { const int e = cc; for (int sl = 256 * tst[e] + ttl[e] + tid_o; sl < 256 * tst[e + 1]; sl += 512) { p.slot_tok[sl] = 0; p.slot_gate[sl] = 0.f; } }
        if (cc == 0) { for (int rt = tid_o; rt < tst[32]; rt += 512) { int e = 0; for (int q = 1; q < 32; ++q) e += (tst[q] <= rt) ? 1 : 0; p.tile_e[rt] = e; }
            if (tid_o == 0) __hip_atomic_store(F.ctl + CW_NTILES + 64 * layer, (unsigned)tst[32], RLX_AGENT); }
    }
}

constexpr int MOE_MAXU = 20;
#ifndef MOE_F8_L0
#define MOE_F8_L0 1
#ifndef OUT_F8
#define OUT_F8 1
#endif
#endif
constexpr int F8_FROM = MOE_F8_L0 ? 0 : 32;
struct MoeSched {
    const char* abase; const char* wbase; LAS const int* lt_e; LAS const int* lt_tok; int ntiles, nct_log, G, c; size_t a_tile_bytes, w_expert_bytes, w_tile_bytes;
    __device__ __forceinline__ bool next(int i, pg::Unit& u) const {
        const int L = i * G + c; if (L >= (ntiles << nct_log) || i >= MOE_MAXU) return false;
        const int rt = L >> nct_log, ct = L & ((1 << nct_log) - 1);
        const int e = __builtin_amdgcn_readfirstlane(lt_e[i]);
        u.a = abase + (size_t)rt * a_tile_bytes; u.b = wbase + (size_t)e * w_expert_bytes + (size_t)ct * w_tile_bytes; u.pm = rt; u.pn = ct; u.e = e; u.x = i; return true;
    }
    __device__ __forceinline__ unsigned arow(const pg::Unit& u, int r) const { return (unsigned)lt_tok[u.x * 256 + r]; }
};
__device__ __forceinline__ void moe_tables(Frame& F, const int* tile_e, const int* slot_tok, int ntiles, int nct_log, bool gather) {
    LAS int* lt_e = (LAS int*)(F.lds + TAB_OFF); LAS int* lt_tok = lt_e + 32;
    __syncthreads();
    for (int i = 0; i < MOE_MAXU; ++i) { const int L = i * F.G + F.vcu; if (L >= (ntiles << nct_log)) break; const int rt = L >> nct_log;
        if (F.tid == 0) lt_e[i] = tile_e[rt];
        if (gather && F.tid < 256) lt_tok[i * 256 + F.tid] = slot_tok[rt * 256 + F.tid]; }
    __syncthreads();
}
struct EpiSwiglu : pg::EpiBase {
    static constexpr bool PERM = true;
    h16* act; const float* b1;
    __device__ __forceinline__ void operator()(const pg::Acc& acc, const pg::Unit& u, int wr, int wc, int fr, int fq) const { EPI_OPAQUE();
        const int c0 = u.pn * 128 + wc * 32 + 8 * fq;
        const float* bg = b1 + (size_t)u.e * 2048 + c0; const float* bl = bg + 1024;
        const f32x4 g0 = *(const f32x4*)bg, g1 = *(const f32x4*)(bg + 4), l0 = *(const f32x4*)bl, l1 = *(const f32x4*)(bl + 4);
#pragma unroll
        for (int ai = 0; ai < 2; ++ai)
#pragma unroll
            for (int m = 0; m < 4; ++m) {
                const size_t row = (size_t)u.pm * 256 + ai * 128 + wr * 64 + m * 16 + fr;
                float r[8];
#pragma unroll
                for (int n = 0; n < 2; ++n)
#pragma unroll
                    for (int j = 0; j < 4; ++j) {
                        const float glu = fminf(acc[ai][0][m][n][j] + (n ? g1[j] : g0[j]), 7.0f);
                        const float lin = fminf(fmaxf(acc[ai][1][m][n][j] + (n ? l1[j] : l0[j]), -7.0f), 7.0f);
                        r[n * 4 + j] = glu * __builtin_amdgcn_rcpf(1.0f + __builtin_amdgcn_exp2f(-1.702f * 1.4426950408889634f * glu)) * (lin + 1.0f);
                    }
                v4u w; w.x = pkh(r[0], r[1]); w.y = pkh(r[2], r[3]); w.z = pkh(r[4], r[5]); w.w = pkh(r[6], r[7]);
                *(v4u*)(act + row * 1024 + c0) = w;
            }
    }
};
template <int VAR> struct EpiSwigluP : pg::EpiBase {
    static constexpr bool PERM = true;
    h16* act; const float* b1;
    __device__ __forceinline__ void operator()(const pg::Acc& acc, const pg::Unit& u, int wr, int wc, int fr, int fq) const { EPI_OPAQUE();
        const int c0 = u.pn * 128 + wc * 32 + 8 * fq;
        const float* bg = b1 + (size_t)u.e * 2048 + c0; const float* bl = bg + 1024;
        const f32x4 g0 = *(const f32x4*)bg, g1 = *(const f32x4*)(bg + 4), l0 = *(const f32x4*)bl, l1 = *(const f32x4*)(bl + 4);
#pragma unroll
        for (int ai = 0; ai < 2; ++ai)
#pragma unroll
            for (int m = 0; m < 4; ++m) {
                const size_t row = (size_t)u.pm * 256 + ai * 128 + wr * 64 + m * 16 + fr;
                float r[8];
#pragma unroll
                for (int n = 0; n < 2; ++n)
#pragma unroll
                    for (int j = 0; j < 4; ++j) {
                        const float glu = fminf(acc[ai][0][m][n][j] + (n ? g1[j] : g0[j]), 7.0f);
                        const float lin = fminf(fmaxf(acc[ai][1][m][n][j] + (n ? l1[j] : l0[j]), -7.0f), 7.0f);
                        r[n * 4 + j] = (VAR == 2) ? glu + lin : glu * __builtin_amdgcn_rcpf(1.0f + __builtin_amdgcn_exp2f(-1.702f * 1.4426950408889634f * glu)) * (lin + 1.0f);
                    }
                v4u w; w.x = pkh(r[0], r[1]); w.y = pkh(r[2], r[3]); w.z = pkh(r[4], r[5]); w.w = pkh(r[6], r[7]);
                if (VAR == 1) { asm volatile("" :: "v"(w.x), "v"(w.y), "v"(w.z), "v"(w.w)); } else { *(v4u*)(act + row * 1024 + c0) = w; }
            }
    }
};
struct EpiMoeOut : pg::EpiBase {
    static constexpr bool PERM = true;
    h16* __restrict__ y; const float* __restrict__ b2; const float* __restrict__ gate;
    __device__ __forceinline__ void operator()(const pg::Acc& acc, const pg::Unit& u, int wr, int wc, int fr, int fq) const { EPI_OPAQUE();
        float gt[2][4]; f32x4 bv[2][2];
#pragma unroll
        for (int ai = 0; ai < 2; ++ai)
#pragma unroll
            for (int m = 0; m < 4; ++m) gt[ai][m] = gate[(size_t)u.pm * 256 + ai * 128 + wr * 64 + m * 16 + fr];
#pragma unroll
        for (int bj = 0; bj < 2; ++bj) { const float* bp = b2 + (size_t)u.e * 1024 + u.pn * 256 + bj * 128 + wc * 32 + 8 * fq; bv[bj][0] = *(const f32x4*)bp; bv[bj][1] = *(const f32x4*)(bp + 4); }
#pragma unroll
        for (int ai = 0; ai < 2; ++ai)
#pragma unroll
            for (int m = 0; m < 4; ++m) {
                const size_t row = (size_t)u.pm * 256 + ai * 128 + wr * 64 + m * 16 + fr;
#pragma unroll
                for (int bj = 0; bj < 2; ++bj) {
                    const int c0 = u.pn * 256 + bj * 128 + wc * 32 + 8 * fq;
                    const f32x4 v0 = (acc[ai][bj][m][0] + bv[bj][0]) * gt[ai][m], v1 = (acc[ai][bj][m][1] + bv[bj][1]) * gt[ai][m];
                    v4u w; w.x = pkh(v0[0], v0[1]); w.y = pkh(v0[2], v0[3]); w.z = pkh(v1[0], v1[1]); w.w = pkh(v1[2], v1[3]);
                    *(v4u*)(y + row * 1024 + c0) = w;
                }
            }
    }
};
template <bool Y8> __device__ __forceinline__ void ph_combine_ln(const Params& p, Frame& F, const h16* xprev, const float* gam, const float* bet, float* outf, h16* outh) {
    int lane = F.lane; asm volatile("" : "+v"(lane));
    const int gw = F.vcu * NWAVES + F.wave, NGW = F.G * NWAVES;
    constexpr int NT = Y8 ? 4 : 3;
    for (int tb = gw * NT; tb < T_; tb += NGW * NT) {
        v4u xw[NT][2], yw[Y8 ? 1 : NT][2][4]; v2u yq[Y8 ? NT : 1][2][4];
#pragma unroll
        for (int u = 0; u < NT; ++u) { const int t = tb + u < T_ ? tb + u : T_ - 1; int sl[4];
#pragma unroll
            for (int k = 0; k < 4; ++k) sl[k] = p.inv[t * 4 + k];
#pragma unroll
            for (int j = 0; j < 2; ++j) { const int c = 8 * lane + 512 * j; xw[u][j] = __builtin_nontemporal_load((const GAS v4u*)(xprev + (size_t)t * 1024 + c));
#pragma unroll
                for (int k = 0; k < 4; ++k) { if constexpr (Y8) yq[u][j][k] = __builtin_nontemporal_load((const GAS v2u*)((const unsigned char*)p.yy + (size_t)sl[k] * 1024 + c)); else yw[u][j][k] = __builtin_nontemporal_load((const GAS v4u*)(p.yy + (size_t)sl[k] * 1024 + c)); } } }
#pragma unroll
        for (int u = 0; u < NT; ++u) { const int t = tb + u; if (t >= T_) break;
            float v[16]; float s = 0.f;
#pragma unroll
            for (int j = 0; j < 2; ++j) { const v4u x4 = xw[u][j];
                float a[8] = {h2f(x4.x & 0xffff) * ALPHA_, h2f(x4.x >> 16) * ALPHA_, h2f(x4.y & 0xffff) * ALPHA_, h2f(x4.y >> 16) * ALPHA_, h2f(x4.z & 0xffff) * ALPHA_, h2f(x4.z >> 16) * ALPHA_, h2f(x4.w & 0xffff) * ALPHA_, h2f(x4.w >> 16) * ALPHA_};
#pragma unroll
                for (int k = 0; k < 4; ++k) {
                    if constexpr (Y8) { const v2u w8 = yq[u][j][k]; const f32x2v p0 = __builtin_amdgcn_cvt_pk_f32_fp8((int)w8.x, false), p1 = __builtin_amdgcn_cvt_pk_f32_fp8((int)w8.x, true), p2 = __builtin_amdgcn_cvt_pk_f32_fp8((int)w8.y, false), p3 = __builtin_amdgcn_cvt_pk_f32_fp8((int)w8.y, true);
                        a[0] += p0.x * 0.03125f; a[1] += p0.y * 0.03125f; a[2] += p1.x * 0.03125f; a[3] += p1.y * 0.03125f; a[4] += p2.x * 0.03125f; a[5] += p2.y * 0.03125f; a[6] += p3.x * 0.03125f; a[7] += p3.y * 0.03125f; }
                    else { const v4u w = yw[u][j][k];
                    a[0] += h2f(w.x & 0xffff); a[1] += h2f(w.x >> 16); a[2] += h2f(w.y & 0xffff); a[3] += h2f(w.y >> 16);
                    a[4] += h2f(w.z & 0xffff); a[5] += h2f(w.z >> 16); a[6] += h2f(w.w & 0xffff); a[7] += h2f(w.w >> 16); } }
#pragma unroll
                for (int q = 0; q < 8; ++q) { v[j * 8 + q] = a[q]; s += a[q]; } }
            const float mean = wave_sum(s) * (1.0f / 1024.0f); float qq = 0.f;
#pragma unroll
            for (int q = 0; q < 16; ++q) { v[q] -= mean; qq += v[q] * v[q]; }
            const float rstd = 1.0f / sqrtf(wave_sum(qq) * (1.0f / 1024.0f) + LN_EPS_);
#pragma unroll
            for (int j = 0; j < 2; ++j) {
                const int c = 8 * lane + 512 * j;
                const f32x4 ga = *(const GAS f32x4*)(gam + c), gb = *(const GAS f32x4*)(gam + c + 4), ba = *(const GAS f32x4*)(bet + c), bb = *(const GAS f32x4*)(bet + c + 4);
                f32x4 oa, ob;
                oa.x = v[j * 8 + 0] * rstd * ga.x + ba.x; oa.y = v[j * 8 + 1] * rstd * ga.y + ba.y; oa.z = v[j * 8 + 2] * rstd * ga.z + ba.z; oa.w = v[j * 8 + 3] * rstd * ga.w + ba.w;
                ob.x = v[j * 8 + 4] * rstd * gb.x + bb.x; ob.y = v[j * 8 + 5] * rstd * gb.y + bb.y; ob.z = v[j * 8 + 6] * rstd * gb.z + bb.z; ob.w = v[j * 8 + 7] * rstd * gb.w + bb.w;
                if (outf) { __builtin_nontemporal_store(oa, (GAS f32x4*)(outf + (size_t)t * 1024 + c)); __builtin_nontemporal_store(ob, (GAS f32x4*)(outf + (size_t)t * 1024 + c + 4)); }
                if (outh) { v4u w; w.x = pkh(oa.x, oa.y); w.y = pkh(oa.z, oa.w); w.z = pkh(ob.x, ob.y); w.w = pkh(ob.z, ob.w); *(GAS v4u*)(outh + (size_t)t * 1024 + c) = w; }
            } }
    }
}
struct CvJob { const float* src; h16* dst; int K, N, n_off, n_cnt, row_off, w1map, f8; };
__device__ __forceinline__ void cv_load(const CvJob& j, int item, int lane, float (&ld)[32]) {
    const int nblk = j.n_cnt / 32, kb = item / nblk, nb = item % nblk, k0 = 64 * kb, n0 = j.n_off + 32 * nb;
#pragma unroll
    for (int i = 0; i < 32; ++i) { const int kk = 2 * i + (lane >> 5); ld[i] = __builtin_nontemporal_load(j.src + (size_t)(k0 + kk) * j.N + n0 + (lane & 31)); }
}
__device__ __forceinline__ void cv_finish(const CvJob& j, LAS float* scr, int item, int lane, const float (&ld)[32]) {
    const int nblk = j.n_cnt / 32, kb = item / nblk, nb = item % nblk, k0 = 64 * kb, n0 = j.n_off + 32 * nb;
#pragma unroll
    for (int i = 0; i < 32; ++i) { const int kk = 2 * i + (lane >> 5); scr[kk * 33 + (lane & 31)] = ld[i]; }
    LDS_WAIT(); asm volatile("" ::: "memory");
    const int c = lane & 7;
#pragma unroll
    for (int q = 0; q < 4; ++q) { const int n = (lane >> 3) + 8 * q; const LAS float* s = scr + (8 * c) * 33 + n;
        const int nn = n0 + n - j.n_off; const int jj = nn & 1023;
        const long dr = j.w1map ? (long)(256 * (jj >> 7) + (nn >> 10) * 128 + (jj & 127)) : (long)(j.row_off + nn);
        if (j.f8) { int lo = 0, hi = 0; const float fs = (float)j.f8;
            lo = __builtin_amdgcn_cvt_pk_fp8_f32(s[0 * 33] * fs, s[1 * 33] * fs, lo, false); lo = __builtin_amdgcn_cvt_pk_fp8_f32(s[2 * 33] * fs, s[3 * 33] * fs, lo, true);
            hi = __builtin_amdgcn_cvt_pk_fp8_f32(s[4 * 33] * fs, s[5 * 33] * fs, hi, false); hi = __builtin_amdgcn_cvt_pk_fp8_f32(s[6 * 33] * fs, s[7 * 33] * fs, hi, true);
            v2u o8; o8.x = (unsigned)lo; o8.y = (unsigned)hi; *(GAS v2u*)((unsigned char*)j.dst + (size_t)dr * j.K + k0 + 8 * c) = o8; }
        else { v4u o; o.x = pkh(s[0 * 33], s[1 * 33]); o.y = pkh(s[2 * 33], s[3 * 33]); o.z = pkh(s[4 * 33], s[5 * 33]); o.w = pkh(s[6 * 33], s[7 * 33]);
            *(GAS v4u*)(j.dst + (size_t)dr * j.K + k0 + 8 * c) = o; } }
    LDS_WAIT(); asm volatile("" ::: "memory");
}
__device__ __forceinline__ int cv_decode(const Params& p, int it, CvJob& j) {
    constexpr int J1 = 1024, J2 = 1024, J3 = 1024, J4 = 1024, J5 = 640, J6 = 512, I1 = 1024, I2 = 512;
    int r = it;
    if (r < J1) { j = CvJob{p.w_ret_in, p.wri_t, 1024, 6144, 0, 2048, 0, 0, 0}; }
    else if ((r -= J1) < J2) { j = CvJob{p.w_ret_in, p.wri_t, 1024, 6144, 4096, 2048, 2048, 0, 0}; }
    else if ((r -= J2) < J3) { j = CvJob{p.w_ret_in, p.wfm_t, 1024, 6144, 2048, 2048, 0, 0, 0}; }
    else if ((r -= J3) < J4) { j = CvJob{p.w_ret_out, p.wro_t, 2048, 1024, 0, 1024, 0, 0, OUT_F8 ? 64 : 0}; }
    else if ((r -= J4) < J5) { j = CvJob{p.w_swa_in, p.wsi_t, 1024, 1280, 0, 1280, 0, 0, 0}; }
    else if ((r -= J5) < J6) { j = CvJob{p.w_swa_out, p.wso_t, 1024, 1024, 0, 1024, 0, 0, OUT_F8 ? 64 : 0}; }
    else if ((r -= J6) < 64 * I1) { const int e = r / I1; r %= I1; if (e < F8_FROM) j = CvJob{p.w_exp_in + (size_t)e * 1024 * 2048, p.w1_t + (size_t)e * 2048 * 1024, 1024, 2048, 0, 2048, 0, 1, 0};
        else j = CvJob{p.w_exp_in + (size_t)e * 1024 * 2048, (h16*)(p.w1q + (size_t)e * 2048 * 1024), 1024, 2048, 0, 2048, 0, 1, 32}; }
    else { r -= 64 * I1; const int e = r / I2; r %= I2; if (e < F8_FROM) j = CvJob{p.w_exp_out + (size_t)e * 1024 * 1024, p.w2_t + (size_t)e * 1024 * 1024, 1024, 1024, 0, 1024, 0, 0, 0};
        else j = CvJob{p.w_exp_out + (size_t)e * 1024 * 1024, (h16*)(p.w2q + (size_t)e * 1024 * 1024), 1024, 1024, 0, 1024, 0, 0, 32}; }
    return r;
}
__device__ __forceinline__ void ph_prologue(const Params& p, Frame& F) {
    LAS float* scr = (LAS float*)(F.lds + RING_OFF + F.wave * 16384);
    const int gw = F.vcu * NWAVES + F.wave, NGW = F.G * NWAVES;
    constexpr int NITEMS = 1024 + 1024 + 1024 + 1024 + 640 + 512 + 64 * (1024 + 512);
    int it = gw; CvJob j0, j1; int r0 = 0, r1 = 0; float ld0[32], ld1[32];
    if (it < NITEMS) { r0 = cv_decode(p, it, j0); cv_load(j0, r0, F.lane, ld0); }
    while (it < NITEMS) {
        const int nit = it + NGW; const bool hn = nit < NITEMS;
        if (hn) { r1 = cv_decode(p, nit, j1); cv_load(j1, r1, F.lane, ld1); }
        cv_finish(j0, scr, r0, F.lane, ld0);
        j0 = j1; r0 = r1;
#pragma unroll
        for (int i = 0; i < 32; ++i) ld0[i] = ld1[i];
        it = nit;
    }
    ph_cvt_rows(p.x, p.xh0, (size_t)T_ * D_, F);
}

struct DenseSched {
    const char* A; const char* B; size_t a_tile_bytes, b_tile_bytes; int nM, nN, nwg, G, c;
    __device__ __forceinline__ void init(const void* A_, int lda, const void* B_, int ldb, int M, int N, int G_, int c_, int rot = 0  , int es = 2  ) {
        A = (const char*)A_; B = (const char*)B_; a_tile_bytes = (size_t)256 * lda * es; b_tile_bytes = (size_t)256 * ldb * es; nM = M / 256; nN = N / 256; nwg = nM * nN; G = G_; c = (c_ + G_ - rot) % G_; }
    __device__ __forceinline__ bool next(int i, pg::Unit& u) const {
        const long L = (long)i * G + c; if (L >= nwg) return false;
        int wgid = (int)L; { const int q = nwg / 8, r = nwg % 8, xcd = wgid % 8, off = wgid / 8; wgid = (xcd < r ? xcd * (q + 1) : r * (q + 1) + (xcd - r) * q) + off; }
        const int nig = 8 * nN, gid = wgid / nig, fm = gid * 8, gsz = (nM - fm) < 8 ? (nM - fm) : 8;
        u.pm = fm + ((wgid % nig) % gsz); u.pn = (wgid % nig) / gsz; u.e = 0; u.x = 0;
        u.a = A + (size_t)u.pm * a_tile_bytes; u.b = B + (size_t)u.pn * b_tile_bytes; return true;
    }
    __device__ __forceinline__ unsigned arow(const pg::Unit&, int) const { return 0u; }
};
struct EpiResid : pg::EpiBase {
    static constexpr bool PERM = true;
    const h16* __restrict__ xprevh; const float* __restrict__ bias; h16* __restrict__ yh; float sc;
    __device__ __forceinline__ void operator()(const pg::Acc& acc, const pg::Unit& u, int wr, int wc, int fr, int fq) const { EPI_OPAQUE();
        f32x4 bv[2][2];
#pragma unroll
        for (int bj = 0; bj < 2; ++bj) { const int col = u.pn * 256 + bj * 128 + wc * 32 + 8 * fq;
            bv[bj][0] = bias ? *(const f32x4*)(bias + col) : (f32x4){0.f, 0.f, 0.f, 0.f}; bv[bj][1] = bias ? *(const f32x4*)(bias + col + 4) : (f32x4){0.f, 0.f, 0.f, 0.f}; }
#pragma unroll
        for (int ai = 0; ai < 2; ++ai) {
            v4u xw[4][2];
#pragma unroll
            for (int m = 0; m < 4; ++m)
#pragma unroll
                for (int bj = 0; bj < 2; ++bj) { const size_t row = (size_t)u.pm * 256 + ai * 128 + wr * 64 + m * 16 + fr; xw[m][bj] = __builtin_nontemporal_load((const v4u*)(xprevh + row * 1024 + u.pn * 256 + bj * 128 + wc * 32 + 8 * fq)); }
#pragma unroll
            for (int m = 0; m < 4; ++m)
#pragma unroll
                for (int bj = 0; bj < 2; ++bj) { const size_t row = (size_t)u.pm * 256 + ai * 128 + wr * 64 + m * 16 + fr; const int col = u.pn * 256 + bj * 128 + wc * 32 + 8 * fq; const v4u x4 = xw[m][bj];
                    const f32x4 a = (f32x4){h2f(x4.x & 0xffff), h2f(x4.x >> 16), h2f(x4.y & 0xffff), h2f(x4.y >> 16)} * ALPHA_ + acc[ai][bj][m][0] * sc + bv[bj][0];
                    const f32x4 b = (f32x4){h2f(x4.z & 0xffff), h2f(x4.z >> 16), h2f(x4.w & 0xffff), h2f(x4.w >> 16)} * ALPHA_ + acc[ai][bj][m][1] * sc + bv[bj][1];
                    v4u w; w.x = pkh(a[0], a[1]); w.y = pkh(a[2], a[3]); w.z = pkh(b[0], b[1]); w.w = pkh(b[2], b[3]);
                    *(v4u*)(yh + row * 1024 + col) = w; } }
    }
};
struct EpiF32 : pg::EpiBase {
    const float* bias; float* c; int ldc;
    __device__ __forceinline__ void operator()(const pg::Acc& acc, const pg::Unit& u, int wr, int wc, int fr, int fq) const { EPI_OPAQUE();
#pragma unroll
        for (int ai = 0; ai < 2; ++ai)
#pragma unroll
            for (int m = 0; m < 4; ++m) { const size_t row = (size_t)u.pm * 256 + ai * 128 + wr * 64 + m * 16 + fr;
#pragma unroll
                for (int bj = 0; bj < 2; ++bj)
#pragma unroll
                    for (int n = 0; n < 2; ++n) { const int col = u.pn * 256 + bj * 128 + wc * 32 + n * 16 + 4 * fq;
                        f32x4 o = acc[ai][bj][m][n]; if (bias) o += *(const f32x4*)(bias + col);
                        *(f32x4*)(c + row * ldc + col) = o; } }
    }
};

constexpr int XROW16 = 1032;
typedef _Float16 f16x8r __attribute__((ext_vector_type(8)));
__device__ __forceinline__ void ph_ln_router(const Params& p, Frame& F, const float* gam, const float* bet, const float* wr, const float* br, unsigned char* xq, const int pmode = 0  ) {
    LAS unsigned short* X = (LAS unsigned short*)(F.lds);
    LAS float* PART = (LAS float*)(X + 32 * XROW16);
    LAS int* se = (LAS int*)(PART + 8 * 32 * 32);
    LAS float* LG = (LAS float*)(se + 512);
    LAS float* TV = LG + 1024;
    LAS int* cnt = (LAS int*)(TV + 128);
    int tid_o = F.tid; asm volatile("" : "+v"(tid_o));
    const int lane = tid_o & 63, w = F.wave, l15 = lane & 15, kg = lane >> 4;
    f16x8r wh[2][4], wl[2][4];
#pragma unroll
    for (int nt = 0; nt < 2; ++nt)
#pragma unroll
        for (int s = 0; s < 4; ++s) {
#pragma unroll
            for (int j = 0; j < 8; ++j) { const float v = wr[(size_t)(128 * w + 32 * s + 8 * kg + j) * 32 + 16 * nt + l15]; const _Float16 h = (_Float16)v; wh[nt][s][j] = h; wl[nt][s][j] = (_Float16)(v - (float)h); } }
    const float bias_e = br[tid_o & 31];
    for (int cc = blockIdx.x; cc < T_ / 128; cc += F.G) {
        v4u pre[4][2];
#pragma unroll
        for (int r = 0; r < 4; ++r)
#pragma unroll
            for (int j = 0; j < 2; ++j) pre[r][j] = __builtin_nontemporal_load((const GAS v4u*)(p.yh + (size_t)(cc * 128 + 4 * w + r) * 1024 + 8 * lane + 512 * j));
        for (int blk = 0; blk < 4; ++blk) {
            const int t0 = cc * 128 + blk * 32;
            v4u cur[4][2];
#pragma unroll
            for (int r = 0; r < 4; ++r)
#pragma unroll
                for (int j = 0; j < 2; ++j) { cur[r][j] = pre[r][j]; if (blk < 3) pre[r][j] = __builtin_nontemporal_load((const GAS v4u*)(p.yh + (size_t)(t0 + 32 + 4 * w + r) * 1024 + 8 * lane + 512 * j)); }
#pragma unroll
            for (int r = 0; r < 4; ++r) {
                const int tl = 4 * w + r; const size_t t = (size_t)(t0 + tl);
                f32x4 v[4]; float s = 0.f;
#pragma unroll
                for (int j = 0; j < 2; ++j) { const v4u pw = cur[r][j]; v[2 * j] = (f32x4){h2f(pw.x & 0xffff), h2f(pw.x >> 16), h2f(pw.y & 0xffff), h2f(pw.y >> 16)}; v[2 * j + 1] = (f32x4){h2f(pw.z & 0xffff), h2f(pw.z >> 16), h2f(pw.w & 0xffff), h2f(pw.w >> 16)}; }
#pragma unroll
                for (int j = 0; j < 4; ++j) s += (v[j].x + v[j].y) + (v[j].z + v[j].w);
                const float mean = wave_sum(s) * (1.0f / 1024.0f); float q = 0.f;
#pragma unroll
                for (int j = 0; j < 4; ++j) { v[j] = v[j] - mean; q += (v[j].x * v[j].x + v[j].y * v[j].y) + (v[j].z * v[j].z + v[j].w * v[j].w); }
                const float rstd = 1.0f / sqrtf(wave_sum(q) * (1.0f / 1024.0f) + LN_EPS_);
#pragma unroll
                for (int j = 0; j < 2; ++j) { const int c = 8 * lane + 512 * j;
                    const f32x4 o0 = v[2 * j] * rstd * *(const GAS f32x4*)(gam + c) + *(const GAS f32x4*)(bet + c), o1 = v[2 * j + 1] * rstd * *(const GAS f32x4*)(gam + c + 4) + *(const GAS f32x4*)(bet + c + 4);
                    v4u hw; hw.x = pkh(o0.x, o0.y); hw.y = pkh(o0.z, o0.w); hw.z = pkh(o1.x, o1.y); hw.w = pkh(o1.z, o1.w);
                    *(GAS v4u*)(p.x1h + t * 1024 + c) = hw;
                    if (xq) { int qa = 0, qb = 0; qa = __builtin_amdgcn_cvt_pk_fp8_f32(o0.x, o0.y, qa, false); qa = __builtin_amdgcn_cvt_pk_fp8_f32(o0.z, o0.w, qa, true); qb = __builtin_amdgcn_cvt_pk_fp8_f32(o1.x, o1.y, qb, false); qb = __builtin_amdgcn_cvt_pk_fp8_f32(o1.z, o1.w, qb, true);
                        v2u q8; q8.x = (unsigned)qa; q8.y = (unsigned)qb; *(GAS v2u*)(xq + t * 1024 + c) = q8; }
                    *(LAS v4u*)(X + tl * XROW16 + c) = hw; }
            }
            if (pmode == 1) continue;
            __syncthreads();
            {
                f32x4 acc[2][2];
#pragma unroll
                for (int mt = 0; mt < 2; ++mt)
#pragma unroll
                    for (int nt = 0; nt < 2; ++nt) acc[mt][nt] = (f32x4){0.f, 0.f, 0.f, 0.f};
#pragma unroll
                for (int s = 0; s < 4; ++s)
#pragma unroll
                    for (int mt = 0; mt < 2; ++mt) { const f16x8r a = *(const LAS f16x8r*)(X + (16 * mt + l15) * XROW16 + 128 * w + 32 * s + 8 * kg);
#pragma unroll
                        for (int nt = 0; nt < 2; ++nt) { acc[mt][nt] = __builtin_amdgcn_mfma_f32_16x16x32_f16(a, wh[nt][s], acc[mt][nt], 0, 0, 0); acc[mt][nt] = __builtin_amdgcn_mfma_f32_16x16x32_f16(a, wl[nt][s], acc[mt][nt], 0, 0, 0); } }
#pragma unroll
                for (int mt = 0; mt < 2; ++mt)
#pragma unroll
                    for (int nt = 0; nt < 2; ++nt)
#pragma unroll
                        for (int r = 0; r < 4; ++r) PART[(w * 32 + 16 * mt + 4 * kg + r) * 32 + 16 * nt + l15] = acc[mt][nt][r];
            }
            __syncthreads();
#pragma unroll
            for (int ps = 0; ps < 2; ++ps) {
                const int tok = (tid_o >> 5) + 16 * ps, e = tid_o & 31; float val = bias_e;
#pragma unroll
                for (int q = 0; q < 8; ++q) val += PART[(q * 32 + tok) * 32 + e];
                LG[tok * 32 + e] = val;
                LDS_WAIT(); asm volatile("" ::: "memory");
                int rank = 0;
#pragma unroll
                for (int q4 = 0; q4 < 8; ++q4) { const f32x4 o = *(const LAS f32x4*)(LG + tok * 32 + 4 * q4);
                    rank += ((o.x > val) || (o.x == val && 4 * q4 < e)) ? 1 : 0; rank += ((o.y > val) || (o.y == val && 4 * q4 + 1 < e)) ? 1 : 0;
                    rank += ((o.z > val) || (o.z == val && 4 * q4 + 2 < e)) ? 1 : 0; rank += ((o.w > val) || (o.w == val && 4 * q4 + 3 < e)) ? 1 : 0; }
                const int t = t0 + tok;
                if (rank < 4) { TV[tok * 4 + rank] = val; p.top_e[t * 4 + rank] = e; se[(blk * 32 + tok) * 4 + rank] = e; }
                LDS_WAIT(); asm volatile("" ::: "memory");
                if (e < 4) { const f32x4 tv = *(const LAS f32x4*)(TV + tok * 4);
                    const float e1 = __expf(tv.y - tv.x), e2 = __expf(tv.z - tv.x), e3 = __expf(tv.w - tv.x); const float inv = 1.0f / (1.0f + e1 + e2 + e3);
                    p.top_g[t * 4 + e] = (e == 0 ? 1.0f : (e == 1 ? e1 : (e == 2 ? e2 : e3))) * inv; }
            }
        }
        __syncthreads();
        if (pmode == 0) {
            const int j = tid_o; const int e = se[j]; int r = 0;
            if (j < 32) cnt[j] = 0;
            __syncthreads();
#pragma unroll 8
            for (int q4 = 0; q4 < 128; ++q4) { const v4u sv = *(const LAS v4u*)(se + 4 * q4);
                r += ((int)sv.x == e && 4 * q4 < j) ? 1 : 0; r += ((int)sv.y == e && 4 * q4 + 1 < j) ? 1 : 0; r += ((int)sv.z == e && 4 * q4 + 2 < j) ? 1 : 0; r += ((int)sv.w == e && 4 * q4 + 3 < j) ? 1 : 0; }
            p.rankp[cc * 512 + j] = r;
            atomicAdd((int*)(cnt + e), 1);
            __syncthreads();
            if (j < 32) p.wg_cnt[cc * 32 + j] = cnt[j];
        }
        __syncthreads();
    }
}

__device__ __forceinline__ float lg2gamma(int h) { return h == 0 ? -0.04580368961312479f : (h == 1 ? -0.02272007650008353f : (h == 2 ? -0.011315313227834146f : -0.005646563141142063f)); }
struct EpiInTok : pg::EpiBase {
    static constexpr bool PERM = true;
    h16 *q, *k, *sg;
    __device__ __forceinline__ void operator()(const pg::Acc& acc, const pg::Unit& u, int wr, int wc, int fr, int fq) const { EPI_OPAQUE();
        const int pn = u.pn; h16* dst; int ld, cb; int mode;
        if (pn < 4) { dst = q; ld = 1024; cb = pn * 256; mode = 0; } else if (pn < 8) { dst = k; ld = 1024; cb = (pn - 4) * 256; mode = 1; } else { dst = sg; ld = 2048; cb = (pn - 8) * 256; mode = 2; }
#pragma unroll
        for (int ai = 0; ai < 2; ++ai)
#pragma unroll
            for (int m = 0; m < 4; ++m) { const size_t row = (size_t)u.pm * 256 + ai * 128 + wr * 64 + m * 16 + fr;
#pragma unroll
                for (int bj = 0; bj < 2; ++bj) { const int c0 = cb + bj * 128 + wc * 32 + 8 * fq; float r[8];
#pragma unroll
                    for (int n = 0; n < 2; ++n)
#pragma unroll
                        for (int j = 0; j < 4; ++j) { float v = acc[ai][bj][m][n][j];
                            if (mode == 1) v *= 0.0625f;
                            if (mode == 2) v = v * __builtin_amdgcn_rcpf(1.0f + __builtin_amdgcn_exp2f(-1.4426950408889634f * v));
                            r[n * 4 + j] = v; }
                    v4u w; w.x = pkh(r[0], r[1]); w.y = pkh(r[2], r[3]); w.z = pkh(r[4], r[5]); w.w = pkh(r[6], r[7]);
                    *(v4u*)(dst + row * ld + c0) = w; } }
    }
};
struct EpiInFeat : pg::EpiBase {
    static constexpr bool PERM = true;
    h16* __restrict__ vt;
    __device__ __forceinline__ void operator()(const pg::Acc& acc, const pg::Unit& u, int wr, int wc, int fr, int fq) const { EPI_OPAQUE();
        h16* dst = vt + ((size_t)u.pn * 2048 + (size_t)u.pm * 256) * 256;
#pragma unroll
        for (int bj = 0; bj < 2; ++bj) { const int c0 = bj * 128 + wc * 32 + 8 * fq;
#pragma unroll
            for (int ai = 0; ai < 2; ++ai)
#pragma unroll
                for (int m = 0; m < 4; ++m) { const size_t row = (size_t)(ai * 128 + wr * 64 + m * 16 + fr);
                    const f32x4 a = acc[ai][bj][m][0], b = acc[ai][bj][m][1];
                    v4u w; w.x = pkh(a[0], a[1]); w.y = pkh(a[2], a[3]); w.z = pkh(b[0], b[1]); w.w = pkh(b[2], b[3]);
                    *(v4u*)(dst + row * 256 + c0) = w; } }
    }
};
constexpr int KT_PITCH = 520;
__device__ __forceinline__ void ph_ktranspose(const Params& p, Frame& F) {
    LAS unsigned char* img = F.lds;
    for (int item = F.vcu; item < 512; item += F.G) {
        const int chunk = item >> 2, h = item & 3;
        __syncthreads();
        v4u ld[16];
#pragma unroll
        for (int i = 0; i < 16; ++i) { const int pc = F.tid + 512 * i, row = pc >> 5, c16 = pc & 31; ld[i] = *(const GAS v4u*)(p.k + ((size_t)(chunk * 256 + row)) * 1024 + h * 256 + c16 * 8); }
#pragma unroll
        for (int i = 0; i < 16; ++i) { const int pc = F.tid + 512 * i, row = pc >> 5, c16 = pc & 31; v2u lo; lo.x = ld[i].x; lo.y = ld[i].y; v2u hi; hi.x = ld[i].z; hi.y = ld[i].w;
            *(LAS v2u*)(img + row * KT_PITCH + c16 * 16) = lo; *(LAS v2u*)(img + row * KT_PITCH + c16 * 16 + 8) = hi; }
        __syncthreads();
        const int tg = F.tid & 31; const float lg = lg2gamma(h); float sc[8];
#pragma unroll
        for (int j = 0; j < 8; ++j) sc[j] = __builtin_amdgcn_exp2f((float)(255 - (8 * tg + j)) * lg);
        h16* dst = p.kdt + ((size_t)chunk * 1024 + h * 256) * 256;
#pragma unroll 4
        for (int r = 0; r < 16; ++r) { const int dk = (F.tid >> 5) + 16 * r; float v[8];
#pragma unroll
            for (int j = 0; j < 8; ++j) v[j] = h2f(*(const LAS unsigned short*)(img + (8 * tg + j) * KT_PITCH + dk * 2)) * sc[j];
            v4u w; w.x = pkh(v[0], v[1]); w.y = pkh(v[2], v[3]); w.z = pkh(v[4], v[5]); w.w = pkh(v[6], v[7]);
            *(GAS v4u*)(dst + (size_t)dk * 256 + 8 * tg) = w; }
    }
    __syncthreads();
}
struct RaSched {
    const h16 *q, *k; int G, c;
    __device__ __forceinline__ bool next(int i, pg::Unit& u) const {
        const int L = i * G + c; if (L >= 512) return false;
        const int bh = L >> 5, cch = L & 31, b = bh >> 2, h = bh & 3; const size_t off = ((size_t)(b * 8192 + cch * 256) * 1024 + h * 256) * 2;
        u.a = (const char*)q + off; u.b = (const char*)k + off; u.pm = L; u.pn = 0; u.e = L; u.x = h; return true; }
    __device__ __forceinline__ unsigned arow(const pg::Unit&, int) const { return 0u; }
};
struct EpiPP : pg::EpiBase {
    static constexpr bool PERM = true;
    h16* pp;
    __device__ __forceinline__ void operator()(const pg::Acc& acc, const pg::Unit& u, int wr, int wc, int fr, int fq) const { EPI_OPAQUE();
        const float lg = lg2gamma(u.x); h16* dst = pp + (size_t)u.e * 65536;
#pragma unroll
        for (int bj = 0; bj < 2; ++bj) { const int c0 = bj * 128 + wc * 32 + 8 * fq; float sc[8];
#pragma unroll
            for (int j = 0; j < 8; ++j) sc[j] = __builtin_amdgcn_exp2f(-(float)(c0 + j + 1) * lg);
#pragma unroll
            for (int ai = 0; ai < 2; ++ai)
#pragma unroll
                for (int m = 0; m < 4; ++m) { const int i = ai * 128 + wr * 64 + m * 16 + fr; float r[8];
#pragma unroll
                    for (int n = 0; n < 2; ++n)
#pragma unroll
                        for (int j = 0; j < 4; ++j) r[n * 4 + j] = (c0 + n * 4 + j <= i) ? acc[ai][bj][m][n][j] * sc[n * 4 + j] : 0.f;
                    v4u w; w.x = pkh(r[0], r[1]); w.y = pkh(r[2], r[3]); w.z = pkh(r[4], r[5]); w.w = pkh(r[6], r[7]);
                    *(v4u*)(dst + (size_t)i * 256 + c0) = w; } }
    }
};
struct R1Sched {
    const h16 *vt, *kdt; int nsub, G, c;
    __device__ __forceinline__ bool next(int i, pg::Unit& u) const {
        const int item = (i / nsub) * G + c, j = i % nsub; if (item >= 256) return false;
        if (nsub == 4 && ((item >> 1) & 7) == 7) return false;
        const int pm = item & 1, seg = (item >> 1) & 7, bh = item >> 4, b = bh >> 2, h = bh & 3; const size_t chunk = (size_t)b * 32 + seg * 4 + j;
        u.a = (const char*)vt + ((chunk * 2048 + h * 512 + pm * 256) * 256) * 2; u.b = (const char*)kdt + ((chunk * 1024 + h * 256) * 256) * 2;
        u.pm = pm; u.pn = j; u.e = item; u.x = h; return true; }
    __device__ __forceinline__ unsigned arow(const pg::Unit&, int) const { return 0u; }
};
__device__ __forceinline__ void acc_scale(pg::Acc& acc, float s) {
#pragma unroll
    for (int a = 0; a < 2; ++a)
#pragma unroll
        for (int b = 0; b < 2; ++b)
#pragma unroll
            for (int m = 0; m < 4; ++m)
#pragma unroll
                for (int n = 0; n < 2; ++n) acc[a][b][m][n] = acc[a][b][m][n] * s;
}
struct EpiSegTot : pg::EpiBase {
    static constexpr bool PERM = true;
    float* L;
    __device__ __forceinline__ void operator()(pg::Acc& acc, const pg::Unit& u, int wr, int wc, int fr, int fq) const { EPI_OPAQUE();
        if (u.pn < 3) { acc_scale(acc, __builtin_amdgcn_exp2f(256.0f * lg2gamma(u.x))); return; }
        float* dst = L + ((size_t)(u.e >> 1) * 512 + u.pm * 256) * 256;
#pragma unroll
        for (int ai = 0; ai < 2; ++ai)
#pragma unroll
            for (int m = 0; m < 4; ++m) { const int r = ai * 128 + wr * 64 + m * 16 + fr;
#pragma unroll
                for (int bj = 0; bj < 2; ++bj) { const int c0 = bj * 128 + wc * 32 + 8 * fq;
                    *(f32x4*)(dst + (size_t)r * 256 + c0) = acc[ai][bj][m][0]; *(f32x4*)(dst + (size_t)r * 256 + c0 + 4) = acc[ai][bj][m][1]; } }
    }
    __device__ __forceinline__ void reinit(pg::Acc& acc, const pg::Unit& cur, const pg::Unit& nxt, int, int, int, int) const { if (nxt.e != cur.e) pg::acc_zero(acc); }
};
struct EpiSnap : pg::EpiBase {
    static constexpr bool PERM = true;
    const float* L; h16* st;
    __device__ __forceinline__ void snap(const pg::Acc& acc, const pg::Unit& u, int j, int wr, int wc, int fr, int fq) const { EPI_OPAQUE();
        const int seg = (u.e >> 1) & 7, bh = u.e >> 4; h16* dst = st + ((size_t)(bh * 32 + seg * 4 + j) * 512 + u.pm * 256) * 256;
#pragma unroll
        for (int ai = 0; ai < 2; ++ai)
#pragma unroll
            for (int m = 0; m < 4; ++m) { const int r = ai * 128 + wr * 64 + m * 16 + fr;
#pragma unroll
                for (int bj = 0; bj < 2; ++bj) { const int c0 = bj * 128 + wc * 32 + 8 * fq; const f32x4 a = acc[ai][bj][m][0], b = acc[ai][bj][m][1];
                    v4u w; w.x = pkh(a[0], a[1]); w.y = pkh(a[2], a[3]); w.z = pkh(b[0], b[1]); w.w = pkh(b[2], b[3]);
                    *(v4u*)(dst + (size_t)r * 256 + c0) = w; } }
    }
    __device__ __forceinline__ void load(pg::Acc& acc, const pg::Unit& u, int wr, int wc, int fr, int fq) const { EPI_OPAQUE();
        const float* src = L + ((size_t)(u.e >> 1) * 512 + u.pm * 256) * 256;
#pragma unroll
        for (int ai = 0; ai < 2; ++ai)
#pragma unroll
            for (int m = 0; m < 4; ++m) { const int r = ai * 128 + wr * 64 + m * 16 + fr;
#pragma unroll
                for (int bj = 0; bj < 2; ++bj) { const int c0 = bj * 128 + wc * 32 + 8 * fq;
                    acc[ai][bj][m][0] = *(const f32x4*)(src + (size_t)r * 256 + c0); acc[ai][bj][m][1] = *(const f32x4*)(src + (size_t)r * 256 + c0 + 4); } }
    }
    __device__ __forceinline__ void init(pg::Acc& acc, const pg::Unit& u, int wr, int wc, int fr, int fq) const { EPI_OPAQUE(); load(acc, u, wr, wc, fr, fq); snap(acc, u, 0, wr, wc, fr, fq); acc_scale(acc, __builtin_amdgcn_exp2f(256.0f * lg2gamma(u.x))); }
    __device__ __forceinline__ void operator()(pg::Acc& acc, const pg::Unit& u, int wr, int wc, int fr, int fq) const { EPI_OPAQUE(); snap(acc, u, u.pn + 1, wr, wc, fr, fq); }
    __device__ __forceinline__ void reinit(pg::Acc& acc, const pg::Unit& cur, const pg::Unit& nxt, int wr, int wc, int fr, int fq) const { EPI_OPAQUE();
        if (nxt.e != cur.e) { load(acc, nxt, wr, wc, fr, fq); snap(acc, nxt, 0, wr, wc, fr, fq); }
        acc_scale(acc, __builtin_amdgcn_exp2f(256.0f * lg2gamma(nxt.x))); }
};
__device__ __forceinline__ void ph_carry(float* L, Frame& F) {
    const size_t n = (size_t)16 * 131072;
    int tid_o = F.tid; asm volatile("" : "+v"(tid_o));
    for (size_t i = ((size_t)blockIdx.x * 512 + tid_o) * 4; i < n; i += (size_t)F.G * 512 * 4) {
        const int bh = (int)(i >> 17); const size_t el = i & 131071; const float g = __builtin_amdgcn_exp2f(1024.0f * lg2gamma(bh & 3));
        f32x4 s = {0.f, 0.f, 0.f, 0.f}, l[8];
#pragma unroll
        for (int sgm = 0; sgm < 8; ++sgm) l[sgm] = *(const GAS f32x4*)(L + ((size_t)(bh * 8 + sgm) << 17) + el);
#pragma unroll
        for (int sgm = 0; sgm < 8; ++sgm) { *(GAS f32x4*)(L + ((size_t)(bh * 8 + sgm) << 17) + el) = s; s = s * g + l[sgm]; }
    }
}
struct R2Sched {
    const h16 *pp, *vt, *q, *st; int G, c;
    __device__ __forceinline__ bool next(int i, pg::Unit& u) const {
        const int ch = (i >> 2) * G + c, pn = (i >> 1) & 1, x = i & 1; if (ch >= 512) return false;
        const int cch = ch & 31, bh = ch >> 5, b = bh >> 2, h = bh & 3; const size_t tok0 = (size_t)b * 8192 + cch * 256;
        if (x == 0) { u.a = (const char*)pp + (size_t)ch * 65536 * 2; u.b = (const char*)vt + (((tok0 >> 8) * 2048 + h * 512 + pn * 256) * 256) * 2; }
        else { u.a = (const char*)q + (tok0 * 1024 + h * 256) * 2; u.b = (const char*)st + ((size_t)ch * 512 + pn * 256) * 256 * 2; }
        u.pm = ch; u.pn = pn; u.e = (int)tok0; u.x = x; return true; }
    __device__ __forceinline__ unsigned arow(const pg::Unit&, int) const { return 0u; }
};
struct EpiRetOut : pg::EpiBase {
    static constexpr bool PERM = true;
    h16* __restrict__ o; const h16* __restrict__ sg; h16* __restrict__ og;
    __device__ __forceinline__ void operator()(const pg::Acc& acc, const pg::Unit& u, int wr, int wc, int fr, int fq) const { EPI_OPAQUE();
        if (u.x == 0) return;
        const int h = (u.pm >> 5) & 3; const float lg = lg2gamma(h);
#pragma unroll
        for (int ai = 0; ai < 2; ++ai)
#pragma unroll
            for (int m = 0; m < 4; ++m) { const int i = ai * 128 + wr * 64 + m * 16 + fr; const float qd = __builtin_amdgcn_exp2f((float)(i + 1) * lg);
                h16* dst = o + (size_t)(u.e + i) * 2048 + h * 512 + u.pn * 256;
#pragma unroll
                for (int bj = 0; bj < 2; ++bj) { const int c0 = bj * 128 + wc * 32 + 8 * fq; const f32x4 a = acc[ai][bj][m][0] * qd, b = acc[ai][bj][m][1] * qd;
                    v4u w; w.x = pkh(a[0], a[1]); w.y = pkh(a[2], a[3]); w.z = pkh(b[0], b[1]); w.w = pkh(b[2], b[3]);
                    *(v4u*)(dst + c0) = w; } }
        if (u.pn == 0) return;
        asm volatile("s_waitcnt vmcnt(0)" ::: "memory");
        __builtin_amdgcn_s_barrier(); asm volatile("" ::: "memory");
        const int wid = __builtin_amdgcn_readfirstlane((int)threadIdx.x >> 6), lane = (fq << 4) | fr;
#pragma unroll 1
        for (int r0 = 0; r0 < 32; r0 += 8) {
            v4u ow[8], gv[8];
#pragma unroll
            for (int q = 0; q < 8; ++q) { const size_t off = (size_t)(u.e + 32 * wid + r0 + q) * 2048 + h * 512 + 8 * lane; ow[q] = __builtin_nontemporal_load((const GAS v4u*)(o + off)); gv[q] = __builtin_nontemporal_load((const GAS v4u*)(sg + off)); }
#pragma unroll
            for (int q = 0; q < 8; ++q) { const size_t off = (size_t)(u.e + 32 * wid + r0 + q) * 2048 + h * 512 + 8 * lane; const v4u o4 = ow[q], g4 = gv[q];
                float v[8] = {h2f(o4.x & 0xffff), h2f(o4.x >> 16), h2f(o4.y & 0xffff), h2f(o4.y >> 16), h2f(o4.z & 0xffff), h2f(o4.z >> 16), h2f(o4.w & 0xffff), h2f(o4.w >> 16)};
                const float g[8] = {h2f(g4.x & 0xffff), h2f(g4.x >> 16), h2f(g4.y & 0xffff), h2f(g4.y >> 16), h2f(g4.z & 0xffff), h2f(g4.z >> 16), h2f(g4.w & 0xffff), h2f(g4.w >> 16)};
                float s = 0.f;
#pragma unroll
                for (int j = 0; j < 8; ++j) s += v[j];
                const float mean = wave_sum(s) * (1.0f / 512.0f); float qq = 0.f;
#pragma unroll
                for (int j = 0; j < 8; ++j) { v[j] -= mean; qq += v[j] * v[j]; }
                const float rstd = 1.0f / sqrtf(wave_sum(qq) * (1.0f / 512.0f) + 1e-6f);
                if (OUT_F8) { int lo = 0, hi = 0;
                    lo = __builtin_amdgcn_cvt_pk_fp8_f32(g[0] * v[0] * rstd, g[1] * v[1] * rstd, lo, false); lo = __builtin_amdgcn_cvt_pk_fp8_f32(g[2] * v[2] * rstd, g[3] * v[3] * rstd, lo, true);
                    hi = __builtin_amdgcn_cvt_pk_fp8_f32(g[4] * v[4] * rstd, g[5] * v[5] * rstd, hi, false); hi = __builtin_amdgcn_cvt_pk_fp8_f32(g[6] * v[6] * rstd, g[7] * v[7] * rstd, hi, true);
                    v2u w8; w8.x = (unsigned)lo; w8.y = (unsigned)hi; *(GAS v2u*)((unsigned char*)og + off) = w8; }
                else { v4u w; w.x = pkh(g[0] * v[0] * rstd, g[1] * v[1] * rstd); w.y = pkh(g[2] * v[2] * rstd, g[3] * v[3] * rstd); w.z = pkh(g[4] * v[4] * rstd, g[5] * v[5] * rstd); w.w = pkh(g[6] * v[6] * rstd, g[7] * v[7] * rstd);
                    *(GAS v4u*)(og + off) = w; } }
        }
    }
    __device__ __forceinline__ void reinit(pg::Acc& acc, const pg::Unit&, const pg::Unit& nxt, int, int, int, int) const { if (nxt.x == 0) pg::acc_zero(acc); }
};
__device__ __forceinline__ void ph_gn_gate(const Params& p, Frame& F) {
    const int gw = F.vcu * NWAVES + F.wave, NGW = F.G * NWAVES, lane = F.lane;
    for (int it0 = gw * 4; it0 < T_ * 4; it0 += NGW * 4) {
        v4u ow[4], gv[4];
#pragma unroll
        for (int u = 0; u < 4; ++u) { const size_t off = (size_t)(it0 + u) * 512 + 8 * lane; ow[u] = *(const GAS v4u*)(p.o + off); gv[u] = *(const GAS v4u*)(p.sg + off); }
#pragma unroll
        for (int u = 0; u < 4; ++u) { const size_t off = (size_t)(it0 + u) * 512 + 8 * lane; const v4u o4 = ow[u], g4 = gv[u];
            float v[8] = {h2f(o4.x & 0xffff), h2f(o4.x >> 16), h2f(o4.y & 0xffff), h2f(o4.y >> 16), h2f(o4.z & 0xffff), h2f(o4.z >> 16), h2f(o4.w & 0xffff), h2f(o4.w >> 16)};
            const float g[8] = {h2f(g4.x & 0xffff), h2f(g4.x >> 16), h2f(g4.y & 0xffff), h2f(g4.y >> 16), h2f(g4.z & 0xffff), h2f(g4.z >> 16), h2f(g4.w & 0xffff), h2f(g4.w >> 16)};
            float s = 0.f;
#pragma unroll
            for (int j = 0; j < 8; ++j) s += v[j];
            const float mean = wave_sum(s) * (1.0f / 512.0f); float q = 0.f;
#pragma unroll
            for (int j = 0; j < 8; ++j) { v[j] -= mean; q += v[j] * v[j]; }
            const float rstd = 1.0f / sqrtf(wave_sum(q) * (1.0f / 512.0f) + 1e-6f);
            v4u w; w.x = pkh(g[0] * v[0] * rstd, g[1] * v[1] * rstd); w.y = pkh(g[2] * v[2] * rstd, g[3] * v[3] * rstd); w.z = pkh(g[4] * v[4] * rstd, g[5] * v[5] * rstd); w.w = pkh(g[6] * v[6] * rstd, g[7] * v[7] * rstd);
            *(GAS v4u*)(p.og + off) = w; }
    }
}
constexpr float SWA_C2 = 0.125f * 1.4426950408889634f;
struct EpiSwaTok : pg::EpiBase {
    static constexpr bool PERM = true;
    h16 *sq, *skv; const float* bias;
    __device__ __forceinline__ void operator()(const pg::Acc& acc, const pg::Unit& u, int wr, int wc, int fr, int fq) const { EPI_OPAQUE();
        const bool isq = u.pn < 4; h16* dst = isq ? sq : skv; const int ld = isq ? 1024 : 256, cb = isq ? u.pn * 256 : 0; const float sc = isq ? SWA_C2 : 1.0f;
#pragma unroll
        for (int bj = 0; bj < 2; ++bj) { const int ct = bj * 128 + wc * 32 + 8 * fq; const float* bp = bias + u.pn * 256 + ct;
            const f32x4 b0 = *(const f32x4*)bp, b1 = *(const f32x4*)(bp + 4);
#pragma unroll
            for (int ai = 0; ai < 2; ++ai)
#pragma unroll
                for (int m = 0; m < 4; ++m) { const size_t row = (size_t)u.pm * 256 + ai * 128 + wr * 64 + m * 16 + fr;
                    const f32x4 a = (acc[ai][bj][m][0] + b0) * sc, b = (acc[ai][bj][m][1] + b1) * sc;
                    v4u w; w.x = pkh(a[0], a[1]); w.y = pkh(a[2], a[3]); w.z = pkh(b[0], b[1]); w.w = pkh(b[2], b[3]);
                    *(v4u*)(dst + row * ld + cb + ct) = w; } }
    }
};
struct EpiSwaFeat : pg::EpiBase {
    static constexpr bool PERM = true;
    h16* __restrict__ kvt; const float* __restrict__ bias;
    __device__ __forceinline__ void operator()(const pg::Acc& acc, const pg::Unit& u, int wr, int wc, int fr, int fq) const { EPI_OPAQUE();
        float bv[2][4];
#pragma unroll
        for (int ai = 0; ai < 2; ++ai)
#pragma unroll
            for (int m = 0; m < 4; ++m) bv[ai][m] = bias[1024 + ai * 128 + wr * 64 + m * 16 + fr];
#pragma unroll
        for (int ai = 0; ai < 2; ++ai)
#pragma unroll
            for (int m = 0; m < 4; ++m) { const int r = ai * 128 + wr * 64 + m * 16 + fr;
#pragma unroll
                for (int bj = 0; bj < 2; ++bj) { const int ct = bj * 128 + wc * 32 + 8 * fq; const f32x4 a = acc[ai][bj][m][0] + bv[ai][m], b = acc[ai][bj][m][1] + bv[ai][m];
                    v4u w; w.x = pkh(a[0], a[1]); w.y = pkh(a[2], a[3]); w.z = pkh(b[0], b[1]); w.w = pkh(b[2], b[3]);
                    *(v4u*)(kvt + (size_t)r * T_ + (size_t)u.pn * 256 + ct) = w; } }
    }
};
typedef float f32x16 __attribute__((ext_vector_type(16)));
typedef _Float16 f16x8v __attribute__((ext_vector_type(8)));
typedef _Float16 f16x4v __attribute__((ext_vector_type(4)));
constexpr int KP = 144, VP = 520;
__device__ __forceinline__ void ph_swa_attn(const Params& p, Frame& F) {
    LAS unsigned char* Ks = F.lds; LAS unsigned char* Vs = F.lds + 256 * KP;
    const int lane = F.lane, w = F.wave, l31 = lane & 31, hh = lane >> 5;
    for (int unit = F.vcu; unit < 512; unit += F.G) {
        const int g = unit & 1, n = (unit >> 1) & 63, b = unit >> 7; const size_t tok0 = (size_t)b * SEQ_ + (size_t)n * 128;
        __syncthreads();
        for (int c = F.tid; c < 256 * 8; c += 512) { const int key = c >> 3, ch = c & 7; v4u val = {0u, 0u, 0u, 0u};
            if (n > 0 || key >= 128) val = *(const GAS v4u*)(p.skv + (tok0 - 128 + key) * 256 + g * 64 + ch * 8);
            *(LAS v4u*)(Ks + key * KP + ch * 16) = val; }
        for (int c = F.tid; c < 64 * 32; c += 512) { const int d = c >> 5, ch = c & 31; v4u val = {0u, 0u, 0u, 0u};
            if (n > 0 || ch >= 16) val = *(const GAS v4u*)(p.kvt + (size_t)(128 + g * 64 + d) * T_ + tok0 - 128 + ch * 8);
            v2u lo2; lo2.x = val.x; lo2.y = val.y; v2u hi2; hi2.x = val.z; hi2.y = val.w;
            *(LAS v2u*)(Vs + d * VP + ch * 16) = lo2; *(LAS v2u*)(Vs + d * VP + ch * 16 + 8) = hi2; }
        __syncthreads();
        const int hq = g * 8 + w; const float slope = __builtin_amdgcn_exp2f(-0.5f * (float)(hq + 1)) * 1.4426950408889634f, sink = p.sinks[hq] * 1.4426950408889634f;
#pragma nounroll
        for (int qi = 0; qi < 4; ++qi) {
            f16x8v qf[4];
            const h16* qrow = p.sq + (tok0 + qi * 32 + l31) * 1024 + hq * 64 + 8 * hh;
#pragma unroll
            for (int s = 0; s < 4; ++s) qf[s] = __builtin_nontemporal_load((const GAS f16x8v*)(qrow + 16 * s));
            f32x16 sc[5];
#pragma unroll
            for (int t = 0; t < 5; ++t) {
                sc[t] = (f32x16){0.f, 0.f, 0.f, 0.f, 0.f, 0.f, 0.f, 0.f, 0.f, 0.f, 0.f, 0.f, 0.f, 0.f, 0.f, 0.f};
                const LAS unsigned char* kp = Ks + ((qi + t) * 32 + l31) * KP + 16 * hh;
#pragma unroll
                for (int s = 0; s < 4; ++s) { const f16x8v kf = *(const LAS f16x8v*)(kp + 32 * s); sc[t] = __builtin_amdgcn_mfma_f32_32x32x16_f16(kf, qf[s], sc[t], 0, 0, 0); }
            }
            float mx = sink;
            float basef = (float)(l31 + 128 - 4 * hh); asm volatile("" : "+v"(basef));
#pragma unroll
            for (int t = 0; t < 5; ++t) { const bool tile_ok = (n > 0) || (qi + t >= 4);
#pragma unroll
                for (int r = 0; r < 16; ++r) { const float distf = basef - (float)(32 * t + (r & 3) + 8 * (r >> 2));
                    bool ok = tile_ok; if (t == 0) ok = ok && (distf < 128.0f); if (t == 4) ok = ok && (distf >= 0.0f);
                    const float v = ok ? sc[t][r] - slope * distf : -INFINITY; sc[t][r] = v; mx = fmaxf(mx, v); } }
            mx = fmaxf(mx, __shfl_xor(mx, 32));
            float ls = 0.f; f16x8v pf[5][2];
#pragma unroll
            for (int t = 0; t < 5; ++t)
#pragma unroll
                for (int s2 = 0; s2 < 2; ++s2) { float e[8];
#pragma unroll
                    for (int j = 0; j < 8; ++j) { e[j] = __builtin_amdgcn_exp2f(sc[t][8 * s2 + j] - mx); ls += e[j]; }
                    v4u pw; pw.x = pkh(e[0], e[1]); pw.y = pkh(e[2], e[3]); pw.z = pkh(e[4], e[5]); pw.w = pkh(e[6], e[7]); pf[t][s2] = __builtin_bit_cast(f16x8v, pw); }
            ls += __shfl_xor(ls, 32); ls += __builtin_amdgcn_exp2f(sink - mx);
            const float rl = 1.0f / ls;
            f32x16 oa[2];
#pragma unroll
            for (int dt = 0; dt < 2; ++dt) { oa[dt] = (f32x16){0.f, 0.f, 0.f, 0.f, 0.f, 0.f, 0.f, 0.f, 0.f, 0.f, 0.f, 0.f, 0.f, 0.f, 0.f, 0.f};
                const LAS unsigned char* vp = Vs + (32 * dt + l31) * VP + (qi * 32 + 4 * hh) * 2;
#pragma unroll
                for (int t = 0; t < 5; ++t)
#pragma unroll
                    for (int s2 = 0; s2 < 2; ++s2) { const f16x4v v0 = *(const LAS f16x4v*)(vp + (t * 32 + s2 * 16) * 2), v1 = *(const LAS f16x4v*)(vp + (t * 32 + s2 * 16 + 8) * 2);
                        const f16x8v vf = __builtin_shufflevector(v0, v1, 0, 1, 2, 3, 4, 5, 6, 7);
                        oa[dt] = __builtin_amdgcn_mfma_f32_32x32x16_f16(vf, pf[t][s2], oa[dt], 0, 0, 0); } }
            h16* orow = p.so + (tok0 + qi * 32 + l31) * 1024 + hq * 64 + 4 * hh;
#pragma unroll
            for (int dt = 0; dt < 2; ++dt)
#pragma unroll
                for (int gq = 0; gq < 4; ++gq) {
                    if (OUT_F8) { const float r8 = rl * 8.0f; int o8 = 0; o8 = __builtin_amdgcn_cvt_pk_fp8_f32(oa[dt][4 * gq] * r8, oa[dt][4 * gq + 1] * r8, o8, false); o8 = __builtin_amdgcn_cvt_pk_fp8_f32(oa[dt][4 * gq + 2] * r8, oa[dt][4 * gq + 3] * r8, o8, true);
                        *(GAS unsigned*)((unsigned char*)p.so + (tok0 + qi * 32 + l31) * 1024 + hq * 64 + 4 * hh + 32 * dt + 8 * gq) = (unsigned)o8; }
                    else { v2u ow; ow.x = pkh(oa[dt][4 * gq] * rl, oa[dt][4 * gq + 1] * rl); ow.y = pkh(oa[dt][4 * gq + 2] * rl, oa[dt][4 * gq + 3] * rl);
                        *(GAS v2u*)(orow + 32 * dt + 8 * gq) = ow; } }
        }
    }
}

struct EpiNull : pg::EpiBase {
    static constexpr bool PERM = true;
    __device__ __forceinline__ void operator()(const pg::Acc& acc, const pg::Unit& u, int wr, int wc, int fr, int fq) const { asm volatile("" :: "v"(acc[0][0][0][0][0]), "v"(acc[1][1][3][1][3])); }
};

struct EpiSwigluQ : pg::EpiBase {
    static constexpr bool PERM = true;
    unsigned char* __restrict__ actq; const float* __restrict__ b1;
    typedef _Float16 h2 __attribute__((ext_vector_type(2)));
    typedef short s2 __attribute__((ext_vector_type(2)));
    __device__ __forceinline__ h2 act2(f32x2v g32, f32x2v l32) const {
        h2 g = __builtin_convertvector(g32, h2), l = __builtin_convertvector(l32, h2);
        g = __builtin_elementwise_min(g, (h2){7.0f16, 7.0f16});
        l = __builtin_elementwise_max(__builtin_elementwise_min(l, (h2){7.0f16, 7.0f16}), (h2){-7.0f16, -7.0f16});
        const h2 e = __builtin_elementwise_exp2(g * (h2){-2.4554f16, -2.4554f16});
        const h2 d = e + (h2){1.0f16, 1.0f16};
        const h2 r = {(_Float16)__builtin_amdgcn_rcph(d.x), (_Float16)__builtin_amdgcn_rcph(d.y)};
        return (g * r) * (l * (h2){4.0f16, 4.0f16} + (h2){4.0f16, 4.0f16});
    }
    __device__ __forceinline__ void operator()(const pg::Acc& acc, const pg::Unit& u, int wr, int wc, int fr, int fq) const { EPI_OPAQUE();
        const int c0 = u.pn * 128 + wc * 32 + 8 * fq;
        const float* bg = b1 + (size_t)u.e * 2048 + c0; const float* bl = bg + 1024;
        const f32x4 g0 = *(const f32x4*)bg, g1 = *(const f32x4*)(bg + 4), l0 = *(const f32x4*)bl, l1 = *(const f32x4*)(bl + 4);
#pragma unroll
        for (int ai = 0; ai < 2; ++ai)
#pragma unroll
            for (int m = 0; m < 4; ++m) {
                const size_t row = (size_t)u.pm * 256 + ai * 128 + wr * 64 + m * 16 + fr;
                const f32x4 ga = acc[ai][0][m][0] * 0.03125f + g0, gb = acc[ai][0][m][1] * 0.03125f + g1, la = acc[ai][1][m][0] * 0.03125f + l0, lb = acc[ai][1][m][1] * 0.03125f + l1;
                s2 lo = {0, 0}, hi = {0, 0};
                lo = __builtin_amdgcn_cvt_scalef32_pk_fp8_f16(lo, act2((f32x2v){ga.x, ga.y}, (f32x2v){la.x, la.y}), 1.0f, false);
                lo = __builtin_amdgcn_cvt_scalef32_pk_fp8_f16(lo, act2((f32x2v){ga.z, ga.w}, (f32x2v){la.z, la.w}), 1.0f, true);
                hi = __builtin_amdgcn_cvt_scalef32_pk_fp8_f16(hi, act2((f32x2v){gb.x, gb.y}, (f32x2v){lb.x, lb.y}), 1.0f, false);
                hi = __builtin_amdgcn_cvt_scalef32_pk_fp8_f16(hi, act2((f32x2v){gb.z, gb.w}, (f32x2v){lb.z, lb.w}), 1.0f, true);
                v2u w; w.x = __builtin_bit_cast(unsigned, lo); w.y = __builtin_bit_cast(unsigned, hi);
                *(v2u*)(actq + row * 1024 + c0) = w;
            }
    }
};
template <int VAR> struct EpiSwigluQP : pg::EpiBase {
    static constexpr bool PERM = true;
    unsigned char* __restrict__ actq; const float* __restrict__ b1;
    typedef _Float16 h2 __attribute__((ext_vector_type(2)));
    typedef short s2 __attribute__((ext_vector_type(2)));
    __device__ __forceinline__ h2 act2(f32x2v g32, f32x2v l32) const {
        h2 g = __builtin_convertvector(g32, h2), l = __builtin_convertvector(l32, h2);
        g = __builtin_elementwise_min(g, (h2){7.0f16, 7.0f16});
        l = __builtin_elementwise_max(__builtin_elementwise_min(l, (h2){7.0f16, 7.0f16}), (h2){-7.0f16, -7.0f16});
        const h2 e = __builtin_elementwise_exp2(g * (h2){-2.4554f16, -2.4554f16});
        const h2 d = e + (h2){1.0f16, 1.0f16};
        const h2 r = {(_Float16)__builtin_amdgcn_rcph(d.x), (_Float16)__builtin_amdgcn_rcph(d.y)};
        return (g * r) * (l * (h2){4.0f16, 4.0f16} + (h2){4.0f16, 4.0f16});
    }
    __device__ __forceinline__ void operator()(const pg::Acc& acc, const pg::Unit& u, int wr, int wc, int fr, int fq) const { EPI_OPAQUE();
        const int c0 = u.pn * 128 + wc * 32 + 8 * fq;
        const float* bg = b1 + (size_t)u.e * 2048 + c0; const float* bl = bg + 1024;
        const f32x4 g0 = *(const f32x4*)bg, g1 = *(const f32x4*)(bg + 4), l0 = *(const f32x4*)bl, l1 = *(const f32x4*)(bl + 4);
        if (VAR == 1) { asm volatile("" :: "v"(g0), "v"(g1), "v"(l0), "v"(l1));
#pragma unroll
            for (int ai = 0; ai < 2; ++ai)
#pragma unroll
                for (int bj = 0; bj < 2; ++bj)
#pragma unroll
                    for (int m = 0; m < 4; ++m) asm volatile("" :: "v"(acc[ai][bj][m][0]), "v"(acc[ai][bj][m][1]));
            return; }
#pragma unroll
        for (int ai = 0; ai < 2; ++ai)
#pragma unroll
            for (int m = 0; m < 4; ++m) {
                const size_t row = (size_t)u.pm * 256 + ai * 128 + wr * 64 + m * 16 + fr;
                const f32x4 ga = acc[ai][0][m][0] * 0.03125f + g0, gb = acc[ai][0][m][1] * 0.03125f + g1, la = acc[ai][1][m][0] * 0.03125f + l0, lb = acc[ai][1][m][1] * 0.03125f + l1;
                s2 lo = {0, 0}, hi = {0, 0};
                lo = __builtin_amdgcn_cvt_scalef32_pk_fp8_f16(lo, act2((f32x2v){ga.x, ga.y}, (f32x2v){la.x, la.y}), 1.0f, false);
                lo = __builtin_amdgcn_cvt_scalef32_pk_fp8_f16(lo, act2((f32x2v){ga.z, ga.w}, (f32x2v){la.z, la.w}), 1.0f, true);
                hi = __builtin_amdgcn_cvt_scalef32_pk_fp8_f16(hi, act2((f32x2v){gb.x, gb.y}, (f32x2v){lb.x, lb.y}), 1.0f, false);
                hi = __builtin_amdgcn_cvt_scalef32_pk_fp8_f16(hi, act2((f32x2v){gb.z, gb.w}, (f32x2v){lb.z, lb.w}), 1.0f, true);
                v2u w; w.x = __builtin_bit_cast(unsigned, lo); w.y = __builtin_bit_cast(unsigned, hi);
                if (VAR == 2) asm volatile("" :: "v"(w.x), "v"(w.y)); else *(v2u*)(actq + row * 1024 + c0) = w;
            }
    }
};
template <bool Y8> struct EpiMoeOutQ : pg::EpiBase {
    static constexpr bool PERM = true;
    unsigned char* __restrict__ y8; const float* __restrict__ b2; const float* __restrict__ gate;
    __device__ __forceinline__ void operator()(const pg::Acc& acc, const pg::Unit& u, int wr, int wc, int fr, int fq) const { EPI_OPAQUE();
        float gt[2][4]; f32x4 bv[2][2];
#pragma unroll
        for (int ai = 0; ai < 2; ++ai)
#pragma unroll
            for (int m = 0; m < 4; ++m) gt[ai][m] = gate[(size_t)u.pm * 256 + ai * 128 + wr * 64 + m * 16 + fr];
#pragma unroll
        for (int bj = 0; bj < 2; ++bj) { const float* bp = b2 + (size_t)u.e * 1024 + u.pn * 256 + bj * 128 + wc * 32 + 8 * fq; bv[bj][0] = *(const f32x4*)bp; bv[bj][1] = *(const f32x4*)(bp + 4); }
#pragma unroll
        for (int ai = 0; ai < 2; ++ai)
#pragma unroll
            for (int m = 0; m < 4; ++m) {
                const size_t row = (size_t)u.pm * 256 + ai * 128 + wr * 64 + m * 16 + fr;
#pragma unroll
                for (int bj = 0; bj < 2; ++bj) {
                    const int c0 = u.pn * 256 + bj * 128 + wc * 32 + 8 * fq;
                    const float gs = gt[ai][m] * (Y8 ? 32.0f : 1.0f);
                    const f32x4 v0 = (acc[ai][bj][m][0] * 0.0078125f + bv[bj][0]) * gs, v1 = (acc[ai][bj][m][1] * 0.0078125f + bv[bj][1]) * gs;
                    if (Y8) { int lo = 0, hi = 0;
                        lo = __builtin_amdgcn_cvt_pk_fp8_f32(v0[0], v0[1], lo, false); lo = __builtin_amdgcn_cvt_pk_fp8_f32(v0[2], v0[3], lo, true);
                        hi = __builtin_amdgcn_cvt_pk_fp8_f32(v1[0], v1[1], hi, false); hi = __builtin_amdgcn_cvt_pk_fp8_f32(v1[2], v1[3], hi, true);
                        v2u w; w.x = (unsigned)lo; w.y = (unsigned)hi; *(v2u*)(y8 + row * 1024 + c0) = w; }
                    else { v4u w; w.x = pkh(v0[0], v0[1]); w.y = pkh(v0[2], v0[3]); w.z = pkh(v1[0], v1[1]); w.w = pkh(v1[2], v1[3]); *(v4u*)((h16*)y8 + row * 1024 + c0) = w; }
                }
            }
    }
};

struct MoeSchedHot : MoeSched {
    __device__ __forceinline__ bool next(int i, pg::Unit& u) const { const bool ok = MoeSched::next(i, u); if (ok) { u.a = abase; u.b = wbase; } return ok; }
    __device__ __forceinline__ unsigned arow(const pg::Unit&, int r) const { return (unsigned)r; }
};

struct EpiKeep : pg::EpiBase {
    static constexpr bool PERM = true;
    __device__ __forceinline__ void operator()(const pg::Acc& acc, const pg::Unit& u, int wr, int wc, int fr, int fq) const {
#pragma unroll
        for (int ai = 0; ai < 2; ++ai)
#pragma unroll
            for (int bj = 0; bj < 2; ++bj)
#pragma unroll
                for (int m = 0; m < 4; ++m) asm volatile("" :: "v"(acc[ai][bj][m][0]), "v"(acc[ai][bj][m][1]));
    }
};
#ifndef PROBE_DBL
#define PROBE_DBL 0
#endif
#ifndef SKEW_STEP
#define SKEW_STEP 0
#endif
#define SKEW(F) (((F).vcu & 3) * SKEW_STEP)
#define DBL(bit, body) do { body; if ((PROBE_DBL >> (bit)) & 1) { GRID_BAR(); body; } } while (0)
template <int layer>
__device__ __forceinline__ void layer_tail(const Params& p, Frame& F, const XcdBarrier& bar) {
#define GRID_BAR() xcd_barrier(bar)
    {
#if OUT_F8
        if (layer == 0) { DenseSched S; S.init(p.og, 2048, p.wro_t, 2048, T_, 1024, F.G, (int)blockIdx.x, 0, 1); EpiResid E; E.yh = p.yh; E.xprevh = p.xh0; E.bias = nullptr; E.sc = 1.0f / 64.0f;
            pg::gemm_phase<EpiResid, DenseSched, 0, true, 1>(F.lds + RING_OFF, 2048, 2048, 16, S, E); }
        else { DenseSched S; S.init(p.so, 1024, p.wso_t, 1024, T_, 1024, F.G, (int)blockIdx.x, 0, 1); EpiResid E; E.yh = p.yh; E.xprevh = p.x2h; E.bias = p.b_swa_out; E.sc = 1.0f / 512.0f;
            pg::gemm_phase<EpiResid, DenseSched, 0, true, 1>(F.lds + RING_OFF, 1024, 1024, 8, S, E); }
#else
        if (layer == 0) { DenseSched S; S.init(p.og, 2048, p.wro_t, 2048, T_, 1024, F.G, (int)blockIdx.x); EpiResid E; E.yh = p.yh; E.xprevh = p.xh0; E.bias = nullptr; E.sc = 1.0f;
            pg::gemm_phase<EpiResid, DenseSched, 0, true>(F.lds + RING_OFF, 2048, 2048, 32, S, E); }
        else { DenseSched S; S.init(p.so, 1024, p.wso_t, 1024, T_, 1024, F.G, (int)blockIdx.x); EpiResid E; E.yh = p.yh; E.xprevh = p.x2h; E.bias = p.b_swa_out; E.sc = 1.0f;
            pg::gemm_phase<EpiResid, DenseSched, 0, true>(F.lds + RING_OFF, 1024, 1024, 16, S, E); }
#endif
    }
    GRID_BAR();
    DBL(1, ph_ln_router(p, F, p.ln_mix_g + layer * 1024, p.ln_mix_b + layer * 1024, p.w_router + layer * 1024 * 32, p.b_router + layer * 32, (layer == 1 || MOE_F8_L0) ? p.x1q : (unsigned char*)nullptr));
#if (PROBE_DBL >> 19) & 1
    GRID_BAR();
    ph_ln_router(p, F, p.ln_mix_g + layer * 1024, p.ln_mix_b + layer * 1024, p.w_router + layer * 1024 * 32, p.b_router + layer * 32, layer == 1 ? p.x1q : (unsigned char*)nullptr, (PROBE_DBL >> 19) & 1);
#endif
    GRID_BAR();
    DBL(5, ph_assign(p, F, layer));
    GRID_BAR();
    {
        const int ntiles = (int)__hip_atomic_load(F.ctl + CW_NTILES + 64 * layer, RLX_AGENT);
        moe_tables(F, p.tile_e, p.slot_tok, ntiles, 3, true);
        if (layer == 0 && !MOE_F8_L0) {
            MoeSched S{(const char*)p.x1h, (const char*)p.w1_t, (LAS const int*)(F.lds + TAB_OFF), (LAS const int*)(F.lds + TAB_OFF) + 32, ntiles, 3, F.G, F.vcu, 0, (size_t)2048 * 1024 * 2, (size_t)256 * 1024 * 2};
            EpiSwiglu E; E.act = p.act; E.b1 = p.b_exp_in;
            pg::gemm_phase<EpiSwiglu, MoeSched, 1, true>(F.lds + RING_OFF, 1024, 1024, 16, S, E);
        } else {
            MoeSched S{(const char*)p.x1q, (const char*)(p.w1q + (size_t)layer * 32 * 2048 * 1024), (LAS const int*)(F.lds + TAB_OFF), (LAS const int*)(F.lds + TAB_OFF) + 32, ntiles, 3, F.G, F.vcu, 0, (size_t)2048 * 1024, (size_t)256 * 1024};
            EpiSwigluQ E; E.actq = p.actq; E.b1 = p.b_exp_in + (size_t)layer * 32 * 2048;
            pg::gemm_phase<EpiSwigluQ, MoeSched, 1, true, 1>(F.lds + RING_OFF, 1024, 1024, 8, S, E, 0, 0, SKEW(F));
        }
    }
    GRID_BAR();
#if (PROBE_DBL >> 21) & 3
    GRID_BAR();
    if (layer == 0) {
        const int ntiles = (int)__hip_atomic_load(F.ctl + CW_NTILES + 64 * layer, RLX_AGENT);
        moe_tables(F, p.tile_e, p.slot_tok, ntiles, 3, true);
        EpiSwigluP<1> E; E.act = p.yy; E.b1 = p.b_exp_in;
        if ((PROBE_DBL >> 22) & 1) { MoeSchedHot S{{((PROBE_DBL >> 23) & 1) ? (const char*)p.ctl : (const char*)p.x1h, ((PROBE_DBL >> 23) & 1) ? (const char*)p.ctl + 524288 : (const char*)p.w1_t, (LAS const int*)(F.lds + TAB_OFF), (LAS const int*)(F.lds + TAB_OFF) + 32, ntiles, 3, F.G, F.vcu, 0, (size_t)2048 * 1024 * 2, (size_t)256 * 1024 * 2}};
            pg::gemm_phase<EpiSwigluP<1>, MoeSchedHot, 1, true, 2, ((PROBE_DBL >> 24) & 1) != 0>(F.lds + RING_OFF, 1024, 1024, 16, S, E); }
        else { MoeSched S{(const char*)p.x1h, (const char*)p.w1_t, (LAS const int*)(F.lds + TAB_OFF), (LAS const int*)(F.lds + TAB_OFF) + 32, ntiles, 3, F.G, F.vcu, 0, (size_t)2048 * 1024 * 2, (size_t)256 * 1024 * 2};
            pg::gemm_phase<EpiSwigluP<1>, MoeSched, 1, true, 2, ((PROBE_DBL >> 24) & 1) != 0>(F.lds + RING_OFF, 1024, 1024, 16, S, E); }
    }
#endif
#if (PROBE_DBL >> 29) & 3
    GRID_BAR();
    {
        const int ntiles = (int)__hip_atomic_load(F.ctl + CW_NTILES + 64 * layer, RLX_AGENT);
        moe_tables(F, p.tile_e, p.slot_tok, ntiles, 3, true);
        MoeSched S{(const char*)p.x1q, (const char*)(p.w1q + (size_t)layer * 32 * 2048 * 1024), (LAS const int*)(F.lds + TAB_OFF), (LAS const int*)(F.lds + TAB_OFF) + 32, ntiles, 3, F.G, F.vcu, 0, (size_t)2048 * 1024, (size_t)256 * 1024};
        EpiSwigluQP<((PROBE_DBL >> 29) & 3)> E; E.actq = p.actq; E.b1 = p.b_exp_in + (size_t)layer * 32 * 2048;
        pg::gemm_phase<EpiSwigluQP<((PROBE_DBL >> 29) & 3)>, MoeSched, 1, true, 1>(F.lds + RING_OFF, 1024, 1024, 8, S, E);
    }
#endif
#if (PROBE_DBL >> 25) & 1
    GRID_BAR();
    {
        const int ntiles = (int)__hip_atomic_load(F.ctl + CW_NTILES + 64 * layer, RLX_AGENT);
        moe_tables(F, p.tile_e, p.slot_tok, ntiles, 3, true);
        MoeSched S{(const char*)p.x1q, (const char*)(p.w1q + (size_t)layer * 32 * 2048 * 1024), (LAS const int*)(F.lds + TAB_OFF), (LAS const int*)(F.lds + TAB_OFF) + 32, ntiles, 3, F.G, F.vcu, 0, (size_t)2048 * 1024, (size_t)256 * 1024};
        EpiKeep E;
        pg::gemm_phase<EpiKeep, MoeSched, 1, true, 1>(F.lds + RING_OFF, 1024, 1024, 8, S, E);
    }
#endif
#if (PROBE_DBL >> 26) & 1
    GRID_BAR();
    {
        const int ntiles = (int)__hip_atomic_load(F.ctl + CW_NTILES + 64 * layer, RLX_AGENT);
        moe_tables(F, p.tile_e, p.slot_tok, ntiles, 3, true);
        MoeSched S{(const char*)p.x1q, (const char*)(p.w1q + (size_t)layer * 32 * 2048 * 1024), (LAS const int*)(F.lds + TAB_OFF), (LAS const int*)(F.lds + TAB_OFF) + 32, ntiles, 3, F.G, F.vcu, 0, (size_t)2048 * 1024, (size_t)256 * 1024};
        EpiSwigluQ E; E.actq = p.actq; E.b1 = p.b_exp_in + (size_t)layer * 32 * 2048;
        pg::gemm_phase<EpiSwigluQ, MoeSched, 1, true, 1>(F.lds + RING_OFF, 1024, 1024, 8, S, E);
    }
#endif
    {
        const int ntiles = (int)__hip_atomic_load(F.ctl + CW_NTILES + 64 * layer, RLX_AGENT);
        moe_tables(F, p.tile_e, p.slot_tok, ntiles, 2, false);
        if (layer == 0 && !MOE_F8_L0) {
            MoeSched S{(const char*)p.act, (const char*)p.w2_t, (LAS const int*)(F.lds + TAB_OFF), (LAS const int*)(F.lds + TAB_OFF) + 32, ntiles, 2, F.G, F.vcu, (size_t)256 * 1024 * 2, (size_t)1024 * 1024 * 2, (size_t)256 * 1024 * 2};
            EpiMoeOut E; E.y = p.yy; E.b2 = p.b_exp_out; E.gate = p.slot_gate;
            pg::gemm_phase<EpiMoeOut, MoeSched, 0, true>(F.lds + RING_OFF, 1024, 1024, 16, S, E);
        } else {
            MoeSched S{(const char*)p.actq, (const char*)(p.w2q + (size_t)layer * 32 * 1024 * 1024), (LAS const int*)(F.lds + TAB_OFF), (LAS const int*)(F.lds + TAB_OFF) + 32, ntiles, 2, F.G, F.vcu, (size_t)256 * 1024, (size_t)1024 * 1024, (size_t)256 * 1024};
            EpiMoeOutQ<layer == 1> E; E.y8 = (unsigned char*)p.yy; E.b2 = p.b_exp_out + (size_t)layer * 32 * 1024; E.gate = p.slot_gate;
            pg::gemm_phase<EpiMoeOutQ<layer == 1>, MoeSched, 0, true, 1>(F.lds + RING_OFF, 1024, 1024, 8, S, E, 0, 0, SKEW(F));
        }
    }
#if (PROBE_DBL >> 27) & 1
    GRID_BAR();
    {
        const int ntiles = (int)__hip_atomic_load(F.ctl + CW_NTILES + 64 * layer, RLX_AGENT);
        moe_tables(F, p.tile_e, p.slot_tok, ntiles, 2, false);
        MoeSched S{(const char*)p.actq, (const char*)(p.w2q + (size_t)layer * 32 * 1024 * 1024), (LAS const int*)(F.lds + TAB_OFF), (LAS const int*)(F.lds + TAB_OFF) + 32, ntiles, 2, F.G, F.vcu, (size_t)256 * 1024, (size_t)1024 * 1024, (size_t)256 * 1024};
        EpiMoeOutQ<layer == 1> E; E.y8 = (unsigned char*)p.yy; E.b2 = p.b_exp_out + (size_t)layer * 32 * 1024; E.gate = p.slot_gate;
        pg::gemm_phase<EpiMoeOutQ<layer == 1>, MoeSched, 0, true, 1>(F.lds + RING_OFF, 1024, 1024, 8, S, E);
    }
#endif
#if (PROBE_DBL >> 28) & 1
    GRID_BAR();
    {
        const int ntiles = (int)__hip_atomic_load(F.ctl + CW_NTILES + 64 * layer, RLX_AGENT);
        moe_tables(F, p.tile_e, p.slot_tok, ntiles, 2, false);
        MoeSched S{(const char*)p.actq, (const char*)(p.w2q + (size_t)layer * 32 * 1024 * 1024), (LAS const int*)(F.lds + TAB_OFF), (LAS const int*)(F.lds + TAB_OFF) + 32, ntiles, 2, F.G, F.vcu, (size_t)256 * 1024, (size_t)1024 * 1024, (size_t)256 * 1024};
        EpiKeep E;
        pg::gemm_phase<EpiKeep, MoeSched, 0, true, 1>(F.lds + RING_OFF, 1024, 1024, 8, S, E);
    }
#endif
    GRID_BAR();
    DBL(2, ph_combine_ln<layer == 1>(p, F, p.x1h, p.ln_ffn_g + layer * 1024, p.ln_ffn_b + layer * 1024, layer == 0 ? (float*)nullptr : p.out, layer == 0 ? p.x2h : (h16*)nullptr));
#undef GRID_BAR
}
__global__ void __launch_bounds__(NWAVES * 64, 2) mk_fwd(Params p) {
    extern __shared__ __attribute__((aligned(16))) unsigned char lds[];
    Frame F;
    F.lds = (LAS unsigned char*)lds;
    F.MISC = (volatile LAS unsigned*)(F.lds + MISC_OFF);
    F.tid = threadIdx.x; F.lane = F.tid & 63; F.wave = __builtin_amdgcn_readfirstlane(F.tid >> 6);
    F.G = gridDim.x; { const int bx = blockIdx.x; F.vcu = (F.G % 8 == 0) ? (bx % 8) * (F.G / 8) + bx / 8 : bx; }
    F.ctl = (gu32*)p.ctl;
    for (int u = F.tid; u < (LDS_BYTES - LDSCTL_OFF) / 4; u += NWAVES * 64) ((LAS unsigned*)(F.lds + LDSCTL_OFF))[u] = 0u;
    __syncthreads();
    XcdBarrier bar = xcd_barrier_post((unsigned*)p.ctl + CW_BAR, F.MISC + 8);
#define GRID_BAR() xcd_barrier(bar)
    DBL(0, ph_prologue(p, F));
    GRID_BAR();
    {
        { DenseSched S; S.init(p.xh0, 1024, p.wri_t, 1024, T_, 4096, F.G, (int)blockIdx.x); EpiInTok E; E.q = p.q; E.k = p.k; E.sg = p.sg;
          pg::gemm_phase<EpiInTok, DenseSched, 0, true>(F.lds + RING_OFF, 1024, 1024, 16, S, E, 0, 0, SKEW(F)); }
        { DenseSched S; S.init(p.wfm_t, 1024, p.xh0, 1024, 2048, T_, F.G, (int)blockIdx.x); EpiInFeat E; E.vt = p.vt;
          pg::gemm_phase<EpiInFeat, DenseSched, 0, true>(F.lds + RING_OFF, 1024, 1024, 16, S, E); }
    }
#if (PROBE_DBL >> 17) & 1
    GRID_BAR();
    { DenseSched S; S.init(p.xh0, 1024, p.wri_t, 1024, T_, 4096, F.G, (int)blockIdx.x); EpiInTok E; E.q = p.q; E.k = p.k; E.sg = p.sg;
      pg::gemm_phase<EpiInTok, DenseSched, 0, true>(F.lds + RING_OFF, 1024, 1024, 16, S, E); }
#endif
#if (PROBE_DBL >> 6) & 1
    GRID_BAR();
    {
        { DenseSched S; S.init(p.xh0, 1024, p.wri_t, 1024, T_, 4096, F.G, (int)blockIdx.x); EpiInTok E; E.q = p.q; E.k = p.k; E.sg = p.sg;
          pg::gemm_phase<EpiInTok, DenseSched, 0, true>(F.lds + RING_OFF, 1024, 1024, 16, S, E); }
        { DenseSched S; S.init(p.wfm_t, 1024, p.xh0, 1024, 2048, T_, F.G, (int)blockIdx.x); EpiInFeat E; E.vt = p.vt;
          pg::gemm_phase<EpiInFeat, DenseSched, 0, true>(F.lds + RING_OFF, 1024, 1024, 16, S, E); }
    }
#endif
    GRID_BAR();
    {
        ph_ktranspose(p, F);
        { RaSched S{p.q, p.k, F.G, F.vcu}; EpiPP E; E.pp = p.pp; pg::gemm_phase<EpiPP, RaSched, 0, true>(F.lds + RING_OFF, 1024, 1024, 4, S, E); }
    }
    GRID_BAR();
    {
        { R1Sched S{p.vt, p.kdt, 4, F.G, F.vcu}; EpiSegTot E; E.L = p.ltot; pg::gemm_phase<EpiSegTot, R1Sched, 0, false>(F.lds + RING_OFF, 256, 256, 4, S, E); }
    }
    GRID_BAR();
    ph_carry(p.ltot, F);
    GRID_BAR();
    { R1Sched S{p.vt, p.kdt, 3, F.G, F.vcu}; EpiSnap E; E.L = p.ltot; E.st = p.st; pg::gemm_phase<EpiSnap, R1Sched, 0, false>(F.lds + RING_OFF, 256, 256, 4, S, E); }
#if (PROBE_DBL >> 8) & 1
    GRID_BAR();
    { R1Sched S{p.vt, p.kdt, 3, F.G, F.vcu}; EpiSnap E; E.L = p.ltot; E.st = p.st; pg::gemm_phase<EpiSnap, R1Sched, 0, false>(F.lds + RING_OFF, 256, 256, 4, S, E); }
#endif
    GRID_BAR();
    { R2Sched S{p.pp, p.vt, p.q, p.st, F.G, F.vcu}; EpiRetOut E; E.o = p.o; E.sg = p.sg; E.og = p.og; pg::gemm_phase<EpiRetOut, R2Sched, 2, true>(F.lds + RING_OFF, 256, 256, 4, S, E, 1024, 256); }
    GRID_BAR();
    layer_tail<0>(p, F, bar);
    GRID_BAR();
    {
        { DenseSched S; S.init(p.x2h, 1024, p.wsi_t, 1024, T_, 1280, F.G, (int)blockIdx.x); EpiSwaTok E; E.sq = p.sq; E.skv = p.skv; E.bias = p.b_swa_in;
          pg::gemm_phase<EpiSwaTok, DenseSched, 0, true>(F.lds + RING_OFF, 1024, 1024, 16, S, E); }
        { DenseSched S; S.init(p.wsi_t + (size_t)1024 * 1024, 1024, p.x2h, 1024, 256, T_, F.G, (int)blockIdx.x, 128); EpiSwaFeat E; E.kvt = p.kvt; E.bias = p.b_swa_in;
          pg::gemm_phase<EpiSwaFeat, DenseSched, 0, true>(F.lds + RING_OFF, 1024, 1024, 16, S, E); }
    }
#if (PROBE_DBL >> 13) & 1
    GRID_BAR();
    {
        { DenseSched S; S.init(p.x2h, 1024, p.wsi_t, 1024, T_, 1280, F.G, (int)blockIdx.x); EpiSwaTok E; E.sq = p.sq; E.skv = p.skv; E.bias = p.b_swa_in;
          pg::gemm_phase<EpiSwaTok, DenseSched, 0, true>(F.lds + RING_OFF, 1024, 1024, 16, S, E); }
        { DenseSched S; S.init(p.wsi_t + (size_t)1024 * 1024, 1024, p.x2h, 1024, 256, T_, F.G, (int)blockIdx.x, 128); EpiSwaFeat E; E.kvt = p.kvt; E.bias = p.b_swa_in;
          pg::gemm_phase<EpiSwaFeat, DenseSched, 0, true>(F.lds + RING_OFF, 1024, 1024, 16, S, E); }
    }
#endif
    GRID_BAR();
    DBL(3, ph_swa_attn(p, F));
    GRID_BAR();
    layer_tail<1>(p, F, bar);
    if (__hip_atomic_load((gu32*)((unsigned*)p.ctl + CW_BAR + XB_TMO), RLX_AGENT) != 0u) {
        __syncthreads();
        for (size_t i = (size_t)blockIdx.x * 512 + F.tid; i < (size_t)T_ * D_; i += (size_t)F.G * 512) p.out[i] = __builtin_nanf("");
    }
#undef GRID_BAR
}

namespace host {
constexpr size_t MiB = 1u << 20;
static int g_grid = 0;
static bool setup() {
    if (g_grid) return g_grid > 0;
    int dev = 0, cus = 0;
    if (hipGetDevice(&dev) != hipSuccess || hipDeviceGetAttribute(&cus, hipDeviceAttributeMultiprocessorCount, dev) != hipSuccess) { g_grid = -1; return false; }
    if (hipFuncSetAttribute((const void*)mk_fwd, hipFuncAttributeMaxDynamicSharedMemorySize, LDS_BYTES) != hipSuccess) { g_grid = -1; return false; }
    (void)hipGetLastError();
    g_grid = cus;
    return true;
}
static void launch(hipStream_t st, Params p) {
    p.ph_lo = 0; p.ph_hi = 0; p.li = 0; p.layer = 0;
    hipLaunchKernelGGL(mk_fwd, dim3(g_grid), dim3(NWAVES * 64), LDS_BYTES, st, p);
}
static void fill_params(Params& p, void* const* d_in, float* out, unsigned char* ws) {
    const float** in = (const float**)&p.x;
    for (int i = 0; i < 18; ++i) in[i] = (const float*)d_in[i];
    p.out = out; p.ctl = (unsigned*)ws;
    const size_t M = MiB;
    p.top_e = (int*)(ws + 1 * M); p.top_g = (float*)(ws + 2 * M); p.rankp = (int*)(ws + 3 * M); p.inv = (int*)(ws + 4 * M); p.slot_tok = (int*)(ws + 5 * M); p.slot_gate = (float*)(ws + 6 * M);
    p.wg_cnt = (int*)(ws + 7 * M); p.tile_e = (int*)(ws + 8 * M);
    p.wri_t = (h16*)(ws + 17 * M); p.wfm_t = (h16*)(ws + 25 * M); p.wro_t = (h16*)(ws + 31 * M); p.wsi_t = (h16*)(ws + 35 * M); p.wso_t = (h16*)(ws + 38 * M);
    p.w1_t = (h16*)(ws + 40 * M); p.w2_t = (h16*)(ws + 296 * M);
    p.xh0 = (h16*)(ws + 424 * M); p.x1h = (h16*)(ws + 488 * M); p.x2h = (h16*)(ws + 552 * M);
    p.x1f = (float*)(ws + 616 * M); p.x2f = (float*)(ws + 744 * M); p.yf = (float*)(ws + 872 * M);
    p.act = (h16*)(ws + 1000 * M); p.yy = (h16*)(ws + 1272 * M);
}
}
extern "C" void kernel_launch(void* const* d_in, const int* in_sizes, int n_in, void* d_out, int out_size, void* d_ws, size_t ws_size, hipStream_t stream) {
    const size_t M = host::MiB;
    if (n_in != 18 || out_size != T_ * D_ || ws_size < 2040 * M) { fprintf(stderr, "kernel_launch: unexpected shapes / workspace (%d inputs, out %d, ws %zu)\n", n_in, out_size, ws_size); return; }
    if (!host::setup()) return;
    unsigned char* ws = (unsigned char*)d_ws; hipStream_t st = stream;
    (void)hipMemsetAsync(ws, 0, CTL_ZERO_BYTES, st);
    Params p{}; host::fill_params(p, d_in, (float*)d_out, ws);
    p.q = (h16*)(ws + 1000 * M); p.k = (h16*)(ws + 1064 * M); p.sg = (h16*)(ws + 1128 * M); p.kdt = (h16*)(ws + 1256 * M); p.vt = (h16*)(ws + 1320 * M);
    p.pp = (h16*)(ws + 1448 * M); p.st = (h16*)(ws + 1512 * M); p.ltot = (float*)(ws + 1640 * M); p.o = (h16*)(ws + 1704 * M); p.og = (h16*)(ws + 1832 * M);
    p.sq = (h16*)(ws + 1000 * M); p.skv = (h16*)(ws + 1064 * M); p.kvt = (h16*)(ws + 1080 * M); p.so = (h16*)(ws + 1096 * M);
    p.w1q = (unsigned char*)p.w1_t + (size_t)32 * 2048 * 1024 * 2; p.w2q = (unsigned char*)p.w2_t + (size_t)32 * 1024 * 1024 * 2;
    p.x1q = ws + 1560 * M; p.actq = (unsigned char*)p.act;
    p.yh = (h16*)p.yf;
    host::launch(st, p);
}
```

```cpp
#include <hip/hip_runtime.h>
#include <cstdio>
#include <cstdint>
#include <cmath>
#define GAS __attribute__((address_space(1)))
#define LAS __attribute__((address_space(3)))
typedef unsigned short bf16;
typedef unsigned v4u __attribute__((ext_vector_type(4)));
typedef float f32x4 __attribute__((ext_vector_type(4)));
typedef short bf16x8 __attribute__((ext_vector_type(8)));
typedef GAS unsigned gu32;
typedef GAS unsigned long long gu64;
#define RLX_AGENT __ATOMIC_RELAXED, __HIP_MEMORY_SCOPE_AGENT
#define LDS_WAIT() asm volatile("s_waitcnt lgkmcnt(0)" ::: "memory")
#define VM_WAIT() asm volatile("s_waitcnt vmcnt(0)" ::: "memory")
__device__ __forceinline__ unsigned long long rt() { return __builtin_amdgcn_s_memrealtime(); }
#define XB_TMO      128
#define XB_XCNT(j)  (256  + 64 * (j))
#define XB_XSUB(j)  (1280 + 64 * (j))
#define XB_XGEN(j)  (2304 + 64 * (j))
#define XB_TOP      3328
#define XB_TOPGEN   3392
#define XCD_BAR_WORDS 3456
#define XB_SPIN_CAP (1u << 18)

__device__ __forceinline__ unsigned xb_ld(unsigned* p)              { return __hip_atomic_load(p, __ATOMIC_RELAXED, __HIP_MEMORY_SCOPE_AGENT); }
__device__ __forceinline__ unsigned xb_add(unsigned* p, unsigned v) { return __hip_atomic_fetch_add(p, v, __ATOMIC_RELAXED, __HIP_MEMORY_SCOPE_AGENT); }
__device__ __forceinline__ unsigned xb_xcc_id() { return (unsigned)__builtin_amdgcn_s_getreg((3 << 11) | 20) & 0xFu; }
#define XB_SPIN(cond, bar) do { unsigned _sp = 0; while (cond) { __builtin_amdgcn_s_sleep(1); \
    if ((++_sp & 255u) == 0u) { if (xb_ld(&(bar)[XB_TMO])) break; if (_sp > XB_SPIN_CAP) { atomicAdd(&(bar)[XB_TMO], 1u); break; } } } } while (0)

struct XcdBarrier {
    unsigned* bar; unsigned x;
    volatile LAS unsigned* st;
};

__device__ __forceinline__ XcdBarrier xcd_barrier_post(unsigned* bar, volatile LAS unsigned* st) {
    XcdBarrier b; b.bar = bar; b.x = xb_xcc_id(); b.st = st;
    if (threadIdx.x == 0) (void)xb_add(&bar[XB_XCNT(b.x)], 1u);
    return b;
}
__device__ __forceinline__ void xcd_barrier_complete(unsigned* bar, unsigned x, unsigned& nloc, unsigned& nx) {
    const unsigned G = gridDim.x * gridDim.y * gridDim.z;
    unsigned sum, cnt, mine, sp = 0u;
    for (;;) {
        sum = 0u; cnt = 0u; mine = 0u;
#pragma unroll
        for (unsigned j = 0; j < 16; ++j) { const unsigned c = xb_ld(&bar[XB_XCNT(j)]); sum += c; cnt += (c > 0u) ? 1u : 0u; mine = (j == x) ? c : mine; }
        if (sum == G) break;
        __builtin_amdgcn_s_sleep(1);
        if ((++sp & 255u) == 0u) { if (xb_ld(&bar[XB_TMO])) break; if (sp > XB_SPIN_CAP) { atomicAdd(&bar[XB_TMO], 1u); break; } }
    }
    nloc = mine > 0u ? mine : 1u; nx = cnt > 0u ? cnt : 1u;
}

__device__ __forceinline__ void xcd_barrier(const XcdBarrier& b) {
    asm volatile("s_waitcnt vmcnt(0)" ::: "memory");
    __syncthreads();
    if (threadIdx.x == 0) {
        unsigned* bar = b.bar;
        __builtin_amdgcn_s_waitcnt(0);
        unsigned nloc = b.st[0], nx = b.st[1];
        if (nloc == 0u) { xcd_barrier_complete(bar, b.x, nloc, nx); b.st[0] = nloc; b.st[1] = nx; }
        const unsigned old = xb_add(&bar[XB_XSUB(b.x)], 1u);
        const unsigned gen = old / nloc;
        if (old + 1u == (gen + 1u) * nloc) {
            __builtin_amdgcn_fence(__ATOMIC_RELEASE, "agent");
            asm volatile("s_waitcnt vmcnt(0)" ::: "memory");
            const unsigned og = xb_add(&bar[XB_TOP], 1u);
            const unsigned tg = og / nx;
            if (og + 1u == (tg + 1u) * nx) xb_add(&bar[XB_TOPGEN], 1u);
            else XB_SPIN(xb_ld(&bar[XB_TOPGEN]) == tg, bar);
            __builtin_amdgcn_fence(__ATOMIC_ACQUIRE, "agent");
            xb_add(&bar[XB_XGEN(b.x)], 1u);
            asm volatile("s_waitcnt vmcnt(0)" ::: "memory");
        } else {
            XB_SPIN(xb_ld(&bar[XB_XGEN(b.x)]) == gen, bar);
            __builtin_amdgcn_fence(__ATOMIC_ACQUIRE, "agent");
            asm volatile("s_waitcnt vmcnt(0)" ::: "memory");
        }
    }
    __syncthreads();
}
namespace pg {
#define PG_LAS __attribute__((address_space(3)))
typedef unsigned short h16;
typedef _Float16 f16x8 __attribute__((ext_vector_type(8)));
typedef __bf16 bf16x8 __attribute__((ext_vector_type(8)));
typedef _Float16 f16x2 __attribute__((ext_vector_type(2)));
typedef float f32x4 __attribute__((ext_vector_type(4)));
typedef float f32x2 __attribute__((ext_vector_type(2)));
typedef unsigned u32x4 __attribute__((ext_vector_type(4)));
typedef unsigned u32x2 __attribute__((ext_vector_type(2)));
constexpr int BM = 256, BK = 64, HALF = 128, HTB = HALF * BK * 2  , STAGE_BYTES = 8 * HTB;

__host__ __device__ __forceinline__ int lds_byte(int r, int c) { const int st = (r >> 4) * 2 + (c >> 5), rr = r & 15, cc = c & 31, ob = rr * 64 + cc * 2; return st * 1024 + (ob ^ (((ob >> 9) & 1) << 5)); }
__host__ __device__ __forceinline__ void stage_rc(int b, int& R, int& C) { const int st = b / 1024, sb = b % 1024, swz = sb ^ (((sb >> 9) & 1) << 5); R = (st >> 1) * 16 + swz / 64; C = (st & 1) * 32 + (swz % 64) / 2; }
__host__ __device__ __forceinline__ int perm32(int rho) { const int n = rho >> 4, i = rho & 15; return 8 * (i >> 2) + 4 * n + (i & 3); }
__device__ __forceinline__ unsigned pkh(float lo, float hi) { const f32x2 v = {lo, hi}; const f16x2 h = __builtin_convertvector(v, f16x2); return __builtin_bit_cast(unsigned, h); }

typedef int i32x8 __attribute__((ext_vector_type(8)));
typedef int i32x4 __attribute__((ext_vector_type(4)));
__device__ __forceinline__ i32x8 cat8(f16x8 lo, f16x8 hi) { return __builtin_shufflevector(__builtin_bit_cast(i32x4, lo), __builtin_bit_cast(i32x4, hi), 0, 1, 2, 3, 4, 5, 6, 7); }
__device__ __forceinline__ void mfma_f8(f32x4& c, const i32x8& a, const i32x8& b, int scale) {
    asm volatile("v_mfma_scale_f32_16x16x128_f8f6f4 %0, %1, %2, %0, %3, %3 op_sel_hi:[0,0,0]" : "+v"(c) : "v"(a), "v"(b), "v"(scale)); }
struct Unit { const char* a; const char* b; int pm, pn, e, x; };
typedef f32x4 Acc[2][2][4][2];
__device__ __forceinline__ void acc_zero(Acc& acc) {
#pragma unroll
    for (int a = 0; a < 2; ++a)
#pragma unroll
        for (int b = 0; b < 2; ++b)
#pragma unroll
            for (int m = 0; m < 4; ++m)
#pragma unroll
                for (int n = 0; n < 2; ++n) acc[a][b][m][n] = (f32x4){0.f, 0.f, 0.f, 0.f};
}
struct EpiBase {
    static constexpr bool PERM = false;
    __device__ __forceinline__ void init(Acc& acc, const Unit&, int, int, int, int) const { acc_zero(acc); }
    __device__ __forceinline__ void reinit(Acc& acc, const Unit&, const Unit&, int, int, int, int) const { acc_zero(acc); }
};

template <class Epi, class Sched, int MODE  , bool ALIGN_EPI, int ES = 2  , bool BF = false  , int ILV = 2  >
__device__ __forceinline__ void gemm_phase(PG_LAS unsigned char* lds, const int lda, const int ldb, const int nt_, const Sched& S, const Epi& E, const int lda1 = 0, const int ldb1 = 0, const int skew_ticks = 0  ) {
    constexpr bool GATHER = (MODE == 1), DUAL = (MODE == 2), I8 = (ES == 1) && BF, F16P = (ES == 2) || I8  ;
    int nt = nt_; asm volatile("" : "+s"(nt));
    int tid_ = threadIdx.x; asm volatile("" : "+v"(tid_));
    const int tid = tid_, wid = __builtin_amdgcn_readfirstlane(tid >> 6), lane = tid & 63, wr = wid >> 2, wc = wid & 3, fr = lane & 15, fq = lane >> 4;
    unsigned voffA[2], voffB[2]; int sR[2], sC[2];
#pragma unroll
    for (int i = 0; i < 2; ++i) { int R, C; stage_rc(tid * 16 + i * 8192, R, C); sR[i] = R; sC[i] = C; const int Rb = Epi::PERM ? ((R & ~31) + perm32(R & 31)) : R;
        voffA[i] = (unsigned)(R * lda * ES + C * 2); voffB[i] = (unsigned)(Rb * ldb * ES + C * 2); }
    const size_t kstep = (size_t)(BK * 2);
    const size_t hstepA0 = GATHER ? 0 : (size_t)HALF * lda * ES, hstepB0 = (size_t)HALF * ldb * ES, hstepA1 = (size_t)HALF * lda1 * ES, hstepB1 = (size_t)HALF * ldb1 * ES;
    unsigned wA1[2], wB1[2];
#pragma unroll
    for (int i = 0; i < 2; ++i) { const int Rb = Epi::PERM ? ((sR[i] & ~31) + perm32(sR[i] & 31)) : sR[i]; wA1[i] = (unsigned)(sR[i] * lda1 * ES + sC[i] * 2); wB1[i] = (unsigned)(Rb * ldb1 * ES + sC[i] * 2); }
    unsigned vAc[2], vBc[2], vAn[2], vBn[2], vA2[2], vB2[2];
    size_t hAc = hstepA0, hBc = hstepB0, hAn = hstepA0, hBn = hstepB0, hA2 = hstepA0, hB2 = hstepB0;
    const unsigned ldsw = (unsigned)wid * 1024u;
    const int aoff = F16P ? lds_byte(wr * 64 + fr, fq * 8) : lds_byte(wr * 64 + fr, fq * 16), boff = F16P ? lds_byte(wc * 32 + fr, fq * 8) : lds_byte(wc * 32 + fr, fq * 16);
    unsigned gc[2][2], gn[2][2], g2[2][2];
#define PG_SA(b, h) (((b) * 2 + (h)) * HTB)
#define PG_SB(b, h) ((4 + (b) * 2 + (h)) * HTB)
#if !defined(PG_GLOBAL_DMA)
#define PG_STAGE(bufoff, gbase, voff) do { const __amdgpu_buffer_rsrc_t _r = __builtin_amdgcn_make_buffer_rsrc((void*)(gbase), 0, 0x7fffffff, 0x00020000); _Pragma("unroll") for (int _i = 0; _i < 2; ++_i) \
        __builtin_amdgcn_raw_ptr_buffer_load_lds(_r, (PG_LAS unsigned*)(lds + (bufoff) + ldsw + _i * 8192), 16, (int)(voff)[_i], 0, 0, 0); } while (0)
#else
#define PG_STAGE(bufoff, gbase, voff) do { _Pragma("unroll") for (int _i = 0; _i < 2; ++_i) \
        __builtin_amdgcn_global_load_lds((const unsigned*)((const char*)(gbase) + (voff)[_i]), (PG_LAS unsigned*)(lds + (bufoff) + ldsw + _i * 8192), 16, 0, 0); } while (0)
#endif
#define PG_STAGE_A(bufoff, kptr, h, G, VA, HA) do { if constexpr (GATHER) { PG_STAGE(bufoff, kptr, G[h]); } else { PG_STAGE(bufoff, (kptr) + (h) * (HA), VA); } } while (0)
#define PG_CFG(u, VA, VB, HA, HB) do { if constexpr (DUAL) { const bool _x = (u).x != 0; _Pragma("unroll") for (int _i = 0; _i < 2; ++_i) { VA[_i] = _x ? wA1[_i] : voffA[_i]; VB[_i] = _x ? wB1[_i] : voffB[_i]; } \
        HA = _x ? hstepA1 : hstepA0; HB = _x ? hstepB1 : hstepB0; } else { _Pragma("unroll") for (int _i = 0; _i < 2; ++_i) { VA[_i] = voffA[_i]; VB[_i] = voffB[_i]; } HA = hstepA0; HB = hstepB0; } } while (0)
#define PG_GLOAD(dst, u) do { _Pragma("unroll") for (int _h = 0; _h < 2; ++_h) _Pragma("unroll") for (int _i = 0; _i < 2; ++_i) \
        dst[_h][_i] = S.arow(u, _h * HALF + sR[_i]) * (unsigned)(lda * ES) + (unsigned)(sC[_i] * 2); } while (0)
#define PG_LDF(p) (*(const PG_LAS f16x8*)(p))
#define PG_LDA(dst, b, h) do { if constexpr (F16P) { _Pragma("unroll") for (int m = 0; m < 4; ++m) _Pragma("unroll") for (int k = 0; k < 2; ++k) dst[m][k] = PG_LDF(lds + PG_SA(b, h) + aoff + m * 2048 + k * 1024); } \
        else { _Pragma("unroll") for (int m = 0; m < 4; ++m) dst##8[m] = cat8(PG_LDF(lds + PG_SA(b, h) + aoff + m * 2048), PG_LDF(lds + PG_SA(b, h) + aoff + m * 2048 + 16)); } } while (0)
#define PG_LDB(dst, b, h) do { if constexpr (F16P) { _Pragma("unroll") for (int n = 0; n < 2; ++n) _Pragma("unroll") for (int k = 0; k < 2; ++k) dst[n][k] = PG_LDF(lds + PG_SB(b, h) + boff + n * 2048 + k * 1024); } \
        else { _Pragma("unroll") for (int n = 0; n < 2; ++n) dst##8[n] = cat8(PG_LDF(lds + PG_SB(b, h) + boff + n * 2048), PG_LDF(lds + PG_SB(b, h) + boff + n * 2048 + 16)); } } while (0)
#define PG_MMA(ai, bj, At, Bt) do { __builtin_amdgcn_s_setprio(1); if constexpr (I8) { _Pragma("unroll") for (int m = 0; m < 4; ++m) _Pragma("unroll") for (int n = 0; n < 2; ++n) _Pragma("unroll") for (int k = 0; k < 2; ++k) \
        acc[ai][bj][m][n] = __builtin_bit_cast(f32x4, __builtin_amdgcn_mfma_i32_16x16x64_i8(__builtin_bit_cast(i32x4, Bt[n][k]), __builtin_bit_cast(i32x4, At[m][k]), __builtin_bit_cast(i32x4, acc[ai][bj][m][n]), 0, 0, 0)); } else if constexpr (ES == 2) { _Pragma("unroll") for (int m = 0; m < 4; ++m) _Pragma("unroll") for (int n = 0; n < 2; ++n) _Pragma("unroll") for (int k = 0; k < 2; ++k) \
        acc[ai][bj][m][n] = BF ? __builtin_amdgcn_mfma_f32_16x16x32_bf16(__builtin_bit_cast(bf16x8, Bt[n][k]), __builtin_bit_cast(bf16x8, At[m][k]), acc[ai][bj][m][n], 0, 0, 0) : __builtin_amdgcn_mfma_f32_16x16x32_f16(Bt[n][k], At[m][k], acc[ai][bj][m][n], 0, 0, 0); } else { _Pragma("unroll") for (int m = 0; m < 4; ++m) _Pragma("unroll") for (int n = 0; n < 2; ++n) \
        mfma_f8(acc[ai][bj][m][n], Bt##8[n], At##8[m], f8scale); } \
        __builtin_amdgcn_s_setprio(0); } while (0)
#define PG_MMH(ai, bj, At, Bt, M0) do { __builtin_amdgcn_s_setprio(1); if constexpr (I8) { _Pragma("unroll") for (int m = (M0); m < (M0) + 2; ++m) _Pragma("unroll") for (int n = 0; n < 2; ++n) _Pragma("unroll") for (int k = 0; k < 2; ++k) \
        acc[ai][bj][m][n] = __builtin_bit_cast(f32x4, __builtin_amdgcn_mfma_i32_16x16x64_i8(__builtin_bit_cast(i32x4, Bt[n][k]), __builtin_bit_cast(i32x4, At[m][k]), __builtin_bit_cast(i32x4, acc[ai][bj][m][n]), 0, 0, 0)); } else if constexpr (ES == 2) { _Pragma("unroll") for (int m = (M0); m < (M0) + 2; ++m) _Pragma("unroll") for (int n = 0; n < 2; ++n) _Pragma("unroll") for (int k = 0; k < 2; ++k) \
        acc[ai][bj][m][n] = BF ? __builtin_amdgcn_mfma_f32_16x16x32_bf16(__builtin_bit_cast(bf16x8, Bt[n][k]), __builtin_bit_cast(bf16x8, At[m][k]), acc[ai][bj][m][n], 0, 0, 0) : __builtin_amdgcn_mfma_f32_16x16x32_f16(Bt[n][k], At[m][k], acc[ai][bj][m][n], 0, 0, 0); } else { _Pragma("unroll") for (int m = (M0); m < (M0) + 2; ++m) _Pragma("unroll") for (int n = 0; n < 2; ++n) \
        mfma_f8(acc[ai][bj][m][n], Bt##8[n], At##8[m], f8scale); } \
        __builtin_amdgcn_s_setprio(0); } while (0)
#define PG_WAIT_V(n) asm volatile("s_waitcnt vmcnt(" #n ")" ::: "memory")
#define PG_WAIT_L(n) asm volatile("s_waitcnt lgkmcnt(" #n ")" ::: "memory")
#define PG_BAR __builtin_amdgcn_s_barrier()
#define PG_SCHED __builtin_amdgcn_sched_barrier(0)
    if (skew_ticks > 0) { const unsigned long long t0 = __builtin_amdgcn_s_memrealtime(); while (__builtin_amdgcn_s_memrealtime() - t0 < (unsigned long long)skew_ticks) __builtin_amdgcn_s_sleep(8); }
    Unit cur, nxt; int ui = 0;
    if (!S.next(0, cur)) return;
    Acc acc;
    E.init(acc, cur, wr, wc, fr, fq);
    f16x8 At[4][2], B0[2][2], B1[2][2];
    int f8scale = 0x7f7f7f7f; asm volatile("" : "+v"(f8scale));
    i32x8 At8[4], B08[2], B18[2];
    const char* cA = cur.a; const char* cB = cur.b;
    if constexpr (GATHER) { PG_GLOAD(gc, cur); }
    PG_CFG(cur, vAc, vBc, hAc, hBc);
    PG_STAGE(PG_SB(0, 0), cB, vBc); PG_STAGE(PG_SB(0, 1), cB + hBc, vBc); PG_STAGE_A(PG_SA(0, 0), cA, 0, gc, vAc, hAc); PG_STAGE_A(PG_SA(0, 1), cA, 1, gc, vAc, hAc);
    if (wr == 1) PG_BAR;
    PG_WAIT_V(2); PG_BAR;
    if constexpr (ILV >= 2 && ILV <= 4) { PG_STAGE(PG_SB(1, 0), cB + kstep, vBc); PG_STAGE(PG_SB(1, 1), cB + hBc + kstep, vBc); PG_WAIT_V(4); PG_BAR; }
    else { PG_STAGE(PG_SB(1, 0), cB + kstep, vBc); PG_STAGE_A(PG_SA(1, 0), cA + kstep, 0, gc, vAc, hAc); PG_STAGE(PG_SB(1, 1), cB + hBc + kstep, vBc);
    PG_WAIT_V(6); PG_BAR; }
    for (;;) {
        const bool has_next = S.next(ui + 1, nxt);
        const char* nA = has_next ? nxt.a : cA; const char* nB = has_next ? nxt.b : cB;
        if constexpr (GATHER) { if (has_next) { PG_GLOAD(gn, nxt); } else {
#pragma unroll
            for (int h = 0; h < 2; ++h)
#pragma unroll
                for (int i = 0; i < 2; ++i) gn[h][i] = gc[h][i]; } }
        if (has_next) { PG_CFG(nxt, vAn, vBn, hAn, hBn); } else { PG_CFG(cur, vAn, vBn, hAn, hBn); }
        for (int t = 0; t < nt; t += 2) {
            const bool last = (t == nt - 2);
            const char* a1 = cA + (size_t)(t + 1) * kstep;
            const char* a2 = last ? nA : cA + (size_t)(t + 2) * kstep; const char* b2 = last ? nB : cB + (size_t)(t + 2) * kstep;
            const char* a3 = a2 + kstep; const char* b3 = b2 + kstep;
            if constexpr (GATHER) {
#pragma unroll
                for (int h = 0; h < 2; ++h)
#pragma unroll
                    for (int i = 0; i < 2; ++i) g2[h][i] = last ? gn[h][i] : gc[h][i]; }
            if constexpr (DUAL) {
#pragma unroll
                for (int i = 0; i < 2; ++i) { vA2[i] = last ? vAn[i] : vAc[i]; vB2[i] = last ? vBn[i] : vBc[i]; }
                hA2 = last ? hAn : hAc; hB2 = last ? hBn : hBc;
            } else {
#pragma unroll
                for (int i = 0; i < 2; ++i) { vA2[i] = vAc[i]; vB2[i] = vBc[i]; }
                hA2 = hAc; hB2 = hBc; }
            if constexpr (ILV == 5) {
            PG_LDB(B0, 0, 0); PG_SCHED; PG_LDA(At, 0, 0); PG_STAGE_A(PG_SA(1, 1), a1, 1, gc, vAc, hAc);
            PG_WAIT_L(8); PG_BAR; PG_WAIT_L(0); PG_MMA(0, 0, At, B0); PG_BAR; PG_SCHED;
            PG_LDB(B1, 0, 1); PG_STAGE(PG_SB(0, 0), b2, vB2);
            PG_BAR; PG_WAIT_L(0); PG_MMA(0, 1, At, B1); PG_BAR; PG_SCHED;
            PG_LDA(At, 0, 1); PG_STAGE_A(PG_SA(0, 0), a2, 0, g2, vA2, hA2);
            PG_BAR; PG_WAIT_L(0); PG_MMA(1, 0, At, B0); PG_BAR; PG_SCHED;
            PG_STAGE(PG_SB(0, 1), b2 + hB2, vB2);
            PG_WAIT_V(6); PG_BAR; PG_MMA(1, 1, At, B1); PG_BAR; PG_SCHED;
            PG_LDB(B0, 1, 0); PG_SCHED; PG_LDA(At, 1, 0); PG_STAGE_A(PG_SA(0, 1), a2, 1, g2, vA2, hA2);
            PG_WAIT_L(8); PG_BAR; PG_WAIT_L(0); PG_MMA(0, 0, At, B0); PG_BAR; PG_SCHED;
            PG_LDB(B1, 1, 1); PG_STAGE(PG_SB(1, 0), b3, vB2);
            PG_BAR; PG_WAIT_L(0); PG_MMA(0, 1, At, B1); PG_BAR; PG_SCHED;
            PG_LDA(At, 1, 1); PG_STAGE_A(PG_SA(1, 0), a3, 0, g2, vA2, hA2);
            PG_BAR; PG_WAIT_L(0); PG_MMA(1, 0, At, B0); PG_BAR; PG_SCHED;
            PG_STAGE(PG_SB(1, 1), b3 + hB2, vB2);
            PG_WAIT_V(6); PG_BAR; PG_MMA(1, 1, At, B1); PG_BAR; PG_SCHED;
            } else if constexpr (ILV == 3) {
            PG_LDB(B0, 0, 0); PG_LDB(B1, 0, 1); PG_SCHED; PG_LDA(At, 0, 0); PG_STAGE_A(PG_SA(1, 0), a1, 0, gc, vAc, hAc);
            PG_WAIT_V(6); PG_WAIT_L(0); PG_BAR; PG_MMA(0, 0, At, B0); PG_SCHED; PG_STAGE_A(PG_SA(1, 1), a1, 1, gc, vAc, hAc); PG_SCHED; PG_MMA(0, 1, At, B1); PG_BAR; PG_SCHED;
            PG_LDA(At, 0, 1); PG_STAGE(PG_SB(0, 0), b2, vB2);
            PG_WAIT_V(4); PG_WAIT_L(0); PG_BAR; PG_MMA(1, 0, At, B0); PG_SCHED; PG_STAGE(PG_SB(0, 1), b2 + hB2, vB2); PG_SCHED; PG_MMA(1, 1, At, B1); PG_BAR; PG_SCHED;
            PG_LDB(B0, 1, 0); PG_LDB(B1, 1, 1); PG_SCHED; PG_LDA(At, 1, 0); PG_STAGE_A(PG_SA(0, 0), a2, 0, g2, vA2, hA2);
            PG_WAIT_V(6); PG_WAIT_L(0); PG_BAR; PG_MMA(0, 0, At, B0); PG_SCHED; PG_STAGE_A(PG_SA(0, 1), a2, 1, g2, vA2, hA2); PG_SCHED; PG_MMA(0, 1, At, B1); PG_BAR; PG_SCHED;
            PG_LDA(At, 1, 1); PG_STAGE(PG_SB(1, 0), b3, vB2);
            PG_WAIT_V(4); PG_WAIT_L(0); PG_BAR; PG_MMA(1, 0, At, B0); PG_SCHED; PG_STAGE(PG_SB(1, 1), b3 + hB2, vB2); PG_SCHED; PG_MMA(1, 1, At, B1); PG_BAR; PG_SCHED;
            } else if constexpr (ILV == 4) {
            PG_LDB(B0, 0, 0); PG_SCHED; PG_STAGE_A(PG_SA(1, 0), a1, 0, gc, vAc, hAc); PG_SCHED; PG_LDA(At, 0, 0); PG_SCHED; PG_STAGE_A(PG_SA(1, 1), a1, 1, gc, vAc, hAc);
            PG_WAIT_V(8); PG_BAR; PG_WAIT_L(0); PG_MMA(0, 0, At, B0); PG_SCHED; PG_LDB(B1, 0, 1); PG_WAIT_L(0); PG_SCHED; PG_MMA(0, 1, At, B1); PG_BAR; PG_SCHED;
            PG_LDA(At, 0, 1); PG_STAGE(PG_SB(0, 0), b2, vB2); PG_STAGE(PG_SB(0, 1), b2 + hB2, vB2);
            PG_WAIT_V(6); PG_BAR; PG_WAIT_L(0); PG_MMA(1, 0, At, B0); PG_MMA(1, 1, At, B1); PG_BAR; PG_SCHED;
            PG_LDB(B0, 1, 0); PG_SCHED; PG_STAGE_A(PG_SA(0, 0), a2, 0, g2, vA2, hA2); PG_SCHED; PG_LDA(At, 1, 0); PG_SCHED; PG_STAGE_A(PG_SA(0, 1), a2, 1, g2, vA2, hA2);
            PG_WAIT_V(8); PG_BAR; PG_WAIT_L(0); PG_MMA(0, 0, At, B0); PG_SCHED; PG_LDB(B1, 1, 1); PG_WAIT_L(0); PG_SCHED; PG_MMA(0, 1, At, B1); PG_BAR; PG_SCHED;
            PG_LDA(At, 1, 1); PG_STAGE(PG_SB(1, 0), b3, vB2); PG_STAGE(PG_SB(1, 1), b3 + hB2, vB2);
            PG_WAIT_V(6); PG_BAR; PG_WAIT_L(0); PG_MMA(1, 0, At, B0); PG_MMA(1, 1, At, B1); PG_BAR; PG_SCHED;
            } else if constexpr (ILV == 2) {
            PG_LDB(B0, 0, 0); PG_LDB(B1, 0, 1); PG_SCHED; PG_STAGE_A(PG_SA(1, 0), a1, 0, gc, vAc, hAc); PG_SCHED; PG_LDA(At, 0, 0); PG_SCHED; PG_STAGE_A(PG_SA(1, 1), a1, 1, gc, vAc, hAc);
            PG_WAIT_V(8); PG_BAR; PG_WAIT_L(0); PG_MMA(0, 0, At, B0); PG_MMA(0, 1, At, B1); PG_BAR; PG_SCHED;
            PG_LDA(At, 0, 1); PG_STAGE(PG_SB(0, 0), b2, vB2); PG_STAGE(PG_SB(0, 1), b2 + hB2, vB2);
            PG_WAIT_V(6); PG_BAR; PG_WAIT_L(0); PG_MMA(1, 0, At, B0); PG_MMA(1, 1, At, B1); PG_BAR; PG_SCHED;
            PG_LDB(B0, 1, 0); PG_LDB(B1, 1, 1); PG_SCHED; PG_STAGE_A(PG_SA(0, 0), a2, 0, g2, vA2, hA2); PG_SCHED; PG_LDA(At, 1, 0); PG_SCHED; PG_STAGE_A(PG_SA(0, 1), a2, 1, g2, vA2, hA2);
            PG_WAIT_V(8); PG_BAR; PG_WAIT_L(0); PG_MMA(0, 0, At, B0); PG_MMA(0, 1, At, B1); PG_BAR; PG_SCHED;
            PG_LDA(At, 1, 1); PG_STAGE(PG_SB(1, 0), b3, vB2); PG_STAGE(PG_SB(1, 1), b3 + hB2, vB2);
            PG_WAIT_V(6); PG_BAR; PG_WAIT_L(0); PG_MMA(1, 0, At, B0); PG_MMA(1, 1, At, B1); PG_BAR; PG_SCHED;
            } else if constexpr (ILV == 1) {
            PG_LDB(B0, 0, 0); PG_LDB(B1, 0, 1); PG_SCHED; PG_LDA(At, 0, 0);
            PG_WAIT_V(6); PG_WAIT_L(0); PG_BAR; PG_MMA(0, 0, At, B0); PG_SCHED; PG_STAGE_A(PG_SA(1, 1), a1, 1, gc, vAc, hAc); PG_SCHED; PG_MMA(0, 1, At, B1); PG_BAR; PG_SCHED;
            PG_LDA(At, 0, 1);
            PG_WAIT_V(2); PG_WAIT_L(0); PG_BAR; PG_MMH(1, 0, At, B0, 0); PG_SCHED; PG_STAGE(PG_SB(0, 0), b2, vB2); PG_SCHED; PG_MMH(1, 0, At, B0, 2); PG_SCHED; PG_STAGE(PG_SB(0, 1), b2 + hB2, vB2); PG_SCHED;
                PG_MMH(1, 1, At, B1, 0); PG_SCHED; PG_STAGE_A(PG_SA(0, 0), a2, 0, g2, vA2, hA2); PG_SCHED; PG_MMH(1, 1, At, B1, 2); PG_BAR; PG_SCHED;
            PG_LDB(B0, 1, 0); PG_LDB(B1, 1, 1); PG_SCHED; PG_LDA(At, 1, 0);
            PG_WAIT_V(6); PG_WAIT_L(0); PG_BAR; PG_MMA(0, 0, At, B0); PG_SCHED; PG_STAGE_A(PG_SA(0, 1), a2, 1, g2, vA2, hA2); PG_SCHED; PG_MMA(0, 1, At, B1); PG_BAR; PG_SCHED;
            PG_LDA(At, 1, 1);
            PG_WAIT_V(2); PG_WAIT_L(0); PG_BAR; PG_MMH(1, 0, At, B0, 0); PG_SCHED; PG_STAGE(PG_SB(1, 0), b3, vB2); PG_SCHED; PG_MMH(1, 0, At, B0, 2); PG_SCHED; PG_STAGE(PG_SB(1, 1), b3 + hB2, vB2); PG_SCHED;
                PG_MMH(1, 1, At, B1, 0); PG_SCHED; PG_STAGE_A(PG_SA(1, 0), a3, 0, g2, vA2, hA2); PG_SCHED; PG_MMH(1, 1, At, B1, 2); PG_BAR; PG_SCHED;
            } else {
            PG_LDB(B0, 0, 0); PG_LDB(B1, 0, 1); PG_SCHED; PG_LDA(At, 0, 0); PG_STAGE_A(PG_SA(1, 1), a1, 1, gc, vAc, hAc);
            PG_WAIT_V(8); PG_WAIT_L(0); PG_BAR; PG_MMA(0, 0, At, B0); PG_MMA(0, 1, At, B1); PG_BAR; PG_SCHED;
            PG_LDA(At, 0, 1); PG_STAGE(PG_SB(0, 0), b2, vB2); PG_STAGE(PG_SB(0, 1), b2 + hB2, vB2); PG_STAGE_A(PG_SA(0, 0), a2, 0, g2, vA2, hA2);
            PG_WAIT_V(8); PG_WAIT_L(0); PG_BAR; PG_MMA(1, 0, At, B0); PG_MMA(1, 1, At, B1); PG_BAR; PG_SCHED;
            PG_LDB(B0, 1, 0); PG_LDB(B1, 1, 1); PG_SCHED; PG_LDA(At, 1, 0); PG_STAGE_A(PG_SA(0, 1), a2, 1, g2, vA2, hA2);
            PG_WAIT_V(8); PG_WAIT_L(0); PG_BAR; PG_MMA(0, 0, At, B0); PG_MMA(0, 1, At, B1); PG_BAR; PG_SCHED;
            PG_LDA(At, 1, 1); PG_STAGE(PG_SB(1, 0), b3, vB2); PG_STAGE(PG_SB(1, 1), b3 + hB2, vB2); PG_STAGE_A(PG_SA(1, 0), a3, 0, g2, vA2, hA2);
            PG_WAIT_V(8); PG_WAIT_L(0); PG_BAR; PG_MMA(1, 0, At, B0); PG_MMA(1, 1, At, B1); PG_BAR; PG_SCHED;
            }
        }
        if constexpr (ES == 1 && !I8) asm volatile("s_nop 15\n\ts_nop 15" ::: "memory");
        if constexpr (I8) {
#pragma unroll
            for (int a = 0; a < 2; ++a)
#pragma unroll
                for (int b = 0; b < 2; ++b)
#pragma unroll
                    for (int m = 0; m < 4; ++m)
#pragma unroll
                        for (int n = 0; n < 2; ++n) acc[a][b][m][n] = __builtin_convertvector(__builtin_bit_cast(i32x4, acc[a][b][m][n]), f32x4); }
        if constexpr (ALIGN_EPI) { if (wr == 0) PG_BAR; }
        E(acc, cur, wr, wc, fr, fq);
        if (!has_next) break;
        E.reinit(acc, cur, nxt, wr, wc, fr, fq);
        cur = nxt; cA = nA; cB = nB; ++ui;
        if constexpr (GATHER) {
#pragma unroll
            for (int h = 0; h < 2; ++h)
#pragma unroll
                for (int i = 0; i < 2; ++i) gc[h][i] = gn[h][i]; }
        if constexpr (DUAL) {
#pragma unroll
            for (int i = 0; i < 2; ++i) { vAc[i] = vAn[i]; vBc[i] = vBn[i]; }
            hAc = hAn; hBc = hBn; }
        if constexpr (ALIGN_EPI) { if (wr == 1) PG_BAR; }
    }
    PG_WAIT_V(0);
    if constexpr (!ALIGN_EPI) { if (wr == 0) PG_BAR; }
    PG_BAR;
#undef PG_SA
#undef PG_SB
#undef PG_STAGE
#undef PG_STAGE_A
#undef PG_GLOAD
#undef PG_CFG
#undef PG_LDA
#undef PG_LDF
#undef PG_LDB
#undef PG_MMA
#undef PG_MMH
#undef PG_WAIT_V
#undef PG_WAIT_L
#undef PG_BAR
#undef PG_SCHED
}
}
constexpr int NWAVES = 8;
constexpr int T_ = 32768, D_ = 1024, SEQ_ = 8192;
constexpr int NSLOT_MAX = (512 + 32) * 256, NTILE_MAX = 544;
constexpr float ALPHA_ = 1.4142135623730951f, LN_EPS_ = 1e-5f;
constexpr int RING_OFF = 0, RING_BYTES = 131072;
constexpr int TAB_OFF = RING_BYTES, TAB_BYTES = 24576;
constexpr int LDSCTL_OFF = TAB_OFF + TAB_BYTES, MISC_OFF = LDSCTL_OFF + 320;
constexpr int LDS_BYTES = 159744;
constexpr int CW_TMO = 0, CW_CODE = 1, CW_NTILES = 64, CW_BAR = 4096;
constexpr int N_BAR_REGIONS = 12;
constexpr size_t CTL_ZERO_BYTES = 1u << 20;
static_assert((CW_BAR + N_BAR_REGIONS * XCD_BAR_WORDS) * 4 <= (int)CTL_ZERO_BYTES, "barrier regions inside the memset region");
typedef unsigned short h16;
typedef float f32x2v __attribute__((ext_vector_type(2)));
typedef unsigned v2u __attribute__((ext_vector_type(2)));
#define EPI_OPAQUE() asm volatile("" : "+v"(fr), "+v"(fq))

struct Params {
    const float *x, *w_ret_in, *w_ret_out, *w_swa_in, *b_swa_in, *w_swa_out, *b_swa_out, *sinks, *ln_mix_g, *ln_mix_b, *w_router, *b_router, *w_exp_in, *b_exp_in, *w_exp_out, *b_exp_out, *ln_ffn_g, *ln_ffn_b;
    float* out;
    unsigned* ctl;
    int *top_e, *rankp, *inv, *slot_tok, *wg_cnt, *tile_e; float *top_g, *slot_gate;
    h16 *wri_t, *wfm_t, *wro_t, *wsi_t, *wso_t, *w1_t, *w2_t;
    h16 *xh0, *x1h, *x2h, *yh; float *x1f, *x2f, *yf;
    h16 *act, *yy;
    h16 *q, *k, *sg, *kdt, *vt, *pp, *st, *o, *og; float* ltot;
    h16 *sq, *skv, *kvt, *so;
    const float* cv_src; h16* cv_dst; size_t cv_n; float* projf;
    unsigned char *w1q, *w2q, *x1q, *actq, *x8;
    float *wri_s, *wfm_s, *wsi_s, *w1_s, *xs, *x1s, *x2s;
    int ph_lo, ph_hi, li, layer;
};

struct Frame {
    LAS unsigned char* lds; volatile LAS unsigned* MISC; gu32* ctl;
    int tid, lane, wave, vcu, G;
};
__device__ __forceinline__ float wave_sum(float v) {
    v += __builtin_bit_cast(float, __builtin_amdgcn_update_dpp(0, __builtin_bit_cast(int, v), 0x111, 0xf, 0xf, true));
    v += __builtin_bit_cast(float, __builtin_amdgcn_update_dpp(0, __builtin_bit_cast(int, v), 0x112, 0xf, 0xf, true));
    v += __builtin_bit_cast(float, __builtin_amdgcn_update_dpp(0, __builtin_bit_cast(int, v), 0x114, 0xf, 0xf, true));
    v += __builtin_bit_cast(float, __builtin_amdgcn_update_dpp(0, __builtin_bit_cast(int, v), 0x118, 0xf, 0xf, true));
    v += __builtin_bit_cast(float, __builtin_amdgcn_update_dpp(0, __builtin_bit_cast(int, v), 0x142, 0xa, 0xf, true));
    v += __builtin_bit_cast(float, __builtin_amdgcn_update_dpp(0, __builtin_bit_cast(int, v), 0x143, 0xc, 0xf, true));
    return __builtin_bit_cast(float, __builtin_amdgcn_readlane(__builtin_bit_cast(int, v), 63));
}
__device__ __forceinline__ float wave_max(float v) {
    v = fmaxf(v, __builtin_bit_cast(float, __builtin_amdgcn_update_dpp(0, __builtin_bit_cast(int, v), 0x111, 0xf, 0xf, true)));
    v = fmaxf(v, __builtin_bit_cast(float, __builtin_amdgcn_update_dpp(0, __builtin_bit_cast(int, v), 0x112, 0xf, 0xf, true)));
    v = fmaxf(v, __builtin_bit_cast(float, __builtin_amdgcn_update_dpp(0, __builtin_bit_cast(int, v), 0x114, 0xf, 0xf, true)));
    v = fmaxf(v, __builtin_bit_cast(float, __builtin_amdgcn_update_dpp(0, __builtin_bit_cast(int, v), 0x118, 0xf, 0xf, true)));
    v = fmaxf(v, __builtin_bit_cast(float, __builtin_amdgcn_update_dpp(0, __builtin_bit_cast(int, v), 0x142, 0xa, 0xf, true)));
    v = fmaxf(v, __builtin_bit_cast(float, __builtin_amdgcn_update_dpp(0, __builtin_bit_cast(int, v), 0x143, 0xc, 0xf, true)));
    return __builtin_bit_cast(float, __builtin_amdgcn_readlane(__builtin_bit_cast(int, v), 63));
}
__device__ __forceinline__ unsigned q8pack4(float a, float b, float c, float d, float inv) {
    const unsigned ua = __builtin_bit_cast(unsigned, __builtin_fmaf(a, inv, 12582912.0f)), ub = __builtin_bit_cast(unsigned, __builtin_fmaf(b, inv, 12582912.0f));
    const unsigned uc = __builtin_bit_cast(unsigned, __builtin_fmaf(c, inv, 12582912.0f)), ud = __builtin_bit_cast(unsigned, __builtin_fmaf(d, inv, 12582912.0f));
    return __builtin_amdgcn_perm(ub, ua, 0x0c0c0400u) | (__builtin_amdgcn_perm(ud, uc, 0x0c0c0400u) << 16);
}
__device__ __forceinline__ unsigned pkh(float lo, float hi) { return pg::pkh(lo, hi); }
__device__ __forceinline__ float h2f(unsigned short h) { return (float)__builtin_bit_cast(_Float16, h); }

template <class RowMap>
__device__ __forceinline__ void transpose_item(const float* W, int K, int N, h16* WT, const RowMap& rm, LAS float* scr, int item, int lane) {
    const int nblk = N / 32, kb = item / nblk, nb = item % nblk, k0 = 64 * kb, n0 = 32 * nb;
#pragma unroll 8
    for (int i = 0; i < 32; ++i) { const int kk = 2 * i + (lane >> 5); scr[kk * 33 + (lane & 31)] = W[(size_t)(k0 + kk) * N + n0 + (lane & 31)]; }
    LDS_WAIT(); asm volatile("" ::: "memory");
    const int c = lane & 7;
#pragma unroll
    for (int j = 0; j < 4; ++j) { const int n = (lane >> 3) + 8 * j; const LAS float* s = scr + (8 * c) * 33 + n;
        v4u o; o.x = pkh(s[0 * 33], s[1 * 33]); o.y = pkh(s[2 * 33], s[3 * 33]); o.z = pkh(s[4 * 33], s[5 * 33]); o.w = pkh(s[6 * 33], s[7 * 33]);
        const long dr = rm(n0 + n);
        if (dr >= 0) *(GAS v4u*)(WT + (size_t)dr * K + k0 + 8 * c) = o; }
    LDS_WAIT(); asm volatile("" ::: "memory");
}
struct RmIdent { int off; __device__ __forceinline__ long operator()(int n) const { return off + n; } };
struct RmW1 { __device__ __forceinline__ long operator()(int n) const { const int j = n & 1023; return 256 * (j >> 7) + (n >> 10) * 128 + (j & 127); } };
struct RmRange { int lo, hi, off; __device__ __forceinline__ long operator()(int n) const { return (n >= lo && n < hi) ? (long)(off + n - lo) : -1; } };

__device__ __forceinline__ void ph_convert_moe(const Params& p, Frame& F, int layer) {
    LAS float* scr = (LAS float*)(F.lds + RING_OFF + F.wave * 16384);
    const int gw = F.vcu * NWAVES + F.wave, NGW = F.G * NWAVES;
    constexpr int I1 = (1024 / 64) * (2048 / 32), I2 = (1024 / 64) * (1024 / 32);
    const float* w1 = p.w_exp_in + (size_t)layer * 32 * 1024 * 2048; const float* w2 = p.w_exp_out + (size_t)layer * 32 * 1024 * 1024;
    h16* w1t = p.w1_t + (size_t)layer * 32 * 2048 * 1024; h16* w2t = p.w2_t + (size_t)layer * 32 * 1024 * 1024;
    for (int it = gw; it < 32 * (I1 + I2); it += NGW) {
        if (it < 32 * I1) { const int e = it / I1, r = it % I1; transpose_item(w1 + (size_t)e * 1024 * 2048, 1024, 2048, w1t + (size_t)e * 2048 * 1024, RmW1{}, scr, r, F.lane); }
        else { const int q = it - 32 * I1, e = q / I2, r = q % I2; transpose_item(w2 + (size_t)e * 1024 * 1024, 1024, 1024, w2t + (size_t)e * 1024 * 1024, RmIdent{0}, scr, r, F.lane); }
    }
}
__device__ __forceinline__ void ph_cvt_rows(const float* src, h16* dst, size_t n, Frame& F, unsigned char* dst8 = nullptr) {
    const size_t stride = (size_t)F.G * 512 * 8;
    for (size_t i0 = ((size_t)blockIdx.x * 512 + F.tid) * 8; i0 < n; i0 += 4 * stride) {
        f32x4 a[4], b[4];
#pragma unroll
        for (int u = 0; u < 4; ++u) { const size_t i = i0 + u * stride; if (i < n) { a[u] = __builtin_nontemporal_load((const GAS f32x4*)(src + i)); b[u] = __builtin_nontemporal_load((const GAS f32x4*)(src + i + 4)); } }
#pragma unroll
        for (int u = 0; u < 4; ++u) { const size_t i = i0 + u * stride; if (i < n) { v4u o; o.x = pkh(a[u].x, a[u].y); o.y = pkh(a[u].z, a[u].w); o.z = pkh(b[u].x, b[u].y); o.w = pkh(b[u].z, b[u].w); *(GAS v4u*)(dst + i) = o;
            if (dst8) { int lo = 0, hi = 0; lo = __builtin_amdgcn_cvt_pk_fp8_f32(a[u].x, a[u].y, lo, false); lo = __builtin_amdgcn_cvt_pk_fp8_f32(a[u].z, a[u].w, lo, true);
                hi = __builtin_amdgcn_cvt_pk_fp8_f32(b[u].x, b[u].y, hi, false); hi = __builtin_amdgcn_cvt_pk_fp8_f32(b[u].z, b[u].w, hi, true); v2u o8; o8.x = (unsigned)lo; o8.y = (unsigned)hi; *(GAS v2u*)(dst8 + i) = o8; } } }
    }
}

__device__ __forceinline__ void ph_quant_rows(const float* src, h16* dsth, unsigned char* dst8, float* scl, Frame& F) {
    const int gw = F.vcu * NWAVES + F.wave, NGW = F.G * NWAVES, lane = F.lane;
    for (int r0 = gw * 4; r0 < T_; r0 += NGW * 4) {
        f32x4 a[4][4];
#pragma unroll
        for (int u = 0; u < 4; ++u)
#pragma unroll
            for (int i = 0; i < 2; ++i) { const float* s = src + (size_t)(r0 + u) * 1024 + i * 512 + lane * 8;
                a[u][2 * i] = __builtin_nontemporal_load((const GAS f32x4*)s); a[u][2 * i + 1] = __builtin_nontemporal_load((const GAS f32x4*)(s + 4)); }
#pragma unroll
        for (int u = 0; u < 4; ++u) { float m = 0.f;
#pragma unroll
            for (int i = 0; i < 4; ++i) m = fmaxf(m, fmaxf(fmaxf(fabsf(a[u][i].x), fabsf(a[u][i].y)), fmaxf(fabsf(a[u][i].z), fabsf(a[u][i].w))));
            m = wave_max(m); const float inv = m > 0.f ? 127.0f / m : 0.f;
            if (lane == 0) scl[r0 + u] = m * (1.0f / 127.0f);
#pragma unroll
            for (int i = 0; i < 2; ++i) { const size_t o = (size_t)(r0 + u) * 1024 + i * 512 + lane * 8; const f32x4 x0 = a[u][2 * i], x1 = a[u][2 * i + 1];
                v4u w; w.x = pkh(x0.x, x0.y); w.y = pkh(x0.z, x0.w); w.z = pkh(x1.x, x1.y); w.w = pkh(x1.z, x1.w); *(GAS v4u*)(dsth + o) = w;
                v2u q; q.x = q8pack4(x0.x, x0.y, x0.z, x0.w, inv); q.y = q8pack4(x1.x, x1.y, x1.z, x1.w, inv); *(GAS v2u*)(dst8 + o) = q; } }
    }
}

__device__ __forceinline__ void ph_rank(const Params& p, Frame& F) {
    LAS int* se = (LAS int*)(F.lds + RING_OFF);
    for (int cc = blockIdx.x; cc < T_ / 128; cc += F.G) {
        __syncthreads();
        const int j = F.tid; const int e = p.top_e[cc * 512 + j];
        se[j] = e;
        __syncthreads();
        int r = 0;
        for (int q = 0; q < j; ++q) r += (se[q] == e) ? 1 : 0;
        p.rankp[cc * 512 + j] = r;
        if (j < 32) { int c = 0; for (int q = 0; q < 512; ++q) c += (se[q] == j) ? 1 : 0; p.wg_cnt[cc * 32 + j] = c; }
    }
}
__device__ __forceinline__ void ph_assign(const Params& p, Frame& F, int layer) {
    int tid_o = F.tid; asm volatile("" : "+v"(tid_o));
    LAS int* tot = (LAS int*)(F.lds + RING_OFF);
    LAS int* bef = tot + 512;
    LAS int* tst = bef + 512;
    LAS int* bas = tst + 64;
    LAS int* ttl = bas + 32;
    for (int cc = blockIdx.x; cc < T_ / 128; cc += F.G) {
        __syncthreads();
        { const int e = tid_o & 31, part = tid_o >> 5; int s = 0, b = 0;
          for (int c2 = part * 16; c2 < part * 16 + 16; ++c2) { const int v = p.wg_cnt[c2 * 32 + e]; s += v; b += (c2 < cc) ? v : 0; }
          tot[part * 32 + e] = s; bef[part * 32 + e] = b; }
        __syncthreads();
        if (tid_o < 32) { int s = 0, b = 0; for (int q = 0; q < 16; ++q) { s += tot[q * 32 + tid_o]; b += bef[q * 32 + tid_o]; } ttl[tid_o] = s; bas[tid_o] = b; }
        __syncthreads();
        if (tid_o == 0) { int ts = 0; for (int e = 0; e < 32; ++e) { tst[e] = ts; ts += (ttl[e] + 255) >> 8; } tst[32] = ts; }
        __syncthreads();
        { const int j = tid_o, ent = cc * 512 + j, e = p.top_e[ent]; const int sl = 256 * tst[e] + bas[e] + p.rankp[ent];
          p.slot_tok[sl] = ent >> 2; p.slot_gate[sl] = p.top_g[ent]; p.inv[ent] = sl; }
        if (cc < 32) { const int e = cc; for (int sl = 256 * tst[e] + ttl[e] + tid_o; sl < 256 * tst[e + 1]; sl += 512) { p.slot_tok[sl] = 0; p.slot_gate[sl] = 0.f; } }
        if (cc == 0) { for (int rt = tid_o; rt < tst[32]; rt += 512) { int e = 0; for (int q = 1; q < 32; ++q) e += (tst[q] <= rt) ? 1 : 0; p.tile_e[rt] = e; }
            if (tid_o == 0) __hip_atomic_store(F.ctl + CW_NTILES + 64 * layer, (unsigned)tst[32], RLX_AGENT); }
    }
}

constexpr int MOE_MAXU = 20;
#ifndef MOE_F8_L0
#define MOE_F8_L0 1
#ifndef I8_LEVEL
#define I8_LEVEL 1
#endif
#ifndef IN_F8
#define IN_F8 0
#endif
#ifndef OUT_F8
#define OUT_F8 1
#endif
#endif
constexpr int F8_FROM = MOE_F8_L0 ? 0 : 32;
struct MoeSched {
    const char* abase; const char* wbase; LAS const int* lt_e; LAS const int* lt_tok; int ntiles, nct_log, G, c; size_t a_tile_bytes, w_expert_bytes, w_tile_bytes;
    __device__ __forceinline__ bool next(int i, pg::Unit& u) const {
        const int L = i * G + c; if (L >= (ntiles << nct_log) || i >= MOE_MAXU) return false;
        const int rt = L >> nct_log, ct = L & ((1 << nct_log) - 1);
        const int e = __builtin_amdgcn_readfirstlane(lt_e[i]);
        u.a = abase + (size_t)rt * a_tile_bytes; u.b = wbase + (size_t)e * w_expert_bytes + (size_t)ct * w_tile_bytes; u.pm = rt; u.pn = ct; u.e = e; u.x = i; return true;
    }
    __device__ __forceinline__ unsigned arow(const pg::Unit& u, int r) const { return (unsigned)lt_tok[u.x * 256 + r]; }
};
__device__ __forceinline__ void moe_tables(Frame& F, const int* tile_e, const int* slot_tok, int ntiles, int nct_log, bool gather) {
    LAS int* lt_e = (LAS int*)(F.lds + TAB_OFF); LAS int* lt_tok = lt_e + 32;
    __syncthreads();
    for (int i = 0; i < MOE_MAXU; ++i) { const int L = i * F.G + F.vcu; if (L >= (ntiles << nct_log)) break; const int rt = L >> nct_log;
        if (F.tid == 0) lt_e[i] = tile_e[rt];
        if (gather && F.tid < 256) lt_tok[i * 256 + F.tid] = slot_tok[rt * 256 + F.tid]; }
    __syncthreads();
}
struct EpiSwiglu : pg::EpiBase {
    static constexpr bool PERM = true;
    h16* act; const float* b1;
    __device__ __forceinline__ void operator()(const pg::Acc& acc, const pg::Unit& u, int wr, int wc, int fr, int fq) const { EPI_OPAQUE();
        const int c0 = u.pn * 128 + wc * 32 + 8 * fq;
        const float* bg = b1 + (size_t)u.e * 2048 + c0; const float* bl = bg + 1024;
        const f32x4 g0 = *(const f32x4*)bg, g1 = *(const f32x4*)(bg + 4), l0 = *(const f32x4*)bl, l1 = *(const f32x4*)(bl + 4);
#pragma unroll
        for (int ai = 0; ai < 2; ++ai)
#pragma unroll
            for (int m = 0; m < 4; ++m) {
                const size_t row = (size_t)u.pm * 256 + ai * 128 + wr * 64 + m * 16 + fr;
                float r[8];
#pragma unroll
                for (int n = 0; n < 2; ++n)
#pragma unroll
                    for (int j = 0; j < 4; ++j) {
                        const float glu = fminf(acc[ai][0][m][n][j] + (n ? g1[j] : g0[j]), 7.0f);
                        const float lin = fminf(fmaxf(acc[ai][1][m][n][j] + (n ? l1[j] : l0[j]), -7.0f), 7.0f);
                        r[n * 4 + j] = glu * __builtin_amdgcn_rcpf(1.0f + __builtin_amdgcn_exp2f(-1.702f * 1.4426950408889634f * glu)) * (lin + 1.0f);
                    }
                v4u w; w.x = pkh(r[0], r[1]); w.y = pkh(r[2], r[3]); w.z = pkh(r[4], r[5]); w.w = pkh(r[6], r[7]);
                *(v4u*)(act + row * 1024 + c0) = w;
            }
    }
};
template <int VAR> struct EpiSwigluP : pg::EpiBase {
    static constexpr bool PERM = true;
    h16* act; const float* b1;
    __device__ __forceinline__ void operator()(const pg::Acc& acc, const pg::Unit& u, int wr, int wc, int fr, int fq) const { EPI_OPAQUE();
        const int c0 = u.pn * 128 + wc * 32 + 8 * fq;
        const float* bg = b1 + (size_t)u.e * 2048 + c0; const float* bl = bg + 1024;
        const f32x4 g0 = *(const f32x4*)bg, g1 = *(const f32x4*)(bg + 4), l0 = *(const f32x4*)bl, l1 = *(const f32x4*)(bl + 4);
#pragma unroll
        for (int ai = 0; ai < 2; ++ai)
#pragma unroll
            for (int m = 0; m < 4; ++m) {
                const size_t row = (size_t)u.pm * 256 + ai * 128 + wr * 64 + m * 16 + fr;
                float r[8];
#pragma unroll
                for (int n = 0; n < 2; ++n)
#pragma unroll
                    for (int j = 0; j < 4; ++j) {
                        const float glu = fminf(acc[ai][0][m][n][j] + (n ? g1[j] : g0[j]), 7.0f);
                        const float lin = fminf(fmaxf(acc[ai][1][m][n][j] + (n ? l1[j] : l0[j]), -7.0f), 7.0f);
                        r[n * 4 + j] = (VAR == 2) ? glu + lin : glu * __builtin_amdgcn_rcpf(1.0f + __builtin_amdgcn_exp2f(-1.702f * 1.4426950408889634f * glu)) * (lin + 1.0f);
                    }
                v4u w; w.x = pkh(r[0], r[1]); w.y = pkh(r[2], r[3]); w.z = pkh(r[4], r[5]); w.w = pkh(r[6], r[7]);
                if (VAR == 1) { asm volatile("" :: "v"(w.x), "v"(w.y), "v"(w.z), "v"(w.w)); } else { *(v4u*)(act + row * 1024 + c0) = w; }
            }
    }
};
struct EpiMoeOut : pg::EpiBase {
    static constexpr bool PERM = true;
    h16* __restrict__ y; const float* __restrict__ b2; const float* __restrict__ gate;
    __device__ __forceinline__ void operator()(const pg::Acc& acc, const pg::Unit& u, int wr, int wc, int fr, int fq) const { EPI_OPAQUE();
        float gt[2][4]; f32x4 bv[2][2];
#pragma unroll
        for (int ai = 0; ai < 2; ++ai)
#pragma unroll
            for (int m = 0; m < 4; ++m) gt[ai][m] = gate[(size_t)u.pm * 256 + ai * 128 + wr * 64 + m * 16 + fr];
#pragma unroll
        for (int bj = 0; bj < 2; ++bj) { const float* bp = b2 + (size_t)u.e * 1024 + u.pn * 256 + bj * 128 + wc * 32 + 8 * fq; bv[bj][0] = *(const f32x4*)bp; bv[bj][1] = *(const f32x4*)(bp + 4); }
#pragma unroll
        for (int ai = 0; ai < 2; ++ai)
#pragma unroll
            for (int m = 0; m < 4; ++m) {
                const size_t row = (size_t)u.pm * 256 + ai * 128 + wr * 64 + m * 16 + fr;
#pragma unroll
                for (int bj = 0; bj < 2; ++bj) {
                    const int c0 = u.pn * 256 + bj * 128 + wc * 32 + 8 * fq;
                    const f32x4 v0 = (acc[ai][bj][m][0] + bv[bj][0]) * gt[ai][m], v1 = (acc[ai][bj][m][1] + bv[bj][1]) * gt[ai][m];
                    v4u w; w.x = pkh(v0[0], v0[1]); w.y = pkh(v0[2], v0[3]); w.z = pkh(v1[0], v1[1]); w.w = pkh(v1[2], v1[3]);
                    *(v4u*)(y + row * 1024 + c0) = w;
                }
            }
    }
};
template <bool Y8> __device__ __forceinline__ void ph_combine_ln(const Params& p, Frame& F, const h16* xprev, const float* gam, const float* bet, float* outf, h16* outh) {
    int lane = F.lane; asm volatile("" : "+v"(lane));
    const int gw = F.vcu * NWAVES + F.wave, NGW = F.G * NWAVES;
    constexpr int NT = Y8 ? 4 : 3;
    for (int tb = gw * NT; tb < T_; tb += NGW * NT) {
        v4u xw[NT][2], yw[Y8 ? 1 : NT][2][4]; v2u yq[Y8 ? NT : 1][2][4];
#pragma unroll
        for (int u = 0; u < NT; ++u) { const int t = tb + u < T_ ? tb + u : T_ - 1; int sl[4];
#pragma unroll
            for (int k = 0; k < 4; ++k) sl[k] = p.inv[t * 4 + k];
#pragma unroll
            for (int j = 0; j < 2; ++j) { const int c = 8 * lane + 512 * j; xw[u][j] = __builtin_nontemporal_load((const GAS v4u*)(xprev + (size_t)t * 1024 + c));
#pragma unroll
                for (int k = 0; k < 4; ++k) { if constexpr (Y8) yq[u][j][k] = __builtin_nontemporal_load((const GAS v2u*)((const unsigned char*)p.yy + (size_t)sl[k] * 1024 + c)); else yw[u][j][k] = __builtin_nontemporal_load((const GAS v4u*)(p.yy + (size_t)sl[k] * 1024 + c)); } } }
#pragma unroll
        for (int u = 0; u < NT; ++u) { const int t = tb + u; if (t >= T_) break;
            float v[16]; float s = 0.f;
#pragma unroll
            for (int j = 0; j < 2; ++j) { const v4u x4 = xw[u][j];
                float a[8] = {h2f(x4.x & 0xffff) * ALPHA_, h2f(x4.x >> 16) * ALPHA_, h2f(x4.y & 0xffff) * ALPHA_, h2f(x4.y >> 16) * ALPHA_, h2f(x4.z & 0xffff) * ALPHA_, h2f(x4.z >> 16) * ALPHA_, h2f(x4.w & 0xffff) * ALPHA_, h2f(x4.w >> 16) * ALPHA_};
#pragma unroll
                for (int k = 0; k < 4; ++k) {
                    if constexpr (Y8) { const v2u w8 = yq[u][j][k]; const f32x2v p0 = __builtin_amdgcn_cvt_pk_f32_fp8((int)w8.x, false), p1 = __builtin_amdgcn_cvt_pk_f32_fp8((int)w8.x, true), p2 = __builtin_amdgcn_cvt_pk_f32_fp8((int)w8.y, false), p3 = __builtin_amdgcn_cvt_pk_f32_fp8((int)w8.y, true);
                        a[0] += p0.x * 0.03125f; a[1] += p0.y * 0.03125f; a[2] += p1.x * 0.03125f; a[3] += p1.y * 0.03125f; a[4] += p2.x * 0.03125f; a[5] += p2.y * 0.03125f; a[6] += p3.x * 0.03125f; a[7] += p3.y * 0.03125f; }
                    else { const v4u w = yw[u][j][k];
                    a[0] += h2f(w.x & 0xffff); a[1] += h2f(w.x >> 16); a[2] += h2f(w.y & 0xffff); a[3] += h2f(w.y >> 16);
                    a[4] += h2f(w.z & 0xffff); a[5] += h2f(w.z >> 16); a[6] += h2f(w.w & 0xffff); a[7] += h2f(w.w >> 16); } }
#pragma unroll
                for (int q = 0; q < 8; ++q) { v[j * 8 + q] = a[q]; s += a[q]; } }
            const float mean = wave_sum(s) * (1.0f / 1024.0f); float qq = 0.f;
#pragma unroll
            for (int q = 0; q < 16; ++q) { v[q] -= mean; qq += v[q] * v[q]; }
            const float rstd = 1.0f / sqrtf(wave_sum(qq) * (1.0f / 1024.0f) + LN_EPS_);
#pragma unroll
            for (int j = 0; j < 2; ++j) {
                const int c = 8 * lane + 512 * j;
                const f32x4 ga = *(const GAS f32x4*)(gam + c), gb = *(const GAS f32x4*)(gam + c + 4), ba = *(const GAS f32x4*)(bet + c), bb = *(const GAS f32x4*)(bet + c + 4);
                f32x4 oa, ob;
                oa.x = v[j * 8 + 0] * rstd * ga.x + ba.x; oa.y = v[j * 8 + 1] * rstd * ga.y + ba.y; oa.z = v[j * 8 + 2] * rstd * ga.z + ba.z; oa.w = v[j * 8 + 3] * rstd * ga.w + ba.w;
                ob.x = v[j * 8 + 4] * rstd * gb.x + bb.x; ob.y = v[j * 8 + 5] * rstd * gb.y + bb.y; ob.z = v[j * 8 + 6] * rstd * gb.z + bb.z; ob.w = v[j * 8 + 7] * rstd * gb.w + bb.w;
                if (outf) { __builtin_nontemporal_store(oa, (GAS f32x4*)(outf + (size_t)t * 1024 + c)); __builtin_nontemporal_store(ob, (GAS f32x4*)(outf + (size_t)t * 1024 + c + 4)); }
                if (outh) { v4u w; w.x = pkh(oa.x, oa.y); w.y = pkh(oa.z, oa.w); w.z = pkh(ob.x, ob.y); w.w = pkh(ob.z, ob.w); *(GAS v4u*)(outh + (size_t)t * 1024 + c) = w; }
            } }
    }
}
struct CvJob { const float* src; h16* dst; int K, N, n_off, n_cnt, row_off, w1map, f8; };
__device__ __forceinline__ void cv_load(const CvJob& j, int item, int lane, float (&ld)[32]) {
    const int nblk = j.n_cnt / 32, kb = item / nblk, nb = item % nblk, k0 = 64 * kb, n0 = j.n_off + 32 * nb;
#pragma unroll
    for (int i = 0; i < 32; ++i) { const int kk = 2 * i + (lane >> 5); ld[i] = __builtin_nontemporal_load(j.src + (size_t)(k0 + kk) * j.N + n0 + (lane & 31)); }
}
__device__ __forceinline__ void cv_finish(const CvJob& j, LAS float* scr, int item, int lane, const float (&ld)[32]) {
    const int nblk = j.n_cnt / 32, kb = item / nblk, nb = item % nblk, k0 = 64 * kb, n0 = j.n_off + 32 * nb;
#pragma unroll
    for (int i = 0; i < 32; ++i) { const int kk = 2 * i + (lane >> 5); scr[kk * 33 + (lane & 31)] = ld[i]; }
    LDS_WAIT(); asm volatile("" ::: "memory");
    const int c = lane & 7;
#pragma unroll
    for (int q = 0; q < 4; ++q) { const int n = (lane >> 3) + 8 * q; const LAS float* s = scr + (8 * c) * 33 + n;
        const int nn = n0 + n - j.n_off; const int jj = nn & 1023;
        const long dr = j.w1map ? (long)(256 * (jj >> 7) + (nn >> 10) * 128 + (jj & 127)) : (long)(j.row_off + nn);
        if (j.f8) { int lo = 0, hi = 0; const float fs = (float)j.f8;
            lo = __builtin_amdgcn_cvt_pk_fp8_f32(s[0 * 33] * fs, s[1 * 33] * fs, lo, false); lo = __builtin_amdgcn_cvt_pk_fp8_f32(s[2 * 33] * fs, s[3 * 33] * fs, lo, true);
            hi = __builtin_amdgcn_cvt_pk_fp8_f32(s[4 * 33] * fs, s[5 * 33] * fs, hi, false); hi = __builtin_amdgcn_cvt_pk_fp8_f32(s[6 * 33] * fs, s[7 * 33] * fs, hi, true);
            v2u o8; o8.x = (unsigned)lo; o8.y = (unsigned)hi; *(GAS v2u*)((unsigned char*)j.dst + (size_t)dr * j.K + k0 + 8 * c) = o8; }
        else { v4u o; o.x = pkh(s[0 * 33], s[1 * 33]); o.y = pkh(s[2 * 33], s[3 * 33]); o.z = pkh(s[4 * 33], s[5 * 33]); o.w = pkh(s[6 * 33], s[7 * 33]);
            *(GAS v4u*)(j.dst + (size_t)dr * j.K + k0 + 8 * c) = o; } }
    LDS_WAIT(); asm volatile("" ::: "memory");
}
constexpr int CV_N_RI = I8_LEVEL >= 1 ? 0 : 3072, CV_N_SI = I8_LEVEL >= 3 ? 0 : 640, CV_N_W1 = I8_LEVEL >= 2 ? 0 : 64 * 1024;
__device__ __forceinline__ int cv_decode(const Params& p, int it, CvJob& j) {
    constexpr int J4 = 1024, J6 = 512, I1 = 1024, I2 = 512;
    int r = it;
    if (r < J4) { j = CvJob{p.w_ret_out, p.wro_t, 2048, 1024, 0, 1024, 0, 0, OUT_F8 ? 64 : 0}; }
    else if ((r -= J4) < J6) { j = CvJob{p.w_swa_out, p.wso_t, 1024, 1024, 0, 1024, 0, 0, OUT_F8 ? 64 : 0}; }
    else if ((r -= J6) < 64 * I2) { const int e = r / I2; r %= I2; j = CvJob{p.w_exp_out + (size_t)e * 1024 * 1024, (h16*)(p.w2q + (size_t)e * 1024 * 1024), 1024, 1024, 0, 1024, 0, 0, 32}; }
#if I8_LEVEL < 1
    else if ((r -= 64 * I2) < 1024) { j = CvJob{p.w_ret_in, p.wri_t, 1024, 6144, 0, 2048, 0, 0, IN_F8 ? 32 : 0}; }
    else if ((r -= 1024) < 1024) { j = CvJob{p.w_ret_in, p.wri_t, 1024, 6144, 4096, 2048, 2048, 0, IN_F8 ? 32 : 0}; }
    else if ((r -= 1024) < 1024) { j = CvJob{p.w_ret_in, p.wfm_t, 1024, 6144, 2048, 2048, 0, 0, IN_F8 ? 32 : 0}; }
    else if ((r -= 1024) < 640) { j = CvJob{p.w_swa_in, p.wsi_t, 1024, 1280, 0, 1280, 0, 0, 0}; }
    else { r -= 640; const int e = r / I1; r %= I1; j = CvJob{p.w_exp_in + (size_t)e * 1024 * 2048, (h16*)(p.w1q + (size_t)e * 2048 * 1024), 1024, 2048, 0, 2048, 0, 1, 32}; }
#elif I8_LEVEL < 2
    else if ((r -= 64 * I2) < 640) { j = CvJob{p.w_swa_in, p.wsi_t, 1024, 1280, 0, 1280, 0, 0, 0}; }
    else { r -= 640; const int e = r / I1; r %= I1; j = CvJob{p.w_exp_in + (size_t)e * 1024 * 2048, (h16*)(p.w1q + (size_t)e * 2048 * 1024), 1024, 2048, 0, 2048, 0, 1, 32}; }
#elif I8_LEVEL < 3
    else { r -= 64 * I2; j = CvJob{p.w_swa_in, p.wsi_t, 1024, 1280, 0, 1280, 0, 0, 0}; }
#else
    else { r = 0; j = CvJob{p.w_swa_out, p.wso_t, 1024, 1024, 0, 1024, 0, 0, OUT_F8 ? 64 : 0}; }
#endif
    return r;
}
struct StripJob { const float* src; unsigned char* dst; float* scl; int N, n0, row0, w1map; };
constexpr int NS_RI = I8_LEVEL >= 1 ? 192 : 0, NS_SI = I8_LEVEL >= 3 ? 40 : 0, NS_W1 = I8_LEVEL >= 2 ? 64 * 64 : 0, NSTRIPS = NS_RI + NS_SI + NS_W1;
__device__ __forceinline__ void strip_decode(const Params& p, int s, StripJob& j) {
    int t = s - NS_W1;
    if (NS_W1 && s < NS_W1) { const int e = s >> 6, nb = s & 63; j = StripJob{p.w_exp_in + (size_t)e * 1024 * 2048, p.w1q + (size_t)e * 2048 * 1024, p.w1_s + e * 2048, 2048, 32 * nb, 0, 1}; }
    else if (t < 64) { j = StripJob{p.w_ret_in, (unsigned char*)p.wri_t, p.wri_s, 6144, 32 * t, 32 * t, 0}; }
    else if (t < 128) { j = StripJob{p.w_ret_in, (unsigned char*)p.wri_t, p.wri_s, 6144, 4096 + 32 * (t - 64), 2048 + 32 * (t - 64), 0}; }
    else if (t < 192) { j = StripJob{p.w_ret_in, (unsigned char*)p.wfm_t, p.wfm_s, 6144, 2048 + 32 * (t - 128), 32 * (t - 128), 0}; }
    else { j = StripJob{p.w_swa_in, (unsigned char*)p.wsi_t, p.wsi_s, 1280, 32 * (t - 192), 32 * (t - 192), 0}; }
}
__device__ __forceinline__ int strip_row(const StripJob& j, int n  ) {
    const int nn = j.n0 + n, jj = nn & 1023;
    return j.w1map ? 256 * (jj >> 7) + (nn >> 10) * 128 + (jj & 127) : j.row0 + n;
}
__device__ __forceinline__ void strip_load(const StripJob& j, int wave, int lane, float (&ld)[64]) {
#pragma unroll
    for (int h = 0; h < 2; ++h) { const int k0 = 64 * (2 * wave + h);
#pragma unroll
        for (int i = 0; i < 32; ++i) { const int kk = 2 * i + (lane >> 5); ld[h * 32 + i] = __builtin_nontemporal_load(j.src + (size_t)(k0 + kk) * j.N + j.n0 + (lane & 31)); } }
}
constexpr int STRIP_SLOT = 2 * 8448;
__device__ __forceinline__ void ph_prologue(const Params& p, Frame& F) {
    if (NSTRIPS > 0) {
        LAS float* scr = (LAS float*)(F.lds + F.wave * STRIP_SLOT);
        LAS float* cmx0 = (LAS float*)(F.lds + 8 * STRIP_SLOT);
        const int wave = F.wave, lane = F.lane, c = lane & 7;
        StripJob j0, j1; float ld[64]; int s = F.vcu, par = 0;
        if (s < NSTRIPS) { strip_decode(p, s, j0); strip_load(j0, wave, lane, ld); }
        while (s < NSTRIPS) {
            const int ns = s + F.G; const bool hn = ns < NSTRIPS;
            LAS float* cmx = cmx0 + par * 256;
            float m = 0.f;
#pragma unroll
            for (int i = 0; i < 64; ++i) m = fmaxf(m, fabsf(ld[i]));
            m = fmaxf(m, __shfl_xor(m, 32));
            if (lane < 32) cmx[wave * 32 + lane] = m;
#pragma unroll
            for (int h = 0; h < 2; ++h)
#pragma unroll
                for (int i = 0; i < 32; ++i) { const int kk = 2 * i + (lane >> 5); scr[h * 2112 + kk * 33 + (lane & 31)] = ld[h * 32 + i]; }
            __syncthreads();
            if (hn) { strip_decode(p, ns, j1); strip_load(j1, wave, lane, ld); }
            float inv[4];
#pragma unroll
            for (int q = 0; q < 4; ++q) { const int n = (lane >> 3) + 8 * q; float cm = 0.f;
#pragma unroll
                for (int w = 0; w < 8; ++w) cm = fmaxf(cm, cmx[w * 32 + n]);
                inv[q] = cm > 0.f ? 127.0f / cm : 0.f; }
            if (wave == 0 && lane < 32) { float cm = 0.f;
#pragma unroll
                for (int w = 0; w < 8; ++w) cm = fmaxf(cm, cmx[w * 32 + lane]);
                j0.scl[strip_row(j0, lane)] = cm * (1.0f / 127.0f); }
#pragma unroll
            for (int h = 0; h < 2; ++h) { const int k0 = 64 * (2 * wave + h);
#pragma unroll
                for (int q = 0; q < 4; ++q) { const int n = (lane >> 3) + 8 * q; const LAS float* sp = scr + h * 2112 + (8 * c) * 33 + n;
                    v2u o8; o8.x = q8pack4(sp[0 * 33], sp[1 * 33], sp[2 * 33], sp[3 * 33], inv[q]); o8.y = q8pack4(sp[4 * 33], sp[5 * 33], sp[6 * 33], sp[7 * 33], inv[q]);
                    *(GAS v2u*)(j0.dst + (size_t)strip_row(j0, n) * 1024 + k0 + 8 * c) = o8; } }
            LDS_WAIT(); asm volatile("" ::: "memory");
            j0 = j1; par ^= 1; s = ns;
        }
        __syncthreads();
    }
    LAS float* scr = (LAS float*)(F.lds + RING_OFF + F.wave * 16384);
    const int gw = F.vcu * NWAVES + F.wave, NGW = F.G * NWAVES;
    constexpr int NITEMS = 1024 + 512 + 64 * 512 + CV_N_RI + CV_N_SI + CV_N_W1;
    int it = gw; CvJob j0, j1; int r0 = 0, r1 = 0; float ld0[32], ld1[32];
    if (it < NITEMS) { r0 = cv_decode(p, it, j0); cv_load(j0, r0, F.lane, ld0); }
    while (it < NITEMS) {
        const int nit = it + NGW; const bool hn = nit < NITEMS;
        if (hn) { r1 = cv_decode(p, nit, j1); cv_load(j1, r1, F.lane, ld1); }
        cv_finish(j0, scr, r0, F.lane, ld0);
        j0 = j1; r0 = r1;
#pragma unroll
        for (int i = 0; i < 32; ++i) ld0[i] = ld1[i];
        it = nit;
    }
    if (I8_LEVEL >= 1) ph_quant_rows(p.x, p.xh0, p.x8, p.xs, F);
    else ph_cvt_rows(p.x, p.xh0, (size_t)T_ * D_, F, IN_F8 ? p.x8 : (unsigned char*)nullptr);
}

struct DenseSched {
    const char* A; const char* B; size_t a_tile_bytes, b_tile_bytes; int nM, nN, nwg, G, c;
    __device__ __forceinline__ void init(const void* A_, int lda, const void* B_, int ldb, int M, int N, int G_, int c_, int rot = 0  , int es = 2  ) {
        A = (const char*)A_; B = (const char*)B_; a_tile_bytes = (size_t)256 * lda * es; b_tile_bytes = (size_t)256 * ldb * es; nM = M / 256; nN = N / 256; nwg = nM * nN; G = G_; c = (c_ + G_ - rot) % G_; }
    __device__ __forceinline__ bool next(int i, pg::Unit& u) const {
        const long L = (long)i * G + c; if (L >= nwg) return false;
        int wgid = (int)L; { const int q = nwg / 8, r = nwg % 8, xcd = wgid % 8, off = wgid / 8; wgid = (xcd < r ? xcd * (q + 1) : r * (q + 1) + (xcd - r) * q) + off; }
        const int nig = 8 * nN, gid = wgid / nig, fm = gid * 8, gsz = (nM - fm) < 8 ? (nM - fm) : 8;
        u.pm = fm + ((wgid % nig) % gsz); u.pn = (wgid % nig) / gsz; u.e = 0; u.x = 0;
        u.a = A + (size_t)u.pm * a_tile_bytes; u.b = B + (size_t)u.pn * b_tile_bytes; return true;
    }
    __device__ __forceinline__ unsigned arow(const pg::Unit&, int) const { return 0u; }
};
struct EpiResid : pg::EpiBase {
    static constexpr bool PERM = true;
    const h16* __restrict__ xprevh; const float* __restrict__ bias; h16* __restrict__ yh; float sc;
    __device__ __forceinline__ void operator()(const pg::Acc& acc, const pg::Unit& u, int wr, int wc, int fr, int fq) const { EPI_OPAQUE();
        f32x4 bv[2][2];
#pragma unroll
        for (int bj = 0; bj < 2; ++bj) { const int col = u.pn * 256 + bj * 128 + wc * 32 + 8 * fq;
            bv[bj][0] = bias ? *(const f32x4*)(bias + col) : (f32x4){0.f, 0.f, 0.f, 0.f}; bv[bj][1] = bias ? *(const f32x4*)(bias + col + 4) : (f32x4){0.f, 0.f, 0.f, 0.f}; }
#pragma unroll
        for (int ai = 0; ai < 2; ++ai) {
            v4u xw[4][2];
#pragma unroll
            for (int m = 0; m < 4; ++m)
#pragma unroll
                for (int bj = 0; bj < 2; ++bj) { const size_t row = (size_t)u.pm * 256 + ai * 128 + wr * 64 + m * 16 + fr; xw[m][bj] = __builtin_nontemporal_load((const v4u*)(xprevh + row * 1024 + u.pn * 256 + bj * 128 + wc * 32 + 8 * fq)); }
#pragma unroll
            for (int m = 0; m < 4; ++m)
#pragma unroll
                for (int bj = 0; bj < 2; ++bj) { const size_t row = (size_t)u.pm * 256 + ai * 128 + wr * 64 + m * 16 + fr; const int col = u.pn * 256 + bj * 128 + wc * 32 + 8 * fq; const v4u x4 = xw[m][bj];
                    const f32x4 a = (f32x4){h2f(x4.x & 0xffff), h2f(x4.x >> 16), h2f(x4.y & 0xffff), h2f(x4.y >> 16)} * ALPHA_ + acc[ai][bj][m][0] * sc + bv[bj][0];
                    const f32x4 b = (f32x4){h2f(x4.z & 0xffff), h2f(x4.z >> 16), h2f(x4.w & 0xffff), h2f(x4.w >> 16)} * ALPHA_ + acc[ai][bj][m][1] * sc + bv[bj][1];
                    v4u w; w.x = pkh(a[0], a[1]); w.y = pkh(a[2], a[3]); w.z = pkh(b[0], b[1]); w.w = pkh(b[2], b[3]);
                    *(v4u*)(yh + row * 1024 + col) = w; } }
    }
};
struct EpiF32 : pg::EpiBase {
    const float* bias; float* c; int ldc;
    __device__ __forceinline__ void operator()(const pg::Acc& acc, const pg::Unit& u, int wr, int wc, int fr, int fq) const { EPI_OPAQUE();
#pragma unroll
        for (int ai = 0; ai < 2; ++ai)
#pragma unroll
            for (int m = 0; m < 4; ++m) { const size_t row = (size_t)u.pm * 256 + ai * 128 + wr * 64 + m * 16 + fr;
#pragma unroll
                for (int bj = 0; bj < 2; ++bj)
#pragma unroll
                    for (int n = 0; n < 2; ++n) { const int col = u.pn * 256 + bj * 128 + wc * 32 + n * 16 + 4 * fq;
                        f32x4 o = acc[ai][bj][m][n]; if (bias) o += *(const f32x4*)(bias + col);
                        *(f32x4*)(c + row * ldc + col) = o; } }
    }
};

constexpr int XROW16 = 1032;
typedef _Float16 f16x8r __attribute__((ext_vector_type(8)));
__device__ __forceinline__ void ph_ln_router(const Params& p, Frame& F, const float* gam, const float* bet, const float* wr, const float* br, unsigned char* xq, const int pmode = 0  ) {
    LAS unsigned short* X = (LAS unsigned short*)(F.lds);
    LAS float* PART = (LAS float*)(X + 32 * XROW16);
    LAS int* se = (LAS int*)(PART + 8 * 32 * 32);
    LAS float* LG = (LAS float*)(se + 512);
    LAS float* TV = LG + 1024;
    LAS int* cnt = (LAS int*)(TV + 128);
    int tid_o = F.tid; asm volatile("" : "+v"(tid_o));
    const int lane = tid_o & 63, w = F.wave, l15 = lane & 15, kg = lane >> 4;
    f16x8r wh[2][4], wl[2][4];
#pragma unroll
    for (int nt = 0; nt < 2; ++nt)
#pragma unroll
        for (int s = 0; s < 4; ++s) {
#pragma unroll
            for (int j = 0; j < 8; ++j) { const float v = wr[(size_t)(128 * w + 32 * s + 8 * kg + j) * 32 + 16 * nt + l15]; const _Float16 h = (_Float16)v; wh[nt][s][j] = h; wl[nt][s][j] = (_Float16)(v - (float)h); } }
    const float bias_e = br[tid_o & 31];
    for (int cc = blockIdx.x; cc < T_ / 128; cc += F.G) {
        v4u pre[4][2];
#pragma unroll
        for (int r = 0; r < 4; ++r)
#pragma unroll
            for (int j = 0; j < 2; ++j) pre[r][j] = __builtin_nontemporal_load((const GAS v4u*)(p.yh + (size_t)(cc * 128 + 4 * w + r) * 1024 + 8 * lane + 512 * j));
        for (int blk = 0; blk < 4; ++blk) {
            const int t0 = cc * 128 + blk * 32;
            v4u cur[4][2];
#pragma unroll
            for (int r = 0; r < 4; ++r)
#pragma unroll
                for (int j = 0; j < 2; ++j) { cur[r][j] = pre[r][j]; if (blk < 3) pre[r][j] = __builtin_nontemporal_load((const GAS v4u*)(p.yh + (size_t)(t0 + 32 + 4 * w + r) * 1024 + 8 * lane + 512 * j)); }
#pragma unroll
            for (int r = 0; r < 4; ++r) {
                const int tl = 4 * w + r; const size_t t = (size_t)(t0 + tl);
                f32x4 v[4]; float s = 0.f;
#pragma unroll
                for (int j = 0; j < 2; ++j) { const v4u pw = cur[r][j]; v[2 * j] = (f32x4){h2f(pw.x & 0xffff), h2f(pw.x >> 16), h2f(pw.y & 0xffff), h2f(pw.y >> 16)}; v[2 * j + 1] = (f32x4){h2f(pw.z & 0xffff), h2f(pw.z >> 16), h2f(pw.w & 0xffff), h2f(pw.w >> 16)}; }
#pragma unroll
                for (int j = 0; j < 4; ++j) s += (v[j].x + v[j].y) + (v[j].z + v[j].w);
                const float mean = wave_sum(s) * (1.0f / 1024.0f); float q = 0.f;
#pragma unroll
                for (int j = 0; j < 4; ++j) { v[j] = v[j] - mean; q += (v[j].x * v[j].x + v[j].y * v[j].y) + (v[j].z * v[j].z + v[j].w * v[j].w); }
                const float rstd = 1.0f / sqrtf(wave_sum(q) * (1.0f / 1024.0f) + LN_EPS_);
#pragma unroll
                for (int j = 0; j < 2; ++j) { const int c = 8 * lane + 512 * j;
                    const f32x4 o0 = v[2 * j] * rstd * *(const GAS f32x4*)(gam + c) + *(const GAS f32x4*)(bet + c), o1 = v[2 * j + 1] * rstd * *(const GAS f32x4*)(gam + c + 4) + *(const GAS f32x4*)(bet + c + 4);
                    v4u hw; hw.x = pkh(o0.x, o0.y); hw.y = pkh(o0.z, o0.w); hw.z = pkh(o1.x, o1.y); hw.w = pkh(o1.z, o1.w);
                    *(GAS v4u*)(p.x1h + t * 1024 + c) = hw;
                    if (xq) { int qa = 0, qb = 0; qa = __builtin_amdgcn_cvt_pk_fp8_f32(o0.x, o0.y, qa, false); qa = __builtin_amdgcn_cvt_pk_fp8_f32(o0.z, o0.w, qa, true); qb = __builtin_amdgcn_cvt_pk_fp8_f32(o1.x, o1.y, qb, false); qb = __builtin_amdgcn_cvt_pk_fp8_f32(o1.z, o1.w, qb, true);
                        v2u q8; q8.x = (unsigned)qa; q8.y = (unsigned)qb; *(GAS v2u*)(xq + t * 1024 + c) = q8; }
                    *(LAS v4u*)(X + tl * XROW16 + c) = hw; }
            }
            if (pmode == 1) continue;
            __syncthreads();
            {
                f32x4 acc[2][2];
#pragma unroll
                for (int mt = 0; mt < 2; ++mt)
#pragma unroll
                    for (int nt = 0; nt < 2; ++nt) acc[mt][nt] = (f32x4){0.f, 0.f, 0.f, 0.f};
#pragma unroll
                for (int s = 0; s < 4; ++s)
#pragma unroll
                    for (int mt = 0; mt < 2; ++mt) { const f16x8r a = *(const LAS f16x8r*)(X + (16 * mt + l15) * XROW16 + 128 * w + 32 * s + 8 * kg);
#pragma unroll
                        for (int nt = 0; nt < 2; ++nt) { acc[mt][nt] = __builtin_amdgcn_mfma_f32_16x16x32_f16(a, wh[nt][s], acc[mt][nt], 0, 0, 0); acc[mt][nt] = __builtin_amdgcn_mfma_f32_16x16x32_f16(a, wl[nt][s], acc[mt][nt], 0, 0, 0); } }
#pragma unroll
                for (int mt = 0; mt < 2; ++mt)
#pragma unroll
                    for (int nt = 0; nt < 2; ++nt)
#pragma unroll
                        for (int r = 0; r < 4; ++r) PART[(w * 32 + 16 * mt + 4 * kg + r) * 32 + 16 * nt + l15] = acc[mt][nt][r];
            }
            __syncthreads();
#pragma unroll
            for (int ps = 0; ps < 2; ++ps) {
                const int tok = (tid_o >> 5) + 16 * ps, e = tid_o & 31; float val = bias_e;
#pragma unroll
                for (int q = 0; q < 8; ++q) val += PART[(q * 32 + tok) * 32 + e];
                LG[tok * 32 + e] = val;
                LDS_WAIT(); asm volatile("" ::: "memory");
                int rank = 0;
#pragma unroll
                for (int q4 = 0; q4 < 8; ++q4) { const f32x4 o = *(const LAS f32x4*)(LG + tok * 32 + 4 * q4);
                    rank += ((o.x > val) || (o.x == val && 4 * q4 < e)) ? 1 : 0; rank += ((o.y > val) || (o.y == val && 4 * q4 + 1 < e)) ? 1 : 0;
                    rank += ((o.z > val) || (o.z == val && 4 * q4 + 2 < e)) ? 1 : 0; rank += ((o.w > val) || (o.w == val && 4 * q4 + 3 < e)) ? 1 : 0; }
                const int t = t0 + tok;
                if (rank < 4) { TV[tok * 4 + rank] = val; p.top_e[t * 4 + rank] = e; se[(blk * 32 + tok) * 4 + rank] = e; }
                LDS_WAIT(); asm volatile("" ::: "memory");
                if (e < 4) { const f32x4 tv = *(const LAS f32x4*)(TV + tok * 4);
                    const float e1 = __expf(tv.y - tv.x), e2 = __expf(tv.z - tv.x), e3 = __expf(tv.w - tv.x); const float inv = 1.0f / (1.0f + e1 + e2 + e3);
                    p.top_g[t * 4 + e] = (e == 0 ? 1.0f : (e == 1 ? e1 : (e == 2 ? e2 : e3))) * inv; }
            }
        }
        __syncthreads();
        if (pmode == 0) {
            const int j = tid_o; const int e = se[j]; int r = 0;
            if (j < 32) cnt[j] = 0;
            __syncthreads();
#pragma unroll 8
            for (int q4 = 0; q4 < 128; ++q4) { const v4u sv = *(const LAS v4u*)(se + 4 * q4);
                r += ((int)sv.x == e && 4 * q4 < j) ? 1 : 0; r += ((int)sv.y == e && 4 * q4 + 1 < j) ? 1 : 0; r += ((int)sv.z == e && 4 * q4 + 2 < j) ? 1 : 0; r += ((int)sv.w == e && 4 * q4 + 3 < j) ? 1 : 0; }
            p.rankp[cc * 512 + j] = r;
            atomicAdd((int*)(cnt + e), 1);
            __syncthreads();
            if (j < 32) p.wg_cnt[cc * 32 + j] = cnt[j];
        }
        __syncthreads();
    }
}

__device__ __forceinline__ float lg2gamma(int h) { return h == 0 ? -0.04580368961312479f : (h == 1 ? -0.02272007650008353f : (h == 2 ? -0.011315313227834146f : -0.005646563141142063f)); }
struct EpiInTok : pg::EpiBase {
    static constexpr bool PERM = true;
    h16 *q, *k, *sg; float sc; const float *rs, *cs;
    __device__ __forceinline__ void operator()(const pg::Acc& acc, const pg::Unit& u, int wr, int wc, int fr, int fq) const { EPI_OPAQUE();
        const int pn = u.pn; h16* dst; int ld, cb; int mode;
        if (pn < 4) { dst = q; ld = 1024; cb = pn * 256; mode = 0; } else if (pn < 8) { dst = k; ld = 1024; cb = (pn - 4) * 256; mode = 1; } else { dst = sg; ld = 2048; cb = (pn - 8) * 256; mode = 2; }
        float cv[2][2][4]; float rv[2][4];
#pragma unroll
        for (int bj = 0; bj < 2; ++bj)
#pragma unroll
            for (int n = 0; n < 2; ++n) {
#if I8_LEVEL >= 1
                const f32x4 t4 = *(const f32x4*)(cs + pn * 256 + bj * 128 + wc * 32 + 8 * fq + 4 * n); cv[bj][n][0] = t4.x; cv[bj][n][1] = t4.y; cv[bj][n][2] = t4.z; cv[bj][n][3] = t4.w;
#else
                cv[bj][n][0] = sc; cv[bj][n][1] = sc; cv[bj][n][2] = sc; cv[bj][n][3] = sc;
#endif
            }
#pragma unroll
        for (int ai = 0; ai < 2; ++ai)
#pragma unroll
            for (int m = 0; m < 4; ++m) {
#if I8_LEVEL >= 1
                rv[ai][m] = rs[(size_t)u.pm * 256 + ai * 128 + wr * 64 + m * 16 + fr];
#else
                rv[ai][m] = 1.0f;
#endif
            }
#pragma unroll
        for (int ai = 0; ai < 2; ++ai)
#pragma unroll
            for (int m = 0; m < 4; ++m) { const size_t row = (size_t)u.pm * 256 + ai * 128 + wr * 64 + m * 16 + fr;
#pragma unroll
                for (int bj = 0; bj < 2; ++bj) { const int c0 = cb + bj * 128 + wc * 32 + 8 * fq; float r[8];
#pragma unroll
                    for (int n = 0; n < 2; ++n)
#pragma unroll
                        for (int j = 0; j < 4; ++j) { float v = acc[ai][bj][m][n][j] * (rv[ai][m] * cv[bj][n][j]);
                            if (mode == 1) v *= 0.0625f;
                            if (mode == 2) v = v * __builtin_amdgcn_rcpf(1.0f + __builtin_amdgcn_exp2f(-1.4426950408889634f * v));
                            r[n * 4 + j] = v; }
                    v4u w; w.x = pkh(r[0], r[1]); w.y = pkh(r[2], r[3]); w.z = pkh(r[4], r[5]); w.w = pkh(r[6], r[7]);
                    *(v4u*)(dst + row * ld + c0) = w; } }
    }
};
struct EpiInFeat : pg::EpiBase {
    static constexpr bool PERM = true;
    h16* __restrict__ vt; float sc; const float *rs, *cs;
    __device__ __forceinline__ void operator()(const pg::Acc& acc, const pg::Unit& u, int wr, int wc, int fr, int fq) const { EPI_OPAQUE();
        h16* dst = vt + ((size_t)u.pn * 2048 + (size_t)u.pm * 256) * 256;
        f32x4 cv[2][2]; float rv[2][4];
#pragma unroll
        for (int bj = 0; bj < 2; ++bj)
#pragma unroll
            for (int n = 0; n < 2; ++n) {
#if I8_LEVEL >= 1
                cv[bj][n] = *(const f32x4*)(cs + u.pn * 256 + bj * 128 + wc * 32 + 8 * fq + 4 * n);
#else
                cv[bj][n] = (f32x4){sc, sc, sc, sc};
#endif
            }
#pragma unroll
        for (int ai = 0; ai < 2; ++ai)
#pragma unroll
            for (int m = 0; m < 4; ++m) {
#if I8_LEVEL >= 1
                rv[ai][m] = rs[u.pm * 256 + ai * 128 + wr * 64 + m * 16 + fr];
#else
                rv[ai][m] = 1.0f;
#endif
            }
#pragma unroll
        for (int bj = 0; bj < 2; ++bj) { const int c0 = bj * 128 + wc * 32 + 8 * fq;
#pragma unroll
            for (int ai = 0; ai < 2; ++ai)
#pragma unroll
                for (int m = 0; m < 4; ++m) { const size_t row = (size_t)(ai * 128 + wr * 64 + m * 16 + fr);
                    const f32x4 a = acc[ai][bj][m][0] * (cv[bj][0] * rv[ai][m]), b = acc[ai][bj][m][1] * (cv[bj][1] * rv[ai][m]);
                    v4u w; w.x = pkh(a[0], a[1]); w.y = pkh(a[2], a[3]); w.z = pkh(b[0], b[1]); w.w = pkh(b[2], b[3]);
                    *(v4u*)(dst + row * 256 + c0) = w; } }
    }
};
constexpr int KT_PITCH = 520;
__device__ __forceinline__ void ph_ktranspose(const Params& p, Frame& F) {
    LAS unsigned char* img = F.lds;
    for (int item = F.vcu; item < 512; item += F.G) {
        const int chunk = item >> 2, h = item & 3;
        __syncthreads();
        v4u ld[16];
#pragma unroll
        for (int i = 0; i < 16; ++i) { const int pc = F.tid + 512 * i, row = pc >> 5, c16 = pc & 31; ld[i] = *(const GAS v4u*)(p.k + ((size_t)(chunk * 256 + row)) * 1024 + h * 256 + c16 * 8); }
#pragma unroll
        for (int i = 0; i < 16; ++i) { const int pc = F.tid + 512 * i, row = pc >> 5, c16 = pc & 31; v2u lo; lo.x = ld[i].x; lo.y = ld[i].y; v2u hi; hi.x = ld[i].z; hi.y = ld[i].w;
            *(LAS v2u*)(img + row * KT_PITCH + c16 * 16) = lo; *(LAS v2u*)(img + row * KT_PITCH + c16 * 16 + 8) = hi; }
        __syncthreads();
        const int tg = F.tid & 31; const float lg = lg2gamma(h); float sc[8];
#pragma unroll
        for (int j = 0; j < 8; ++j) sc[j] = __builtin_amdgcn_exp2f((float)(255 - (8 * tg + j)) * lg);
        h16* dst = p.kdt + ((size_t)chunk * 1024 + h * 256) * 256;
#pragma unroll 4
        for (int r = 0; r < 16; ++r) { const int dk = (F.tid >> 5) + 16 * r; float v[8];
#pragma unroll
            for (int j = 0; j < 8; ++j) v[j] = h2f(*(const LAS unsigned short*)(img + (8 * tg + j) * KT_PITCH + dk * 2)) * sc[j];
            v4u w; w.x = pkh(v[0], v[1]); w.y = pkh(v[2], v[3]); w.z = pkh(v[4], v[5]); w.w = pkh(v[6], v[7]);
            *(GAS v4u*)(dst + (size_t)dk * 256 + 8 * tg) = w; }
    }
    __syncthreads();
}
struct RaSched {
    const h16 *q, *k; int G, c;
    __device__ __forceinline__ bool next(int i, pg::Unit& u) const {
        const int L = i * G + c; if (L >= 512) return false;
        const int bh = L >> 5, cch = L & 31, b = bh >> 2, h = bh & 3; const size_t off = ((size_t)(b * 8192 + cch * 256) * 1024 + h * 256) * 2;
        u.a = (const char*)q + off; u.b = (const char*)k + off; u.pm = L; u.pn = 0; u.e = L; u.x = h; return true; }
    __device__ __forceinline__ unsigned arow(const pg::Unit&, int) const { return 0u; }
};
struct EpiPP : pg::EpiBase {
    static constexpr bool PERM = true;
    h16* pp;
    __device__ __forceinline__ void operator()(const pg::Acc& acc, const pg::Unit& u, int wr, int wc, int fr, int fq) const { EPI_OPAQUE();
        const float lg = lg2gamma(u.x); h16* dst = pp + (size_t)u.e * 65536;
#pragma unroll
        for (int bj = 0; bj < 2; ++bj) { const int c0 = bj * 128 + wc * 32 + 8 * fq; float sc[8];
#pragma unroll
            for (int j = 0; j < 8; ++j) sc[j] = __builtin_amdgcn_exp2f(-(float)(c0 + j + 1) * lg);
#pragma unroll
            for (int ai = 0; ai < 2; ++ai)
#pragma unroll
                for (int m = 0; m < 4; ++m) { const int i = ai * 128 + wr * 64 + m * 16 + fr; float r[8];
#pragma unroll
                    for (int n = 0; n < 2; ++n)
#pragma unroll
                        for (int j = 0; j < 4; ++j) r[n * 4 + j] = (c0 + n * 4 + j <= i) ? acc[ai][bj][m][n][j] * sc[n * 4 + j] : 0.f;
                    v4u w; w.x = pkh(r[0], r[1]); w.y = pkh(r[2], r[3]); w.z = pkh(r[4], r[5]); w.w = pkh(r[6], r[7]);
                    *(v4u*)(dst + (size_t)i * 256 + c0) = w; } }
    }
};
struct R1Sched {
    const h16 *vt, *kdt; int nsub, G, c;
    __device__ __forceinline__ bool next(int i, pg::Unit& u) const {
        const int item = (i / nsub) * G + c, j = i % nsub; if (item >= 256) return false;
        if (nsub == 4 && ((item >> 1) & 7) == 7) return false;
        const int pm = item & 1, seg = (item >> 1) & 7, bh = item >> 4, b = bh >> 2, h = bh & 3; const size_t chunk = (size_t)b * 32 + seg * 4 + j;
        u.a = (const char*)vt + ((chunk * 2048 + h * 512 + pm * 256) * 256) * 2; u.b = (const char*)kdt + ((chunk * 1024 + h * 256) * 256) * 2;
        u.pm = pm; u.pn = j; u.e = item; u.x = h; return true; }
    __device__ __forceinline__ unsigned arow(const pg::Unit&, int) const { return 0u; }
};
__device__ __forceinline__ void acc_scale(pg::Acc& acc, float s) {
#pragma unroll
    for (int a = 0; a < 2; ++a)
#pragma unroll
        for (int b = 0; b < 2; ++b)
#pragma unroll
            for (int m = 0; m < 4; ++m)
#pragma unroll
                for (int n = 0; n < 2; ++n) acc[a][b][m][n] = acc[a][b][m][n] * s;
}
struct EpiSegTot : pg::EpiBase {
    static constexpr bool PERM = true;
    float* L;
    __device__ __forceinline__ void operator()(pg::Acc& acc, const pg::Unit& u, int wr, int wc, int fr, int fq) const { EPI_OPAQUE();
        if (u.pn < 3) { acc_scale(acc, __builtin_amdgcn_exp2f(256.0f * lg2gamma(u.x))); return; }
        float* dst = L + ((size_t)(u.e >> 1) * 512 + u.pm * 256) * 256;
#pragma unroll
        for (int ai = 0; ai < 2; ++ai)
#pragma unroll
            for (int m = 0; m < 4; ++m) { const int r = ai * 128 + wr * 64 + m * 16 + fr;
#pragma unroll
                for (int bj = 0; bj < 2; ++bj) { const int c0 = bj * 128 + wc * 32 + 8 * fq;
                    *(f32x4*)(dst + (size_t)r * 256 + c0) = acc[ai][bj][m][0]; *(f32x4*)(dst + (size_t)r * 256 + c0 + 4) = acc[ai][bj][m][1]; } }
    }
    __device__ __forceinline__ void reinit(pg::Acc& acc, const pg::Unit& cur, const pg::Unit& nxt, int, int, int, int) const { if (nxt.e != cur.e) pg::acc_zero(acc); }
};
struct EpiSnap : pg::EpiBase {
    static constexpr bool PERM = true;
    const float* L; h16* st;
    __device__ __forceinline__ void snap(const pg::Acc& acc, const pg::Unit& u, int j, int wr, int wc, int fr, int fq) const { EPI_OPAQUE();
        const int seg = (u.e >> 1) & 7, bh = u.e >> 4; h16* dst = st + ((size_t)(bh * 32 + seg * 4 + j) * 512 + u.pm * 256) * 256;
#pragma unroll
        for (int ai = 0; ai < 2; ++ai)
#pragma unroll
            for (int m = 0; m < 4; ++m) { const int r = ai * 128 + wr * 64 + m * 16 + fr;
#pragma unroll
                for (int bj = 0; bj < 2; ++bj) { const int c0 = bj * 128 + wc * 32 + 8 * fq; const f32x4 a = acc[ai][bj][m][0], b = acc[ai][bj][m][1];
                    v4u w; w.x = pkh(a[0], a[1]); w.y = pkh(a[2], a[3]); w.z = pkh(b[0], b[1]); w.w = pkh(b[2], b[3]);
                    *(v4u*)(dst + (size_t)r * 256 + c0) = w; } }
    }
    __device__ __forceinline__ void load(pg::Acc& acc, const pg::Unit& u, int wr, int wc, int fr, int fq) const { EPI_OPAQUE();
        const float* src = L + ((size_t)(u.e >> 1) * 512 + u.pm * 256) * 256;
#pragma unroll
        for (int ai = 0; ai < 2; ++ai)
#pragma unroll
            for (int m = 0; m < 4; ++m) { const int r = ai * 128 + wr * 64 + m * 16 + fr;
#pragma unroll
                for (int bj = 0; bj < 2; ++bj) { const int c0 = bj * 128 + wc * 32 + 8 * fq;
                    acc[ai][bj][m][0] = *(const f32x4*)(src + (size_t)r * 256 + c0); acc[ai][bj][m][1] = *(const f32x4*)(src + (size_t)r * 256 + c0 + 4); } }
    }
    __device__ __forceinline__ void init(pg::Acc& acc, const pg::Unit& u, int wr, int wc, int fr, int fq) const { EPI_OPAQUE(); load(acc, u, wr, wc, fr, fq); snap(acc, u, 0, wr, wc, fr, fq); acc_scale(acc, __builtin_amdgcn_exp2f(256.0f * lg2gamma(u.x))); }
    __device__ __forceinline__ void operator()(pg::Acc& acc, const pg::Unit& u, int wr, int wc, int fr, int fq) const { EPI_OPAQUE(); snap(acc, u, u.pn + 1, wr, wc, fr, fq); }
    __device__ __forceinline__ void reinit(pg::Acc& acc, const pg::Unit& cur, const pg::Unit& nxt, int wr, int wc, int fr, int fq) const { EPI_OPAQUE();
        if (nxt.e != cur.e) { load(acc, nxt, wr, wc, fr, fq); snap(acc, nxt, 0, wr, wc, fr, fq); }
        acc_scale(acc, __builtin_amdgcn_exp2f(256.0f * lg2gamma(nxt.x))); }
};
__device__ __forceinline__ void ph_carry(float* L, Frame& F) {
    const size_t n = (size_t)16 * 131072;
    int tid_o = F.tid; asm volatile("" : "+v"(tid_o));
    for (size_t i = ((size_t)blockIdx.x * 512 + tid_o) * 4; i < n; i += (size_t)F.G * 512 * 4) {
        const int bh = (int)(i >> 17); const size_t el = i & 131071; const float g = __builtin_amdgcn_exp2f(1024.0f * lg2gamma(bh & 3));
        f32x4 s = {0.f, 0.f, 0.f, 0.f}, l[8];
#pragma unroll
        for (int sgm = 0; sgm < 8; ++sgm) l[sgm] = *(const GAS f32x4*)(L + ((size_t)(bh * 8 + sgm) << 17) + el);
#pragma unroll
        for (int sgm = 0; sgm < 8; ++sgm) { *(GAS f32x4*)(L + ((size_t)(bh * 8 + sgm) << 17) + el) = s; s = s * g + l[sgm]; }
    }
}
struct R2Sched {
    const h16 *pp, *vt, *q, *st; int G, c;
    __device__ __forceinline__ bool next(int i, pg::Unit& u) const {
        const int ch = (i >> 2) * G + c, pn = (i >> 1) & 1, x = i & 1; if (ch >= 512) return false;
        const int cch = ch & 31, bh = ch >> 5, b = bh >> 2, h = bh & 3; const size_t tok0 = (size_t)b * 8192 + cch * 256;
        if (x == 0) { u.a = (const char*)pp + (size_t)ch * 65536 * 2; u.b = (const char*)vt + (((tok0 >> 8) * 2048 + h * 512 + pn * 256) * 256) * 2; }
        else { u.a = (const char*)q + (tok0 * 1024 + h * 256) * 2; u.b = (const char*)st + ((size_t)ch * 512 + pn * 256) * 256 * 2; }
        u.pm = ch; u.pn = pn; u.e = (int)tok0; u.x = x; return true; }
    __device__ __forceinline__ unsigned arow(const pg::Unit&, int) const { return 0u; }
};
struct EpiRetOut : pg::EpiBase {
    static constexpr bool PERM = true;
    h16* __restrict__ o; const h16* __restrict__ sg; h16* __restrict__ og;
    __device__ __forceinline__ void operator()(const pg::Acc& acc, const pg::Unit& u, int wr, int wc, int fr, int fq) const { EPI_OPAQUE();
        if (u.x == 0) return;
        const int h = (u.pm >> 5) & 3; const float lg = lg2gamma(h);
#pragma unroll
        for (int ai = 0; ai < 2; ++ai)
#pragma unroll
            for (int m = 0; m < 4; ++m) { const int i = ai * 128 + wr * 64 + m * 16 + fr; const float qd = __builtin_amdgcn_exp2f((float)(i + 1) * lg);
                h16* dst = o + (size_t)(u.e + i) * 2048 + h * 512 + u.pn * 256;
#pragma unroll
                for (int bj = 0; bj < 2; ++bj) { const int c0 = bj * 128 + wc * 32 + 8 * fq; const f32x4 a = acc[ai][bj][m][0] * qd, b = acc[ai][bj][m][1] * qd;
                    v4u w; w.x = pkh(a[0], a[1]); w.y = pkh(a[2], a[3]); w.z = pkh(b[0], b[1]); w.w = pkh(b[2], b[3]);
                    *(v4u*)(dst + c0) = w; } }
        if (u.pn == 0) return;
        asm volatile("s_waitcnt vmcnt(0)" ::: "memory");
        __builtin_amdgcn_s_barrier(); asm volatile("" ::: "memory");
        const int wid = __builtin_amdgcn_readfirstlane((int)threadIdx.x >> 6), lane = (fq << 4) | fr;
#pragma unroll 1
        for (int r0 = 0; r0 < 32; r0 += 8) {
            v4u ow[8], gv[8];
#pragma unroll
            for (int q = 0; q < 8; ++q) { const size_t off = (size_t)(u.e + 32 * wid + r0 + q) * 2048 + h * 512 + 8 * lane; ow[q] = __builtin_nontemporal_load((const GAS v4u*)(o + off)); gv[q] = __builtin_nontemporal_load((const GAS v4u*)(sg + off)); }
#pragma unroll
            for (int q = 0; q < 8; ++q) { const size_t off = (size_t)(u.e + 32 * wid + r0 + q) * 2048 + h * 512 + 8 * lane; const v4u o4 = ow[q], g4 = gv[q];
                float v[8] = {h2f(o4.x & 0xffff), h2f(o4.x >> 16), h2f(o4.y & 0xffff), h2f(o4.y >> 16), h2f(o4.z & 0xffff), h2f(o4.z >> 16), h2f(o4.w & 0xffff), h2f(o4.w >> 16)};
                const float g[8] = {h2f(g4.x & 0xffff), h2f(g4.x >> 16), h2f(g4.y & 0xffff), h2f(g4.y >> 16), h2f(g4.z & 0xffff), h2f(g4.z >> 16), h2f(g4.w & 0xffff), h2f(g4.w >> 16)};
                float s = 0.f;
#pragma unroll
                for (int j = 0; j < 8; ++j) s += v[j];
                const float mean = wave_sum(s) * (1.0f / 512.0f); float qq = 0.f;
#pragma unroll
                for (int j = 0; j < 8; ++j) { v[j] -= mean; qq += v[j] * v[j]; }
                const float rstd = 1.0f / sqrtf(wave_sum(qq) * (1.0f / 512.0f) + 1e-6f);
                if (OUT_F8) { int lo = 0, hi = 0;
                    lo = __builtin_amdgcn_cvt_pk_fp8_f32(g[0] * v[0] * rstd, g[1] * v[1] * rstd, lo, false); lo = __builtin_amdgcn_cvt_pk_fp8_f32(g[2] * v[2] * rstd, g[3] * v[3] * rstd, lo, true);
                    hi = __builtin_amdgcn_cvt_pk_fp8_f32(g[4] * v[4] * rstd, g[5] * v[5] * rstd, hi, false); hi = __builtin_amdgcn_cvt_pk_fp8_f32(g[6] * v[6] * rstd, g[7] * v[7] * rstd, hi, true);
                    v2u w8; w8.x = (unsigned)lo; w8.y = (unsigned)hi; *(GAS v2u*)((unsigned char*)og + off) = w8; }
                else { v4u w; w.x = pkh(g[0] * v[0] * rstd, g[1] * v[1] * rstd); w.y = pkh(g[2] * v[2] * rstd, g[3] * v[3] * rstd); w.z = pkh(g[4] * v[4] * rstd, g[5] * v[5] * rstd); w.w = pkh(g[6] * v[6] * rstd, g[7] * v[7] * rstd);
                    *(GAS v4u*)(og + off) = w; } }
        }
    }
    __device__ __forceinline__ void reinit(pg::Acc& acc, const pg::Unit&, const pg::Unit& nxt, int, int, int, int) const { if (nxt.x == 0) pg::acc_zero(acc); }
};
__device__ __forceinline__ void ph_gn_gate(const Params& p, Frame& F) {
    const int gw = F.vcu * NWAVES + F.wave, NGW = F.G * NWAVES, lane = F.lane;
    for (int it0 = gw * 4; it0 < T_ * 4; it0 += NGW * 4) {
        v4u ow[4], gv[4];
#pragma unroll
        for (int u = 0; u < 4; ++u) { const size_t off = (size_t)(it0 + u) * 512 + 8 * lane; ow[u] = *(const GAS v4u*)(p.o + off); gv[u] = *(const GAS v4u*)(p.sg + off); }
#pragma unroll
        for (int u = 0; u < 4; ++u) { const size_t off = (size_t)(it0 + u) * 512 + 8 * lane; const v4u o4 = ow[u], g4 = gv[u];
            float v[8] = {h2f(o4.x & 0xffff), h2f(o4.x >> 16), h2f(o4.y & 0xffff), h2f(o4.y >> 16), h2f(o4.z & 0xffff), h2f(o4.z >> 16), h2f(o4.w & 0xffff), h2f(o4.w >> 16)};
            const float g[8] = {h2f(g4.x & 0xffff), h2f(g4.x >> 16), h2f(g4.y & 0xffff), h2f(g4.y >> 16), h2f(g4.z & 0xffff), h2f(g4.z >> 16), h2f(g4.w & 0xffff), h2f(g4.w >> 16)};
            float s = 0.f;
#pragma unroll
            for (int j = 0; j < 8; ++j) s += v[j];
            const float mean = wave_sum(s) * (1.0f / 512.0f); float q = 0.f;
#pragma unroll
            for (int j = 0; j < 8; ++j) { v[j] -= mean; q += v[j] * v[j]; }
            const float rstd = 1.0f / sqrtf(wave_sum(q) * (1.0f / 512.0f) + 1e-6f);
            v4u w; w.x = pkh(g[0] * v[0] * rstd, g[1] * v[1] * rstd); w.y = pkh(g[2] * v[2] * rstd, g[3] * v[3] * rstd); w.z = pkh(g[4] * v[4] * rstd, g[5] * v[5] * rstd); w.w = pkh(g[6] * v[6] * rstd, g[7] * v[7] * rstd);
            *(GAS v4u*)(p.og + off) = w; }
    }
}
constexpr float SWA_C2 = 0.125f * 1.4426950408889634f;
struct EpiSwaTok : pg::EpiBase {
    static constexpr bool PERM = true;
    h16 *sq, *skv; const float* bias;
    __device__ __forceinline__ void operator()(const pg::Acc& acc, const pg::Unit& u, int wr, int wc, int fr, int fq) const { EPI_OPAQUE();
        const bool isq = u.pn < 4; h16* dst = isq ? sq : skv; const int ld = isq ? 1024 : 256, cb = isq ? u.pn * 256 : 0; const float sc = isq ? SWA_C2 : 1.0f;
#pragma unroll
        for (int bj = 0; bj < 2; ++bj) { const int ct = bj * 128 + wc * 32 + 8 * fq; const float* bp = bias + u.pn * 256 + ct;
            const f32x4 b0 = *(const f32x4*)bp, b1 = *(const f32x4*)(bp + 4);
#pragma unroll
            for (int ai = 0; ai < 2; ++ai)
#pragma unroll
                for (int m = 0; m < 4; ++m) { const size_t row = (size_t)u.pm * 256 + ai * 128 + wr * 64 + m * 16 + fr;
                    const f32x4 a = (acc[ai][bj][m][0] + b0) * sc, b = (acc[ai][bj][m][1] + b1) * sc;
                    v4u w; w.x = pkh(a[0], a[1]); w.y = pkh(a[2], a[3]); w.z = pkh(b[0], b[1]); w.w = pkh(b[2], b[3]);
                    *(v4u*)(dst + row * ld + cb + ct) = w; } }
    }
};
struct EpiSwaFeat : pg::EpiBase {
    static constexpr bool PERM = true;
    h16* __restrict__ kvt; const float* __restrict__ bias;
    __device__ __forceinline__ void operator()(const pg::Acc& acc, const pg::Unit& u, int wr, int wc, int fr, int fq) const { EPI_OPAQUE();
        float bv[2][4];
#pragma unroll
        for (int ai = 0; ai < 2; ++ai)
#pragma unroll
            for (int m = 0; m < 4; ++m) bv[ai][m] = bias[1024 + ai * 128 + wr * 64 + m * 16 + fr];
#pragma unroll
        for (int ai = 0; ai < 2; ++ai)
#pragma unroll
            for (int m = 0; m < 4; ++m) { const int r = ai * 128 + wr * 64 + m * 16 + fr;
#pragma unroll
                for (int bj = 0; bj < 2; ++bj) { const int ct = bj * 128 + wc * 32 + 8 * fq; const f32x4 a = acc[ai][bj][m][0] + bv[ai][m], b = acc[ai][bj][m][1] + bv[ai][m];
                    v4u w; w.x = pkh(a[0], a[1]); w.y = pkh(a[2], a[3]); w.z = pkh(b[0], b[1]); w.w = pkh(b[2], b[3]);
                    *(v4u*)(kvt + (size_t)r * T_ + (size_t)u.pn * 256 + ct) = w; } }
    }
};
typedef float f32x16 __attribute__((ext_vector_type(16)));
typedef _Float16 f16x8v __attribute__((ext_vector_type(8)));
typedef _Float16 f16x4v __attribute__((ext_vector_type(4)));
constexpr int KP = 144, VP = 520;
__device__ __forceinline__ void ph_swa_attn(const Params& p, Frame& F) {
    LAS unsigned char* Ks = F.lds; LAS unsigned char* Vs = F.lds + 256 * KP;
    const int lane = F.lane, w = F.wave, l31 = lane & 31, hh = lane >> 5;
    for (int unit = F.vcu; unit < 512; unit += F.G) {
        const int g = unit & 1, n = (unit >> 1) & 63, b = unit >> 7; const size_t tok0 = (size_t)b * SEQ_ + (size_t)n * 128;
        __syncthreads();
        for (int c = F.tid; c < 256 * 8; c += 512) { const int key = c >> 3, ch = c & 7; v4u val = {0u, 0u, 0u, 0u};
            if (n > 0 || key >= 128) val = *(const GAS v4u*)(p.skv + (tok0 - 128 + key) * 256 + g * 64 + ch * 8);
            *(LAS v4u*)(Ks + key * KP + ch * 16) = val; }
        for (int c = F.tid; c < 64 * 32; c += 512) { const int d = c >> 5, ch = c & 31; v4u val = {0u, 0u, 0u, 0u};
            if (n > 0 || ch >= 16) val = *(const GAS v4u*)(p.kvt + (size_t)(128 + g * 64 + d) * T_ + tok0 - 128 + ch * 8);
            v2u lo2; lo2.x = val.x; lo2.y = val.y; v2u hi2; hi2.x = val.z; hi2.y = val.w;
            *(LAS v2u*)(Vs + d * VP + ch * 16) = lo2; *(LAS v2u*)(Vs + d * VP + ch * 16 + 8) = hi2; }
        __syncthreads();
        const int hq = g * 8 + w; const float slope = __builtin_amdgcn_exp2f(-0.5f * (float)(hq + 1)) * 1.4426950408889634f, sink = p.sinks[hq] * 1.4426950408889634f;
#pragma nounroll
        for (int qi = 0; qi < 4; ++qi) {
            f16x8v qf[4];
            const h16* qrow = p.sq + (tok0 + qi * 32 + l31) * 1024 + hq * 64 + 8 * hh;
#pragma unroll
            for (int s = 0; s < 4; ++s) qf[s] = __builtin_nontemporal_load((const GAS f16x8v*)(qrow + 16 * s));
            f32x16 sc[5];
#pragma unroll
            for (int t = 0; t < 5; ++t) {
                sc[t] = (f32x16){0.f, 0.f, 0.f, 0.f, 0.f, 0.f, 0.f, 0.f, 0.f, 0.f, 0.f, 0.f, 0.f, 0.f, 0.f, 0.f};
                const LAS unsigned char* kp = Ks + ((qi + t) * 32 + l31) * KP + 16 * hh;
#pragma unroll
                for (int s = 0; s < 4; ++s) { const f16x8v kf = *(const LAS f16x8v*)(kp + 32 * s); sc[t] = __builtin_amdgcn_mfma_f32_32x32x16_f16(kf, qf[s], sc[t], 0, 0, 0); }
            }
            float mx = sink;
            float basef = (float)(l31 + 128 - 4 * hh); asm volatile("" : "+v"(basef));
#pragma unroll
            for (int t = 0; t < 5; ++t) { const bool tile_ok = (n > 0) || (qi + t >= 4);
#pragma unroll
                for (int r = 0; r < 16; ++r) { const float distf = basef - (float)(32 * t + (r & 3) + 8 * (r >> 2));
                    bool ok = tile_ok; if (t == 0) ok = ok && (distf < 128.0f); if (t == 4) ok = ok && (distf >= 0.0f);
                    const float v = ok ? sc[t][r] - slope * distf : -INFINITY; sc[t][r] = v; mx = fmaxf(mx, v); } }
            mx = fmaxf(mx, __shfl_xor(mx, 32));
            float ls = 0.f; f16x8v pf[5][2];
#pragma unroll
            for (int t = 0; t < 5; ++t)
#pragma unroll
                for (int s2 = 0; s2 < 2; ++s2) { float e[8];
#pragma unroll
                    for (int j = 0; j < 8; ++j) { e[j] = __builtin_amdgcn_exp2f(sc[t][8 * s2 + j] - mx); ls += e[j]; }
                    v4u pw; pw.x = pkh(e[0], e[1]); pw.y = pkh(e[2], e[3]); pw.z = pkh(e[4], e[5]); pw.w = pkh(e[6], e[7]); pf[t][s2] = __builtin_bit_cast(f16x8v, pw); }
            ls += __shfl_xor(ls, 32); ls += __builtin_amdgcn_exp2f(sink - mx);
            const float rl = 1.0f / ls;
            f32x16 oa[2];
#pragma unroll
            for (int dt = 0; dt < 2; ++dt) { oa[dt] = (f32x16){0.f, 0.f, 0.f, 0.f, 0.f, 0.f, 0.f, 0.f, 0.f, 0.f, 0.f, 0.f, 0.f, 0.f, 0.f, 0.f};
                const LAS unsigned char* vp = Vs + (32 * dt + l31) * VP + (qi * 32 + 4 * hh) * 2;
#pragma unroll
                for (int t = 0; t < 5; ++t)
#pragma unroll
                    for (int s2 = 0; s2 < 2; ++s2) { const f16x4v v0 = *(const LAS f16x4v*)(vp + (t * 32 + s2 * 16) * 2), v1 = *(const LAS f16x4v*)(vp + (t * 32 + s2 * 16 + 8) * 2);
                        const f16x8v vf = __builtin_shufflevector(v0, v1, 0, 1, 2, 3, 4, 5, 6, 7);
                        oa[dt] = __builtin_amdgcn_mfma_f32_32x32x16_f16(vf, pf[t][s2], oa[dt], 0, 0, 0); } }
            h16* orow = p.so + (tok0 + qi * 32 + l31) * 1024 + hq * 64 + 4 * hh;
#pragma unroll
            for (int dt = 0; dt < 2; ++dt)
#pragma unroll
                for (int gq = 0; gq < 4; ++gq) {
                    if (OUT_F8) { const float r8 = rl * 8.0f; int o8 = 0; o8 = __builtin_amdgcn_cvt_pk_fp8_f32(oa[dt][4 * gq] * r8, oa[dt][4 * gq + 1] * r8, o8, false); o8 = __builtin_amdgcn_cvt_pk_fp8_f32(oa[dt][4 * gq + 2] * r8, oa[dt][4 * gq + 3] * r8, o8, true);
                        *(GAS unsigned*)((unsigned char*)p.so + (tok0 + qi * 32 + l31) * 1024 + hq * 64 + 4 * hh + 32 * dt + 8 * gq) = (unsigned)o8; }
                    else { v2u ow; ow.x = pkh(oa[dt][4 * gq] * rl, oa[dt][4 * gq + 1] * rl); ow.y = pkh(oa[dt][4 * gq + 2] * rl, oa[dt][4 * gq + 3] * rl);
                        *(GAS v2u*)(orow + 32 * dt + 8 * gq) = ow; } }
        }
    }
}

struct EpiNull : pg::EpiBase {
    static constexpr bool PERM = true;
    __device__ __forceinline__ void operator()(const pg::Acc& acc, const pg::Unit& u, int wr, int wc, int fr, int fq) const { asm volatile("" :: "v"(acc[0][0][0][0][0]), "v"(acc[1][1][3][1][3])); }
};

struct EpiSwigluQ : pg::EpiBase {
    static constexpr bool PERM = true;
    unsigned char* __restrict__ actq; const float* __restrict__ b1;
    typedef _Float16 h2 __attribute__((ext_vector_type(2)));
    typedef short s2 __attribute__((ext_vector_type(2)));
    __device__ __forceinline__ h2 act2(f32x2v g32, f32x2v l32) const {
        h2 g = __builtin_convertvector(g32, h2), l = __builtin_convertvector(l32, h2);
        g = __builtin_elementwise_min(g, (h2){7.0f16, 7.0f16});
        l = __builtin_elementwise_max(__builtin_elementwise_min(l, (h2){7.0f16, 7.0f16}), (h2){-7.0f16, -7.0f16});
        const h2 e = __builtin_elementwise_exp2(g * (h2){-2.4554f16, -2.4554f16});
        const h2 d = e + (h2){1.0f16, 1.0f16};
        const h2 r = {(_Float16)__builtin_amdgcn_rcph(d.x), (_Float16)__builtin_amdgcn_rcph(d.y)};
        return (g * r) * (l * (h2){4.0f16, 4.0f16} + (h2){4.0f16, 4.0f16});
    }
    __device__ __forceinline__ void operator()(const pg::Acc& acc, const pg::Unit& u, int wr, int wc, int fr, int fq) const { EPI_OPAQUE();
        const int c0 = u.pn * 128 + wc * 32 + 8 * fq;
        const float* bg = b1 + (size_t)u.e * 2048 + c0; const float* bl = bg + 1024;
        const f32x4 g0 = *(const f32x4*)bg, g1 = *(const f32x4*)(bg + 4), l0 = *(const f32x4*)bl, l1 = *(const f32x4*)(bl + 4);
#pragma unroll
        for (int ai = 0; ai < 2; ++ai)
#pragma unroll
            for (int m = 0; m < 4; ++m) {
                const size_t row = (size_t)u.pm * 256 + ai * 128 + wr * 64 + m * 16 + fr;
                const f32x4 ga = acc[ai][0][m][0] * 0.03125f + g0, gb = acc[ai][0][m][1] * 0.03125f + g1, la = acc[ai][1][m][0] * 0.03125f + l0, lb = acc[ai][1][m][1] * 0.03125f + l1;
                s2 lo = {0, 0}, hi = {0, 0};
                lo = __builtin_amdgcn_cvt_scalef32_pk_fp8_f16(lo, act2((f32x2v){ga.x, ga.y}, (f32x2v){la.x, la.y}), 1.0f, false);
                lo = __builtin_amdgcn_cvt_scalef32_pk_fp8_f16(lo, act2((f32x2v){ga.z, ga.w}, (f32x2v){la.z, la.w}), 1.0f, true);
                hi = __builtin_amdgcn_cvt_scalef32_pk_fp8_f16(hi, act2((f32x2v){gb.x, gb.y}, (f32x2v){lb.x, lb.y}), 1.0f, false);
                hi = __builtin_amdgcn_cvt_scalef32_pk_fp8_f16(hi, act2((f32x2v){gb.z, gb.w}, (f32x2v){lb.z, lb.w}), 1.0f, true);
                v2u w; w.x = __builtin_bit_cast(unsigned, lo); w.y = __builtin_bit_cast(unsigned, hi);
                *(v2u*)(actq + row * 1024 + c0) = w;
            }
    }
};
template <int VAR> struct EpiSwigluQP : pg::EpiBase {
    static constexpr bool PERM = true;
    unsigned char* __restrict__ actq; const float* __restrict__ b1;
    typedef _Float16 h2 __attribute__((ext_vector_type(2)));
    typedef short s2 __attribute__((ext_vector_type(2)));
    __device__ __forceinline__ h2 act2(f32x2v g32, f32x2v l32) const {
        h2 g = __builtin_convertvector(g32, h2), l = __builtin_convertvector(l32, h2);
        g = __builtin_elementwise_min(g, (h2){7.0f16, 7.0f16});
        l = __builtin_elementwise_max(__builtin_elementwise_min(l, (h2){7.0f16, 7.0f16}), (h2){-7.0f16, -7.0f16});
        const h2 e = __builtin_elementwise_exp2(g * (h2){-2.4554f16, -2.4554f16});
        const h2 d = e + (h2){1.0f16, 1.0f16};
        const h2 r = {(_Float16)__builtin_amdgcn_rcph(d.x), (_Float16)__builtin_amdgcn_rcph(d.y)};
        return (g * r) * (l * (h2){4.0f16, 4.0f16} + (h2){4.0f16, 4.0f16});
    }
    __device__ __forceinline__ void operator()(const pg::Acc& acc, const pg::Unit& u, int wr, int wc, int fr, int fq) const { EPI_OPAQUE();
        const int c0 = u.pn * 128 + wc * 32 + 8 * fq;
        const float* bg = b1 + (size_t)u.e * 2048 + c0; const float* bl = bg + 1024;
        const f32x4 g0 = *(const f32x4*)bg, g1 = *(const f32x4*)(bg + 4), l0 = *(const f32x4*)bl, l1 = *(const f32x4*)(bl + 4);
        if (VAR == 1) { asm volatile("" :: "v"(g0), "v"(g1), "v"(l0), "v"(l1));
#pragma unroll
            for (int ai = 0; ai < 2; ++ai)
#pragma unroll
                for (int bj = 0; bj < 2; ++bj)
#pragma unroll
                    for (int m = 0; m < 4; ++m) asm volatile("" :: "v"(acc[ai][bj][m][0]), "v"(acc[ai][bj][m][1]));
            return; }
#pragma unroll
        for (int ai = 0; ai < 2; ++ai)
#pragma unroll
            for (int m = 0; m < 4; ++m) {
                const size_t row = (size_t)u.pm * 256 + ai * 128 + wr * 64 + m * 16 + fr;
                const f32x4 ga = acc[ai][0][m][0] * 0.03125f + g0, gb = acc[ai][0][m][1] * 0.03125f + g1, la = acc[ai][1][m][0] * 0.03125f + l0, lb = acc[ai][1][m][1] * 0.03125f + l1;
                s2 lo = {0, 0}, hi = {0, 0};
                lo = __builtin_amdgcn_cvt_scalef32_pk_fp8_f16(lo, act2((f32x2v){ga.x, ga.y}, (f32x2v){la.x, la.y}), 1.0f, false);
                lo = __builtin_amdgcn_cvt_scalef32_pk_fp8_f16(lo, act2((f32x2v){ga.z, ga.w}, (f32x2v){la.z, la.w}), 1.0f, true);
                hi = __builtin_amdgcn_cvt_scalef32_pk_fp8_f16(hi, act2((f32x2v){gb.x, gb.y}, (f32x2v){lb.x, lb.y}), 1.0f, false);
                hi = __builtin_amdgcn_cvt_scalef32_pk_fp8_f16(hi, act2((f32x2v){gb.z, gb.w}, (f32x2v){lb.z, lb.w}), 1.0f, true);
                v2u w; w.x = __builtin_bit_cast(unsigned, lo); w.y = __builtin_bit_cast(unsigned, hi);
                if (VAR == 2) asm volatile("" :: "v"(w.x), "v"(w.y)); else *(v2u*)(actq + row * 1024 + c0) = w;
            }
    }
};
template <bool Y8> struct EpiMoeOutQ : pg::EpiBase {
    static constexpr bool PERM = true;
    unsigned char* __restrict__ y8; const float* __restrict__ b2; const float* __restrict__ gate;
    __device__ __forceinline__ void operator()(const pg::Acc& acc, const pg::Unit& u, int wr, int wc, int fr, int fq) const { EPI_OPAQUE();
        float gt[2][4]; f32x4 bv[2][2];
#pragma unroll
        for (int ai = 0; ai < 2; ++ai)
#pragma unroll
            for (int m = 0; m < 4; ++m) gt[ai][m] = gate[(size_t)u.pm * 256 + ai * 128 + wr * 64 + m * 16 + fr];
#pragma unroll
        for (int bj = 0; bj < 2; ++bj) { const float* bp = b2 + (size_t)u.e * 1024 + u.pn * 256 + bj * 128 + wc * 32 + 8 * fq; bv[bj][0] = *(const f32x4*)bp; bv[bj][1] = *(const f32x4*)(bp + 4); }
#pragma unroll
        for (int ai = 0; ai < 2; ++ai)
#pragma unroll
            for (int m = 0; m < 4; ++m) {
                const size_t row = (size_t)u.pm * 256 + ai * 128 + wr * 64 + m * 16 + fr;
#pragma unroll
                for (int bj = 0; bj < 2; ++bj) {
                    const int c0 = u.pn * 256 + bj * 128 + wc * 32 + 8 * fq;
                    const float gs = gt[ai][m] * (Y8 ? 32.0f : 1.0f);
                    const f32x4 v0 = (acc[ai][bj][m][0] * 0.0078125f + bv[bj][0]) * gs, v1 = (acc[ai][bj][m][1] * 0.0078125f + bv[bj][1]) * gs;
                    if (Y8) { int lo = 0, hi = 0;
                        lo = __builtin_amdgcn_cvt_pk_fp8_f32(v0[0], v0[1], lo, false); lo = __builtin_amdgcn_cvt_pk_fp8_f32(v0[2], v0[3], lo, true);
                        hi = __builtin_amdgcn_cvt_pk_fp8_f32(v1[0], v1[1], hi, false); hi = __builtin_amdgcn_cvt_pk_fp8_f32(v1[2], v1[3], hi, true);
                        v2u w; w.x = (unsigned)lo; w.y = (unsigned)hi; *(v2u*)(y8 + row * 1024 + c0) = w; }
                    else { v4u w; w.x = pkh(v0[0], v0[1]); w.y = pkh(v0[2], v0[3]); w.z = pkh(v1[0], v1[1]); w.w = pkh(v1[2], v1[3]); *(v4u*)((h16*)y8 + row * 1024 + c0) = w; }
                }
            }
    }
};

struct MoeSchedHot : MoeSched {
    __device__ __forceinline__ bool next(int i, pg::Unit& u) const { const bool ok = MoeSched::next(i, u); if (ok) { u.a = abase; u.b = wbase; } return ok; }
    __device__ __forceinline__ unsigned arow(const pg::Unit&, int r) const { return (unsigned)r; }
};

struct EpiKeep : pg::EpiBase {
    static constexpr bool PERM = true;
    __device__ __forceinline__ void operator()(const pg::Acc& acc, const pg::Unit& u, int wr, int wc, int fr, int fq) const {
#pragma unroll
        for (int ai = 0; ai < 2; ++ai)
#pragma unroll
            for (int bj = 0; bj < 2; ++bj)
#pragma unroll
                for (int m = 0; m < 4; ++m) asm volatile("" :: "v"(acc[ai][bj][m][0]), "v"(acc[ai][bj][m][1]));
    }
};
#ifndef PROBE_DBL
#define PROBE_DBL 0
#endif
#ifndef SKEW_STEP
#define SKEW_STEP 0
#endif
#define SKEW(F) (((F).vcu & 3) * SKEW_STEP)
#define DBL(bit, body) do { body; if ((PROBE_DBL >> (bit)) & 1) { GRID_BAR(); body; } } while (0)
template <int layer>
__device__ __forceinline__ void layer_tail(const Params& p, Frame& F, const XcdBarrier& bar) {
#define GRID_BAR() xcd_barrier(bar)
    {
#if OUT_F8
        if (layer == 0) { DenseSched S; S.init(p.og, 2048, p.wro_t, 2048, T_, 1024, F.G, (int)blockIdx.x, 0, 1); EpiResid E; E.yh = p.yh; E.xprevh = p.xh0; E.bias = nullptr; E.sc = 1.0f / 64.0f;
            pg::gemm_phase<EpiResid, DenseSched, 0, true, 1>(F.lds + RING_OFF, 2048, 2048, 16, S, E); }
        else { DenseSched S; S.init(p.so, 1024, p.wso_t, 1024, T_, 1024, F.G, (int)blockIdx.x, 0, 1); EpiResid E; E.yh = p.yh; E.xprevh = p.x2h; E.bias = p.b_swa_out; E.sc = 1.0f / 512.0f;
            pg::gemm_phase<EpiResid, DenseSched, 0, true, 1>(F.lds + RING_OFF, 1024, 1024, 8, S, E); }
#else
        if (layer == 0) { DenseSched S; S.init(p.og, 2048, p.wro_t, 2048, T_, 1024, F.G, (int)blockIdx.x); EpiResid E; E.yh = p.yh; E.xprevh = p.xh0; E.bias = nullptr; E.sc = 1.0f;
            pg::gemm_phase<EpiResid, DenseSched, 0, true>(F.lds + RING_OFF, 2048, 2048, 32, S, E); }
        else { DenseSched S; S.init(p.so, 1024, p.wso_t, 1024, T_, 1024, F.G, (int)blockIdx.x); EpiResid E; E.yh = p.yh; E.xprevh = p.x2h; E.bias = p.b_swa_out; E.sc = 1.0f;
            pg::gemm_phase<EpiResid, DenseSched, 0, true>(F.lds + RING_OFF, 1024, 1024, 16, S, E); }
#endif
    }
    GRID_BAR();
    DBL(1, ph_ln_router(p, F, p.ln_mix_g + layer * 1024, p.ln_mix_b + layer * 1024, p.w_router + layer * 1024 * 32, p.b_router + layer * 32, (layer == 1 || MOE_F8_L0) ? p.x1q : (unsigned char*)nullptr));
#if (PROBE_DBL >> 19) & 1
    GRID_BAR();
    ph_ln_router(p, F, p.ln_mix_g + layer * 1024, p.ln_mix_b + layer * 1024, p.w_router + layer * 1024 * 32, p.b_router + layer * 32, layer == 1 ? p.x1q : (unsigned char*)nullptr, (PROBE_DBL >> 19) & 1);
#endif
    GRID_BAR();
    DBL(5, ph_assign(p, F, layer));
    GRID_BAR();
    {
        const int ntiles = (int)__hip_atomic_load(F.ctl + CW_NTILES + 64 * layer, RLX_AGENT);
        moe_tables(F, p.tile_e, p.slot_tok, ntiles, 3, true);
        if (layer == 0 && !MOE_F8_L0) {
            MoeSched S{(const char*)p.x1h, (const char*)p.w1_t, (LAS const int*)(F.lds + TAB_OFF), (LAS const int*)(F.lds + TAB_OFF) + 32, ntiles, 3, F.G, F.vcu, 0, (size_t)2048 * 1024 * 2, (size_t)256 * 1024 * 2};
            EpiSwiglu E; E.act = p.act; E.b1 = p.b_exp_in;
            pg::gemm_phase<EpiSwiglu, MoeSched, 1, true>(F.lds + RING_OFF, 1024, 1024, 16, S, E);
        } else {
            MoeSched S{(const char*)p.x1q, (const char*)(p.w1q + (size_t)layer * 32 * 2048 * 1024), (LAS const int*)(F.lds + TAB_OFF), (LAS const int*)(F.lds + TAB_OFF) + 32, ntiles, 3, F.G, F.vcu, 0, (size_t)2048 * 1024, (size_t)256 * 1024};
            EpiSwigluQ E; E.actq = p.actq; E.b1 = p.b_exp_in + (size_t)layer * 32 * 2048;
            pg::gemm_phase<EpiSwigluQ, MoeSched, 1, true, 1>(F.lds + RING_OFF, 1024, 1024, 8, S, E, 0, 0, SKEW(F));
        }
    }
    GRID_BAR();
#if (PROBE_DBL >> 21) & 3
    GRID_BAR();
    if (layer == 0) {
        const int ntiles = (int)__hip_atomic_load(F.ctl + CW_NTILES + 64 * layer, RLX_AGENT);
        moe_tables(F, p.tile_e, p.slot_tok, ntiles, 3, true);
        EpiSwigluP<1> E; E.act = p.yy; E.b1 = p.b_exp_in;
        if ((PROBE_DBL >> 22) & 1) { MoeSchedHot S{{((PROBE_DBL >> 23) & 1) ? (const char*)p.ctl : (const char*)p.x1h, ((PROBE_DBL >> 23) & 1) ? (const char*)p.ctl + 524288 : (const char*)p.w1_t, (LAS const int*)(F.lds + TAB_OFF), (LAS const int*)(F.lds + TAB_OFF) + 32, ntiles, 3, F.G, F.vcu, 0, (size_t)2048 * 1024 * 2, (size_t)256 * 1024 * 2}};
            pg::gemm_phase<EpiSwigluP<1>, MoeSchedHot, 1, true, 2, ((PROBE_DBL >> 24) & 1) != 0>(F.lds + RING_OFF, 1024, 1024, 16, S, E); }
        else { MoeSched S{(const char*)p.x1h, (const char*)p.w1_t, (LAS const int*)(F.lds + TAB_OFF), (LAS const int*)(F.lds + TAB_OFF) + 32, ntiles, 3, F.G, F.vcu, 0, (size_t)2048 * 1024 * 2, (size_t)256 * 1024 * 2};
            pg::gemm_phase<EpiSwigluP<1>, MoeSched, 1, true, 2, ((PROBE_DBL >> 24) & 1) != 0>(F.lds + RING_OFF, 1024, 1024, 16, S, E); }
    }
#endif
#if (PROBE_DBL >> 29) & 3
    GRID_BAR();
    {
        const int ntiles = (int)__hip_atomic_load(F.ctl + CW_NTILES + 64 * layer, RLX_AGENT);
        moe_tables(F, p.tile_e, p.slot_tok, ntiles, 3, true);
        MoeSched S{(const char*)p.x1q, (const char*)(p.w1q + (size_t)layer * 32 * 2048 * 1024), (LAS const int*)(F.lds + TAB_OFF), (LAS const int*)(F.lds + TAB_OFF) + 32, ntiles, 3, F.G, F.vcu, 0, (size_t)2048 * 1024, (size_t)256 * 1024};
        EpiSwigluQP<((PROBE_DBL >> 29) & 3)> E; E.actq = p.actq; E.b1 = p.b_exp_in + (size_t)layer * 32 * 2048;
        pg::gemm_phase<EpiSwigluQP<((PROBE_DBL >> 29) & 3)>, MoeSched, 1, true, 1>(F.lds + RING_OFF, 1024, 1024, 8, S, E);
    }
#endif
#if (PROBE_DBL >> 25) & 1
    GRID_BAR();
    {
        const int ntiles = (int)__hip_atomic_load(F.ctl + CW_NTILES + 64 * layer, RLX_AGENT);
        moe_tables(F, p.tile_e, p.slot_tok, ntiles, 3, true);
        MoeSched S{(const char*)p.x1q, (const char*)(p.w1q + (size_t)layer * 32 * 2048 * 1024), (LAS const int*)(F.lds + TAB_OFF), (LAS const int*)(F.lds + TAB_OFF) + 32, ntiles, 3, F.G, F.vcu, 0, (size_t)2048 * 1024, (size_t)256 * 1024};
        EpiKeep E;
        pg::gemm_phase<EpiKeep, MoeSched, 1, true, 1>(F.lds + RING_OFF, 1024, 1024, 8, S, E);
    }
#endif
#if (PROBE_DBL >> 26) & 1
    GRID_BAR();
    {
        const int ntiles = (int)__hip_atomic_load(F.ctl + CW_NTILES + 64 * layer, RLX_AGENT);
        moe_tables(F, p.tile_e, p.slot_tok, ntiles, 3, true);
        MoeSched S{(const char*)p.x1q, (const char*)(p.w1q + (size_t)layer * 32 * 2048 * 1024), (LAS const int*)(F.lds + TAB_OFF), (LAS const int*)(F.lds + TAB_OFF) + 32, ntiles, 3, F.G, F.vcu, 0, (size_t)2048 * 1024, (size_t)256 * 1024};
        EpiSwigluQ E; E.actq = p.actq; E.b1 = p.b_exp_in + (size_t)layer * 32 * 2048;
        pg::gemm_phase<EpiSwigluQ, MoeSched, 1, true, 1>(F.lds + RING_OFF, 1024, 1024, 8, S, E);
    }
#endif
    {
        const int ntiles = (int)__hip_atomic_load(F.ctl + CW_NTILES + 64 * layer, RLX_AGENT);
        moe_tables(F, p.tile_e, p.slot_tok, ntiles, 2, false);
        if (layer == 0 && !MOE_F8_L0) {
            MoeSched S{(const char*)p.act, (const char*)p.w2_t, (LAS const int*)(F.lds + TAB_OFF), (LAS const int*)(F.lds + TAB_OFF) + 32, ntiles, 2, F.G, F.vcu, (size_t)256 * 1024 * 2, (size_t)1024 * 1024 * 2, (size_t)256 * 1024 * 2};
            EpiMoeOut E; E.y = p.yy; E.b2 = p.b_exp_out; E.gate = p.slot_gate;
            pg::gemm_phase<EpiMoeOut, MoeSched, 0, true>(F.lds + RING_OFF, 1024, 1024, 16, S, E);
        } else {
            MoeSched S{(const char*)p.actq, (const char*)(p.w2q + (size_t)layer * 32 * 1024 * 1024), (LAS const int*)(F.lds + TAB_OFF), (LAS const int*)(F.lds + TAB_OFF) + 32, ntiles, 2, F.G, F.vcu, (size_t)256 * 1024, (size_t)1024 * 1024, (size_t)256 * 1024};
            EpiMoeOutQ<layer == 1> E; E.y8 = (unsigned char*)p.yy; E.b2 = p.b_exp_out + (size_t)layer * 32 * 1024; E.gate = p.slot_gate;
            pg::gemm_phase<EpiMoeOutQ<layer == 1>, MoeSched, 0, true, 1>(F.lds + RING_OFF, 1024, 1024, 8, S, E, 0, 0, SKEW(F));
        }
    }
#if (PROBE_DBL >> 27) & 1
    GRID_BAR();
    {
        const int ntiles = (int)__hip_atomic_load(F.ctl + CW_NTILES + 64 * layer, RLX_AGENT);
        moe_tables(F, p.tile_e, p.slot_tok, ntiles, 2, false);
        MoeSched S{(const char*)p.actq, (const char*)(p.w2q + (size_t)layer * 32 * 1024 * 1024), (LAS const int*)(F.lds + TAB_OFF), (LAS const int*)(F.lds + TAB_OFF) + 32, ntiles, 2, F.G, F.vcu, (size_t)256 * 1024, (size_t)1024 * 1024, (size_t)256 * 1024};
        EpiMoeOutQ<layer == 1> E; E.y8 = (unsigned char*)p.yy; E.b2 = p.b_exp_out + (size_t)layer * 32 * 1024; E.gate = p.slot_gate;
        pg::gemm_phase<EpiMoeOutQ<layer == 1>, MoeSched, 0, true, 1>(F.lds + RING_OFF, 1024, 1024, 8, S, E);
    }
#endif
#if (PROBE_DBL >> 28) & 1
    GRID_BAR();
    {
        const int ntiles = (int)__hip_atomic_load(F.ctl + CW_NTILES + 64 * layer, RLX_AGENT);
        moe_tables(F, p.tile_e, p.slot_tok, ntiles, 2, false);
        MoeSched S{(const char*)p.actq, (const char*)(p.w2q + (size_t)layer * 32 * 1024 * 1024), (LAS const int*)(F.lds + TAB_OFF), (LAS const int*)(F.lds + TAB_OFF) + 32, ntiles, 2, F.G, F.vcu, (size_t)256 * 1024, (size_t)1024 * 1024, (size_t)256 * 1024};
        EpiKeep E;
        pg::gemm_phase<EpiKeep, MoeSched, 0, true, 1>(F.lds + RING_OFF, 1024, 1024, 8, S, E);
    }
#endif
    GRID_BAR();
    DBL(2, ph_combine_ln<layer == 1>(p, F, p.x1h, p.ln_ffn_g + layer * 1024, p.ln_ffn_b + layer * 1024, layer == 0 ? (float*)nullptr : p.out, layer == 0 ? p.x2h : (h16*)nullptr));
#undef GRID_BAR
}
#if I8_LEVEL >= 1
#define P1_TOK() do { DenseSched S; S.init(p.x8, 1024, p.wri_t, 1024, T_, 4096, F.G, (int)blockIdx.x, 0, 1); EpiInTok E; E.q = p.q; E.k = p.k; E.sg = p.sg; E.sc = 1.0f; E.rs = p.xs; E.cs = p.wri_s; \
          pg::gemm_phase<EpiInTok, DenseSched, 0, true, 1, true>(F.lds + RING_OFF, 1024, 1024, 8, S, E); } while (0)
#define P1_FEAT() do { DenseSched S; S.init(p.wfm_t, 1024, p.x8, 1024, 2048, T_, F.G, (int)blockIdx.x, 0, 1); EpiInFeat E; E.vt = p.vt; E.sc = 1.0f; E.rs = p.wfm_s; E.cs = p.xs; \
          pg::gemm_phase<EpiInFeat, DenseSched, 0, true, 1, true>(F.lds + RING_OFF, 1024, 1024, 8, S, E); } while (0)
#elif IN_F8
#define P1_TOK() do { DenseSched S; S.init(p.x8, 1024, p.wri_t, 1024, T_, 4096, F.G, (int)blockIdx.x, 0, 1); EpiInTok E; E.q = p.q; E.k = p.k; E.sg = p.sg; E.sc = 1.0f / 32.0f; E.rs = nullptr; E.cs = nullptr; \
          pg::gemm_phase<EpiInTok, DenseSched, 0, true, 1>(F.lds + RING_OFF, 1024, 1024, 8, S, E); } while (0)
#define P1_FEAT() do { DenseSched S; S.init(p.wfm_t, 1024, p.x8, 1024, 2048, T_, F.G, (int)blockIdx.x, 0, 1); EpiInFeat E; E.vt = p.vt; E.sc = 1.0f / 32.0f; E.rs = nullptr; E.cs = nullptr; \
          pg::gemm_phase<EpiInFeat, DenseSched, 0, true, 1>(F.lds + RING_OFF, 1024, 1024, 8, S, E); } while (0)
#else
#define P1_TOK() do { DenseSched S; S.init(p.xh0, 1024, p.wri_t, 1024, T_, 4096, F.G, (int)blockIdx.x); EpiInTok E; E.q = p.q; E.k = p.k; E.sg = p.sg; E.sc = 1.0f; E.rs = nullptr; E.cs = nullptr; \
          pg::gemm_phase<EpiInTok, DenseSched, 0, true>(F.lds + RING_OFF, 1024, 1024, 16, S, E); } while (0)
#define P1_FEAT() do { DenseSched S; S.init(p.wfm_t, 1024, p.xh0, 1024, 2048, T_, F.G, (int)blockIdx.x); EpiInFeat E; E.vt = p.vt; E.sc = 1.0f; E.rs = nullptr; E.cs = nullptr; \
          pg::gemm_phase<EpiInFeat, DenseSched, 0, true>(F.lds + RING_OFF, 1024, 1024, 16, S, E); } while (0)
#endif
__global__ void __launch_bounds__(NWAVES * 64, 2) mk_fwd(Params p) {
    extern __shared__ __attribute__((aligned(16))) unsigned char lds[];
    Frame F;
    F.lds = (LAS unsigned char*)lds;
    F.MISC = (volatile LAS unsigned*)(F.lds + MISC_OFF);
    F.tid = threadIdx.x; F.lane = F.tid & 63; F.wave = __builtin_amdgcn_readfirstlane(F.tid >> 6);
    F.G = gridDim.x; { const int bx = blockIdx.x; F.vcu = (F.G % 8 == 0) ? (bx % 8) * (F.G / 8) + bx / 8 : bx; }
    F.ctl = (gu32*)p.ctl;
    for (int u = F.tid; u < (LDS_BYTES - LDSCTL_OFF) / 4; u += NWAVES * 64) ((LAS unsigned*)(F.lds + LDSCTL_OFF))[u] = 0u;
    __syncthreads();
    XcdBarrier bar = xcd_barrier_post((unsigned*)p.ctl + CW_BAR, F.MISC + 8);
#define GRID_BAR() xcd_barrier(bar)
    DBL(0, ph_prologue(p, F));
    GRID_BAR();
    {
        P1_TOK(); P1_FEAT();
    }
#if (PROBE_DBL >> 17) & 1
    GRID_BAR();
    P1_TOK();
#endif
#if (PROBE_DBL >> 6) & 1
    GRID_BAR();
    {
        P1_TOK(); P1_FEAT();
    }
#endif
    GRID_BAR();
    {
        ph_ktranspose(p, F);
        { RaSched S{p.q, p.k, F.G, F.vcu}; EpiPP E; E.pp = p.pp; pg::gemm_phase<EpiPP, RaSched, 0, true>(F.lds + RING_OFF, 1024, 1024, 4, S, E); }
    }
    GRID_BAR();
    {
        { R1Sched S{p.vt, p.kdt, 4, F.G, F.vcu}; EpiSegTot E; E.L = p.ltot; pg::gemm_phase<EpiSegTot, R1Sched, 0, false>(F.lds + RING_OFF, 256, 256, 4, S, E); }
    }
    GRID_BAR();
    ph_carry(p.ltot, F);
    GRID_BAR();
    { R1Sched S{p.vt, p.kdt, 3, F.G, F.vcu}; EpiSnap E; E.L = p.ltot; E.st = p.st; pg::gemm_phase<EpiSnap, R1Sched, 0, false>(F.lds + RING_OFF, 256, 256, 4, S, E); }
#if (PROBE_DBL >> 8) & 1
    GRID_BAR();
    { R1Sched S{p.vt, p.kdt, 3, F.G, F.vcu}; EpiSnap E; E.L = p.ltot; E.st = p.st; pg::gemm_phase<EpiSnap, R1Sched, 0, false>(F.lds + RING_OFF, 256, 256, 4, S, E); }
#endif
    GRID_BAR();
    { R2Sched S{p.pp, p.vt, p.q, p.st, F.G, F.vcu}; EpiRetOut E; E.o = p.o; E.sg = p.sg; E.og = p.og; pg::gemm_phase<EpiRetOut, R2Sched, 2, true>(F.lds + RING_OFF, 256, 256, 4, S, E, 1024, 256); }
    GRID_BAR();
    layer_tail<0>(p, F, bar);
    GRID_BAR();
    {
        { DenseSched S; S.init(p.x2h, 1024, p.wsi_t, 1024, T_, 1280, F.G, (int)blockIdx.x); EpiSwaTok E; E.sq = p.sq; E.skv = p.skv; E.bias = p.b_swa_in;
          pg::gemm_phase<EpiSwaTok, DenseSched, 0, true>(F.lds + RING_OFF, 1024, 1024, 16, S, E); }
        { DenseSched S; S.init(p.wsi_t + (size_t)1024 * 1024, 1024, p.x2h, 1024, 256, T_, F.G, (int)blockIdx.x, 128); EpiSwaFeat E; E.kvt = p.kvt; E.bias = p.b_swa_in;
          pg::gemm_phase<EpiSwaFeat, DenseSched, 0, true>(F.lds + RING_OFF, 1024, 1024, 16, S, E); }
    }
#if (PROBE_DBL >> 13) & 1
    GRID_BAR();
    {
        { DenseSched S; S.init(p.x2h, 1024, p.wsi_t, 1024, T_, 1280, F.G, (int)blockIdx.x); EpiSwaTok E; E.sq = p.sq; E.skv = p.skv; E.bias = p.b_swa_in;
          pg::gemm_phase<EpiSwaTok, DenseSched, 0, true>(F.lds + RING_OFF, 1024, 1024, 16, S, E); }
        { DenseSched S; S.init(p.wsi_t + (size_t)1024 * 1024, 1024, p.x2h, 1024, 256, T_, F.G, (int)blockIdx.x, 128); EpiSwaFeat E; E.kvt = p.kvt; E.bias = p.b_swa_in;
          pg::gemm_phase<EpiSwaFeat, DenseSched, 0, true>(F.lds + RING_OFF, 1024, 1024, 16, S, E); }
    }
#endif
    GRID_BAR();
    DBL(3, ph_swa_attn(p, F));
    GRID_BAR();
    layer_tail<1>(p, F, bar);
    if (__hip_atomic_load((gu32*)((unsigned*)p.ctl + CW_BAR + XB_TMO), RLX_AGENT) != 0u) {
        __syncthreads();
        for (size_t i = (size_t)blockIdx.x * 512 + F.tid; i < (size_t)T_ * D_; i += (size_t)F.G * 512) p.out[i] = __builtin_nanf("");
    }
#undef GRID_BAR
}

namespace host {
constexpr size_t MiB = 1u << 20;
static int g_grid = 0;
static bool setup() {
    if (g_grid) return g_grid > 0;
    int dev = 0, cus = 0;
    if (hipGetDevice(&dev) != hipSuccess || hipDeviceGetAttribute(&cus, hipDeviceAttributeMultiprocessorCount, dev) != hipSuccess) { g_grid = -1; return false; }
    if (hipFuncSetAttribute((const void*)mk_fwd, hipFuncAttributeMaxDynamicSharedMemorySize, LDS_BYTES) != hipSuccess) { g_grid = -1; return false; }
    (void)hipGetLastError();
    g_grid = cus;
    return true;
}
static void launch(hipStream_t st, Params p) {
    p.ph_lo = 0; p.ph_hi = 0; p.li = 0; p.layer = 0;
    hipLaunchKernelGGL(mk_fwd, dim3(g_grid), dim3(NWAVES * 64), LDS_BYTES, st, p);
}
static void fill_params(Params& p, void* const* d_in, float* out, unsigned char* ws) {
    const float** in = (const float**)&p.x;
    for (int i = 0; i < 18; ++i) in[i] = (const float*)d_in[i];
    p.out = out; p.ctl = (unsigned*)ws;
    const size_t M = MiB;
    p.top_e = (int*)(ws + 1 * M); p.top_g = (float*)(ws + 2 * M); p.rankp = (int*)(ws + 3 * M); p.inv = (int*)(ws + 4 * M); p.slot_tok = (int*)(ws + 5 * M); p.slot_gate = (float*)(ws + 6 * M);
    p.wg_cnt = (int*)(ws + 7 * M); p.tile_e = (int*)(ws + 8 * M);
    p.wri_t = (h16*)(ws + 17 * M); p.wfm_t = (h16*)(ws + 25 * M); p.wro_t = (h16*)(ws + 31 * M); p.wsi_t = (h16*)(ws + 35 * M); p.wso_t = (h16*)(ws + 38 * M);
    p.w1_t = (h16*)(ws + 40 * M); p.w2_t = (h16*)(ws + 296 * M);
    p.xh0 = (h16*)(ws + 424 * M); p.x1h = (h16*)(ws + 488 * M); p.x2h = (h16*)(ws + 552 * M);
    p.x1f = (float*)(ws + 616 * M); p.x2f = (float*)(ws + 744 * M); p.yf = (float*)(ws + 872 * M);
    p.act = (h16*)(ws + 1000 * M); p.yy = (h16*)(ws + 1272 * M);
}
}
extern "C" void kernel_launch(void* const* d_in, const int* in_sizes, int n_in, void* d_out, int out_size, void* d_ws, size_t ws_size, hipStream_t stream) {
    const size_t M = host::MiB;
    if (n_in != 18 || out_size != T_ * D_ || ws_size < 2040 * M) { fprintf(stderr, "kernel_launch: unexpected shapes / workspace (%d inputs, out %d, ws %zu)\n", n_in, out_size, ws_size); return; }
    if (!host::setup()) return;
    unsigned char* ws = (unsigned char*)d_ws; hipStream_t st = stream;
    (void)hipMemsetAsync(ws, 0, CTL_ZERO_BYTES, st);
    Params p{}; host::fill_params(p, d_in, (float*)d_out, ws);
    p.q = (h16*)(ws + 1000 * M); p.k = (h16*)(ws + 1064 * M); p.sg = (h16*)(ws + 1128 * M); p.kdt = (h16*)(ws + 1256 * M); p.vt = (h16*)(ws + 1320 * M);
    p.pp = (h16*)(ws + 1448 * M); p.st = (h16*)(ws + 1512 * M); p.ltot = (float*)(ws + 1640 * M); p.o = (h16*)(ws + 1704 * M); p.og = (h16*)(ws + 1832 * M);
    p.sq = (h16*)(ws + 1000 * M); p.skv = (h16*)(ws + 1064 * M); p.kvt = (h16*)(ws + 1080 * M); p.so = (h16*)(ws + 1096 * M);
    p.w1q = (unsigned char*)p.w1_t + (size_t)32 * 2048 * 1024 * 2; p.w2q = (unsigned char*)p.w2_t + (size_t)32 * 1024 * 1024 * 2;
    p.x1q = ws + 1560 * M; p.x8 = ws + 1896 * M;
    p.w1_s = (float*)(ws + 9 * M); p.wri_s = (float*)(ws + 10 * M); p.wfm_s = p.wri_s + 4096; p.wsi_s = p.wfm_s + 2048; p.xs = (float*)(ws + 11 * M); p.x1s = (float*)(ws + 12 * M); p.x2s = (float*)(ws + 13 * M); p.actq = (unsigned char*)p.act;
    p.yh = (h16*)p.yf;
    host::launch(st, p);
}
```
